# Optimizing an MI355X kernel written in HIP

```python
import numpy as np
import jax
import jax.numpy as jnp
from jax import lax

D_MODEL = 1024
BATCH = 16
SEQ = 4096
DEPTH = 2

PLE_DIM = 256
DN_ALPHA = (2 * DEPTH) ** 0.25
DN_BETA = (8 * DEPTH) ** -0.25
LN_EPS = 1e-5
ROPE_THETA = 10000.0

RW_WIDTH = D_MODEL // 2
RW_HEAD = 64
RW_HEADS = RW_WIDTH // RW_HEAD
RW_DECAY_LORA = 64
RW_AAA_LORA = 64
RW_GATE_LORA = 128
RW_GN_EPS = RW_HEAD * 1e-5
RW_SPLITS = (RW_WIDTH, RW_WIDTH, RW_WIDTH, RW_DECAY_LORA, RW_AAA_LORA, RW_GATE_LORA)
RW_COLS = sum(RW_SPLITS)

NSA_WIDTH = D_MODEL - RW_WIDTH
NSA_HEAD = 64
NSA_HEADS = NSA_WIDTH // NSA_HEAD
NSA_KV_HEADS = 2
NSA_GROUP = NSA_HEADS // NSA_KV_HEADS
NSA_KV = NSA_KV_HEADS * NSA_HEAD
CMP_LEN = 32
CMP_STRIDE = 16
CMP_HIDDEN = 128
SEL_LEN = 64
SEL_TOP = 16
WINDOW = 512
NSA_QBLOCK = 32
NSA_SPLITS = (NSA_WIDTH,) + (NSA_KV,) * 6 + (3 * NSA_HEADS,)
NSA_COLS = sum(NSA_SPLITS)
EV_COLS = RW_COLS + NSA_COLS

HG_HEAD = 128
HG_HEADS = D_MODEL // HG_HEAD
HG_CHUNK = 16
HG_SPLITS = (D_MODEL, D_MODEL, D_MODEL, D_MODEL)
HG_COLS = sum(HG_SPLITS)

MOE_GROUPS = 4
MOE_PER_GROUP = 8
MOE_EXPERTS = MOE_GROUPS * MOE_PER_GROUP
MOE_TOPK = 2
MOE_HIDDEN = 512
MOE_BLOCK = 256

N_EVEN = (DEPTH + 1) // 2
N_ODD = DEPTH // 2

kernel_name = 'hybrid_rwkv7_nsa_hgrn2_hmoe'


def _split(z, sizes):
    cuts = [int(c) for c in np.cumsum(sizes)[:-1]]
    return jnp.split(z, cuts, axis=-1)


def _layer_norm(x, g, b):
    xf = x.astype(jnp.float32)
    xc = xf - jnp.mean(xf, -1, keepdims=True)
    var = jnp.mean(xc * xc, -1, keepdims=True)
    return (xc * lax.rsqrt(var + LN_EPS) * g + b).astype(x.dtype)


def _rope_tables(positions, dim):
    inv = (1.0 / (ROPE_THETA ** (np.arange(0, dim, 2, dtype=np.float32) / dim))).astype(np.float32)
    ang = positions.astype(jnp.float32)[..., None] * inv
    return jnp.cos(ang)[:, :, None, :], jnp.sin(ang)[:, :, None, :]


def _apply_rope(x, cos, sin):
    half = x.shape[-1] // 2
    xf = x.astype(jnp.float32)
    x1, x2 = xf[..., :half], xf[..., half:]
    return jnp.concatenate([x1 * cos - x2 * sin, x2 * cos + x1 * sin], -1).astype(x.dtype)


def _masked_softmax(s, mask):
    s = jnp.where(mask, s.astype(jnp.float32), -jnp.inf)
    m = jnp.max(s, axis=-1, keepdims=True)
    m = jnp.where(jnp.isfinite(m), m, 0.0)
    e = jnp.exp(s - m)
    return e / jnp.maximum(jnp.sum(e, -1, keepdims=True), 1e-30)


def _rwkv7_scan(r, w, k, v, kk, a):
    B, T, H, N = r.shape

    def step(S, inp):
        r_t, w_t, k_t, v_t, kk_t, a_t = inp
        sa = jnp.einsum('bhvk,bhk->bhv', S, kk_t)
        S = S * w_t[:, :, None, :] - sa[..., None] * (kk_t * a_t)[:, :, None, :] + v_t[..., None] * k_t[:, :, None, :]
        return S, jnp.einsum('bhvk,bhk->bhv', S, r_t)

    xs = tuple(jnp.moveaxis(t, 1, 0) for t in (r, w, k, v, kk, a))
    _, o = lax.scan(step, jnp.zeros((B, H, N, N), jnp.float32), xs)
    return jnp.moveaxis(o, 0, 1)


def _rwkv7_group(z, mu, w0, w2, a0, a2, g2, k_k, k_a, r_k, gn_g, gn_b):
    B, T, _ = z.shape
    z = z.astype(jnp.float32)
    z_prev = jnp.pad(z, ((0, 0), (1, 0), (0, 0)))[:, :-1]
    z = z + mu * (z_prev - z)
    r, k, v, wd, ad, gd = _split(z, RW_SPLITS)
    w = -jax.nn.softplus(-(w0 + jnp.tanh(wd) @ w2)) - 0.5
    decay = jnp.exp(-jnp.exp(w))
    a = jax.nn.sigmoid(a0 + ad @ a2)
    g = jax.nn.sigmoid(gd) @ g2
    heads = lambda t: t.reshape(B, T, RW_HEADS, RW_HEAD)
    kk = heads(k * k_k)
    kk = kk / jnp.maximum(jnp.sqrt(jnp.sum(kk * kk, -1, keepdims=True)), 1e-12)
    k = k * (1.0 + (a - 1.0) * k_a)
    r, k, v, a = heads(r), heads(k), heads(v), heads(a)
    o = _rwkv7_scan(r, heads(decay), k, v, kk, a)
    oc = o - jnp.mean(o, -1, keepdims=True)
    o = oc * lax.rsqrt(jnp.mean(oc * oc, -1, keepdims=True) + RW_GN_EPS)
    o = o.reshape(B, T, RW_WIDTH) * gn_g + gn_b
    bonus = (jnp.sum(r * k * r_k, -1, keepdims=True) * v).reshape(B, T, RW_WIDTH)
    return (o + bonus) * g


def _cmp_sel_overlap(n_cmp, n_sel):
    cs = np.arange(n_cmp)[:, None] * CMP_STRIDE
    ss = np.arange(n_sel)[None, :] * SEL_LEN
    ov = np.clip(np.minimum(cs + CMP_LEN, ss + SEL_LEN) - np.maximum(cs, ss), 0, None)
    return (ov / CMP_LEN).astype(np.float32)


def _nsa_group(z, cos, sin, cmp_pos, cmp_w1, cmp_w2):
    B, T, _ = z.shape
    q, kc, vc, ksl, vsl, kwn, vwn, gl = _split(z, NSA_SPLITS)
    kv_heads = lambda t: t.reshape(B, T, NSA_KV_HEADS, NSA_HEAD)
    q = q.reshape(B, T, NSA_HEADS, NSA_HEAD)
    q_rot = _apply_rope(q, cos, sin).reshape(B, T, NSA_KV_HEADS, NSA_GROUP, NSA_HEAD)
    q_raw = q.reshape(B, T, NSA_KV_HEADS, NSA_GROUP, NSA_HEAD)
    ksl = _apply_rope(kv_heads(ksl), cos, sin)
    kwn = _apply_rope(kv_heads(kwn), cos, sin)
    vsl, vwn = kv_heads(vsl), kv_heads(vwn)
    gates = jax.nn.sigmoid(gl.astype(jnp.float32)).reshape(B, T, NSA_KV_HEADS, NSA_GROUP, 3)

    n_cmp = (T - CMP_LEN) // CMP_STRIDE + 1
    blk_idx = np.arange(n_cmp)[:, None] * CMP_STRIDE + np.arange(CMP_LEN)[None, :]
    blocks = jnp.stack([kv_heads(kc), kv_heads(vc)])[:, :, blk_idx]
    blocks = blocks + cmp_pos[:, None, None, :, None, :]
    blocks = jnp.moveaxis(blocks, 3, 4).reshape(2, B, n_cmp, NSA_KV_HEADS, CMP_LEN * NSA_HEAD)
    hid = jax.nn.gelu(jnp.einsum('zbnhi,zio->zbnho', blocks, cmp_w1))
    kv_cmp = jnp.einsum('zbnho,zod->zbnhd', hid, cmp_w2)
    k_cmp, v_cmp = kv_cmp[0], kv_cmp[1]
    cmp_last = np.arange(n_cmp) * CMP_STRIDE + CMP_LEN - 1

    n_sel = T // SEL_LEN
    n_top = min(SEL_TOP, n_sel)
    overlap = jnp.asarray(_cmp_sel_overlap(n_cmp, n_sel))
    sel_blocks = lambda t: jnp.moveaxis(t.reshape(B, n_sel, SEL_LEN, NSA_KV_HEADS, NSA_HEAD), 3, 1)
    k_blk, v_blk = sel_blocks(ksl), sel_blocks(vsl)
    gather = jax.vmap(jax.vmap(lambda blk, ix: blk[ix]))
    blk_ids = np.arange(n_sel)
    in_blk = np.arange(SEL_LEN)

    pad = ((0, 0), (WINDOW, 0), (0, 0), (0, 0))
    k_win, v_win = jnp.pad(kwn, pad), jnp.pad(vwn, pad)
    win_off = np.arange(WINDOW + NSA_QBLOCK) - WINDOW
    scale = NSA_HEAD ** -0.5

    def q_block(c):
        t0 = c * NSA_QBLOCK
        tq = t0 + jnp.arange(NSA_QBLOCK)
        sl = lambda t: lax.dynamic_slice_in_dim(t, t0, NSA_QBLOCK, axis=1)
        qc, qr, gc = sl(q_raw) * scale, sl(q_rot) * scale, sl(gates)
        s_c = jnp.einsum('bqhgd,bnhd->bhgqn', qc, k_cmp)
        p_c = _masked_softmax(s_c, cmp_last[None, :] <= tq[:, None])
        o_c = jnp.einsum('bhgqn,bnhd->bqhgd', p_c, v_cmp)
        imp = jnp.einsum('bhgqn,ns->bhqs', p_c, overlap)
        cur = (tq // SEL_LEN)[:, None]
        forced = (blk_ids[None, :] == 0) | (blk_ids[None, :] == cur) | (blk_ids[None, :] == cur - 1)
        imp = jnp.where(forced, jnp.inf, jnp.where(blk_ids[None, :] > cur, -jnp.inf, imp))
        _, sel = lax.top_k(imp, n_top)
        k_g = gather(k_blk, sel).reshape(B, NSA_KV_HEADS, NSA_QBLOCK, n_top * SEL_LEN, NSA_HEAD)
        v_g = gather(v_blk, sel).reshape(B, NSA_KV_HEADS, NSA_QBLOCK, n_top * SEL_LEN, NSA_HEAD)
        pos_s = (sel[..., None] * SEL_LEN + in_blk).reshape(B, NSA_KV_HEADS, NSA_QBLOCK, n_top * SEL_LEN)
        s_s = jnp.einsum('bqhgd,bhqkd->bhgqk', qr, k_g)
        p_s = _masked_softmax(s_s, (pos_s <= tq[:, None])[:, :, None])
        o_s = jnp.einsum('bhgqk,bhqkd->bqhgd', p_s, v_g)
        kw = lax.dynamic_slice_in_dim(k_win, t0, WINDOW + NSA_QBLOCK, axis=1)
        vw = lax.dynamic_slice_in_dim(v_win, t0, WINDOW + NSA_QBLOCK, axis=1)
        pos_w = t0 + win_off
        valid_w = (pos_w[None, :] >= 0) & (pos_w[None, :] <= tq[:, None]) & (pos_w[None, :] > tq[:, None] - WINDOW)
        s_w = jnp.einsum('bqhgd,bkhd->bhgqk', qr, kw)
        p_w = _masked_softmax(s_w, valid_w)
        o_w = jnp.einsum('bhgqk,bkhd->bqhgd', p_w, vw)
        return gc[..., 0:1] * o_c + gc[..., 1:2] * o_s + gc[..., 2:3] * o_w

    out = lax.map(q_block, jnp.arange(T // NSA_QBLOCK))
    return jnp.moveaxis(out, 0, 1).reshape(B, T, NSA_WIDTH)


def _hgrn2_chunkwise(q, k, v, logf):
    B, T, H, dk = q.shape
    dv = v.shape[-1]
    C = HG_CHUNK
    N = T // C
    to_chunks = lambda t: t.reshape(B, N, C, H, t.shape[-1]).transpose(0, 3, 1, 2, 4)
    q, k, v, logf = to_chunks(q), to_chunks(k), to_chunks(v), to_chunks(logf)
    b = jnp.cumsum(logf, axis=3)
    b_last = b[:, :, :, -1:, :]
    q_e = q * jnp.exp(b)
    k_e = k * jnp.exp(-b)
    k_tail = k * jnp.exp(b_last - b)
    causal = np.tril(np.ones((C, C), dtype=bool))
    A = jnp.where(causal, jnp.einsum('bhncd,bhnsd->bhncs', q_e, k_e), 0.0)
    o_intra = jnp.einsum('bhncs,bhnsv->bhncv', A, v)

    def step(S, inp):
        qn, kn, vn, dn = inp
        o = jnp.einsum('bhcd,bhdv->bhcv', qn, S)
        S = S * dn[..., None] + jnp.einsum('bhcd,bhcv->bhdv', kn, vn)
        return S, o

    xs = (jnp.moveaxis(q_e, 2, 0), jnp.moveaxis(k_tail, 2, 0), jnp.moveaxis(v, 2, 0),
          jnp.moveaxis(jnp.exp(b_last[:, :, :, 0]), 2, 0))
    _, o_inter = lax.scan(step, jnp.zeros((B, H, dk, dv), jnp.float32), xs)
    o = o_intra + jnp.moveaxis(o_inter, 0, 2)
    return o.transpose(0, 2, 3, 1, 4).reshape(B, T, H, dv)


def _hgrn2_mixer(x, w_in, w_out, lb, norm_g):
    B, T, _ = x.shape
    q, f, i, g = _split(x @ w_in, HG_SPLITS)
    heads = lambda t: t.astype(jnp.float32).reshape(B, T, HG_HEADS, HG_HEAD)
    lb = lb.reshape(HG_HEADS, HG_HEAD)
    f = heads(f)
    forget = lb + (1.0 - lb) * jax.nn.sigmoid(f)
    k = (1.0 - lb) * jax.nn.sigmoid(-f)
    o = _hgrn2_chunkwise(jax.nn.silu(heads(q)), k, heads(i), jnp.log(forget))
    o = o * lax.rsqrt(jnp.mean(o * o, -1, keepdims=True) + LN_EPS) * norm_g
    o = o.reshape(B, T, D_MODEL) * jax.nn.silu(g.astype(jnp.float32))
    return o.astype(x.dtype) @ w_out


def _hier_moe(h, w_rg, b_rg, w_re, b_re, w1, w3, w2):
    B, T, D = h.shape
    M = B * T
    A = M * MOE_TOPK
    xt = h.reshape(M, D)
    lg = (xt @ w_rg + b_rg).astype(jnp.float32)
    g_sel = jnp.argmax(lg, -1)
    p_grp = jnp.max(jax.nn.softmax(lg, -1), -1)
    le = (xt @ w_re + b_re).astype(jnp.float32).reshape(M, MOE_GROUPS, MOE_PER_GROUP)
    le = le[jnp.arange(M), g_sel]
    top_v, top_i = lax.top_k(le, MOE_TOPK)
    gate = (p_grp[:, None] * jax.nn.softmax(top_v, -1)).reshape(A)
    eid = (g_sel[:, None] * MOE_PER_GROUP + top_i).reshape(A)
    tok = jnp.repeat(jnp.arange(M), MOE_TOPK)
    order = jnp.argsort(eid)
    e_s, tok_s, gate_s = eid[order], tok[order], gate[order]
    counts = jnp.bincount(eid, length=MOE_EXPERTS)
    padded = (counts + MOE_BLOCK - 1) // MOE_BLOCK * MOE_BLOCK
    ends = jnp.cumsum(padded)
    start = ends - padded
    off = jnp.cumsum(counts) - counts
    dest = start[e_s] + jnp.arange(A) - off[e_s]
    P = A + MOE_EXPERTS * MOE_BLOCK
    n_blk = P // MOE_BLOCK
    xbuf = jnp.zeros((P, D), h.dtype).at[dest].set(xt[tok_s])
    blk_e = jnp.minimum(jnp.searchsorted(ends, jnp.arange(n_blk) * MOE_BLOCK, side='right'), MOE_EXPERTS - 1)

    def expert_block(args):
        xb, e = args
        return (jax.nn.silu(xb @ w1[e]) * (xb @ w3[e])) @ w2[e]

    ybuf = lax.map(expert_block, (xbuf.reshape(n_blk, MOE_BLOCK, D), blk_e)).reshape(P, D)
    y = jnp.zeros((M, D), jnp.float32).at[tok_s].add(gate_s[:, None] * ybuf[dest].astype(jnp.float32))
    return y.reshape(B, T, D).astype(h.dtype)


def setup_inputs(seed: int = 0) -> dict:
    key = jax.random.key(seed)
    keys = iter(jax.random.split(key, 40))

    def nrm(shape, scale):
        return jax.random.normal(next(keys), shape, jnp.float32) * scale

    def col_scale(spec):
        return jnp.asarray(np.concatenate([np.full(n, s, np.float32) for n, s in spec]))

    b = DN_BETA
    ev_spec = [(RW_WIDTH, 1.0), (RW_WIDTH, 1.0), (RW_WIDTH, b), (RW_DECAY_LORA, 1.0), (RW_AAA_LORA, 1.0),
               (RW_GATE_LORA, 1.0), (NSA_WIDTH, 1.0), (NSA_KV, 1.0), (NSA_KV, b), (NSA_KV, 1.0), (NSA_KV, b),
               (NSA_KV, 1.0), (NSA_KV, b), (3 * NSA_HEADS, 1.0)]
    hg_spec = [(D_MODEL, 1.0), (D_MODEL, 1.0), (D_MODEL, b), (D_MODEL, 1.0)]
    d_inv = D_MODEL ** -0.5
    return {
        'x': nrm((BATCH, SEQ, D_MODEL), 1.0),
        'p': nrm((DEPTH, BATCH, SEQ, PLE_DIM), 1.0),
        'positions': jnp.broadcast_to(jnp.arange(SEQ, dtype=jnp.int32)[None, :], (BATCH, SEQ)),
        'ev_w_in': nrm((N_EVEN, D_MODEL, EV_COLS), d_inv) * col_scale(ev_spec),
        'ev_w_out': nrm((N_EVEN, D_MODEL, D_MODEL), d_inv * b),
        'rw_mu': jax.random.uniform(next(keys), (N_EVEN, RW_COLS), jnp.float32, 0.0, 1.0),
        'rw_w0': jax.random.uniform(next(keys), (N_EVEN, RW_WIDTH), jnp.float32, -3.0, 1.0),
        'rw_w2': nrm((N_EVEN, RW_DECAY_LORA, RW_WIDTH), 0.5 * RW_DECAY_LORA ** -0.5),
        'rw_a0': nrm((N_EVEN, RW_WIDTH), 0.5),
        'rw_a2': nrm((N_EVEN, RW_AAA_LORA, RW_WIDTH), 0.5 * RW_AAA_LORA ** -0.5),
        'rw_g2': nrm((N_EVEN, RW_GATE_LORA, RW_WIDTH), RW_GATE_LORA ** -0.5),
        'rw_k_k': 0.85 + nrm((N_EVEN, RW_WIDTH), 0.05),
        'rw_k_a': 1.0 + nrm((N_EVEN, RW_WIDTH), 0.05),
        'rw_r_k': nrm((N_EVEN, RW_HEADS, RW_HEAD), 0.1),
        'rw_gn_g': 1.0 + nrm((N_EVEN, RW_WIDTH), 0.02),
        'rw_gn_b': nrm((N_EVEN, RW_WIDTH), 0.02),
        'nsa_cmp_pos': nrm((N_EVEN, 2, CMP_LEN, NSA_HEAD), 0.02),
        'nsa_cmp_w1': nrm((N_EVEN, 2, CMP_LEN * NSA_HEAD, CMP_HIDDEN), (CMP_LEN * NSA_HEAD) ** -0.5),
        'nsa_cmp_w2': nrm((N_EVEN, 2, CMP_HIDDEN, NSA_HEAD), CMP_HIDDEN ** -0.5),
        'od_w_in': nrm((N_ODD, D_MODEL, HG_COLS), d_inv) * col_scale(hg_spec),
        'od_w_out': nrm((N_ODD, D_MODEL, D_MODEL), d_inv * b),
        'hg_lb': nrm((DEPTH, D_MODEL), 0.1),
        'hg_norm_g': 1.0 + nrm((N_ODD, HG_HEAD), 0.02),
        'moe_w_rg': nrm((DEPTH, D_MODEL, MOE_GROUPS), d_inv),
        'moe_b_rg': nrm((DEPTH, MOE_GROUPS), 0.01),
        'moe_w_re': nrm((DEPTH, D_MODEL, MOE_EXPERTS), d_inv),
        'moe_b_re': nrm((DEPTH, MOE_EXPERTS), 0.01),
        'moe_w1': nrm((DEPTH, MOE_EXPERTS, D_MODEL, MOE_HIDDEN), d_inv),
        'moe_w3': nrm((DEPTH, MOE_EXPERTS, D_MODEL, MOE_HIDDEN), d_inv),
        'moe_w2': nrm((DEPTH, MOE_EXPERTS, MOE_HIDDEN, D_MODEL), MOE_HIDDEN ** -0.5 * b),
        'ln_g': 1.0 + nrm((DEPTH, 2, D_MODEL), 0.02),
        'ln_b': nrm((DEPTH, 2, D_MODEL), 0.02),
        'ple_w': nrm((DEPTH, PLE_DIM, D_MODEL), PLE_DIM ** -0.5),
        'ple_gate_w': nrm((DEPTH, D_MODEL, D_MODEL), d_inv),
    }


def reference(x, p, positions, ev_w_in, ev_w_out, rw_mu, rw_w0, rw_w2, rw_a0, rw_a2, rw_g2, rw_k_k, rw_k_a,
              rw_r_k, rw_gn_g, rw_gn_b, nsa_cmp_pos, nsa_cmp_w1, nsa_cmp_w2, od_w_in, od_w_out, hg_lb, hg_norm_g,
              moe_w_rg, moe_b_rg, moe_w_re, moe_b_re, moe_w1, moe_w3, moe_w2, ln_g, ln_b, ple_w, ple_gate_w):
    cos, sin = _rope_tables(positions, NSA_HEAD)
    lb_soft = jax.nn.softmax(hg_lb.astype(jnp.float32), axis=0)
    lb_all = jnp.cumsum(lb_soft, axis=0) - lb_soft[0:1]
    for li in range(DEPTH):
        j = li // 2
        if li % 2 == 0:
            z_rw, z_nsa = jnp.split(x @ ev_w_in[j], [RW_COLS], axis=-1)
            y_rw = _rwkv7_group(z_rw, rw_mu[j], rw_w0[j], rw_w2[j], rw_a0[j], rw_a2[j], rw_g2[j], rw_k_k[j],
                                rw_k_a[j], rw_r_k[j], rw_gn_g[j], rw_gn_b[j])
            y_nsa = _nsa_group(z_nsa, cos, sin, nsa_cmp_pos[j], nsa_cmp_w1[j], nsa_cmp_w2[j])
            mix = jnp.concatenate([y_rw.astype(x.dtype), y_nsa.astype(x.dtype)], -1) @ ev_w_out[j]
        else:
            mix = _hgrn2_mixer(x, od_w_in[j], od_w_out[j], lb_all[li], hg_norm_g[j])
        h = _layer_norm(DN_ALPHA * x + mix, ln_g[li, 0], ln_b[li, 0])
        ffn = _hier_moe(h, moe_w_rg[li], moe_b_rg[li], moe_w_re[li], moe_b_re[li], moe_w1[li], moe_w3[li], moe_w2[li])
        h = _layer_norm(DN_ALPHA * h + ffn, ln_g[li, 1], ln_b[li, 1])
        x = h + jax.nn.sigmoid(h @ ple_gate_w[li]) * (p[li] @ ple_w[li])
    return x
```

```cpp
#include <hip/hip_runtime.h>
#ifndef PROBE_DUP
#define PROBE_DUP 0
#endif
#include <cstdio>
#include <cstdint>

#define LAS __attribute__((address_space(3)))
#define GAS __attribute__((address_space(1)))
typedef unsigned short bf16_t;
typedef short bf16x8 __attribute__((ext_vector_type(8)));
typedef float f32x4 __attribute__((ext_vector_type(4)));
typedef float f32x2 __attribute__((ext_vector_type(2)));
typedef unsigned u32x4 __attribute__((ext_vector_type(4)));
typedef unsigned u32x2 __attribute__((ext_vector_type(2)));

constexpr int NB = 16, T = 4096, M = NB * T, D = 1024, PLE = 256, DEPTH = 2;
constexpr float DN_ALPHA = 1.41421356237f;
constexpr float LN_EPS = 1e-5f;
constexpr int EVN = 3096, EVP = 3328;
constexpr int NEXP = 32, MOE_H = 512, MOE_BLK = 256, MOE_A = 2 * M, MOE_P = MOE_A + NEXP * MOE_BLK, MOE_TILES = MOE_P / 256;

constexpr size_t MiB = 1u << 20;
constexpr size_t WS_CTL = 0, CTL_ZERO_BYTES = 1 * MiB;
constexpr size_t WS_WEVIN = 1 * MiB, WS_WEVOUT = 8 * MiB, WS_WODIN = 10 * MiB, WS_WODOUT = 18 * MiB, WS_WGATE = 20 * MiB, WS_WPLE = 24 * MiB, WS_WLORA = 25 * MiB, WS_WCMP = 26 * MiB;
constexpr size_t WS_MISC = 27 * MiB;
constexpr size_t WS_WMOE13 = 33 * MiB, WS_WMOE2 = 97 * MiB, WS_PBF = 129 * MiB, WS_XB = 161 * MiB, WS_ARENA = 289 * MiB;
constexpr size_t A_H = WS_ARENA, A_HID = WS_ARENA + 128 * MiB, A_XBUF = WS_ARENA + 264 * MiB, A_PP1 = WS_ARENA + 536 * MiB;
constexpr size_t A_ACT = WS_ARENA + 416 * MiB, A_DEC = A_ACT + 32 * MiB, A_AA = A_DEC + 128 * MiB, A_GG = A_AA + 64 * MiB;
constexpr size_t A_SC4 = A_ACT;
constexpr size_t DOUT_QR = 160 * MiB, DOUT_SEG = 224 * MiB;
constexpr size_t A_HC2 = WS_ARENA + 704 * MiB, A_KVC2 = A_HC2 + 16 * MiB;
static_assert(A_KVC2 + 2 * MiB <= 1024 * MiB && A_GG + 64 * MiB <= A_HC2, "arena map");
static_assert(A_PP1 + 128 * MiB <= 1024 * MiB && A_PP1 >= WS_ARENA + 512 * MiB && A_XBUF + 272 * MiB <= A_PP1 && A_HID + 136 * MiB <= A_XBUF, "post-mixer arena map");
constexpr size_t WS_END = 1024 * MiB;
constexpr size_t WS_WRB = 29 * MiB;
constexpr size_t MISC_LBT = 31 * MiB;
constexpr size_t WS_TOKS = 30 * MiB;
constexpr size_t MISC_EID = WS_MISC, MISC_GATE = WS_MISC + 512 * 1024, MISC_SLOT = WS_MISC + 1024 * 1024, MISC_BCNT = WS_MISC + 1536 * 1024, MISC_TILEE = MISC_BCNT + 64 * 1024, MISC_CMPB = MISC_TILEE + 4096;
constexpr int CW_BAR = 4096;

constexpr int NWAVES = 8, NTHR = 512;
typedef __bf16 bf16x2_t __attribute__((ext_vector_type(2)));
__device__ __forceinline__ unsigned cvt_pk_bf16(float lo, float hi) { f32x2 v = {lo, hi}; return __builtin_bit_cast(unsigned, __builtin_convertvector(v, bf16x2_t)); }
__device__ __forceinline__ float bf2f(unsigned short b) { return __uint_as_float(((unsigned)b) << 16); }
__device__ __forceinline__ float bflo(unsigned w) { return __uint_as_float(w << 16); }
__device__ __forceinline__ float bfhi(unsigned w) { return __uint_as_float(w & 0xffff0000u); }
template <int CTRL, int RM> __device__ __forceinline__ float dpp_addx(float v) { return v + __builtin_bit_cast(float, __builtin_amdgcn_update_dpp(0, __builtin_bit_cast(int, v), CTRL, RM, 0xf, false)); }
__device__ __forceinline__ float wave_sum(float v) {
    v = dpp_addx<0xB1, 0xf>(v); v = dpp_addx<0x4E, 0xf>(v); v = dpp_addx<0x141, 0xf>(v); v = dpp_addx<0x140, 0xf>(v);
    v = dpp_addx<0x142, 0xa>(v); v = dpp_addx<0x143, 0xc>(v);
    return __builtin_bit_cast(float, __builtin_amdgcn_readlane(__builtin_bit_cast(int, v), 63));
}
__device__ __forceinline__ float sigmoidf_(float x) { return __builtin_amdgcn_rcpf(1.0f + __expf(-x)); }
__device__ __forceinline__ float siluf_(float x) { return x * __builtin_amdgcn_rcpf(1.0f + __expf(-x)); }
__device__ __forceinline__ int pinned_tid() { int t = threadIdx.x; asm volatile("" : "+v"(t)); return t; }
#define LDS_WAIT() asm volatile("s_waitcnt lgkmcnt(0)" ::: "memory")
#define VM_WAIT() asm volatile("s_waitcnt vmcnt(0)" ::: "memory")

namespace pg8 {
constexpr int BM = 256, BK = 64, HALF = 128, HTB = HALF * BK * 2, STAGE_BYTES = 8 * HTB, NXCD = 8, WGM = 8;
__host__ __device__ __forceinline__ int lds_byte(int r, int c) { const int st = (r >> 4) * 2 + (c >> 5), rr = r & 15, cc = c & 31, ob = rr * 64 + cc * 2; return st * 1024 + (ob ^ (((ob >> 9) & 1) << 5)); }
__host__ __device__ __forceinline__ void stage_rc(int b, int& R, int& C) { const int st = b / 1024, sb = b % 1024, swz = sb ^ (((sb >> 9) & 1) << 5); R = (st >> 1) * 16 + swz / 64; C = (st & 1) * 32 + (swz % 64) / 2; }
__host__ __device__ __forceinline__ int perm32(int rho) { const int n = rho >> 4, i = rho & 15; return 8 * (i >> 2) + 4 * n + (i & 3); }

struct Unit { int pm, pn, pb; };
struct Gemm { const bf16_t* A; const bf16_t* Bt; int lda, ldb, K; };

struct DenseOrder {
    int nM, nN, nwg, G, c;
    __device__ void init(int M_, int N_, int G_, int c_) { nM = M_ / BM; nN = N_ / BM; nwg = nM * nN; G = G_; c = c_; }
    __device__ bool next(int i, Unit& u) const {
        const long L = (long)i * G + c; if (L >= nwg) return false;
        int wgid = (int)L; { const int q = nwg / NXCD, r = nwg % NXCD, xcd = wgid % NXCD, off = wgid / NXCD; wgid = (xcd < r ? xcd * (q + 1) : r * (q + 1) + (xcd - r) * q) + off; }
        const int nig = WGM * nN, gid = wgid / nig, fm = gid * WGM, gsz = (nM - fm) < WGM ? (nM - fm) : WGM;
        u.pm = fm + ((wgid % nig) % gsz); u.pn = (wgid % nig) / gsz; u.pb = u.pn; return true;
    }
};
struct MoeOrder {
    const int* tile_e; int ntiles, G, c;
    __device__ bool next(int i, Unit& u) const {
        if ((G & 7) == 0) {
            const int x = c & 7, r = c >> 3, w = G >> 3, k = i * w + r, q = k >> 2, t = q * 8 + x;
            if (t >= ntiles) return false;
            u.pm = t; u.pn = k & 3; u.pb = __builtin_amdgcn_readfirstlane(tile_e[t]) * 4 + u.pn; return true;
        }
        const long L = (long)i * G + c; if (L >= (long)ntiles * 4) return false;
        u.pm = (int)(L >> 2); u.pn = (int)(L & 3); u.pb = __builtin_amdgcn_readfirstlane(tile_e[u.pm]) * 4 + u.pn; return true;
    }
};

template <class Epi, class Sched>
__device__ __forceinline__ void gemm_phase(LAS unsigned char* lds, const Gemm g, const Sched& S, const Epi& E) {
    int tid_ = threadIdx.x; asm volatile("" : "+v"(tid_)); const int tid = tid_, wid = __builtin_amdgcn_readfirstlane(tid >> 6), lane = tid & 63, wr = wid >> 2, wc = wid & 3, fr = lane & 15, fq = lane >> 4;
    int K_ = g.K, lda_ = g.lda, ldb_ = g.ldb; asm volatile("" : "+s"(K_), "+s"(lda_), "+s"(ldb_)); const int K = K_, nt = K / BK;
    unsigned voffA[2], voffB[2];
#pragma unroll
    for (int i = 0; i < 2; ++i) { int R, C; stage_rc(tid * 16 + i * 8192, R, C); const int Rb = Epi::PERM ? ((R & ~31) + perm32(R & 31)) : R;
        voffA[i] = (unsigned)(R * lda_ + C) * 2u; voffB[i] = (unsigned)(Rb * ldb_ + C) * 2u; }
    const size_t kstep = (size_t)(BK * 2);
    const size_t hstepA = (size_t)HALF * lda_ * 2, hstepB = (size_t)HALF * ldb_ * 2;
    const size_t tstepA = 2 * hstepA, tstepB = 2 * hstepB;
    const unsigned ldsw = (unsigned)wid * 1024u;
    const int aoff = lds_byte(wr * 64 + fr, fq * 8), boff = lds_byte(wc * 32 + fr, fq * 8);
#define PG8_SA(b, h) (((b) * 2 + (h)) * HTB)
#define PG8_SB(b, h) ((4 + (b) * 2 + (h)) * HTB)
#define PG8_STAGE(bufoff, gbase, voff) do { _Pragma("unroll") for (int _i = 0; _i < 2; ++_i) \
        __builtin_amdgcn_global_load_lds((const unsigned*)((const char*)(gbase) + (voff)[_i]), (LAS unsigned*)(lds + (bufoff) + ldsw + _i * 8192), 16, 0, 0); } while (0)
#define PG8_LDA(dst, b, h) do { _Pragma("unroll") for (int m = 0; m < 4; ++m) _Pragma("unroll") for (int k = 0; k < 2; ++k) dst[m][k] = *(const LAS bf16x8*)(lds + PG8_SA(b, h) + aoff + m * 2048 + k * 1024); } while (0)
#define PG8_LDB(dst, b, h) do { _Pragma("unroll") for (int n = 0; n < 2; ++n) _Pragma("unroll") for (int k = 0; k < 2; ++k) dst[n][k] = *(const LAS bf16x8*)(lds + PG8_SB(b, h) + boff + n * 2048 + k * 1024); } while (0)
#define PG8_MMA(ai, bj, At, Bt) do { __builtin_amdgcn_s_setprio(1); _Pragma("unroll") for (int m = 0; m < 4; ++m) _Pragma("unroll") for (int n = 0; n < 2; ++n) _Pragma("unroll") for (int k = 0; k < 2; ++k) \
        acc[ai][bj][m][n] = __builtin_amdgcn_mfma_f32_16x16x32_bf16(Bt[n][k], At[m][k], acc[ai][bj][m][n], 0, 0, 0); __builtin_amdgcn_s_setprio(0); } while (0)
#define PG8_WAIT_V(n) asm volatile("s_waitcnt vmcnt(" #n ")" ::: "memory")
#define PG8_WAIT_L(n) asm volatile("s_waitcnt lgkmcnt(" #n ")" ::: "memory")
#define PG8_BAR __builtin_amdgcn_s_barrier()
#define PG8_SCHED __builtin_amdgcn_sched_barrier(0)
    Unit cur, nxt; int ui = 0;
    if (!S.next(0, cur)) return;
    f32x4 acc[2][2][4][2];
#pragma unroll
    for (int a = 0; a < 2; ++a)
#pragma unroll
        for (int b = 0; b < 2; ++b)
#pragma unroll
            for (int m = 0; m < 4; ++m)
#pragma unroll
                for (int n = 0; n < 2; ++n) acc[a][b][m][n] = (f32x4){0.f, 0.f, 0.f, 0.f};
    bf16x8 At[4][2], B0[2][2], B1[2][2];
    const char* cA = (const char*)g.A + (size_t)cur.pm * tstepA; const char* cB = (const char*)g.Bt + (size_t)cur.pb * tstepB;
    PG8_STAGE(PG8_SB(0, 0), cB, voffB); PG8_STAGE(PG8_SB(0, 1), cB + hstepB, voffB); PG8_STAGE(PG8_SA(0, 0), cA, voffA); PG8_STAGE(PG8_SA(0, 1), cA + hstepA, voffA);
    if (wr == 1) PG8_BAR;
    PG8_WAIT_V(2); PG8_BAR;
    PG8_STAGE(PG8_SB(1, 0), cB + kstep, voffB); PG8_STAGE(PG8_SA(1, 0), cA + kstep, voffA); PG8_STAGE(PG8_SB(1, 1), cB + hstepB + kstep, voffB);
    PG8_WAIT_V(6); PG8_BAR;
    for (;;) {
        const bool has_next = S.next(ui + 1, nxt);
        const char* nA = has_next ? (const char*)g.A + (size_t)nxt.pm * tstepA : cA; const char* nB = has_next ? (const char*)g.Bt + (size_t)nxt.pb * tstepB : cB;
#pragma nounroll
        for (int t = 0; t < nt; t += 2) {
            const bool last = (t == nt - 2);
            const char* a1 = cA + (size_t)(t + 1) * kstep;
            const char* a2 = last ? nA : cA + (size_t)(t + 2) * kstep; const char* b2 = last ? nB : cB + (size_t)(t + 2) * kstep;
            const char* a3 = a2 + kstep; const char* b3 = b2 + kstep;
            PG8_LDB(B0, 0, 0); PG8_LDB(B1, 0, 1); PG8_SCHED; PG8_LDA(At, 0, 0); PG8_STAGE(PG8_SA(1, 1), a1 + hstepA, voffA);
            PG8_WAIT_V(8); PG8_WAIT_L(0); PG8_BAR; PG8_MMA(0, 0, At, B0); PG8_MMA(0, 1, At, B1); PG8_BAR; PG8_SCHED;
            PG8_LDA(At, 0, 1); PG8_STAGE(PG8_SB(0, 0), b2, voffB); PG8_STAGE(PG8_SB(0, 1), b2 + hstepB, voffB); PG8_STAGE(PG8_SA(0, 0), a2, voffA);
            PG8_WAIT_V(8); PG8_WAIT_L(0); PG8_BAR; PG8_MMA(1, 0, At, B0); PG8_MMA(1, 1, At, B1); PG8_BAR; PG8_SCHED;
            PG8_LDB(B0, 1, 0); PG8_LDB(B1, 1, 1); PG8_SCHED; PG8_LDA(At, 1, 0); PG8_STAGE(PG8_SA(0, 1), a2 + hstepA, voffA);
            PG8_WAIT_V(8); PG8_WAIT_L(0); PG8_BAR; PG8_MMA(0, 0, At, B0); PG8_MMA(0, 1, At, B1); PG8_BAR; PG8_SCHED;
            PG8_LDA(At, 1, 1); PG8_STAGE(PG8_SB(1, 0), b3, voffB); PG8_STAGE(PG8_SB(1, 1), b3 + hstepB, voffB); PG8_STAGE(PG8_SA(1, 0), a3, voffA);
            PG8_WAIT_V(8); PG8_WAIT_L(0); PG8_BAR; PG8_MMA(1, 0, At, B0); PG8_MMA(1, 1, At, B1); PG8_BAR; PG8_SCHED;
        }
        if (wr == 0) PG8_BAR;
        E(acc, cur, wr, wc, fr, fq);
        if (!has_next) break;
#pragma unroll
        for (int a = 0; a < 2; ++a)
#pragma unroll
            for (int b = 0; b < 2; ++b)
#pragma unroll
                for (int m = 0; m < 4; ++m)
#pragma unroll
                    for (int n = 0; n < 2; ++n) acc[a][b][m][n] = (f32x4){0.f, 0.f, 0.f, 0.f};
        cur = nxt; cA = nA; cB = nB; ++ui;
        if (wr == 1) PG8_BAR;
    }
    PG8_WAIT_V(0);
    PG8_BAR;
#undef PG8_SA
#undef PG8_SB
#undef PG8_STAGE
#undef PG8_LDA
#undef PG8_LDB
#undef PG8_MMA
#undef PG8_WAIT_V
#undef PG8_WAIT_L
#undef PG8_BAR
#undef PG8_SCHED
}

template <class Epi, class Sched>
__device__ __forceinline__ void gemm_phase_gather(LAS unsigned char* lds, const Gemm g, const Sched& S, const Epi& E, const int* toks) {
    int tid_ = threadIdx.x; asm volatile("" : "+v"(tid_)); const int tid = tid_, wid = __builtin_amdgcn_readfirstlane(tid >> 6), lane = tid & 63, wr = wid >> 2, wc = wid & 3, fr = lane & 15, fq = lane >> 4;
    int K_ = g.K, lda_ = g.lda, ldb_ = g.ldb; asm volatile("" : "+s"(K_), "+s"(lda_), "+s"(ldb_)); const int K = K_, nt = K / BK;
    unsigned voffB[2]; int RA[2]; unsigned CA[2];
#pragma unroll
    for (int i = 0; i < 2; ++i) { int R, C; stage_rc(tid * 16 + i * 8192, R, C); const int Rb = Epi::PERM ? ((R & ~31) + perm32(R & 31)) : R;
        RA[i] = R; CA[i] = (unsigned)C * 2u; voffB[i] = (unsigned)(Rb * ldb_ + C) * 2u; }
    unsigned voC[2][2], voN[2][2];
#define PG8_GOFF(VO, U) do { _Pragma("unroll") for (int h_ = 0; h_ < 2; ++h_) _Pragma("unroll") for (int i_ = 0; i_ < 2; ++i_) VO[h_][i_] = (unsigned)(toks[(U).pm * BM + h_ * HALF + RA[i_]] & 0xffff) * (unsigned)(lda_ * 2) + CA[i_]; } while (0)
    const size_t kstep = (size_t)(BK * 2);
    const size_t hstepA = (size_t)HALF * lda_ * 2, hstepB = (size_t)HALF * ldb_ * 2;
    const size_t tstepA = 2 * hstepA, tstepB = 2 * hstepB;
    const unsigned ldsw = (unsigned)wid * 1024u;
    const int aoff = lds_byte(wr * 64 + fr, fq * 8), boff = lds_byte(wc * 32 + fr, fq * 8);
#define PG8_SA(b, h) (((b) * 2 + (h)) * HTB)
#define PG8_SB(b, h) ((4 + (b) * 2 + (h)) * HTB)
#define PG8_STAGE(bufoff, gbase, voff) do { _Pragma("unroll") for (int _i = 0; _i < 2; ++_i) \
        __builtin_amdgcn_global_load_lds((const unsigned*)((const char*)(gbase) + (voff)[_i]), (LAS unsigned*)(lds + (bufoff) + ldsw + _i * 8192), 16, 0, 0); } while (0)
#define PG8_LDA(dst, b, h) do { _Pragma("unroll") for (int m = 0; m < 4; ++m) _Pragma("unroll") for (int k = 0; k < 2; ++k) dst[m][k] = *(const LAS bf16x8*)(lds + PG8_SA(b, h) + aoff + m * 2048 + k * 1024); } while (0)
#define PG8_LDB(dst, b, h) do { _Pragma("unroll") for (int n = 0; n < 2; ++n) _Pragma("unroll") for (int k = 0; k < 2; ++k) dst[n][k] = *(const LAS bf16x8*)(lds + PG8_SB(b, h) + boff + n * 2048 + k * 1024); } while (0)
#define PG8_MMA(ai, bj, At, Bt) do { __builtin_amdgcn_s_setprio(1); _Pragma("unroll") for (int m = 0; m < 4; ++m) _Pragma("unroll") for (int n = 0; n < 2; ++n) _Pragma("unroll") for (int k = 0; k < 2; ++k) \
        acc[ai][bj][m][n] = __builtin_amdgcn_mfma_f32_16x16x32_bf16(Bt[n][k], At[m][k], acc[ai][bj][m][n], 0, 0, 0); __builtin_amdgcn_s_setprio(0); } while (0)
#define PG8_WAIT_V(n) asm volatile("s_waitcnt vmcnt(" #n ")" ::: "memory")
#define PG8_WAIT_L(n) asm volatile("s_waitcnt lgkmcnt(" #n ")" ::: "memory")
#define PG8_BAR __builtin_amdgcn_s_barrier()
#define PG8_SCHED __builtin_amdgcn_sched_barrier(0)
    Unit cur, nxt; int ui = 0;
    if (!S.next(0, cur)) return;
    f32x4 acc[2][2][4][2];
#pragma unroll
    for (int a = 0; a < 2; ++a)
#pragma unroll
        for (int b = 0; b < 2; ++b)
#pragma unroll
            for (int m = 0; m < 4; ++m)
#pragma unroll
                for (int n = 0; n < 2; ++n) acc[a][b][m][n] = (f32x4){0.f, 0.f, 0.f, 0.f};
    bf16x8 At[4][2], B0[2][2], B1[2][2];
    const char* const kA = (const char*)g.A; const char* cB = (const char*)g.Bt + (size_t)cur.pb * tstepB;
    PG8_GOFF(voC, cur);
    PG8_STAGE(PG8_SB(0, 0), cB, voffB); PG8_STAGE(PG8_SB(0, 1), cB + hstepB, voffB); PG8_STAGE(PG8_SA(0, 0), kA, voC[0]); PG8_STAGE(PG8_SA(0, 1), kA, voC[1]);
    if (wr == 1) PG8_BAR;
    PG8_WAIT_V(2); PG8_BAR;
    PG8_STAGE(PG8_SB(1, 0), cB + kstep, voffB); PG8_STAGE(PG8_SA(1, 0), kA + kstep, voC[0]); PG8_STAGE(PG8_SB(1, 1), cB + hstepB + kstep, voffB);
    PG8_WAIT_V(6); PG8_BAR;
    for (;;) {
        const bool has_next = S.next(ui + 1, nxt);
        const char* nB = has_next ? (const char*)g.Bt + (size_t)nxt.pb * tstepB : cB;
        if (has_next) PG8_GOFF(voN, nxt); else { _Pragma("unroll") for (int h_ = 0; h_ < 2; ++h_) _Pragma("unroll") for (int i_ = 0; i_ < 2; ++i_) voN[h_][i_] = voC[h_][i_]; }
#pragma nounroll
        for (int t = 0; t < nt; t += 2) {
            const bool last = (t == nt - 2);
            const char* a1 = kA + (size_t)(t + 1) * kstep;
            const char* a2 = last ? kA : kA + (size_t)(t + 2) * kstep; const char* b2 = last ? nB : cB + (size_t)(t + 2) * kstep;
            unsigned vo2[2][2];
#pragma unroll
            for (int h_ = 0; h_ < 2; ++h_)
#pragma unroll
                for (int i_ = 0; i_ < 2; ++i_) vo2[h_][i_] = last ? voN[h_][i_] : voC[h_][i_];
            const char* a3 = a2 + kstep; const char* b3 = b2 + kstep;
            PG8_LDB(B0, 0, 0); PG8_LDB(B1, 0, 1); PG8_SCHED; PG8_LDA(At, 0, 0); PG8_STAGE(PG8_SA(1, 1), a1, voC[1]);
            PG8_WAIT_V(8); PG8_WAIT_L(0); PG8_BAR; PG8_MMA(0, 0, At, B0); PG8_MMA(0, 1, At, B1); PG8_BAR; PG8_SCHED;
            PG8_LDA(At, 0, 1); PG8_STAGE(PG8_SB(0, 0), b2, voffB); PG8_STAGE(PG8_SB(0, 1), b2 + hstepB, voffB); PG8_STAGE(PG8_SA(0, 0), a2, vo2[0]);
            PG8_WAIT_V(8); PG8_WAIT_L(0); PG8_BAR; PG8_MMA(1, 0, At, B0); PG8_MMA(1, 1, At, B1); PG8_BAR; PG8_SCHED;
            PG8_LDB(B0, 1, 0); PG8_LDB(B1, 1, 1); PG8_SCHED; PG8_LDA(At, 1, 0); PG8_STAGE(PG8_SA(0, 1), a2, vo2[1]);
            PG8_WAIT_V(8); PG8_WAIT_L(0); PG8_BAR; PG8_MMA(0, 0, At, B0); PG8_MMA(0, 1, At, B1); PG8_BAR; PG8_SCHED;
            PG8_LDA(At, 1, 1); PG8_STAGE(PG8_SB(1, 0), b3, voffB); PG8_STAGE(PG8_SB(1, 1), b3 + hstepB, voffB); PG8_STAGE(PG8_SA(1, 0), a3, vo2[0]);
            PG8_WAIT_V(8); PG8_WAIT_L(0); PG8_BAR; PG8_MMA(1, 0, At, B0); PG8_MMA(1, 1, At, B1); PG8_BAR; PG8_SCHED;
        }
        if (wr == 0) PG8_BAR;
        E(acc, cur, wr, wc, fr, fq);
        if (!has_next) break;
#pragma unroll
        for (int a = 0; a < 2; ++a)
#pragma unroll
            for (int b = 0; b < 2; ++b)
#pragma unroll
                for (int m = 0; m < 4; ++m)
#pragma unroll
                    for (int n = 0; n < 2; ++n) acc[a][b][m][n] = (f32x4){0.f, 0.f, 0.f, 0.f};
        cur = nxt; cB = nB; ++ui;
#pragma unroll
        for (int h_ = 0; h_ < 2; ++h_)
#pragma unroll
            for (int i_ = 0; i_ < 2; ++i_) voC[h_][i_] = voN[h_][i_];
        if (wr == 1) PG8_BAR;
    }
    PG8_WAIT_V(0);
    PG8_BAR;
#undef PG8_GOFF
#undef PG8_SA
#undef PG8_SB
#undef PG8_STAGE
#undef PG8_LDA
#undef PG8_LDB
#undef PG8_MMA
#undef PG8_WAIT_V
#undef PG8_WAIT_L
#undef PG8_BAR
#undef PG8_SCHED
}


struct EpiBf16 {
    static constexpr bool PERM = true;
    bf16_t* O; int ldc; unsigned silu_mask; unsigned fg_mask; const float* lbt;
    __device__ __forceinline__ void operator()(const f32x4 (&acc)[2][2][4][2], const Unit& u, int wr, int wc, int fr, int fq) const {
        const int row0 = u.pm * BM + wr * 64 + fr, col0 = u.pn * BM + wc * 32 + 8 * fq;
        const bool act = (silu_mask >> u.pn) & 1u, fgm = (fg_mask >> u.pn) & 1u;
#pragma unroll
        for (int bj = 0; bj < 2; ++bj) {
            f32x4 l0 = (f32x4){0.f, 0.f, 0.f, 0.f}, l1 = l0;
            if (fgm) { const int cc = (col0 & 1023) + bj * HALF; l0 = *(const f32x4*)(lbt + cc); l1 = *(const f32x4*)(lbt + cc + 4); }
#pragma unroll
            for (int ai = 0; ai < 2; ++ai)
#pragma unroll
                for (int m = 0; m < 4; ++m) { bf16_t* rowp = O + (size_t)(row0 + ai * HALF + m * 16) * ldc + col0;
                    f32x4 v0 = acc[ai][bj][m][0], v1 = acc[ai][bj][m][1];
                    if (act) {
#pragma unroll
                        for (int j = 0; j < 4; ++j) { v0[j] = siluf_(v0[j]); v1[j] = siluf_(v1[j]); } }
                    if (fgm) {
#pragma unroll
                        for (int j = 0; j < 4; ++j) { v0[j] = l0[j] + (1.0f - l0[j]) * sigmoidf_(v0[j]); v1[j] = l1[j] + (1.0f - l1[j]) * sigmoidf_(v1[j]); } }
                    u32x4 w; w.x = cvt_pk_bf16(v0[0], v0[1]); w.y = cvt_pk_bf16(v0[2], v0[3]); w.z = cvt_pk_bf16(v1[0], v1[1]); w.w = cvt_pk_bf16(v1[2], v1[3]);
                    *(u32x4*)(rowp + bj * HALF) = w; }
        }
    }
};
struct EpiGate {
    static constexpr bool PERM = true;
    const bf16_t* h2; const bf16_t* pp; float* xout; bf16_t* xb;
    __device__ __forceinline__ void operator()(const f32x4 (&acc)[2][2][4][2], const Unit& u, int wr, int wc, int fr, int fq) const {
        const int row0 = u.pm * BM + wr * 64 + fr, col0 = u.pn * BM + wc * 32 + 8 * fq;
#pragma unroll
        for (int ai = 0; ai < 2; ++ai)
#pragma unroll
            for (int m = 0; m < 4; ++m) { const size_t off = (size_t)(row0 + ai * HALF + m * 16) * D + col0;
#pragma unroll
                for (int bj = 0; bj < 2; ++bj) { const size_t o = off + bj * HALF;
                    const u32x4 hw = *(const u32x4*)(h2 + o), pw = *(const u32x4*)(pp + o); const f32x4 a0 = acc[ai][bj][m][0], a1 = acc[ai][bj][m][1];
                    f32x4 r0, r1;
                    r0[0] = bflo(hw.x) + sigmoidf_(a0[0]) * bflo(pw.x); r0[1] = bfhi(hw.x) + sigmoidf_(a0[1]) * bfhi(pw.x); r0[2] = bflo(hw.y) + sigmoidf_(a0[2]) * bflo(pw.y); r0[3] = bfhi(hw.y) + sigmoidf_(a0[3]) * bfhi(pw.y);
                    r1[0] = bflo(hw.z) + sigmoidf_(a1[0]) * bflo(pw.z); r1[1] = bfhi(hw.z) + sigmoidf_(a1[1]) * bfhi(pw.z); r1[2] = bflo(hw.w) + sigmoidf_(a1[2]) * bflo(pw.w); r1[3] = bfhi(hw.w) + sigmoidf_(a1[3]) * bfhi(pw.w);
                    if (xout) { *(f32x4*)(xout + o) = r0; *(f32x4*)(xout + o + 4) = r1; }
                    else *(u32x4*)(xb + o) = (u32x4){cvt_pk_bf16(r0[0], r0[1]), cvt_pk_bf16(r0[2], r0[3]), cvt_pk_bf16(r1[0], r1[1]), cvt_pk_bf16(r1[2], r1[3])}; }
                asm volatile("" ::: "memory"); }
    }
};
struct EpiPre {
    static constexpr bool PERM = true;
    const float* xf; const bf16_t* xh; bf16_t* pre;
    __device__ __forceinline__ void operator()(const f32x4 (&acc)[2][2][4][2], const Unit& u, int wr, int wc, int fr, int fq) const {
        const int row0 = u.pm * BM + wr * 64 + fr, col0 = u.pn * BM + wc * 32 + 8 * fq;
#pragma unroll
        for (int ai = 0; ai < 2; ++ai)
#pragma unroll
            for (int m = 0; m < 4; ++m) { const size_t off = (size_t)(row0 + ai * HALF + m * 16) * D + col0;
#pragma unroll
                for (int bj = 0; bj < 2; ++bj) { const size_t o = off + bj * HALF; f32x4 x0, x1;
                    if (xf) { x0 = *(const f32x4*)(xf + o); x1 = *(const f32x4*)(xf + o + 4); }
                    else { const u32x4 w = *(const u32x4*)(xh + o); x0 = (f32x4){bflo(w.x), bfhi(w.x), bflo(w.y), bfhi(w.y)}; x1 = (f32x4){bflo(w.z), bfhi(w.z), bflo(w.w), bfhi(w.w)}; }
                    const f32x4 r0 = x0 * DN_ALPHA + acc[ai][bj][m][0], r1 = x1 * DN_ALPHA + acc[ai][bj][m][1];
                    *(u32x4*)(pre + o) = (u32x4){cvt_pk_bf16(r0[0], r0[1]), cvt_pk_bf16(r0[2], r0[3]), cvt_pk_bf16(r1[0], r1[1]), cvt_pk_bf16(r1[2], r1[3])}; }
                asm volatile("" ::: "memory"); }
    }
};
struct EpiMoe1 {
    static constexpr bool PERM = true;
    bf16_t* hid;
    __device__ __forceinline__ void operator()(const f32x4 (&acc)[2][2][4][2], const Unit& u, int wr, int wc, int fr, int fq) const {
        const int row0 = u.pm * BM + wr * 64 + fr, col0 = u.pn * HALF + wc * 32 + 8 * fq;
#pragma unroll
        for (int ai = 0; ai < 2; ++ai)
#pragma unroll
            for (int m = 0; m < 4; ++m) { bf16_t* rowp = hid + (size_t)(row0 + ai * HALF + m * 16) * MOE_H + col0;
                f32x4 v0, v1;
#pragma unroll
                for (int j = 0; j < 4; ++j) { v0[j] = siluf_(acc[ai][0][m][0][j]) * acc[ai][1][m][0][j]; v1[j] = siluf_(acc[ai][0][m][1][j]) * acc[ai][1][m][1][j]; }
                u32x4 w; w.x = cvt_pk_bf16(v0[0], v0[1]); w.y = cvt_pk_bf16(v0[2], v0[3]); w.z = cvt_pk_bf16(v1[0], v1[1]); w.w = cvt_pk_bf16(v1[2], v1[3]);
                *(u32x4*)rowp = w; }
    }
};
struct EpiLora {
    static constexpr bool PERM = true;
    const float* w0; const float* a0; float* dec; bf16_t* aa; bf16_t* gg;
    __device__ __forceinline__ void operator()(const f32x4 (&acc)[2][2][4][2], const Unit& u, int wr, int wc, int fr, int fq) const {
        const int row0 = u.pm * BM + wr * 64 + fr, seg = u.pn >> 1, c0 = (u.pn & 1) * BM + wc * 32 + 8 * fq;
#pragma unroll
        for (int bj = 0; bj < 2; ++bj) {
            const int c = c0 + bj * HALF;
            f32x4 b0 = (f32x4){0.f, 0.f, 0.f, 0.f}, b1 = b0;
            if (seg == 0) { b0 = *(const f32x4*)(w0 + c); b1 = *(const f32x4*)(w0 + c + 4); } else if (seg == 1) { b0 = *(const f32x4*)(a0 + c); b1 = *(const f32x4*)(a0 + c + 4); }
#pragma unroll
            for (int ai = 0; ai < 2; ++ai)
#pragma unroll
                for (int m = 0; m < 4; ++m) { const size_t o = (size_t)(row0 + ai * HALF + m * 16) * 512 + c;
                    f32x4 v0 = acc[ai][bj][m][0] + b0, v1 = acc[ai][bj][m][1] + b1;
                    if (seg == 0) {
#pragma unroll
                        for (int j = 0; j < 4; ++j) { v0[j] = __expf(-0.60653066f * sigmoidf_(v0[j])); v1[j] = __expf(-0.60653066f * sigmoidf_(v1[j])); }
                        *(f32x4*)(dec + o) = v0; *(f32x4*)(dec + o + 4) = v1;
                    } else {
                        if (seg == 1) {
#pragma unroll
                            for (int j = 0; j < 4; ++j) { v0[j] = sigmoidf_(v0[j]); v1[j] = sigmoidf_(v1[j]); } }
                        u32x4 w; w.x = cvt_pk_bf16(v0[0], v0[1]); w.y = cvt_pk_bf16(v0[2], v0[3]); w.z = cvt_pk_bf16(v1[0], v1[1]); w.w = cvt_pk_bf16(v1[2], v1[3]);
                        if (seg == 1) *(u32x4*)(aa + o) = w; else *(u32x4*)(gg + o) = w;
                    } }
        }
    }
};
struct EpiF32 {
    static constexpr bool PERM = false;
    float* C; int ldc;
    __device__ __forceinline__ void operator()(const f32x4 (&acc)[2][2][4][2], const Unit& u, int wr, int wc, int fr, int fq) const {
        const int row0 = u.pm * BM + wr * 64 + fr, col0 = u.pn * BM + wc * 32 + 4 * fq;
#pragma unroll
        for (int ai = 0; ai < 2; ++ai)
#pragma unroll
            for (int m = 0; m < 4; ++m) { float* rowp = C + (size_t)(row0 + ai * HALF + m * 16) * ldc + col0;
#pragma unroll
                for (int bj = 0; bj < 2; ++bj)
#pragma unroll
                    for (int n = 0; n < 2; ++n) *(f32x4*)(rowp + bj * HALF + n * 16) = acc[ai][bj][m][n]; }
    }
};
struct CmpOrder {
    int G, c;
    __device__ bool next(int i, Unit& u) const { const int L = i * G + c; if (L >= 64) return false; u.pm = L; u.pn = 0; u.pb = L >> 5; return true; }
};
struct EpiLogit {
    static constexpr bool PERM = false;
    float* LG;
    __device__ __forceinline__ void operator()(const f32x4 (&acc)[2][2][4][2], const Unit& u, int wr, int wc, int fr, int fq) const {
        if (wc >= 2) return;
        const int row0 = u.pm * BM + wr * 64 + fr, col0 = wc * 32 + 4 * fq;
#pragma unroll
        for (int ai = 0; ai < 2; ++ai)
#pragma unroll
            for (int m = 0; m < 4; ++m) { float* rowp = LG + (size_t)(row0 + ai * HALF + m * 16) * 64 + col0;
#pragma unroll
                for (int n = 0; n < 2; ++n) *(f32x4*)(rowp + n * 16) = acc[ai][0][m][n]; }
    }
};
}

#define XB_TMO      128
#define XB_XCNT(j)  (256  + 64 * (j))
#define XB_XSUB(j)  (1280 + 64 * (j))
#define XB_XGEN(j)  (2304 + 64 * (j))
#define XB_TOP      3328
#define XB_TOPGEN   3392
#define XCD_BAR_WORDS 3456
#define XB_SPIN_CAP (1u << 18)
__device__ __forceinline__ unsigned xb_ld(unsigned* p)              { return __hip_atomic_load(p, __ATOMIC_RELAXED, __HIP_MEMORY_SCOPE_AGENT); }
__device__ __forceinline__ unsigned xb_add(unsigned* p, unsigned v) { return __hip_atomic_fetch_add(p, v, __ATOMIC_RELAXED, __HIP_MEMORY_SCOPE_AGENT); }
__device__ __forceinline__ unsigned xb_xcc_id() { return (unsigned)__builtin_amdgcn_s_getreg((3 << 11) | 20) & 0xFu; }
#define XB_SPIN(cond, bar) do { unsigned _sp = 0; while (cond) { __builtin_amdgcn_s_sleep(1); \
    if ((++_sp & 255u) == 0u) { if (xb_ld(&(bar)[XB_TMO])) break; if (_sp > XB_SPIN_CAP) { atomicAdd(&(bar)[XB_TMO], 1u); break; } } } } while (0)
struct XcdBarrier { unsigned* bar; unsigned x; volatile LAS unsigned* st; };
__device__ __forceinline__ XcdBarrier xcd_barrier_post(unsigned* bar, volatile LAS unsigned* st) {
    XcdBarrier b; b.bar = bar; b.x = xb_xcc_id(); b.st = st;
    if (threadIdx.x == 0) (void)xb_add(&bar[XB_XCNT(b.x)], 1u);
    return b;
}
__device__ __forceinline__ void xcd_barrier_complete(unsigned* bar, unsigned x, unsigned& nloc, unsigned& nx) {
    const unsigned G = gridDim.x * gridDim.y * gridDim.z;
    unsigned sum, cnt, mine, sp = 0u;
    for (;;) {
        sum = 0u; cnt = 0u; mine = 0u;
#pragma unroll
        for (unsigned j = 0; j < 16; ++j) { const unsigned c = xb_ld(&bar[XB_XCNT(j)]); sum += c; cnt += (c > 0u) ? 1u : 0u; mine = (j == x) ? c : mine; }
        if (sum == G) break;
        __builtin_amdgcn_s_sleep(1);
        if ((++sp & 255u) == 0u) { if (xb_ld(&bar[XB_TMO])) break; if (sp > XB_SPIN_CAP) { atomicAdd(&bar[XB_TMO], 1u); break; } }
    }
    nloc = mine > 0u ? mine : 1u; nx = cnt > 0u ? cnt : 1u;
}
__device__ __forceinline__ void xcd_barrier(const XcdBarrier& b) {
    asm volatile("s_waitcnt vmcnt(0)" ::: "memory");
    __syncthreads();
    if (threadIdx.x == 0) {
        unsigned* bar = b.bar;
        __builtin_amdgcn_s_waitcnt(0);
        unsigned nloc = b.st[0], nx = b.st[1];
        if (nloc == 0u) { xcd_barrier_complete(bar, b.x, nloc, nx); b.st[0] = nloc; b.st[1] = nx; }
        const unsigned old = xb_add(&bar[XB_XSUB(b.x)], 1u);
        const unsigned gen = old / nloc;
        if (old + 1u == (gen + 1u) * nloc) {
            __builtin_amdgcn_fence(__ATOMIC_RELEASE, "agent");
            asm volatile("s_waitcnt vmcnt(0)" ::: "memory");
            const unsigned og = xb_add(&bar[XB_TOP], 1u);
            const unsigned tg = og / nx;
            if (og + 1u == (tg + 1u) * nx) xb_add(&bar[XB_TOPGEN], 1u);
            else XB_SPIN(xb_ld(&bar[XB_TOPGEN]) == tg, bar);
            __builtin_amdgcn_fence(__ATOMIC_ACQUIRE, "agent");
            xb_add(&bar[XB_XGEN(b.x)], 1u);
            asm volatile("s_waitcnt vmcnt(0)" ::: "memory");
        } else {
            XB_SPIN(xb_ld(&bar[XB_XGEN(b.x)]) == gen, bar);
            __builtin_amdgcn_fence(__ATOMIC_ACQUIRE, "agent");
            asm volatile("s_waitcnt vmcnt(0)" ::: "memory");
        }
    }
    __syncthreads();
}


typedef float f32x16 __attribute__((ext_vector_type(16)));
#define MFMA32(a, b, c) __builtin_amdgcn_mfma_f32_32x32x16_bf16((a), (b), (c), 0, 0, 0)
__device__ __forceinline__ int crow(int reg, int h) { return (reg & 3) + 8 * (reg >> 2) + 4 * h; }
constexpr int HG_LQE = 0, HG_LKE = HG_LQE + 64 * 272, HG_LKTT = HG_LKE + 64 * 272, HG_LVT = HG_LKTT + 128 * 144, HG_LAT = HG_LVT + 128 * 144, HG_LST = HG_LAT + 64 * 144,
              HG_LO = HG_LST + 128 * 272, HG_LBL = HG_LO + 64 * 528, HG_LPART = HG_LBL + 512, HG_LEND = HG_LPART + 4096;
static_assert(HG_LEND <= 163840 - 512, "hgrn lds");
__device__ __forceinline__ void hgrn_phase(LAS unsigned char* lds, const bf16_t* Z, const float* hg_lb, const float* norm_g, bf16_t* OG, int G, int bx) {
    const int tid = pinned_tid(), lane = tid & 63, wave = __builtin_amdgcn_readfirstlane(tid >> 6), half = lane >> 5, l32 = lane & 31;
    const int d = 2 * (tid & 63), jq = tid >> 6;
    for (int unit = bx; unit < NB * 8; unit += G) {
        const int b = unit >> 3, h = unit & 7;
        for (int i = tid; i < 128 * 272 / 4; i += NTHR) ((LAS unsigned*)(lds + HG_LST))[i] = 0u;
        f32x16 S0, S1;
#pragma unroll
        for (int r = 0; r < 16; ++r) { S0[r] = 0.f; S1[r] = 0.f; }
        __syncthreads();
        unsigned qn[8], fn[8], vn[8];
#define HG_LOAD(n_) do { const bf16_t* zr_ = Z + ((size_t)(b * T + (n_) * 64 + jq * 8)) * 4096 + h * 128 + d; \
            _Pragma("unroll") for (int jj = 0; jj < 8; ++jj) { qn[jj] = *(const unsigned*)(zr_ + (size_t)jj * 4096); fn[jj] = *(const unsigned*)(zr_ + (size_t)jj * 4096 + 1024); vn[jj] = *(const unsigned*)(zr_ + (size_t)jj * 4096 + 2048); } } while (0)
        u32x4 gc0, gc1, gn0, gn1;
#define HG_LOADG(n_, A_, B_) do { const bf16_t* gp_ = Z + (size_t)(b * T + (n_) * 64 + (tid >> 3)) * 4096 + 3072 + h * 128 + (tid & 7) * 16; A_ = *(const u32x4*)gp_; B_ = *(const u32x4*)(gp_ + 8); } while (0)
        HG_LOAD(0); HG_LOADG(0, gc0, gc1);
        for (int n = 0; n < T / 64; ++n) {
            float q0[8], q1[8], k0[8], k1[8], p0[8], p1[8]; unsigned vr[8];
            float run0 = 1.f, run1 = 1.f;
#pragma unroll
            for (int jj = 0; jj < 8; ++jj) { const float fg0 = bflo(fn[jj]), fg1 = bfhi(fn[jj]); run0 *= fg0; run1 *= fg1; p0[jj] = run0; p1[jj] = run1; k0[jj] = 1.0f - fg0; k1[jj] = 1.0f - fg1;
                q0[jj] = bflo(qn[jj]); q1[jj] = bfhi(qn[jj]); vr[jj] = vn[jj]; }
            *(LAS f32x2*)(lds + HG_LPART + (jq * 128 + d) * 4) = (f32x2){run0, run1};
            __syncthreads();
            float pre0 = 1.f, pre1 = 1.f, tot0 = 1.f, tot1 = 1.f;
#pragma unroll
            for (int q = 0; q < 8; ++q) { const f32x2 pq = *(const LAS f32x2*)(lds + HG_LPART + (q * 128 + d) * 4); tot0 *= pq[0]; tot1 *= pq[1]; if (q < jq) { pre0 *= pq[0]; pre1 *= pq[1]; } }
            if (jq == 0) *(LAS f32x2*)(lds + HG_LBL + d * 4) = (f32x2){tot0, tot1};
            unsigned kt0[4], kt1[4], vt0[4], vt1[4];
#pragma unroll
            for (int jj = 0; jj < 8; ++jj) {
                const float e0 = p0[jj] * pre0, e1 = p1[jj] * pre1, r0 = __builtin_amdgcn_rcpf(e0), r1 = __builtin_amdgcn_rcpf(e1);
                const int j = jq * 8 + jj;
                *(LAS unsigned*)(lds + HG_LQE + j * 272 + d * 2) = cvt_pk_bf16(q0[jj] * e0, q1[jj] * e1);
                *(LAS unsigned*)(lds + HG_LKE + j * 272 + d * 2) = cvt_pk_bf16(k0[jj] * r0, k1[jj] * r1);
                const float t0 = k0[jj] * r0 * tot0, t1 = k1[jj] * r1 * tot1;
                if (jj & 1) { kt0[jj >> 1] = cvt_pk_bf16(p0[jj - 1], t0); kt1[jj >> 1] = cvt_pk_bf16(p1[jj - 1], t1); vt0[jj >> 1] = (vr[jj - 1] & 0xffffu) | (vr[jj] << 16); vt1[jj >> 1] = (vr[jj - 1] >> 16) | (vr[jj] & 0xffff0000u); }
                else { p0[jj] = t0; p1[jj] = t1; }
            }
            *(LAS u32x4*)(lds + HG_LKTT + d * 144 + jq * 16) = (u32x4){kt0[0], kt0[1], kt0[2], kt0[3]}; *(LAS u32x4*)(lds + HG_LKTT + (d + 1) * 144 + jq * 16) = (u32x4){kt1[0], kt1[1], kt1[2], kt1[3]};
            *(LAS u32x4*)(lds + HG_LVT + d * 144 + jq * 16) = (u32x4){vt0[0], vt0[1], vt0[2], vt0[3]}; *(LAS u32x4*)(lds + HG_LVT + (d + 1) * 144 + jq * 16) = (u32x4){vt1[0], vt1[1], vt1[2], vt1[3]};
            __syncthreads();
            if (n + 1 < T / 64) { HG_LOAD(n + 1); HG_LOADG(n + 1, gn0, gn1); }
            if (wave < 4) {
                const int tj = wave >> 1, ti = wave & 1;
                f32x16 acc;
#pragma unroll
                for (int r = 0; r < 16; ++r) acc[r] = 0.f;
                if (tj <= ti) {
#pragma unroll
                    for (int s = 0; s < 8; ++s) {
                        const bf16x8 a = *(const LAS bf16x8*)(lds + HG_LKE + (32 * tj + l32) * 272 + (16 * s + 8 * half) * 2);
                        const bf16x8 bq = *(const LAS bf16x8*)(lds + HG_LQE + (32 * ti + l32) * 272 + (16 * s + 8 * half) * 2);
                        acc = MFMA32(a, bq, acc);
                    }
                }
                const int ig = 32 * ti + l32;
#pragma unroll
                for (int g4 = 0; g4 < 4; ++g4) {
                    const int j0 = 32 * tj + 8 * g4 + 4 * half;
                    float v0 = acc[4 * g4], v1 = acc[4 * g4 + 1], v2 = acc[4 * g4 + 2], v3 = acc[4 * g4 + 3];
                    v0 = (j0 <= ig) ? v0 : 0.f; v1 = (j0 + 1 <= ig) ? v1 : 0.f; v2 = (j0 + 2 <= ig) ? v2 : 0.f; v3 = (j0 + 3 <= ig) ? v3 : 0.f;
                    *(LAS u32x2*)(lds + HG_LAT + ig * 144 + j0 * 2) = (u32x2){cvt_pk_bf16(v0, v1), cvt_pk_bf16(v2, v3)};
                }
            }
            {
                const int td = wave & 3, tc0 = (wave >> 2) * 2;
#pragma unroll
                for (int r = 0; r < 16; ++r) { const float sc = ((LAS float*)(lds + HG_LBL))[32 * td + crow(r, half)]; S0[r] *= sc; S1[r] *= sc; }
#pragma unroll
                for (int s = 0; s < 4; ++s) {
                    const bf16x8 a = *(const LAS bf16x8*)(lds + HG_LKTT + (32 * td + l32) * 144 + (16 * s + 8 * half) * 2);
                    const bf16x8 b0 = *(const LAS bf16x8*)(lds + HG_LVT + (32 * tc0 + l32) * 144 + (16 * s + 8 * half) * 2);
                    const bf16x8 b1 = *(const LAS bf16x8*)(lds + HG_LVT + (32 * (tc0 + 1) + l32) * 144 + (16 * s + 8 * half) * 2);
                    S0 = MFMA32(a, b0, S0); S1 = MFMA32(a, b1, S1);
                }
            }
            __syncthreads();
            {
                const int ti = wave >> 2, tc = wave & 3;
                f32x16 acc;
#pragma unroll
                for (int r = 0; r < 16; ++r) acc[r] = 0.f;
#pragma unroll
                for (int s = 0; s < 4; ++s) {
                    const bf16x8 a = *(const LAS bf16x8*)(lds + HG_LAT + (32 * ti + l32) * 144 + (16 * s + 8 * half) * 2);
                    const bf16x8 bv = *(const LAS bf16x8*)(lds + HG_LVT + (32 * tc + l32) * 144 + (16 * s + 8 * half) * 2);
                    acc = MFMA32(a, bv, acc);
                }
#pragma unroll
                for (int s = 0; s < 8; ++s) {
                    const bf16x8 a = *(const LAS bf16x8*)(lds + HG_LQE + (32 * ti + l32) * 272 + (16 * s + 8 * half) * 2);
                    const bf16x8 bs = *(const LAS bf16x8*)(lds + HG_LST + (32 * tc + l32) * 272 + (16 * s + 8 * half) * 2);
                    acc = MFMA32(a, bs, acc);
                }
#pragma unroll
                for (int r = 0; r < 16; ++r) ((LAS float*)(lds + HG_LO + (32 * ti + crow(r, half)) * 528))[32 * tc + l32] = acc[r];
            }
            __syncthreads();
            {
                const int td = wave & 3, tc0 = (wave >> 2) * 2;
#pragma unroll
                for (int g4 = 0; g4 < 4; ++g4) {
                    const int d0 = 32 * td + 8 * g4 + 4 * half;
                    *(LAS u32x2*)(lds + HG_LST + (32 * tc0 + l32) * 272 + d0 * 2) = (u32x2){cvt_pk_bf16(S0[4 * g4], S0[4 * g4 + 1]), cvt_pk_bf16(S0[4 * g4 + 2], S0[4 * g4 + 3])};
                    *(LAS u32x2*)(lds + HG_LST + (32 * (tc0 + 1) + l32) * 272 + d0 * 2) = (u32x2){cvt_pk_bf16(S1[4 * g4], S1[4 * g4 + 1]), cvt_pk_bf16(S1[4 * g4 + 2], S1[4 * g4 + 3])};
                }
            }
            {
                const int i = tid >> 3, seg = tid & 7;
                f32x4 ov[4]; float ss = 0.f;
#pragma unroll
                for (int q = 0; q < 4; ++q) { ov[q] = *(const LAS f32x4*)(lds + HG_LO + i * 528 + seg * 64 + q * 16); ss += (ov[q][0] * ov[q][0] + ov[q][1] * ov[q][1]) + (ov[q][2] * ov[q][2] + ov[q][3] * ov[q][3]); }
                ss = dpp_addx<0xB1, 0xf>(ss); ss = dpp_addx<0x4E, 0xf>(ss); ss = dpp_addx<0x141, 0xf>(ss);
                const float rstd = __builtin_amdgcn_rsqf(ss * (1.0f / 128.0f) + LN_EPS);
                const size_t row = (size_t)(b * T + n * 64 + i);
                const u32x4 g0 = gc0, g1 = gc1;
                const unsigned gw_[8] = {g0.x, g0.y, g0.z, g0.w, g1.x, g1.y, g1.z, g1.w};
                unsigned ow[8];
#pragma unroll
                for (int q = 0; q < 4; ++q) { const f32x4 ng = *(const f32x4*)(norm_g + seg * 16 + q * 4);
                    ow[2 * q] = cvt_pk_bf16(ov[q][0] * rstd * ng[0] * bflo(gw_[2 * q]), ov[q][1] * rstd * ng[1] * bfhi(gw_[2 * q]));
                    ow[2 * q + 1] = cvt_pk_bf16(ov[q][2] * rstd * ng[2] * bflo(gw_[2 * q + 1]), ov[q][3] * rstd * ng[3] * bfhi(gw_[2 * q + 1])); }
                *(u32x4*)(OG + row * D + h * 128 + seg * 16) = (u32x4){ow[0], ow[1], ow[2], ow[3]}; *(u32x4*)(OG + row * D + h * 128 + seg * 16 + 8) = (u32x4){ow[4], ow[5], ow[6], ow[7]};
            }
            gc0 = gn0; gc1 = gn1;
            __syncthreads();
        }
    }
}


__device__ __forceinline__ void unpack8(const u32x4 w, float (&f)[8]) { f[0] = bflo(w.x); f[1] = bfhi(w.x); f[2] = bflo(w.y); f[3] = bfhi(w.y); f[4] = bflo(w.z); f[5] = bfhi(w.z); f[6] = bflo(w.w); f[7] = bfhi(w.w); }
__device__ __forceinline__ void rope_row(int m, bf16_t* ZB, bf16_t* QRB, const int* posi, LAS float* tb, int lane, bool write_k) {
    const float inv_me = exp2f(-(float)(lane & 31) * (13.287712379549449f / 32.0f));
    { const float pf = (float)posi[m]; float s1, c1; sincosf(pf * inv_me, &s1, &c1); if (lane < 32) { tb[lane] = c1; tb[32 + lane] = s1; } LDS_WAIT(); }
    if (lane < 48) {
        const bf16_t* zrow = ZB + (size_t)m * EVP;
        const int hs = lane >> 2, d0 = 8 * (lane & 3);
        const f32x4 ca = *(const LAS f32x4*)(tb + d0), cb = *(const LAS f32x4*)(tb + d0 + 4), sa = *(const LAS f32x4*)(tb + 32 + d0), sb = *(const LAS f32x4*)(tb + 32 + d0 + 4);
        const int scol = hs < 8 ? 1792 + hs * 64 : ((hs & 2) ? 2816 : 2560) + (hs & 1) * 64;
        const u32x4 a = *(const u32x4*)(zrow + scol + d0), bq = *(const u32x4*)(zrow + scol + 32 + d0);
        float x1[8], x2[8], o1[8], o2[8]; unpack8(a, x1); unpack8(bq, x2);
#pragma unroll
        for (int i = 0; i < 8; ++i) { const float c = i < 4 ? ca[i & 3] : cb[i & 3], sn = i < 4 ? sa[i & 3] : sb[i & 3]; o1[i] = x1[i] * c - x2[i] * sn; o2[i] = x2[i] * c + x1[i] * sn; }
        const u32x4 w1 = (u32x4){cvt_pk_bf16(o1[0], o1[1]), cvt_pk_bf16(o1[2], o1[3]), cvt_pk_bf16(o1[4], o1[5]), cvt_pk_bf16(o1[6], o1[7])}, w2 = (u32x4){cvt_pk_bf16(o2[0], o2[1]), cvt_pk_bf16(o2[2], o2[3]), cvt_pk_bf16(o2[4], o2[5]), cvt_pk_bf16(o2[6], o2[7])};
        if (hs < 8) { bf16_t* dst = QRB + (size_t)m * 512 + hs * 64 + d0; *(u32x4*)dst = w1; *(u32x4*)(dst + 32) = w2; }
        else if (write_k) { bf16_t* dst = ZB + (size_t)m * EVP + scol + d0; *(u32x4*)dst = w1; *(u32x4*)(dst + 32) = w2; }
    }
    LDS_WAIT();
}
__device__ __forceinline__ void cmpcomb_row(int rr, const float* HC, const float* cb, const float* cw2, bf16_t* KVC, LAS float* hs, int lane) {
    const int hq = rr & 1, n = (rr >> 1) & 255, bq_ = (rr >> 9) & 15, zsel = rr >> 13;
    float outv = 0.f;
    if (n < 255) {
        const float* ha = HC + ((size_t)zsel * 8192 + (size_t)(bq_ * 256 + n) * 2 + hq) * 256; const float* hb = ha + 2 * 256 + 128;
#pragma unroll
        for (int q = 0; q < 2; ++q) { const int c = lane + 64 * q; const float xx = ha[c] + hb[c] + cb[zsel * 128 + c];
            hs[c] = 0.5f * xx * (1.0f + tanhf(0.7978845608028654f * (xx + 0.044715f * xx * xx * xx))); }
        LDS_WAIT();
        const float* w2p = cw2 + (size_t)zsel * 128 * 64 + lane;
#pragma unroll 16
        for (int c = 0; c < 128; ++c) outv += hs[c] * w2p[c * 64];
        LDS_WAIT();
    }
    KVC[((size_t)(zsel * 32 + bq_ * 2 + hq) * 256 + n) * 64 + lane] = (bf16_t)(cvt_pk_bf16(outv, 0.f) & 0xffffu);
}
constexpr int LATE_CONV_ITEMS = 2048 + 4 * 512 + 2 * 128;
__device__ __forceinline__ void conv_late_item(int it, const float* odin, const float* odout, const float* evout, const float* gatew, const float* plew, unsigned char* ws, LAS float* scr, int lane);
constexpr int MOE_CONV_ITEMS = NEXP * 3 * 256;
__device__ __forceinline__ void conv_moe_item(const float* w1, const float* w3, const float* w2, int li, bf16_t* w13, bf16_t* w2t, LAS float* scr, int it, int lane);
constexpr int RW_LW = 0, RW_LKK = 16384, RW_LBB = 32768, RW_LK2 = 49152, RW_LWR = 65536, RW_LV = 81920, RW_LC = 90112, RW_LO = 90624;
template <int CTRL> __device__ __forceinline__ float dpp_b(float v) { return __builtin_bit_cast(float, __builtin_amdgcn_mov_dpp(__builtin_bit_cast(int, v), CTRL, 0xf, 0xf, true)); }
__device__ __forceinline__ float sum16b(float v) { v += dpp_b<0xB1>(v); v += dpp_b<0x4E>(v); v += dpp_b<0x141>(v); v += dpp_b<0x140>(v); return v; }
__device__ __forceinline__ float sum8b(float v) { v += dpp_b<0xB1>(v); v += dpp_b<0x4E>(v); v += dpp_b<0x141>(v); return v; }
__device__ __forceinline__ float afma(float a, float b, float c) { float d; asm("v_fma_f32 %0, %1, %2, %3" : "=v"(d) : "v"(a), "v"(b), "v"(c)); return d; }
__device__ __forceinline__ float anfma(float a, float b, float c) { float d; asm("v_fma_f32 %0, -%1, %2, %3" : "=v"(d) : "v"(a), "v"(b), "v"(c)); return d; }
__device__ __forceinline__ float amul(float a, float b) { float d; asm("v_mul_f32 %0, %1, %2" : "=v"(d) : "v"(a), "v"(b)); return d; }
struct RwRaw { u32x4 r, k, v, rp, kp, vp, a; f32x4 w0, w1, sc; };
__device__ __forceinline__ void rwkv_phase(LAS unsigned char* lds, const bf16_t* Z, const float* dec, const bf16_t* aa, const float* sc4, const float* mu, const float* k_k, const float* k_a, bf16_t* Y, int G, int bx,
                                           const float* mw1, const float* mw3, const float* mw2, bf16_t* w13, bf16_t* w2t, bool conv,
                                           const float* HC, const float* cb, const float* cw2, bf16_t* KVC, const float* pin, bf16_t* pbf0, bf16_t* pbf1, bf16_t* ZW, bf16_t* QRB, const int* posi,
                                           const float* lodin, const float* lodout, const float* levout, const float* lgate, const float* lple, unsigned char* wsb) {
    for (int unit = bx; unit < NB * 16; unit += G) {
        const int tid = pinned_tid();
        const int rowl = (tid >> 3) & 31, kc = tid & 7;
        const int sst = tid >> 3, c8 = (tid & 7) * 8;
        const int b = unit >> 4, h = (unit >> 1) & 7, rh = unit & 1, hc0 = h * 64 + c8;
        float p_mr[8], p_mk[8], p_mv[8], p_kk[8], p_ka[8];
#pragma unroll
        for (int i = 0; i < 8; ++i) { p_mr[i] = mu[hc0 + i]; p_mk[i] = mu[512 + hc0 + i]; p_mv[i] = mu[1024 + hc0 + i]; p_kk[i] = k_k[hc0 + i]; p_ka[i] = k_a[hc0 + i]; }
        float S[8];
#pragma unroll
        for (int i = 0; i < 8; ++i) S[i] = 0.f;
        RwRaw rw;
#define RW_LOAD(n_) do { const int t_ = (n_) * 64 + sst; const size_t row_ = (size_t)(b * T + t_); const bf16_t* zc_ = Z + row_ * EVP + hc0; \
            rw.r = *(const u32x4*)zc_; rw.k = *(const u32x4*)(zc_ + 512); rw.v = *(const u32x4*)(zc_ + 1024); \
            if (t_ > 0) { rw.rp = *(const u32x4*)(zc_ - EVP); rw.kp = *(const u32x4*)(zc_ + 512 - EVP); rw.vp = *(const u32x4*)(zc_ + 1024 - EVP); } else { rw.rp = (u32x4){0u, 0u, 0u, 0u}; rw.kp = rw.rp; rw.vp = rw.rp; } \
            rw.a = *(const u32x4*)(aa + row_ * 512 + hc0); rw.w0 = *(const f32x4*)(dec + row_ * 512 + hc0); rw.w1 = *(const f32x4*)(dec + row_ * 512 + hc0 + 4); rw.sc = *(const f32x4*)(sc4 + (row_ * 8 + h) * 4); } while (0)
#define RW_FINISH() do { float r_[8], k_[8], v_[8], rp_[8], kp_[8], vp_[8], a_[8]; unpack8(rw.r, r_); unpack8(rw.k, k_); unpack8(rw.v, v_); unpack8(rw.rp, rp_); unpack8(rw.kp, kp_); unpack8(rw.vp, vp_); unpack8(rw.a, a_); \
            float ow_[8], oq_[8], ob_[8], ok_[8], ou_[8], ov_[8]; \
            _Pragma("unroll") for (int i = 0; i < 8; ++i) { const float rr = r_[i] + p_mr[i] * (rp_[i] - r_[i]), k0 = k_[i] + p_mk[i] * (kp_[i] - k_[i]), vv = v_[i] + p_mv[i] * (vp_[i] - v_[i]), w = i < 4 ? rw.w0[i & 3] : rw.w1[i & 3]; \
                const float kk = k0 * p_kk[i] * rw.sc[0]; ow_[i] = w; oq_[i] = kk; ob_[i] = kk * a_[i]; ok_[i] = k0 * (1.0f + (a_[i] - 1.0f) * p_ka[i]); ou_[i] = w * rr; ov_[i] = vv; } \
            LAS float* d_ = (LAS float*)(lds + sst * 256 + c8 * 4); \
            *(LAS f32x4*)(d_ + RW_LW / 4) = (f32x4){ow_[0], ow_[1], ow_[2], ow_[3]}; *(LAS f32x4*)(d_ + RW_LW / 4 + 4) = (f32x4){ow_[4], ow_[5], ow_[6], ow_[7]}; \
            *(LAS f32x4*)(d_ + RW_LKK / 4) = (f32x4){oq_[0], oq_[1], oq_[2], oq_[3]}; *(LAS f32x4*)(d_ + RW_LKK / 4 + 4) = (f32x4){oq_[4], oq_[5], oq_[6], oq_[7]}; \
            *(LAS f32x4*)(d_ + RW_LBB / 4) = (f32x4){ob_[0], ob_[1], ob_[2], ob_[3]}; *(LAS f32x4*)(d_ + RW_LBB / 4 + 4) = (f32x4){ob_[4], ob_[5], ob_[6], ob_[7]}; \
            *(LAS f32x4*)(d_ + RW_LK2 / 4) = (f32x4){ok_[0], ok_[1], ok_[2], ok_[3]}; *(LAS f32x4*)(d_ + RW_LK2 / 4 + 4) = (f32x4){ok_[4], ok_[5], ok_[6], ok_[7]}; \
            *(LAS f32x4*)(d_ + RW_LWR / 4) = (f32x4){ou_[0], ou_[1], ou_[2], ou_[3]}; *(LAS f32x4*)(d_ + RW_LWR / 4 + 4) = (f32x4){ou_[4], ou_[5], ou_[6], ou_[7]}; \
            if ((c8 >> 5) == rh) { LAS float* dv_ = (LAS float*)(lds + RW_LV + sst * 128 + (c8 & 31) * 4); *(LAS f32x4*)dv_ = (f32x4){ov_[0], ov_[1], ov_[2], ov_[3]}; *(LAS f32x4*)(dv_ + 4) = (f32x4){ov_[4], ov_[5], ov_[6], ov_[7]}; } \
            if (c8 == 0) *(LAS f32x2*)(lds + RW_LC + sst * 8) = (f32x2){rw.sc[1], rw.sc[2]}; } while (0)
        RW_LOAD(0);
        RW_FINISH();
        __syncthreads();
        for (int n = 0; n < T / 64; ++n) {
            if (n + 1 < T / 64) RW_LOAD(n + 1);
            if (tid >= 256) {
                if (conv) rope_row(n * (G * 4) + bx * 4 + ((tid >> 6) - 4), ZW, QRB, posi, (LAS float*)(lds + 100 * 1024 + 4 * 8704 + ((tid >> 6) - 4) * 256), tid & 63, true);
                const int it_ = n * (G * 4) + bx * 4 + ((tid >> 6) - 4);
                if (conv && it_ < MOE_CONV_ITEMS) conv_moe_item(mw1, mw3, mw2, 0, w13, w2t, (LAS float*)(lds + 100 * 1024 + ((tid >> 6) - 4) * 8704), it_, tid & 63);
                else if (conv && it_ - MOE_CONV_ITEMS < 2 * 16 * 256 * 2) cmpcomb_row(it_ - MOE_CONV_ITEMS, HC, cb, cw2, KVC, (LAS float*)(lds + 100 * 1024 + ((tid >> 6) - 4) * 8704), tid & 63);
                else if (conv && n >= 56) { const int li_ = (n - 56) * (G * 4) + bx * 4 + ((tid >> 6) - 4);
                    if (li_ < LATE_CONV_ITEMS) conv_late_item(li_, lodin, lodout, levout, lgate, lple, wsb, (LAS float*)(lds + 100 * 1024 + ((tid >> 6) - 4) * 8704), tid & 63); }
                else if (conv && n >= 40 && n < 56) {
                    const int lane_ = tid & 63, w_ = (n - 40) * (G * 4) + bx * 4 + ((tid >> 6) - 4);
#pragma unroll
                    for (int q = 0; q < 8; ++q) { const int row = w_ * 8 + q; const f32x4 v = *((const f32x4*)(pin + (size_t)row * PLE) + lane_);
                        bf16_t* dst = row < M ? pbf0 + (size_t)row * PLE : pbf1 + (size_t)(row - M) * PLE; *((u32x2*)dst + lane_) = (u32x2){cvt_pk_bf16(v[0], v[1]), cvt_pk_bf16(v[2], v[3])}; }
                }
            }
            if (tid < 256) {
            f32x4 cw0 = *(const LAS f32x4*)(lds + RW_LW + kc * 32), cw1 = *(const LAS f32x4*)(lds + RW_LW + kc * 32 + 16), cq0 = *(const LAS f32x4*)(lds + RW_LKK + kc * 32), cq1 = *(const LAS f32x4*)(lds + RW_LKK + kc * 32 + 16),
                  cb0 = *(const LAS f32x4*)(lds + RW_LBB + kc * 32), cb1 = *(const LAS f32x4*)(lds + RW_LBB + kc * 32 + 16), ck0 = *(const LAS f32x4*)(lds + RW_LK2 + kc * 32), ck1 = *(const LAS f32x4*)(lds + RW_LK2 + kc * 32 + 16),
                  cu0 = *(const LAS f32x4*)(lds + RW_LWR + kc * 32), cu1 = *(const LAS f32x4*)(lds + RW_LWR + kc * 32 + 16);
            float cv = ((const LAS float*)(lds + RW_LV))[rowl]; f32x2 cc = *(const LAS f32x2*)(lds + RW_LC);
            LAS float* const obase = (kc == 0 ? (LAS float*)(lds + RW_LO) : (LAS float*)(lds + 136 * 1024)) + rowl;
#if PROBE_DUP == 10
            float T0[8];
#pragma unroll
            for (int i = 0; i < 8; ++i) T0[i] = S[i];
            for (int rep_ = 0; rep_ < 2; ++rep_) {
            if (rep_ == 1) {
#pragma unroll
                for (int i = 0; i < 8; ++i) S[i] = T0[i]; }
#endif
#pragma unroll 4
            for (int st = 0; st < 64; ++st) {
                const int sn = (st + 1) & 63;
                const f32x4 nw0 = *(const LAS f32x4*)(lds + RW_LW + sn * 256 + kc * 32), nw1 = *(const LAS f32x4*)(lds + RW_LW + sn * 256 + kc * 32 + 16), nq0 = *(const LAS f32x4*)(lds + RW_LKK + sn * 256 + kc * 32), nq1 = *(const LAS f32x4*)(lds + RW_LKK + sn * 256 + kc * 32 + 16),
                            nb0 = *(const LAS f32x4*)(lds + RW_LBB + sn * 256 + kc * 32), nb1 = *(const LAS f32x4*)(lds + RW_LBB + sn * 256 + kc * 32 + 16), nk0 = *(const LAS f32x4*)(lds + RW_LK2 + sn * 256 + kc * 32), nk1 = *(const LAS f32x4*)(lds + RW_LK2 + sn * 256 + kc * 32 + 16),
                            nu0 = *(const LAS f32x4*)(lds + RW_LWR + sn * 256 + kc * 32), nu1 = *(const LAS f32x4*)(lds + RW_LWR + sn * 256 + kc * 32 + 16);
                const float nv = ((const LAS float*)(lds + RW_LV))[sn * 32 + rowl]; const f32x2 nc = *(const LAS f32x2*)(lds + RW_LC + sn * 8);
                float sa = afma(S[3], cq0[3], afma(S[2], cq0[2], afma(S[1], cq0[1], amul(S[0], cq0[0])))), sa2 = afma(S[7], cq1[3], afma(S[6], cq1[2], afma(S[5], cq1[1], amul(S[4], cq1[0]))));
                float oo = afma(S[3], cu0[3], afma(S[2], cu0[2], afma(S[1], cu0[1], amul(S[0], cu0[0])))), oo2 = afma(S[7], cu1[3], afma(S[6], cu1[2], afma(S[5], cu1[1], amul(S[4], cu1[0]))));
                sa = sum8b(sa + sa2); oo = sum8b(oo + oo2);
                obase[st * 32] = afma(cv, cc[1], anfma(sa, cc[0], oo));
#pragma unroll
                for (int i = 0; i < 4; ++i) { S[i] = afma(S[i], cw0[i], anfma(sa, cb0[i], amul(cv, ck0[i]))); S[4 + i] = afma(S[4 + i], cw1[i], anfma(sa, cb1[i], amul(cv, ck1[i]))); }
                cw0 = nw0; cw1 = nw1; cq0 = nq0; cq1 = nq1; cb0 = nb0; cb1 = nb1; ck0 = nk0; ck1 = nk1; cu0 = nu0; cu1 = nu1; cv = nv; cc = nc;
            }
#if PROBE_DUP == 10
            }
#endif
            }
            __syncthreads();
            { const int st = tid >> 3, r4 = (tid & 7) * 4; const f32x4 o = *(const LAS f32x4*)(lds + RW_LO + st * 128 + r4 * 4);
              *(u32x2*)(Y + (size_t)(b * T + n * 64 + st) * D + h * 64 + rh * 32 + r4) = (u32x2){cvt_pk_bf16(o[0], o[1]), cvt_pk_bf16(o[2], o[3])}; }
            if (n + 1 < T / 64) RW_FINISH();
            __syncthreads();
        }
#undef RW_LOAD
#undef RW_FINISH
    }
}

typedef short s16x4 __attribute__((ext_vector_type(4)));
constexpr int AT_KS = 144, AT_VS = 192, AT_KT = 64 * AT_KS, AT_VT = 64 * AT_VS;
constexpr int AT_LK = 0, AT_LV = 4 * AT_KT, AT_LIT = AT_LV + 4 * AT_VT, AT_LIH = AT_LIT + 16384, AT_LSM = AT_LIH + 16384, AT_LKEY = AT_LSM + 512, AT_LEND = AT_LKEY + 32768;
static_assert(AT_LEND <= 163840 - 512, "attention lds");
constexpr float AT_C = 0.125f * 1.4426950408889634f;
constexpr float AT_NEG = -1.0e30f;
__device__ __forceinline__ void qk_tile(const LAS unsigned char* Kt, const bf16x8 (&Q)[4], int l32, int half, f32x16& s0, f32x16& s1) {
#pragma unroll
    for (int r = 0; r < 16; ++r) { s0[r] = 0.f; s1[r] = 0.f; }
#pragma unroll
    for (int s = 0; s < 4; ++s) {
        const bf16x8 a0 = *(const LAS bf16x8*)(Kt + l32 * AT_KS + (16 * s + 8 * half) * 2), a1 = *(const LAS bf16x8*)(Kt + (32 + l32) * AT_KS + (16 * s + 8 * half) * 2);
        s0 = MFMA32(a0, Q[s], s0); s1 = MFMA32(a1, Q[s], s1);
    }
}
#define AT_TR4(vb, OFF, r00, r01, r10, r11) asm volatile("ds_read_b64_tr_b16 %0, %4 offset:%5\n\tds_read_b64_tr_b16 %1, %4 offset:%6\n\tds_read_b64_tr_b16 %2, %4 offset:%7\n\tds_read_b64_tr_b16 %3, %4 offset:%8\n\ts_waitcnt lgkmcnt(0)" \
    : "=&v"(r00), "=&v"(r01), "=&v"(r10), "=&v"(r11) : "v"(vb), "i"(OFF), "i"((OFF) + 8 * AT_VS), "i"((OFF) + 64), "i"((OFF) + 8 * AT_VS + 64) : "memory")
__device__ __forceinline__ bf16x8 pack8(const f32x16& p, int s2) {
    u32x4 w; w.x = cvt_pk_bf16(p[8 * s2], p[8 * s2 + 1]); w.y = cvt_pk_bf16(p[8 * s2 + 2], p[8 * s2 + 3]); w.z = cvt_pk_bf16(p[8 * s2 + 4], p[8 * s2 + 5]); w.w = cvt_pk_bf16(p[8 * s2 + 6], p[8 * s2 + 7]);
    return __builtin_bit_cast(bf16x8, w);
}
#define AT_TR8(vb, OFF, r0, r1, r2, r3, r4, r5, r6, r7) asm volatile("ds_read_b64_tr_b16 %0, %8 offset:%9\n\tds_read_b64_tr_b16 %1, %8 offset:%10\n\tds_read_b64_tr_b16 %2, %8 offset:%11\n\tds_read_b64_tr_b16 %3, %8 offset:%12\n\t" \
    "ds_read_b64_tr_b16 %4, %8 offset:%13\n\tds_read_b64_tr_b16 %5, %8 offset:%14\n\tds_read_b64_tr_b16 %6, %8 offset:%15\n\tds_read_b64_tr_b16 %7, %8 offset:%16\n\ts_waitcnt lgkmcnt(0)" \
    : "=&v"(r0), "=&v"(r1), "=&v"(r2), "=&v"(r3), "=&v"(r4), "=&v"(r5), "=&v"(r6), "=&v"(r7) \
    : "v"(vb), "i"(OFF), "i"((OFF) + 8 * AT_VS), "i"((OFF) + 64), "i"((OFF) + 8 * AT_VS + 64), "i"((OFF) + 16 * AT_VS), "i"((OFF) + 24 * AT_VS), "i"((OFF) + 16 * AT_VS + 64), "i"((OFF) + 24 * AT_VS + 64) : "memory")
__device__ __forceinline__ void pv_tile(unsigned vb, const f32x16& p0, const f32x16& p1, f32x16& O0, f32x16& O1, bool zero_all) {
    s16x4 r0, r1, r2, r3, r4, r5, r6, r7;
    const bf16x8 zf = (bf16x8){0, 0, 0, 0, 0, 0, 0, 0};
#define AT_PV2(P, OFF) { bf16x8 b0 = pack8(P, 0), b1 = pack8(P, 1); if (zero_all) { b0 = zf; b1 = zf; } AT_TR8(vb, OFF, r0, r1, r2, r3, r4, r5, r6, r7); \
        const bf16x8 a00 = __builtin_shufflevector(r0, r1, 0, 1, 2, 3, 4, 5, 6, 7), a01 = __builtin_shufflevector(r2, r3, 0, 1, 2, 3, 4, 5, 6, 7), a10 = __builtin_shufflevector(r4, r5, 0, 1, 2, 3, 4, 5, 6, 7), a11 = __builtin_shufflevector(r6, r7, 0, 1, 2, 3, 4, 5, 6, 7); \
        O0 = MFMA32(a00, b0, O0); O1 = MFMA32(a01, b0, O1); O0 = MFMA32(a10, b1, O0); O1 = MFMA32(a11, b1, O1); }
    AT_PV2(p0, 0) AT_PV2(p1, 32 * AT_VS)
#undef AT_PV2
}
template <int CTRL> __device__ __forceinline__ float dppq(float v) { return __builtin_bit_cast(float, __builtin_amdgcn_update_dpp(0, __builtin_bit_cast(int, v), CTRL, 0xf, 0xf, false)); }
__device__ __forceinline__ float sum4(float v) { v += dppq<0xB1>(v); v += dppq<0x4E>(v); return v; }
__device__ __forceinline__ void xhalf_swap(float& a, float& b) { asm volatile("s_nop 1\n\tv_permlane32_swap_b32 %0, %1\n\ts_nop 1" : "+v"(a), "+v"(b)); }
__device__ __forceinline__ float xhalf_max(float v) { float a = v, b = v; xhalf_swap(a, b); return fmaxf(a, b); }
__device__ __forceinline__ float xhalf_sum(float v) { float a = v, b = v; xhalf_swap(a, b); return a + b; }
constexpr float AT_THR = 8.0f / AT_C;
template <int MODE>
__device__ __forceinline__ void attn_tile(const LAS unsigned char* Kt, unsigned vb, const bf16x8 (&Q)[4], int l32, int half, bool on, bool edge, int dbase, float& mrun, float& lrun, f32x16& O0, f32x16& O1) {
    f32x16 s0, s1;
    qk_tile(Kt, Q, l32, half, s0, s1);
#if PROBE_DUP == 33
    { float keep_ = s0[0]; asm volatile("" : "+v"(keep_)); qk_tile(Kt, Q, l32, half, s0, s1); s0[0] = 0.5f * (s0[0] + keep_); }
#endif
    if (edge) {
#pragma unroll
        for (int r = 0; r < 16; ++r) {
            const int d0 = dbase - ((r & 3) + 8 * (r >> 2)), d1 = d0 - 32;
            const bool v0 = (MODE == 1 ? d0 >= 0 : (unsigned)d0 < 512u), v1 = (MODE == 1 ? d1 >= 0 : (unsigned)d1 < 512u);
            s0[r] = v0 ? s0[r] : AT_NEG; s1[r] = v1 ? s1[r] : AT_NEG;
        }
    }
    float mt = fmaxf(__builtin_fmaxf(s0[0], s1[0]), AT_NEG);
#pragma unroll
    for (int r = 1; r < 16; ++r) mt = fmaxf(mt, fmaxf(s0[r], s1[r]));
    mt = on ? mt : AT_NEG;
    mt = xhalf_max(mt);
    if (__any(mt > mrun + AT_THR)) {
        const float mnew = fmaxf(mrun, mt), alpha = __builtin_amdgcn_exp2f(AT_C * (mrun - mnew)); mrun = mnew; lrun *= alpha;
#pragma unroll
        for (int r = 0; r < 16; ++r) { O0[r] *= alpha; O1[r] *= alpha; }
    }
    const float mc = mrun * AT_C;
    f32x16 p0, p1;
#pragma unroll
    for (int r = 0; r < 16; ++r) { p0[r] = __builtin_amdgcn_exp2f(__builtin_fmaf(s0[r], AT_C, -mc)); p1[r] = __builtin_amdgcn_exp2f(__builtin_fmaf(s1[r], AT_C, -mc)); }
#if PROBE_DUP == 34
    { float mc2 = mc; asm volatile("" : "+v"(mc2));
#pragma unroll
      for (int r = 0; r < 16; ++r) { p0[r] = 0.5f * (p0[r] + __builtin_amdgcn_exp2f(__builtin_fmaf(s0[r], AT_C, -mc2))); p1[r] = 0.5f * (p1[r] + __builtin_amdgcn_exp2f(__builtin_fmaf(s1[r], AT_C, -mc2))); } }
#endif
    if (edge) {
#pragma unroll
        for (int r = 0; r < 16; ++r) { p0[r] = s0[r] > 0.5f * AT_NEG ? p0[r] : 0.f; p1[r] = s1[r] > 0.5f * AT_NEG ? p1[r] : 0.f; }
    }
    float ps = 0.f;
#pragma unroll
    for (int r = 0; r < 16; ++r) ps += p0[r] + p1[r];
    lrun += on ? ps : 0.f;
#if PROBE_DUP == 35
#pragma unroll
    for (int r = 0; r < 16; ++r) { p0[r] *= 0.5f; p1[r] *= 0.5f; }
    pv_tile(vb, p0, p1, O0, O1, !on);
#endif
    pv_tile(vb, p0, p1, O0, O1, !on);
}
template <int MODE>
__device__ __forceinline__ void attn_stream(LAS unsigned char* lds, const bf16_t* Kg, const bf16_t* Vg, int jlo, int cur, int tokl, const bf16x8 (&Q)[4], unsigned selm_lo, unsigned selm_hi,
                                            int tid, int l32, int half, unsigned vb0, f32x16& O0, f32x16& O1, float& lout) {
    const int key = tid >> 3, chunk = tid & 7;
    const size_t goff = (size_t)key * EVP + chunk * 8;
    const unsigned kofs = key * AT_KS + chunk * 16, vofs = key * AT_VS + chunk * 16;
#define AT_GLD(kr, vr, jj) do { const int j_ = (jj) <= cur ? (jj) : cur; kr = *(const u32x4*)(Kg + (size_t)j_ * 64 * EVP + goff); vr = *(const u32x4*)(Vg + (size_t)j_ * 64 * EVP + goff); } while (0)
#define AT_LST(kr, vr, jj) do { const int nb_ = (jj) & 3; *(LAS u32x4*)(lds + AT_LK + nb_ * AT_KT + kofs) = kr; *(LAS u32x4*)(lds + AT_LV + nb_ * AT_VT + vofs) = vr; } while (0)
    u32x4 ka, va, kb, vb;
    AT_GLD(ka, va, jlo); AT_GLD(kb, vb, jlo + 1);
    AT_LST(ka, va, jlo); AT_LST(kb, vb, jlo + 1);
    __syncthreads();
    float mrun = AT_NEG, lrun = 0.f;
#pragma unroll
    for (int r = 0; r < 16; ++r) { O0[r] = 0.f; O1[r] = 0.f; }
    for (int j = jlo; j <= cur; j += 2) {
        AT_GLD(ka, va, j + 2); AT_GLD(kb, vb, j + 3);
#pragma unroll
        for (int u = 0; u < 2; ++u) {
            const int jj = j + u;
            if (jj <= cur) {
                const int buf = jj & 3;
                bool on = true;
                if (MODE == 1) on = ((jj < 32 ? (selm_lo >> jj) : (selm_hi >> (jj - 32))) & 1u) != 0u;
                const int dbase = (cur - jj) * 64 + tokl - 4 * half;
                const bool edge = (jj == cur) || (MODE == 2 && cur >= 8 && jj == jlo);
                if (MODE != 1 || __any(on)) attn_tile<MODE>(lds + AT_LK + buf * AT_KT, vb0 + buf * AT_VT, Q, l32, half, on, edge, dbase, mrun, lrun, O0, O1);
            }
        }
        AT_LST(ka, va, j + 2); AT_LST(kb, vb, j + 3);
        __syncthreads();
    }
#undef AT_GLD
#undef AT_LST
    lout = xhalf_sum(lrun);
}

__device__ __forceinline__ void nsa_attn_phase(LAS unsigned char* lds, const bf16_t* Z, const bf16_t* QR, const bf16_t* KVC, bf16_t* Y, int G, int bx) {
    for (int it = 0;; ++it) {
        const int L = it * G + bx; if (L >= NB * 2 * 64) break;
        const int tid = pinned_tid(), lane = tid & 63, wave = __builtin_amdgcn_readfirstlane(tid >> 6), half = lane >> 5, l32 = lane & 31;
        const unsigned vb0 = (unsigned)(AT_LV + (4 * half + ((lane & 15) >> 2)) * AT_VS + (16 * ((lane >> 4) & 1) + 4 * (lane & 3)) * 2);
        const int tokl = 8 * wave + (l32 >> 2), g = l32 & 3;
        const int qt = (G == 256) ? 63 - (8 * it + ((it & 1) ? 7 - (bx >> 5) : (bx >> 5))) : 63 - (L >> 5);
        const int bh = L & 31, b = bh >> 1, hk = bh & 1, t0 = qt * 64, t = t0 + tokl, head = hk * 4 + g, cur = qt;
        const size_t m = (size_t)b * T + t;
        bf16x8 Qraw[4], Qrot[4];
#pragma unroll
        for (int s = 0; s < 4; ++s) { Qraw[s] = *(const bf16x8*)(Z + m * EVP + 1792 + head * 64 + 16 * s + 8 * half); Qrot[s] = *(const bf16x8*)(QR + m * 512 + head * 64 + 16 * s + 8 * half); }
        const float gate_c = sigmoidf_(bf2f(Z[m * EVP + 3072 + head * 3])), gate_s = sigmoidf_(bf2f(Z[m * EVP + 3072 + head * 3 + 1])), gate_w = sigmoidf_(bf2f(Z[m * EVP + 3072 + head * 3 + 2]));
        f32x16 Y0, Y1;
        const int nct = (4 * qt + 3 + 63) >> 6;
        unsigned selm_lo = 0u, selm_hi = 0u;
        for (int repc_ = 0; repc_ < (PROBE_DUP == 30 ? 2 : 1); ++repc_) {
        { const int key = tid >> 3, chunk = tid & 7; const bf16_t* kc = KVC + ((size_t)(b * 2 + hk) * 256) * 64; const bf16_t* vc = kc + (size_t)32 * 256 * 64;
          for (int jt = 0; jt < nct; ++jt) { *(LAS u32x4*)(lds + AT_LK + jt * AT_KT + key * AT_KS + chunk * 16) = *(const u32x4*)(kc + (size_t)(jt * 64 + key) * 64 + chunk * 8);
                                             *(LAS u32x4*)(lds + AT_LV + jt * AT_VT + key * AT_VS + chunk * 16) = *(const u32x4*)(vc + (size_t)(jt * 64 + key) * 64 + chunk * 8); }
#pragma unroll
          for (int q = 0; q < 8; ++q) { ((LAS float*)(lds + AT_LIT))[(8 * wave + q) * 64 + lane] = 0.f; ((LAS float*)(lds + AT_LIH))[(8 * wave + q) * 64 + lane] = 0.f; } }
        __syncthreads();
        {
            const int nvalid = t >= 31 ? ((t - 31) >> 4) + 1 : 0;
            float mrun = AT_NEG, lrun = 0.f;
            for (int jt = 0; jt < nct; ++jt) {
                f32x16 s0, s1; qk_tile(lds + AT_LK + jt * AT_KT, Qraw, l32, half, s0, s1);
                const int nb = nvalid - 64 * jt - 4 * half;
                float mt = AT_NEG;
#pragma unroll
                for (int r = 0; r < 16; ++r) { const int o = (r & 3) + 8 * (r >> 2); s0[r] = o < nb ? s0[r] : AT_NEG; s1[r] = o + 32 < nb ? s1[r] : AT_NEG; mt = fmaxf(mt, fmaxf(s0[r], s1[r])); }
                mt = xhalf_max(mt);
                const float mnew = fmaxf(mrun, mt); lrun *= __builtin_amdgcn_exp2f(AT_C * (mrun - mnew)); mrun = mnew;
#pragma unroll
                for (int r = 0; r < 16; ++r) { lrun += (s0[r] > 0.5f * AT_NEG ? __builtin_amdgcn_exp2f(AT_C * (s0[r] - mnew)) : 0.f) + (s1[r] > 0.5f * AT_NEG ? __builtin_amdgcn_exp2f(AT_C * (s1[r] - mnew)) : 0.f); }
            }
            const float lt = xhalf_sum(lrun), inv = lt > 0.f ? 1.0f / lt : 0.f;
            f32x16 O0, O1;
#pragma unroll
            for (int r = 0; r < 16; ++r) { O0[r] = 0.f; O1[r] = 0.f; }
            for (int jt = 0; jt < nct; ++jt) {
                f32x16 s0, s1; qk_tile(lds + AT_LK + jt * AT_KT, Qraw, l32, half, s0, s1);
                const int nb = nvalid - 64 * jt - 4 * half;
#pragma unroll
                for (int r = 0; r < 16; ++r) { const int o = (r & 3) + 8 * (r >> 2); s0[r] = o < nb ? __builtin_amdgcn_exp2f(AT_C * (s0[r] - mrun)) * inv : 0.f; s1[r] = o + 32 < nb ? __builtin_amdgcn_exp2f(AT_C * (s1[r] - mrun)) * inv : 0.f; }
#pragma unroll
                for (int g4 = 0; g4 < 4; ++g4) {
                    const float ta = sum4((s0[4 * g4] + s0[4 * g4 + 1]) + (s0[4 * g4 + 2] + s0[4 * g4 + 3])), ha = sum4(0.5f * s0[4 * g4 + 3]);
                    const float tb = sum4((s1[4 * g4] + s1[4 * g4 + 1]) + (s1[4 * g4 + 2] + s1[4 * g4 + 3])), hb = sum4(0.5f * s1[4 * g4 + 3]);
                    if (g == 0) { const int sa = 16 * jt + 2 * g4 + half; ((LAS float*)(lds + AT_LIT))[tokl * 64 + sa] = ta; ((LAS float*)(lds + AT_LIH))[tokl * 64 + sa] = ha;
                                  ((LAS float*)(lds + AT_LIT))[tokl * 64 + sa + 8] = tb; ((LAS float*)(lds + AT_LIH))[tokl * 64 + sa + 8] = hb; }
                }
                pv_tile(vb0 + jt * AT_VT, s0, s1, O0, O1, false);
            }
#pragma unroll
            for (int r = 0; r < 16; ++r) { Y0[r] = gate_c * O0[r]; Y1[r] = gate_c * O1[r]; }
        }
        {
            LDS_WAIT();
            const int tk = 8 * wave + (lane >> 3), sb = (lane & 7) * 8;
            float v[8];
#pragma unroll
            for (int i = 0; i < 8; ++i) { const int sidx = sb + i;
                float x = ((const LAS float*)(lds + AT_LIT))[tk * 64 + sidx] - ((const LAS float*)(lds + AT_LIH))[tk * 64 + sidx];
                if (sidx > 0) x += ((const LAS float*)(lds + AT_LIH))[tk * 64 + sidx - 1];
                if (sidx == 0 || sidx == cur || sidx == cur - 1) x = 3.0e38f; else if (sidx > cur) x = -3.0e38f;
                v[i] = x; }
            unsigned long long key[8];
#pragma unroll
            for (int i = 0; i < 8; ++i) { const unsigned u = __float_as_uint(v[i]), mu_ = (u & 0x80000000u) ? ~u : (u | 0x80000000u); key[i] = ((unsigned long long)mu_ << 32) | (unsigned)(63 - (sb + i));
                ((LAS unsigned long long*)(lds + AT_LKEY))[tk * 64 + sb + i] = key[i]; }
            LDS_WAIT();
            int rank[8];
#pragma unroll
            for (int i = 0; i < 8; ++i) rank[i] = 0;
#pragma unroll 4
            for (int sp = 0; sp < 64; ++sp) { const unsigned long long x = ((const LAS unsigned long long*)(lds + AT_LKEY))[tk * 64 + sp];
#pragma unroll
                for (int i = 0; i < 8; ++i) rank[i] += (x > key[i]) ? 1 : 0; }
            unsigned byte = 0u;
#pragma unroll
            for (int i = 0; i < 8; ++i) byte |= (rank[i] < 16 && sb + i <= cur) ? (1u << i) : 0u;
            ((LAS unsigned char*)(lds + AT_LSM))[tk * 8 + (lane & 7)] = (unsigned char)byte;
            LDS_WAIT();
            const u32x2 sm = *(const LAS u32x2*)(lds + AT_LSM + tokl * 8); selm_lo = sm.x; selm_hi = sm.y;
        }
        __syncthreads();
        }
        const bf16_t* zb = Z + ((size_t)b * T) * EVP + hk * 64;
        {
            f32x16 O0, O1; float lt;
            for (int rep_ = 0; rep_ < (PROBE_DUP == 31 ? 2 : 1); ++rep_) attn_stream<1>(lds, zb + 2560, zb + 2688, 0, cur, tokl, Qrot, selm_lo, selm_hi, tid, l32, half, vb0, O0, O1, lt);
            const float sc = lt > 0.f ? gate_s / lt : 0.f;
#pragma unroll
            for (int r = 0; r < 16; ++r) { Y0[r] += sc * O0[r]; Y1[r] += sc * O1[r]; }
        }
        {
            f32x16 O0, O1; float lt;
            for (int rep_ = 0; rep_ < (PROBE_DUP == 32 ? 2 : 1); ++rep_) attn_stream<2>(lds, zb + 2816, zb + 2944, cur >= 8 ? cur - 8 : 0, cur, tokl, Qrot, 0u, 0u, tid, l32, half, vb0, O0, O1, lt);
            const float sc = lt > 0.f ? gate_w / lt : 0.f;
#pragma unroll
            for (int r = 0; r < 16; ++r) { Y0[r] += sc * O0[r]; Y1[r] += sc * O1[r]; }
        }
        bf16_t* yo = Y + m * D + 512 + head * 64;
#pragma unroll
        for (int g4 = 0; g4 < 4; ++g4) {
            *(u32x2*)(yo + 8 * g4 + 4 * half) = (u32x2){cvt_pk_bf16(Y0[4 * g4], Y0[4 * g4 + 1]), cvt_pk_bf16(Y0[4 * g4 + 2], Y0[4 * g4 + 3])};
            *(u32x2*)(yo + 32 + 8 * g4 + 4 * half) = (u32x2){cvt_pk_bf16(Y1[4 * g4], Y1[4 * g4 + 1]), cvt_pk_bf16(Y1[4 * g4 + 2], Y1[4 * g4 + 3])};
        }
    }
}

constexpr int LDS_BYTES = 163840;
constexpr int LDSCTL_OFF = LDS_BYTES - 512;
constexpr int RING_BYTES = 131072;

struct Args { const void* in[34]; float* out; unsigned char* ws; int ph_lo, ph_hi; };

enum { I_X = 0, I_P, I_POS, I_EVWIN, I_EVWOUT, I_MU, I_W0, I_W2, I_A0, I_A2, I_G2, I_KK, I_KA, I_RK, I_GNG, I_GNB, I_CPOS, I_CW1, I_CW2, I_ODWIN, I_ODWOUT,
       I_HGLB, I_HGNG, I_WRG, I_BRG, I_WRE, I_BRE, I_MW1, I_MW3, I_MW2, I_LNG, I_LNB, I_PLEW, I_PLEGW };

__device__ __forceinline__ void transpose_item(const float* W, int ldw, int k0, int n0, int nvalid, bf16_t* WT, int ldt, int drow0, int dcol0, LAS float* scr, int lane) {
    const int nl = lane & 31; const bool ok = (n0 + nl) < nvalid;
#pragma unroll 8
    for (int i = 0; i < 32; ++i) { const int kk = 2 * i + (lane >> 5); scr[kk * 33 + nl] = ok ? W[(size_t)(k0 + kk) * ldw + n0 + nl] : 0.f; }
    LDS_WAIT(); asm volatile("" ::: "memory");
    const int c = lane & 7;
#pragma unroll
    for (int j = 0; j < 4; ++j) { const int n = (lane >> 3) + 8 * j; const LAS float* s = scr + (8 * c) * 33 + n;
        u32x4 o; o.x = cvt_pk_bf16(s[0 * 33], s[1 * 33]); o.y = cvt_pk_bf16(s[2 * 33], s[3 * 33]); o.z = cvt_pk_bf16(s[4 * 33], s[5 * 33]); o.w = cvt_pk_bf16(s[6 * 33], s[7 * 33]);
        *(u32x4*)(WT + (size_t)(drow0 + n) * ldt + dcol0 + k0 + 8 * c) = o; }
    LDS_WAIT(); asm volatile("" ::: "memory");
}
__device__ __forceinline__ void conv_late_item(int it, const float* odin, const float* odout, const float* evout, const float* gatew, const float* plew, unsigned char* ws, LAS float* scr, int lane) {
    const float* W; bf16_t* WT; int K = D, N = D, q = it;
    if (it < 2048) { W = odin; WT = (bf16_t*)(ws + WS_WODIN); N = 4 * D; }
    else if (it < 2560) { q = it - 2048; W = odout; WT = (bf16_t*)(ws + WS_WODOUT); }
    else if (it < 3072) { q = it - 2560; W = evout; WT = (bf16_t*)(ws + WS_WEVOUT); }
    else if (it < 4096) { q = it - 3072; const int l_ = q >> 9; q &= 511; W = gatew + (size_t)l_ * D * D; WT = (bf16_t*)(ws + WS_WGATE) + (size_t)l_ * D * D; }
    else { q = it - 4096; const int l_ = q >> 7; q &= 127; K = PLE; W = plew + (size_t)l_ * PLE * D; WT = (bf16_t*)(ws + WS_WPLE) + (size_t)l_ * D * PLE; }
    const int nblk = N / 32, kb = q / nblk, nb = q % nblk;
    transpose_item(W, N, 64 * kb, 32 * nb, N, WT, K, 32 * nb, 0, scr, lane);
}
__device__ __forceinline__ void conv_matrix(const float* W, int K, int N, int npad, bf16_t* WT, LAS float* scr, int gw, int ngw, int lane) {
    const int nblk = npad / 32, nitems = (K / 64) * nblk;
    for (int it = gw; it < nitems; it += ngw) { const int kb = it / nblk, nb = it % nblk; transpose_item(W, N, 64 * kb, 32 * nb, N, WT, K, 32 * nb, 0, scr, lane); }
}
__device__ __forceinline__ void row_to_bf16(const float* xrow, bf16_t* orow, int lane) {
    const f32x4* xr = (const f32x4*)xrow + lane; u32x2* o8 = (u32x2*)orow + lane;
#pragma unroll
    for (int j = 0; j < 4; ++j) { const f32x4 v = xr[64 * j]; u32x2 w; w.x = cvt_pk_bf16(v[0], v[1]); w.y = cvt_pk_bf16(v[2], v[3]); o8[64 * j] = w; }
}
__device__ __forceinline__ void conv_moe_item(const float* w1, const float* w3, const float* w2, int li, bf16_t* w13, bf16_t* w2t, LAS float* scr, int it, int lane) {
    constexpr int I13 = (1024 / 64) * (512 / 32), I2 = (512 / 64) * (1024 / 32);
    if (it < NEXP * 2 * I13) {
        const int e = it / (2 * I13), r = it % (2 * I13), which = r / I13, q = r % I13, kb = q / 16, nb = q % 16, n0 = 32 * nb;
        const float* W = (which ? w3 : w1) + ((size_t)(li * NEXP + e)) * 1024 * 512;
        transpose_item(W, 512, 64 * kb, n0, 512, w13, 1024, e * 1024 + (n0 >> 7) * 256 + which * 128 + (n0 & 127), 0, scr, lane);
    } else {
        const int it2 = it - NEXP * 2 * I13, e = it2 / I2, q = it2 % I2, kb = q / 32, nb = q % 32;
        transpose_item(w2 + ((size_t)(li * NEXP + e)) * 512 * 1024, 1024, 64 * kb, 32 * nb, 1024, w2t, 512, e * 1024 + 32 * nb, 0, scr, lane);
    }
}
__device__ __forceinline__ void conv_moe_weights(const float* w1, const float* w3, const float* w2, int li, bf16_t* w13, bf16_t* w2t, LAS float* scr, int gw, int ngw, int lane, int parts = 3) {
    constexpr int I13 = (1024 / 64) * (512 / 32);
    if (parts & 1) for (int it = gw; it < NEXP * 2 * I13; it += ngw) {
        const int e = it / (2 * I13), r = it % (2 * I13), which = r / I13, q = r % I13, kb = q / 16, nb = q % 16, n0 = 32 * nb;
        const float* W = (which ? w3 : w1) + ((size_t)(li * NEXP + e)) * 1024 * 512;
        transpose_item(W, 512, 64 * kb, n0, 512, w13, 1024, e * 1024 + (n0 >> 7) * 256 + which * 128 + (n0 & 127), 0, scr, lane);
    }
    constexpr int I2 = (512 / 64) * (1024 / 32);
    if (parts & 2) for (int it = gw; it < NEXP * I2; it += ngw) {
        const int e = it / I2, q = it % I2, kb = q / 32, nb = q % 32;
        transpose_item(w2 + ((size_t)(li * NEXP + e)) * 512 * 1024, 1024, 64 * kb, 32 * nb, 1024, w2t, 512, e * 1024 + 32 * nb, 0, scr, lane);
    }
}

__device__ __forceinline__ int row_elem(int lane, int j) { return (j < 2 ? 0 : 512) + 8 * lane + 4 * (j & 1); }
__device__ __forceinline__ void load_row_bf16(const bf16_t* row, f32x4 (&v)[4], int lane) {
    const u32x4 a = *((const u32x4*)row + lane), b = *((const u32x4*)row + 64 + lane);
    v[0] = (f32x4){bflo(a.x), bfhi(a.x), bflo(a.y), bfhi(a.y)}; v[1] = (f32x4){bflo(a.z), bfhi(a.z), bflo(a.w), bfhi(a.w)};
    v[2] = (f32x4){bflo(b.x), bfhi(b.x), bflo(b.y), bfhi(b.y)}; v[3] = (f32x4){bflo(b.z), bfhi(b.z), bflo(b.w), bfhi(b.w)};
}
__device__ __forceinline__ void store_row_bf16(bf16_t* row, const f32x4 (&v)[4], int lane) {
    *((u32x4*)row + lane) = (u32x4){cvt_pk_bf16(v[0][0], v[0][1]), cvt_pk_bf16(v[0][2], v[0][3]), cvt_pk_bf16(v[1][0], v[1][1]), cvt_pk_bf16(v[1][2], v[1][3])};
    *((u32x4*)row + 64 + lane) = (u32x4){cvt_pk_bf16(v[2][0], v[2][1]), cvt_pk_bf16(v[2][2], v[2][3]), cvt_pk_bf16(v[3][0], v[3][1]), cvt_pk_bf16(v[3][2], v[3][3])};
}
__device__ __forceinline__ void ln_row(f32x4 (&v)[4], const float* g, const float* b, int lane) {
    float s = 0.f;
#pragma unroll
    for (int j = 0; j < 4; ++j) s += (v[j][0] + v[j][1]) + (v[j][2] + v[j][3]);
    const float mean = wave_sum(s) * (1.f / D); float s2 = 0.f;
#pragma unroll
    for (int j = 0; j < 4; ++j) { v[j] = v[j] - mean; s2 += (v[j][0] * v[j][0] + v[j][1] * v[j][1]) + (v[j][2] * v[j][2] + v[j][3] * v[j][3]); }
    const float rstd = __builtin_amdgcn_rsqf(wave_sum(s2) * (1.f / D) + LN_EPS);
#pragma unroll
    for (int j = 0; j < 4; ++j) { const f32x4 gg = *(const f32x4*)(g + row_elem(lane, j)), bb = *(const f32x4*)(b + row_elem(lane, j)); v[j] = v[j] * rstd * gg + bb; }
}

__device__ __forceinline__ const void* ptab_get(LAS unsigned char* lds, int i) {
    const unsigned long long v = ((const volatile LAS unsigned long long*)(lds + 163840 - 512 + 64))[i];
    const unsigned lo = __builtin_amdgcn_readfirstlane((unsigned)v), hi = __builtin_amdgcn_readfirstlane((unsigned)(v >> 32));
    return (const void*)(const GAS char*)(((unsigned long long)hi << 32) | lo);
}
#define INF(i) ((const float*)ptab_get(lds, (i)))
#define WSB ((unsigned char*)ptab_get(lds, 35))
#define OUTP ((float*)ptab_get(lds, 34))
__global__ void __launch_bounds__(NTHR, 2) fwd(Args args) {
    extern __shared__ __attribute__((aligned(16))) unsigned char lds_raw[];
    LAS unsigned char* lds = (LAS unsigned char*)lds_raw;
    const int G = gridDim.x, bx = blockIdx.x;
    const int vcu = (G % 8 == 0) ? (bx % 8) * (G / 8) + bx / 8 : bx;
    const int ngw = G * NWAVES;
#define PH_LOCALS const int tid = pinned_tid(), lane = tid & 63, wave = __builtin_amdgcn_readfirstlane(tid >> 6), gw = vcu * NWAVES + wave; (void)tid; (void)lane; (void)gw;
    LAS unsigned long long* ptab = (LAS unsigned long long*)(lds + LDSCTL_OFF + 64);
    for (int u = threadIdx.x; u < (LDS_BYTES - LDSCTL_OFF) / 4; u += NTHR) ((LAS unsigned*)(lds + LDSCTL_OFF))[u] = 0u;
    __syncthreads();
    if (threadIdx.x == 0) {
#define PT_(i) ptab[i] = (unsigned long long)args.in[i];
        PT_(0) PT_(1) PT_(2) PT_(3) PT_(4) PT_(5) PT_(6) PT_(7) PT_(8) PT_(9) PT_(10) PT_(11) PT_(12) PT_(13) PT_(14) PT_(15) PT_(16) PT_(17) PT_(18) PT_(19) PT_(20) PT_(21) PT_(22) PT_(23) PT_(24) PT_(25) PT_(26) PT_(27) PT_(28) PT_(29) PT_(30) PT_(31) PT_(32) PT_(33)
#undef PT_
        ptab[34] = (unsigned long long)args.out; ptab[35] = (unsigned long long)args.ws;
    }
    __syncthreads();
    XcdBarrier bar = xcd_barrier_post((unsigned*)(args.ws + WS_CTL) + CW_BAR, (volatile LAS unsigned*)(lds + LDSCTL_OFF + 32));
    const int lo = args.ph_lo, hi = args.ph_hi;
    int pc = 0;
#define PH_PTRS unsigned char* const ws = WSB; (void)ws; \
    bf16_t* const W_evin = (bf16_t*)(ws + WS_WEVIN); bf16_t* const W_evout = (bf16_t*)(ws + WS_WEVOUT); bf16_t* const W_odin = (bf16_t*)(ws + WS_WODIN); bf16_t* const W_odout = (bf16_t*)(ws + WS_WODOUT); \
    bf16_t* const W_gate = (bf16_t*)(ws + WS_WGATE); bf16_t* const W_ple = (bf16_t*)(ws + WS_WPLE); bf16_t* const W_m13 = (bf16_t*)(ws + WS_WMOE13); bf16_t* const W_m2 = (bf16_t*)(ws + WS_WMOE2); \
    bf16_t* const pbf = (bf16_t*)(ws + WS_PBF); bf16_t* const XB = (bf16_t*)(ws + WS_XB); bf16_t* const Hb = (bf16_t*)(ws + A_H); bf16_t* const PP = (bf16_t*)(ws + A_XBUF); bf16_t* const XB1 = (bf16_t*)OUTP; bf16_t* const PBF1 = (bf16_t*)OUTP + (size_t)M * D; bf16_t* const PP1 = (bf16_t*)(ws + A_PP1); bf16_t* const ZB = (bf16_t*)(ws + WS_ARENA); \
    (void)W_evin; (void)W_evout; (void)W_odin; (void)W_odout; (void)W_gate; (void)W_ple; (void)W_m13; (void)W_m2; (void)pbf; (void)XB; (void)Hb; (void)PP; (void)XB1; (void)PBF1; (void)PP1; (void)ZB;
#define PH_RUN (pc >= lo && pc < hi)
#define PH_END do { if (pc >= lo && pc + 1 < hi) xcd_barrier(bar); ++pc; } while (0)

    if (PH_RUN) for (int rep_ = 0; rep_ < (PROBE_DUP == 20 ? 2 : 1); ++rep_) { PH_PTRS PH_LOCALS
        LAS float* scr = (LAS float*)(lds + wave * 16384);
        conv_matrix(INF(I_EVWIN), D, EVN, EVP, W_evin, scr, gw, ngw, lane);
        if (G != NB * 16) {
        conv_matrix(INF(I_EVWOUT), D, D, D, W_evout, scr, gw, ngw, lane);
        conv_matrix(INF(I_ODWIN), D, 4 * D, 4 * D, W_odin, scr, gw, ngw, lane);
        conv_matrix(INF(I_ODWOUT), D, D, D, W_odout, scr, gw, ngw, lane);
        for (int li = 0; li < DEPTH; ++li) {
            conv_matrix(INF(I_PLEGW) + (size_t)li * D * D, D, D, D, W_gate + (size_t)li * D * D, scr, gw, ngw, lane);
            conv_matrix(INF(I_PLEW) + (size_t)li * PLE * D, PLE, D, D, W_ple + (size_t)li * D * PLE, scr, gw, ngw, lane);
        }
        }
        { const float* w2 = INF(I_W2); const float* a2 = INF(I_A2); const float* g2 = INF(I_G2); bf16_t* WL = (bf16_t*)(ws + WS_WLORA);
          for (int idx = gw * 64 + lane; idx < 1536 * 256; idx += ngw * 64) { const int n = idx >> 8, k = idx & 255; float v = 0.f;
              if (n < 512) { if (k < 64) v = w2[k * 512 + n]; } else if (n < 1024) { if (k >= 64 && k < 128) v = a2[(k - 64) * 512 + (n - 512)]; } else { if (k >= 128) v = g2[(k - 128) * 512 + (n - 1024)]; }
              WL[idx] = (bf16_t)(cvt_pk_bf16(v, 0.f) & 0xffffu); } }
        { const float* cw1 = INF(I_CW1); bf16_t* WC = (bf16_t*)(ws + WS_WCMP);
          for (int it = gw; it < 4 * 64; it += ngw) { const int zh = it >> 6, q = it & 63, kb = q >> 2, nb = q & 3;
              transpose_item(cw1 + (size_t)zh * 1024 * 128, 128, 64 * kb, 32 * nb, 128, WC, 1024, zh * 128 + 32 * nb, 0, scr, lane); }
          const float* cpos = INF(I_CPOS); float* cb = (float*)(ws + MISC_CMPB);
          for (int o = gw; o < 256; o += ngw) { const int zz = o >> 7, c = o & 127; float a = 0.f; for (int i = lane; i < 2048; i += 64) a += cpos[zz * 2048 + i] * cw1[((size_t)zz * 2048 + i) * 128 + c]; a = wave_sum(a); if (lane == 0) cb[o] = a; } }
        { bf16_t* WRB = (bf16_t*)(ws + WS_WRB); const float* wrg = INF(I_WRG); const float* wre = INF(I_WRE);
          for (int idx = gw * 64 + lane; idx < DEPTH * 256 * 1024; idx += ngw * 64) { const int l_ = idx >> 18, n = (idx >> 10) & 255, k = idx & 1023;
              const float v = n < 4 ? wrg[((size_t)l_ * D + k) * 4 + n] : n < 36 ? wre[((size_t)l_ * D + k) * NEXP + (n - 4)] : 0.f; WRB[idx] = (bf16_t)(cvt_pk_bf16(v, 0.f) & 0xffffu); } }
        { const float* hl = INF(I_HGLB); float* lbt = (float*)(ws + MISC_LBT);
          for (int c = gw * 64 + lane; c < D; c += ngw * 64) { const float a0 = hl[c], a1 = hl[D + c], mx = fmaxf(a0, a1), e0 = __expf(a0 - mx), e1 = __expf(a1 - mx); lbt[c] = e1 / (e0 + e1); } }
        const float* xin_ = INF(I_X);
        for (int m = gw; m < M; m += 4 * ngw) {
            f32x4 v[4][4];
#pragma unroll
            for (int r = 0; r < 4; ++r)
#pragma unroll
                for (int j = 0; j < 4; ++j) v[r][j] = *(const f32x4*)(xin_ + (size_t)(m + r * ngw) * D + row_elem(lane, j));
#pragma unroll
            for (int r = 0; r < 4; ++r) store_row_bf16(XB + (size_t)(m + r * ngw) * D, v[r], lane);
        }
    }
    PH_END;

    for (int li = 0; li < DEPTH; ++li) {
                if (li == 0) {
            if (PH_RUN) { PH_PTRS
                pg8::Gemm g{XB, W_evin, D, D, D}; pg8::DenseOrder S; S.init(M, EVP, G, bx);
                pg8::EpiBf16 E{ZB, EVP, 0u, 0u, nullptr};
                for (int rep_ = 0; rep_ < (PROBE_DUP == 4 ? 2 : 1); ++rep_) pg8::gemm_phase<pg8::EpiBf16, pg8::DenseOrder>(lds, g, S, E);
            }
            PH_END;
            if (PH_RUN) for (int rep_ = 0; rep_ < (PROBE_DUP == 21 ? 2 : 1); ++rep_) { PH_PTRS PH_LOCALS const bool dry_ = (PROBE_DUP == 21 && rep_ == 0);
                const float* mu = INF(I_MU); bf16_t* ACT = (bf16_t*)(ws + A_ACT); const int* posi = (const int*)INF(I_POS); bf16_t* QRB = (bf16_t*)((unsigned char*)OUTP + DOUT_QR); bf16_t* SEGB = (bf16_t*)((unsigned char*)OUTP + DOUT_SEG);
                const float inv_me = exp2f(-(float)(lane & 31) * (13.287712379549449f / 32.0f));
                f32x4 mu8a = (f32x4){0.f, 0.f, 0.f, 0.f}, mu8b = mu8a; if (lane < 32) { mu8a = *(const f32x4*)(mu + 1536 + 8 * lane); mu8b = *(const f32x4*)(mu + 1536 + 8 * lane + 4); }
                LAS float* tb = (LAS float*)(lds + wave * 256);
                for (int m = gw; m < M; m += ngw) {
                    const bf16_t* zrow = ZB + (size_t)m * EVP;
                    if (lane < 32) {
                        const u32x4 zc = *(const u32x4*)(zrow + 1536 + 8 * lane); u32x4 zp = (u32x4){0u, 0u, 0u, 0u};
                        if ((m & (T - 1)) != 0) zp = *(const u32x4*)(zrow - EVP + 1536 + 8 * lane);
                        float v[8], pv[8]; unpack8(zc, v); unpack8(zp, pv);
#pragma unroll
                        for (int j = 0; j < 8; ++j) { v[j] += (j < 4 ? mu8a[j & 3] : mu8b[j & 3]) * (pv[j] - v[j]); if (lane < 8) { const float e2 = __expf(2.0f * fminf(fmaxf(v[j], -15.0f), 15.0f)); v[j] = (e2 - 1.0f) * __builtin_amdgcn_rcpf(e2 + 1.0f); } else if (lane >= 16) v[j] = sigmoidf_(v[j]); }
                        *(u32x4*)(ACT + (size_t)m * 256 + 8 * lane) = (u32x4){cvt_pk_bf16(v[0], v[1]), cvt_pk_bf16(v[2], v[3]), cvt_pk_bf16(v[4], v[5]), cvt_pk_bf16(v[6], v[7])};
                    }
                    if (G != NB * 16) rope_row(m, ZB, QRB, posi, tb, lane, !dry_);
                    if (lane < 48) {
                    } else {
                        const int bq_ = m >> 12, tt = m & (T - 1), jj = tt >> 4, ll = tt & 15;
#pragma unroll
                        for (int q = 0; q < 2; ++q) { const int idx = (lane - 48) * 2 + q, piece = idx >> 3, ch = idx & 7, zsel = piece >> 1, hq = piece & 1;
                            *(u32x4*)(SEGB + ((size_t)zsel * 8192 + (size_t)(bq_ * 256 + jj) * 2 + hq) * 1024 + ll * 64 + ch * 8) = *(const u32x4*)(zrow + 2304 + zsel * 128 + hq * 64 + ch * 8); }
                    }
                    LDS_WAIT();
                }
            }
            PH_END;
            if (PH_RUN) { PH_PTRS
                pg8::Gemm g{(const bf16_t*)(ws + A_ACT), (const bf16_t*)(ws + WS_WLORA), 256, 256, 256}; pg8::DenseOrder S; S.init(M, 1536, G, bx);
                pg8::EpiLora E{INF(I_W0), INF(I_A0), (float*)(ws + A_DEC), (bf16_t*)(ws + A_AA), (bf16_t*)(ws + A_GG)};
                for (int rep_ = 0; rep_ < ((PROBE_DUP == 4 || PROBE_DUP == 42) ? 2 : 1); ++rep_) pg8::gemm_phase<pg8::EpiLora, pg8::DenseOrder>(lds, g, S, E);
            }
            PH_END;
            if (PH_RUN) { PH_PTRS
              if (G > 64 && bx < 64) {
                pg8::Gemm g{(const bf16_t*)((unsigned char*)OUTP + DOUT_SEG), (const bf16_t*)(ws + WS_WCMP), 1024, 1024, 1024}; pg8::CmpOrder S{G, bx};
                pg8::EpiF32 E{(float*)(ws + A_HC2), 256};
                pg8::gemm_phase<pg8::EpiF32, pg8::CmpOrder>(lds, g, S, E);
              } else { PH_LOCALS
                const int gwp = G > 64 ? (bx - 64) * NWAVES + wave : gw, ngwp = G > 64 ? (G - 64) * NWAVES : ngw;
                const float* mu = INF(I_MU); const float* kkp = INF(I_KK); const float* kap = INF(I_KA); const float* rkp = INF(I_RK); const bf16_t* AAp = (const bf16_t*)(ws + A_AA); float* sc4 = (float*)(ws + A_SC4);
                float p_mr[8], p_mk[8], p_kk[8], p_ka[8], p_rk[8];
#pragma unroll
                for (int i = 0; i < 8; ++i) { p_mr[i] = mu[8 * lane + i]; p_mk[i] = mu[512 + 8 * lane + i]; p_kk[i] = kkp[8 * lane + i]; p_ka[i] = kap[8 * lane + i]; p_rk[i] = rkp[8 * lane + i]; }
                for (int m = gwp; m < M; m += ngwp) {
                    const bf16_t* zc = ZB + (size_t)m * EVP + 8 * lane;
                    const u32x4 rw_ = *(const u32x4*)zc, kw_ = *(const u32x4*)(zc + 512), aw_ = *(const u32x4*)(AAp + (size_t)m * 512 + 8 * lane); u32x4 rpw = (u32x4){0u, 0u, 0u, 0u}, kpw = rpw;
                    if ((m & (T - 1)) != 0) { rpw = *(const u32x4*)(zc - EVP); kpw = *(const u32x4*)(zc + 512 - EVP); }
                    float r_[8], k_[8], rp_[8], kp_[8], a_[8]; unpack8(rw_, r_); unpack8(kw_, k_); unpack8(rpw, rp_); unpack8(kpw, kp_); unpack8(aw_, a_);
                    float n2 = 0.f, c1 = 0.f, c2 = 0.f, bc = 0.f;
#pragma unroll
                    for (int i = 0; i < 8; ++i) { const float rr = r_[i] + p_mr[i] * (rp_[i] - r_[i]), k0 = k_[i] + p_mk[i] * (kp_[i] - k_[i]), kk = k0 * p_kk[i], k2 = k0 * (1.0f + (a_[i] - 1.0f) * p_ka[i]);
                        n2 += kk * kk; c1 += kk * a_[i] * rr; c2 += k2 * rr; bc += rr * k2 * p_rk[i]; }
                    n2 = sum8b(n2); c1 = sum8b(c1); c2 = sum8b(c2); bc = sum8b(bc);
                    const float inv = __builtin_amdgcn_rsqf(fmaxf(n2, 1e-24f));
                    if ((lane & 7) == 0) *(f32x4*)(sc4 + ((size_t)m * 8 + (lane >> 3)) * 4) = (f32x4){inv, c1 * inv, c2, bc};
                }
            }
              if (G <= 64) { __syncthreads(); pg8::Gemm g{(const bf16_t*)((unsigned char*)OUTP + DOUT_SEG), (const bf16_t*)(ws + WS_WCMP), 1024, 1024, 1024}; pg8::CmpOrder S{G, bx}; pg8::EpiF32 E{(float*)(ws + A_HC2), 256}; pg8::gemm_phase<pg8::EpiF32, pg8::CmpOrder>(lds, g, S, E); }
            }
            PH_END;
            if (PH_RUN) for (int rep_ = 0; rep_ < (PROBE_DUP == 1 ? 2 : 1); ++rep_) { PH_PTRS rwkv_phase(lds, ZB, (const float*)(ws + A_DEC), (const bf16_t*)(ws + A_AA), (const float*)(ws + A_SC4), INF(I_MU), INF(I_KK), INF(I_KA), XB, G, bx, INF(I_MW1), INF(I_MW3), INF(I_MW2), W_m13, W_m2, G == NB * 16 && PROBE_DUP != 1,
                                   (const float*)(ws + A_HC2), (const float*)(ws + MISC_CMPB), INF(I_CW2), (bf16_t*)(ws + A_KVC2), INF(I_P), pbf, PBF1, ZB, (bf16_t*)((unsigned char*)OUTP + DOUT_QR), (const int*)INF(I_POS),
                                   INF(I_ODWIN), INF(I_ODWOUT), INF(I_EVWOUT), INF(I_PLEGW), INF(I_PLEW), ws); }
            PH_END;
            if (PH_RUN) for (int rep_ = 0; rep_ < (PROBE_DUP == 23 ? 2 : 1); ++rep_) { PH_PTRS PH_LOCALS bf16_t* yout_ = (PROBE_DUP == 23 && rep_ == 0) ? (bf16_t*)(ws + A_DEC) : XB;
                const float* mu = INF(I_MU); const float* gng = INF(I_GNG); const float* gnb = INF(I_GNB); const bf16_t* GGp = (const bf16_t*)(ws + A_GG); const float* sc4 = (const float*)(ws + A_SC4);
                float p_mv[8], p_g[8], p_b[8];
#pragma unroll
                for (int i = 0; i < 8; ++i) { p_mv[i] = mu[1024 + 8 * lane + i]; p_g[i] = gng[8 * lane + i]; p_b[i] = gnb[8 * lane + i]; }
                for (int m = gw; m < M; m += ngw) {
                    const bf16_t* zc = ZB + (size_t)m * EVP + 1024 + 8 * lane;
                    const u32x4 vw_ = *(const u32x4*)zc, ow_ = *(const u32x4*)(XB + (size_t)m * D + 8 * lane), gw_ = *(const u32x4*)(GGp + (size_t)m * 512 + 8 * lane); u32x4 vpw = (u32x4){0u, 0u, 0u, 0u};
                    if ((m & (T - 1)) != 0) vpw = *(const u32x4*)(zc - EVP);
                    const float bc = sc4[((size_t)m * 8 + (lane >> 3)) * 4 + 3];
                    float v_[8], vp_[8], o_[8], g_[8]; unpack8(vw_, v_); unpack8(vpw, vp_); unpack8(ow_, o_); unpack8(gw_, g_);
                    float s1 = 0.f;
#pragma unroll
                    for (int i = 0; i < 8; ++i) s1 += o_[i];
                    const float mean = sum8b(s1) * (1.0f / 64.0f); float s2 = 0.f;
#pragma unroll
                    for (int i = 0; i < 8; ++i) { o_[i] -= mean; s2 += o_[i] * o_[i]; }
                    const float rstd = __builtin_amdgcn_rsqf(sum8b(s2) * (1.0f / 64.0f) + 64e-5f);
                    float y_[8];
#pragma unroll
                    for (int i = 0; i < 8; ++i) { const float vv = v_[i] + p_mv[i] * (vp_[i] - v_[i]); y_[i] = (o_[i] * rstd * p_g[i] + p_b[i] + bc * vv) * g_[i]; }
                    *(u32x4*)(yout_ + (size_t)m * (yout_ == XB ? D : 512) + 8 * lane) = (u32x4){cvt_pk_bf16(y_[0], y_[1]), cvt_pk_bf16(y_[2], y_[3]), cvt_pk_bf16(y_[4], y_[5]), cvt_pk_bf16(y_[6], y_[7])};
                }
            }
            if (PH_RUN && !(G == NB * 16 && PROBE_DUP != 1)) { PH_PTRS PH_LOCALS
                LAS float* w2s = (LAS float*)lds; LAS float* hs = (LAS float*)(lds + 65536 + wave * 512);
                { const float* cw2 = INF(I_CW2); for (int i = tid; i < 2 * 128 * 64; i += NTHR) w2s[i] = cw2[i]; }
                __syncthreads();
                const float* HC = (const float*)(ws + A_HC2); const float* cb = (const float*)(ws + MISC_CMPB); bf16_t* KVC = (bf16_t*)(ws + A_KVC2);
                for (int rr = gw; rr < 2 * 16 * 256 * 2; rr += ngw) {
                    const int hq = rr & 1, n = (rr >> 1) & 255, bq_ = (rr >> 9) & 15, zsel = rr >> 13;
                    float outv = 0.f;
                    if (n < 255) {
                        const float* ha = HC + ((size_t)zsel * 8192 + (size_t)(bq_ * 256 + n) * 2 + hq) * 256; const float* hb = ha + 2 * 256 + 128;
#pragma unroll
                        for (int q = 0; q < 2; ++q) { const int c = lane + 64 * q; const float xx = ha[c] + hb[c] + cb[zsel * 128 + c];
                            hs[c] = 0.5f * xx * (1.0f + tanhf(0.7978845608028654f * (xx + 0.044715f * xx * xx * xx))); }
                        LDS_WAIT();
                        for (int c = 0; c < 128; ++c) outv += hs[c] * w2s[(zsel * 128 + c) * 64 + lane];
                        LDS_WAIT();
                    }
                    KVC[((size_t)(zsel * 32 + bq_ * 2 + hq) * 256 + n) * 64 + lane] = (bf16_t)(cvt_pk_bf16(outv, 0.f) & 0xffffu);
                }
            }
            PH_END;
            if (PH_RUN) for (int rep_ = 0; rep_ < (PROBE_DUP == 2 ? 2 : 1); ++rep_) { PH_PTRS nsa_attn_phase(lds, ZB, (const bf16_t*)((unsigned char*)OUTP + DOUT_QR), (const bf16_t*)(ws + A_KVC2), XB, G, bx); }
            PH_END;
            if (PH_RUN) { PH_PTRS
                pg8::Gemm g{XB, W_evout, D, D, D}; pg8::DenseOrder S; S.init(M, D, G, bx);
                pg8::EpiPre E{INF(I_X), nullptr, Hb};
                for (int rep_ = 0; rep_ < (PROBE_DUP == 4 ? 2 : 1); ++rep_) pg8::gemm_phase<pg8::EpiPre, pg8::DenseOrder>(lds, g, S, E);
            }
            PH_END;
        }
        if (li == 1) {
            if (PH_RUN) { PH_PTRS
                pg8::Gemm g{XB1, W_odin, D, D, D}; pg8::DenseOrder S; S.init(M, 4 * D, G, bx);
                pg8::EpiBf16 E{ZB, 4 * D, 0xF00Fu, 0x00F0u, (const float*)(ws + MISC_LBT)};
                for (int rep_ = 0; rep_ < (PROBE_DUP == 7 ? 2 : 1); ++rep_) pg8::gemm_phase<pg8::EpiBf16, pg8::DenseOrder>(lds, g, S, E);
            }
            PH_END;
            if (PH_RUN) for (int rep_ = 0; rep_ < (PROBE_DUP == 3 ? 2 : 1); ++rep_) { PH_PTRS
                if (G > NB * 8 && bx >= NB * 8) {
                    { pg8::Gemm g{PBF1, W_ple + (size_t)D * PLE, PLE, PLE, PLE}; pg8::DenseOrder S; S.init(M, D, G - NB * 8, bx - NB * 8);
                      pg8::EpiBf16 E{PP1, D, 0u, 0u, nullptr};
                      pg8::gemm_phase<pg8::EpiBf16, pg8::DenseOrder>(lds, g, S, E); }
                    __syncthreads();
                    { PH_LOCALS
                      const int gwi = (bx - NB * 8) * NWAVES + wave, ngwi = (G - NB * 8) * NWAVES;
                      LAS float* scr = (LAS float*)(lds + wave * 8704);
                      conv_moe_weights(INF(I_MW1), INF(I_MW3), INF(I_MW2), 1, W_m13, W_m2, scr, gwi, ngwi, lane, 3); }
                } else hgrn_phase(lds, ZB, INF(I_HGLB), INF(I_HGNG), XB, G, bx); }
            PH_END;
            if (PH_RUN) { PH_PTRS
                pg8::Gemm g{XB, W_odout, D, D, D}; pg8::DenseOrder S; S.init(M, D, G, bx);
                pg8::EpiPre E{nullptr, XB1, Hb};
                for (int rep_ = 0; rep_ < (PROBE_DUP == 7 ? 2 : 1); ++rep_) pg8::gemm_phase<pg8::EpiPre, pg8::DenseOrder>(lds, g, S, E);
            }
            PH_END;
        }
        if (PH_RUN) for (int rep_ = 0; rep_ < (PROBE_DUP == 25 ? 2 : 1); ++rep_) { PH_PTRS PH_LOCALS bf16_t* hout_ = (PROBE_DUP == 25 && rep_ == 0) ? (bf16_t*)(ws + A_XBUF) : Hb;
            const float* lng = INF(I_LNG) + (size_t)li * 2 * D; const float* lnb = INF(I_LNB) + (size_t)li * 2 * D;
            for (int m = gw; m < M; m += 4 * ngw) {
                f32x4 v[4][4];
#pragma unroll
                for (int r = 0; r < 4; ++r) load_row_bf16(Hb + (size_t)(m + r * ngw) * D, v[r], lane);
#pragma unroll
                for (int r = 0; r < 4; ++r) { ln_row(v[r], lng, lnb, lane); store_row_bf16(hout_ + (size_t)(m + r * ngw) * D, v[r], lane); }
            }
        }
        PH_END;
        if (PH_RUN) { PH_PTRS
            pg8::Gemm g{Hb, (const bf16_t*)(ws + WS_WRB) + (size_t)li * 256 * D, D, D, D}; pg8::DenseOrder S; S.init(M, 256, G, bx);
            pg8::EpiLogit E{(float*)(ws + A_XBUF)};
            pg8::gemm_phase<pg8::EpiLogit, pg8::DenseOrder>(lds, g, S, E);
        }
        PH_END;
        if (PH_RUN) { PH_PTRS PH_LOCALS
            LAS int* hist = (LAS int*)lds;
            if (tid < NEXP) hist[tid] = 0;
            __syncthreads();
            const float* brg = INF(I_BRG) + li * 4; const float* bre = INF(I_BRE) + li * NEXP; const float* LG = (const float*)(ws + A_XBUF);
            int* eid_o = (int*)(ws + MISC_EID); float* gate_o = (float*)(ws + MISC_GATE);
            const int npair = M / 2 / ngw;
            for (int q0 = 0; q0 < npair; q0 += 32) {
                const int q = q0 + (lane >> 1);
                if (q < npair) {
                    const int m = 2 * (gw + q * ngw) + (lane & 1);
                    float lg[36];
#pragma unroll
                    for (int c = 0; c < 9; ++c) { const f32x4 t = *(const f32x4*)(LG + (size_t)m * 64 + 4 * c); lg[4 * c] = t[0]; lg[4 * c + 1] = t[1]; lg[4 * c + 2] = t[2]; lg[4 * c + 3] = t[3]; }
                    float g0 = lg[0] + brg[0], g1 = lg[1] + brg[1], g2 = lg[2] + brg[2], g3 = lg[3] + brg[3];
                    int gs = 0; float gm = g0; if (g1 > gm) { gm = g1; gs = 1; } if (g2 > gm) { gm = g2; gs = 2; } if (g3 > gm) { gm = g3; gs = 3; }
                    const float pg = __builtin_amdgcn_rcpf(__expf(g0 - gm) + __expf(g1 - gm) + __expf(g2 - gm) + __expf(g3 - gm));
                    float le[8];
#pragma unroll
                    for (int e = 0; e < 8; ++e) { const float a = gs == 0 ? lg[4 + e] : gs == 1 ? lg[12 + e] : gs == 2 ? lg[20 + e] : lg[28 + e]; le[e] = a + bre[gs * 8 + e]; }
                    int i1 = 0; float v1 = le[0];
#pragma unroll
                    for (int e = 1; e < 8; ++e) if (le[e] > v1) { v1 = le[e]; i1 = e; }
                    int i2 = -1; float v2 = -3.0e38f;
#pragma unroll
                    for (int e = 0; e < 8; ++e) if (e != i1 && le[e] > v2) { v2 = le[e]; i2 = e; }
                    const float e2 = __expf(v2 - v1), den = __builtin_amdgcn_rcpf(1.0f + e2);
                    const int ea = gs * 8 + i1, eb = gs * 8 + i2;
                    *(int2*)(eid_o + 2 * (size_t)m) = make_int2(ea, eb); *(float2*)(gate_o + 2 * (size_t)m) = make_float2(pg * den, pg * e2 * den);
                    __hip_atomic_fetch_add(&hist[ea], 1, __ATOMIC_RELAXED, __HIP_MEMORY_SCOPE_WORKGROUP); __hip_atomic_fetch_add(&hist[eb], 1, __ATOMIC_RELAXED, __HIP_MEMORY_SCOPE_WORKGROUP);
                }
            }
            __syncthreads();
            if (tid < NEXP) ((int*)(ws + MISC_BCNT))[vcu * NEXP + tid] = hist[tid];
        }
        PH_END;
        if (PH_RUN) for (int rep_ = 0; rep_ < (PROBE_DUP == 26 ? 2 : 1); ++rep_) { PH_PTRS PH_LOCALS
            __syncthreads();
            LAS int* tot = (LAS int*)lds; LAS int* prt = tot + 16 * NEXP; LAS int* cursor = prt + 16 * NEXP; LAS int* startv = cursor + NEXP; LAS int* padv = startv + NEXP;
            const int* bcnt = (const int*)(ws + MISC_BCNT);
            { const int e = tid & 31, part = tid >> 5; int a = 0, p = 0; for (int w = part; w < G; w += 16) { const int c = bcnt[w * NEXP + e]; a += c; if (w < vcu) p += c; } tot[part * NEXP + e] = a; prt[part * NEXP + e] = p; }
            __syncthreads();
            if (tid < NEXP) { int a = 0, p = 0; for (int q = 0; q < 16; ++q) { a += tot[q * NEXP + tid]; p += prt[q * NEXP + tid]; } padv[tid] = (a + 255) & ~255; cursor[tid] = p; }
            __syncthreads();
            if (tid == 0) { int run = 0;
#pragma nounroll
                for (int e = 0; e < NEXP; ++e) { startv[e] = run; run += padv[e]; } }
            __syncthreads();
            if (tid < NEXP) cursor[tid] += startv[tid];
            if (bx == 0) { int* te = (int*)(ws + MISC_TILEE); const int ntl = (startv[NEXP - 1] + padv[NEXP - 1]) >> 8; if (tid == 0) te[0] = ntl;
                for (int t = tid; t < ntl; t += NTHR) { int e = 0;
#pragma nounroll
                    for (int q = 0; q < NEXP; ++q) e += ((startv[q] + padv[q]) <= 256 * t) ? 1 : 0;
                    te[1 + t] = e; } }
            __syncthreads();
            const int* eid_i = (const int*)(ws + MISC_EID); int* slot_o = (int*)(ws + MISC_SLOT); int* toks_o = (int*)(ws + WS_TOKS);
            for (int mm = 2 * gw; mm < M; mm += 2 * ngw) for (int m = mm; m < mm + 2; ++m) {
                int s0 = 0, s1 = 0;
                if (lane == 0) { const int2 ee = *(const int2*)(eid_i + 2 * (size_t)m); s0 = __hip_atomic_fetch_add(&cursor[ee.x], 1, __ATOMIC_RELAXED, __HIP_MEMORY_SCOPE_WORKGROUP); s1 = __hip_atomic_fetch_add(&cursor[ee.y], 1, __ATOMIC_RELAXED, __HIP_MEMORY_SCOPE_WORKGROUP); *(int2*)(slot_o + 2 * (size_t)m) = make_int2(s0, s1); }
                s0 = __builtin_amdgcn_readfirstlane(s0); s1 = __builtin_amdgcn_readfirstlane(s1);
                if (lane == 0) { toks_o[s0] = m; toks_o[s1] = m; }
            }
            { LAS float* scr = (LAS float*)(lds + 16384 + wave * 8704);
              const bool shadow = (G > NB * 8);
              const int parts_ = (li == 1 && shadow) ? 0 : ((li == 0 && G == NB * 16) ? 0 : 3);
              if (parts_) conv_moe_weights(INF(I_MW1), INF(I_MW3), INF(I_MW2), li, W_m13, W_m2, scr, gw, ngw, lane, parts_);
              const int np = (li == 1 && shadow) ? 0 : ((li == 0 && G == NB * 16) ? 0 : ((li == 0 && shadow) ? 2 : 1));
              for (int q = 0; q < np; ++q) { const float* pl = INF(I_P) + (size_t)(li + q) * M * PLE; bf16_t* pd = q ? PBF1 : pbf;
                for (int m = gw; m < M; m += 4 * ngw) { f32x4 v[4];
#pragma unroll
                    for (int r = 0; r < 4; ++r) v[r] = *((const f32x4*)(pl + (size_t)(m + r * ngw) * PLE) + lane);
#pragma unroll
                    for (int r = 0; r < 4; ++r) *((u32x2*)(pd + (size_t)(m + r * ngw) * PLE) + lane) = (u32x2){cvt_pk_bf16(v[r][0], v[r][1]), cvt_pk_bf16(v[r][2], v[r][3])}; } } }
        }
        PH_END;
        if (PH_RUN) { PH_PTRS
            const int* te = (const int*)(ws + MISC_TILEE);
            pg8::Gemm g{Hb, W_m13, D, D, D}; pg8::MoeOrder S{te + 1, __builtin_amdgcn_readfirstlane(te[0]), G, bx};
            pg8::EpiMoe1 E{(bf16_t*)(ws + A_HID)};
            for (int rep_ = 0; rep_ < (PROBE_DUP == 5 ? 2 : 1); ++rep_) pg8::gemm_phase_gather<pg8::EpiMoe1, pg8::MoeOrder>(lds, g, S, E, (const int*)(ws + WS_TOKS));
        }
        PH_END;
        if (PH_RUN) { PH_PTRS
            const int* te = (const int*)(ws + MISC_TILEE);
            pg8::Gemm g{(const bf16_t*)(ws + A_HID), W_m2, MOE_H, MOE_H, MOE_H}; pg8::MoeOrder S{te + 1, __builtin_amdgcn_readfirstlane(te[0]), G, bx};
            pg8::EpiBf16 E{(bf16_t*)(ws + A_XBUF), D, 0u, 0u, nullptr};
            for (int rep_ = 0; rep_ < (PROBE_DUP == 5 ? 2 : 1); ++rep_) pg8::gemm_phase<pg8::EpiBf16, pg8::MoeOrder>(lds, g, S, E);
        }
        PH_END;
        if (PH_RUN) for (int rep_ = 0; rep_ < (PROBE_DUP == 27 ? 2 : 1); ++rep_) { PH_PTRS PH_LOCALS bf16_t* hout_ = (PROBE_DUP == 27 && rep_ == 0) ? (bf16_t*)OUTP : XB;
            const float* lng = INF(I_LNG) + (size_t)li * 2 * D; const float* lnb = INF(I_LNB) + (size_t)li * 2 * D;
            const int* slot_i = (const int*)(ws + MISC_SLOT); const float* gate_i = (const float*)(ws + MISC_GATE); const bf16_t* ybuf = (const bf16_t*)(ws + A_XBUF);
            for (int m0 = gw; m0 < M; m0 += 2 * ngw) {
                int2 sl[2]; float2 gt[2]; u32x4 hw_[2][2], y0[2][2], y1[2][2];
#pragma unroll
                for (int r = 0; r < 2; ++r) { const int m = m0 + r * ngw; sl[r] = *(const int2*)(slot_i + 2 * (size_t)m); gt[r] = *(const float2*)(gate_i + 2 * (size_t)m); }
#pragma unroll
                for (int r = 0; r < 2; ++r) { const int m = m0 + r * ngw;
#pragma unroll
                    for (int q = 0; q < 2; ++q) { hw_[r][q] = *((const u32x4*)(Hb + (size_t)m * D) + lane + 64 * q); y0[r][q] = *((const u32x4*)(ybuf + (size_t)sl[r].x * D) + lane + 64 * q); y1[r][q] = *((const u32x4*)(ybuf + (size_t)sl[r].y * D) + lane + 64 * q); } }
#pragma unroll
                for (int r = 0; r < 2; ++r) { const int m = m0 + r * ngw; f32x4 v[4];
#pragma unroll
                    for (int q = 0; q < 2; ++q) { const unsigned hh_[4] = {hw_[r][q].x, hw_[r][q].y, hw_[r][q].z, hw_[r][q].w}, ya[4] = {y0[r][q].x, y0[r][q].y, y0[r][q].z, y0[r][q].w}, yb[4] = {y1[r][q].x, y1[r][q].y, y1[r][q].z, y1[r][q].w};
#pragma unroll
                        for (int e = 0; e < 4; ++e) { v[2 * q + (e >> 1)][2 * (e & 1)] = bflo(hh_[e]) * DN_ALPHA + (gt[r].x * bflo(ya[e]) + gt[r].y * bflo(yb[e])); v[2 * q + (e >> 1)][2 * (e & 1) + 1] = bfhi(hh_[e]) * DN_ALPHA + (gt[r].x * bfhi(ya[e]) + gt[r].y * bfhi(yb[e])); } }
                    ln_row(v, lng + D, lnb + D, lane);
                    store_row_bf16(hout_ + (size_t)m * D, v, lane); }
            }
        }
        PH_END;
        if (!(li == 1 && G > NB * 8)) {
        if (PH_RUN) { PH_PTRS PH_LOCALS
            pg8::Gemm g{pbf, W_ple + (size_t)li * D * PLE, PLE, PLE, PLE}; pg8::DenseOrder S; S.init(M, D, G, bx);
            pg8::EpiBf16 E{PP, D, 0u, 0u, nullptr};
            for (int rep_ = 0; rep_ < ((PROBE_DUP == 6 || PROBE_DUP == 41) ? 2 : 1); ++rep_) pg8::gemm_phase<pg8::EpiBf16, pg8::DenseOrder>(lds, g, S, E);
        }
        PH_END;
        }
        if (PH_RUN) { PH_PTRS PH_LOCALS
            pg8::Gemm g{XB, W_gate + (size_t)li * D * D, D, D, D}; pg8::DenseOrder S; S.init(M, D, G, bx);
            pg8::EpiGate E{XB, (li == 1 && G > NB * 8) ? PP1 : PP, li == DEPTH - 1 ? OUTP : nullptr, XB1};
            for (int rep_ = 0; rep_ < (PROBE_DUP == 6 ? 2 : 1); ++rep_) pg8::gemm_phase<pg8::EpiGate, pg8::DenseOrder>(lds, g, S, E);
        }
        PH_END;
    }
#undef PH_RUN
#undef PH_END
}
constexpr int TOTAL_PHASES = 1 + 8 + 9 + 3 + 8;

extern "C" void kernel_launch(void* const* d_in, const int* in_sizes, int n_in, void* d_out, int out_size, void* d_ws, size_t ws_size, hipStream_t stream) {
    static int grid = 0;
    if (grid == 0) {
        if (n_in != 34 || in_sizes[0] != M * D || out_size != M * D || ws_size < WS_END) { fprintf(stderr, "kernel_launch: unexpected shapes: n_in %d in0 %d out %d ws %zu (need %zu)\n", n_in, n_in > 0 ? in_sizes[0] : -1, out_size, ws_size, (size_t)WS_END); grid = -1; return; }
        int dev = 0, cus = 0, per_cu = 0;
        if (hipGetDevice(&dev) != hipSuccess || hipDeviceGetAttribute(&cus, hipDeviceAttributeMultiprocessorCount, dev) != hipSuccess) { grid = -1; return; }
        if (hipFuncSetAttribute((const void*)fwd, hipFuncAttributeMaxDynamicSharedMemorySize, LDS_BYTES) != hipSuccess) { fprintf(stderr, "kernel_launch: hipFuncSetAttribute failed\n"); grid = -1; return; }
        if (hipOccupancyMaxActiveBlocksPerMultiprocessor(&per_cu, (const void*)fwd, NTHR, LDS_BYTES) != hipSuccess || per_cu < 1) fprintf(stderr, "kernel_launch: occupancy query reports %d\n", per_cu);
        (void)hipGetLastError();
        grid = cus;
    }
    if (grid < 0) return;
    if (hipMemsetAsync((char*)d_ws + WS_CTL, 0, CTL_ZERO_BYTES, stream) != hipSuccess) return;
    Args a{};
    for (int i = 0; i < 34; ++i) a.in[i] = d_in[i];
    a.out = (float*)d_out; a.ws = (unsigned char*)d_ws; a.ph_lo = 0; a.ph_hi = TOTAL_PHASES;
    hipLaunchKernelGGL(fwd, dim3(grid), dim3(NTHR), LDS_BYTES, stream, a);
}
```

```cpp
#include <hip/hip_runtime.h>
#ifndef PROBE_DUP
#define PROBE_DUP 0
#endif
#include <cstdio>
#include <cstdint>

#define LAS __attribute__((address_space(3)))
#define GAS __attribute__((address_space(1)))
typedef unsigned short bf16_t;
typedef short bf16x8 __attribute__((ext_vector_type(8)));
typedef float f32x4 __attribute__((ext_vector_type(4)));
typedef float f32x2 __attribute__((ext_vector_type(2)));
typedef unsigned u32x4 __attribute__((ext_vector_type(4)));
typedef unsigned u32x2 __attribute__((ext_vector_type(2)));

constexpr int NB = 16, T = 4096, M = NB * T, D = 1024, PLE = 256, DEPTH = 2;
constexpr float DN_ALPHA = 1.41421356237f;
constexpr float LN_EPS = 1e-5f;
constexpr int EVN = 3096, EVP = 3328;
constexpr int NEXP = 32, MOE_H = 512, MOE_BLK = 256, MOE_A = 2 * M, MOE_P = MOE_A + NEXP * MOE_BLK, MOE_TILES = MOE_P / 256;

constexpr size_t MiB = 1u << 20;
constexpr size_t WS_CTL = 0, CTL_ZERO_BYTES = 1 * MiB;
constexpr size_t WS_WEVIN = 1 * MiB, WS_WEVOUT = 8 * MiB, WS_WODIN = 10 * MiB, WS_WODOUT = 18 * MiB, WS_WGATE = 20 * MiB, WS_WPLE = 24 * MiB, WS_WLORA = 25 * MiB, WS_WCMP = 26 * MiB;
constexpr size_t WS_MISC = 27 * MiB;
constexpr size_t WS_WMOE13 = 33 * MiB, WS_WMOE2 = 97 * MiB, WS_PBF = 129 * MiB, WS_XB = 161 * MiB, WS_ARENA = 289 * MiB;
constexpr size_t A_H = WS_ARENA, A_HID = WS_ARENA + 128 * MiB, A_H8 = A_HID + 68 * MiB, A_XBUF = WS_ARENA + 264 * MiB, A_PP1 = WS_ARENA + 536 * MiB;
static_assert((size_t)MOE_P * MOE_H <= 68 * MiB && A_H8 + (size_t)M * D <= A_XBUF, "e4m3 buffers");
constexpr size_t A_UNUSED_ = 0;
constexpr size_t A_ACT = WS_ARENA + 416 * MiB, A_DEC = A_ACT + 32 * MiB, A_AA = A_DEC + 128 * MiB, A_GG = A_AA + 64 * MiB;
constexpr size_t A_SC4 = A_ACT;
constexpr size_t DOUT_QR = 160 * MiB, DOUT_SEG = 224 * MiB;
constexpr size_t A_HC2 = WS_ARENA + 704 * MiB, A_KVC2 = A_HC2 + 16 * MiB;
static_assert(A_KVC2 + 2 * MiB <= 1024 * MiB && A_GG + 64 * MiB <= A_HC2, "arena map");
static_assert(A_PP1 + 128 * MiB <= 1024 * MiB && A_PP1 >= WS_ARENA + 512 * MiB && A_XBUF + 272 * MiB <= A_PP1 && A_HID + 136 * MiB <= A_XBUF, "post-mixer arena map");
constexpr size_t WS_END = 1024 * MiB;
constexpr size_t WS_WRB = 29 * MiB;
constexpr size_t MISC_LBT = 31 * MiB;
constexpr size_t WS_TOKS = 30 * MiB;
constexpr size_t MISC_EID = WS_MISC, MISC_GATE = WS_MISC + 512 * 1024, MISC_SLOT = WS_MISC + 1024 * 1024, MISC_BCNT = WS_MISC + 1536 * 1024, MISC_TILEE = MISC_BCNT + 64 * 1024, MISC_CMPB = MISC_TILEE + 4096;
constexpr int CW_BAR = 4096;

constexpr int NWAVES = 8, NTHR = 512;
typedef __bf16 bf16x2_t __attribute__((ext_vector_type(2)));
__device__ __forceinline__ unsigned cvt_pk_bf16(float lo, float hi) { f32x2 v = {lo, hi}; return __builtin_bit_cast(unsigned, __builtin_convertvector(v, bf16x2_t)); }
__device__ __forceinline__ float bf2f(unsigned short b) { return __uint_as_float(((unsigned)b) << 16); }
__device__ __forceinline__ unsigned cvt_pk4_fp8(float a, float b, float c, float d) { int w = __builtin_amdgcn_cvt_pk_fp8_f32(a, b, 0, false); return (unsigned)__builtin_amdgcn_cvt_pk_fp8_f32(c, d, w, true); }
__device__ __forceinline__ float f8clamp(float x) { return __builtin_amdgcn_fmed3f(x, -448.0f, 448.0f); }
__device__ __forceinline__ unsigned cvt_pk4_fp8_sat(float a, float b, float c, float d) { return cvt_pk4_fp8(f8clamp(a), f8clamp(b), f8clamp(c), f8clamp(d)); }
__device__ __forceinline__ float bflo(unsigned w) { return __uint_as_float(w << 16); }
__device__ __forceinline__ float bfhi(unsigned w) { return __uint_as_float(w & 0xffff0000u); }
template <int CTRL, int RM> __device__ __forceinline__ float dpp_addx(float v) { return v + __builtin_bit_cast(float, __builtin_amdgcn_update_dpp(0, __builtin_bit_cast(int, v), CTRL, RM, 0xf, false)); }
__device__ __forceinline__ float wave_sum(float v) {
    v = dpp_addx<0xB1, 0xf>(v); v = dpp_addx<0x4E, 0xf>(v); v = dpp_addx<0x141, 0xf>(v); v = dpp_addx<0x140, 0xf>(v);
    v = dpp_addx<0x142, 0xa>(v); v = dpp_addx<0x143, 0xc>(v);
    return __builtin_bit_cast(float, __builtin_amdgcn_readlane(__builtin_bit_cast(int, v), 63));
}
__device__ __forceinline__ float sigmoidf_(float x) { return __builtin_amdgcn_rcpf(1.0f + __expf(-x)); }
__device__ __forceinline__ float siluf_(float x) { return x * __builtin_amdgcn_rcpf(1.0f + __expf(-x)); }
__device__ __forceinline__ int pinned_tid() { int t = threadIdx.x; asm volatile("" : "+v"(t)); return t; }
#define LDS_WAIT() asm volatile("s_waitcnt lgkmcnt(0)" ::: "memory")
#define VM_WAIT() asm volatile("s_waitcnt vmcnt(0)" ::: "memory")

namespace pg8 {
constexpr int BM = 256, BK = 64, HALF = 128, HTB = HALF * BK * 2, STAGE_BYTES = 8 * HTB, NXCD = 8, WGM = 8;
__host__ __device__ __forceinline__ int lds_byte(int r, int c) { const int st = (r >> 4) * 2 + (c >> 5), rr = r & 15, cc = c & 31, ob = rr * 64 + cc * 2; return st * 1024 + (ob ^ (((ob >> 9) & 1) << 5)); }
__host__ __device__ __forceinline__ void stage_rc(int b, int& R, int& C) { const int st = b / 1024, sb = b % 1024, swz = sb ^ (((sb >> 9) & 1) << 5); R = (st >> 1) * 16 + swz / 64; C = (st & 1) * 32 + (swz % 64) / 2; }
__host__ __device__ __forceinline__ int perm32(int rho) { const int n = rho >> 4, i = rho & 15; return 8 * (i >> 2) + 4 * n + (i & 3); }

struct Unit { int pm, pn, pb; };
struct Gemm { const bf16_t* A; const bf16_t* Bt; int lda, ldb, K; };

struct DenseOrder {
    int nM, nN, nwg, G, c;
    __device__ void init(int M_, int N_, int G_, int c_) { nM = M_ / BM; nN = N_ / BM; nwg = nM * nN; G = G_; c = c_; }
    __device__ bool next(int i, Unit& u) const {
        const long L = (long)i * G + c; if (L >= nwg) return false;
        int wgid = (int)L; { const int q = nwg / NXCD, r = nwg % NXCD, xcd = wgid % NXCD, off = wgid / NXCD; wgid = (xcd < r ? xcd * (q + 1) : r * (q + 1) + (xcd - r) * q) + off; }
        const int nig = WGM * nN, gid = wgid / nig, fm = gid * WGM, gsz = (nM - fm) < WGM ? (nM - fm) : WGM;
        u.pm = fm + ((wgid % nig) % gsz); u.pn = (wgid % nig) / gsz; u.pb = u.pn; return true;
    }
};
struct MoeOrder {
    const int* tile_e; int ntiles, G, c;
    __device__ bool next(int i, Unit& u) const {
        if ((G & 7) == 0) {
            const int x = c & 7, r = c >> 3, w = G >> 3, k = i * w + r, q = k >> 2, t = q * 8 + x;
            if (t >= ntiles) return false;
            u.pm = t; u.pn = k & 3; u.pb = __builtin_amdgcn_readfirstlane(tile_e[t]) * 4 + u.pn; return true;
        }
        const long L = (long)i * G + c; if (L >= (long)ntiles * 4) return false;
        u.pm = (int)(L >> 2); u.pn = (int)(L & 3); u.pb = __builtin_amdgcn_readfirstlane(tile_e[u.pm]) * 4 + u.pn; return true;
    }
};

template <class Epi, class Sched>
__device__ __forceinline__ void gemm_phase(LAS unsigned char* lds, const Gemm g, const Sched& S, const Epi& E) {
    int tid_ = threadIdx.x; asm volatile("" : "+v"(tid_)); const int tid = tid_, wid = __builtin_amdgcn_readfirstlane(tid >> 6), lane = tid & 63, wr = wid >> 2, wc = wid & 3, fr = lane & 15, fq = lane >> 4;
    int K_ = g.K, lda_ = g.lda, ldb_ = g.ldb; asm volatile("" : "+s"(K_), "+s"(lda_), "+s"(ldb_)); const int K = K_, nt = K / BK;
    unsigned voffA[2], voffB[2];
#pragma unroll
    for (int i = 0; i < 2; ++i) { int R, C; stage_rc(tid * 16 + i * 8192, R, C); const int Rb = Epi::PERM ? ((R & ~31) + perm32(R & 31)) : R;
        voffA[i] = (unsigned)(R * lda_ + C) * 2u; voffB[i] = (unsigned)(Rb * ldb_ + C) * 2u; }
    const size_t kstep = (size_t)(BK * 2);
    const size_t hstepA = (size_t)HALF * lda_ * 2, hstepB = (size_t)HALF * ldb_ * 2;
    const size_t tstepA = 2 * hstepA, tstepB = 2 * hstepB;
    const unsigned ldsw = (unsigned)wid * 1024u;
    const int aoff = lds_byte(wr * 64 + fr, fq * 8), boff = lds_byte(wc * 32 + fr, fq * 8);
#define PG8_SA(b, h) (((b) * 2 + (h)) * HTB)
#define PG8_SB(b, h) ((4 + (b) * 2 + (h)) * HTB)
#define PG8_STAGE(bufoff, gbase, voff) do { _Pragma("unroll") for (int _i = 0; _i < 2; ++_i) \
        __builtin_amdgcn_global_load_lds((const unsigned*)((const char*)(gbase) + (voff)[_i]), (LAS unsigned*)(lds + (bufoff) + ldsw + _i * 8192), 16, 0, 0); } while (0)
#define PG8_LDA(dst, b, h) do { _Pragma("unroll") for (int m = 0; m < 4; ++m) _Pragma("unroll") for (int k = 0; k < 2; ++k) dst[m][k] = *(const LAS bf16x8*)(lds + PG8_SA(b, h) + aoff + m * 2048 + k * 1024); } while (0)
#define PG8_LDB(dst, b, h) do { _Pragma("unroll") for (int n = 0; n < 2; ++n) _Pragma("unroll") for (int k = 0; k < 2; ++k) dst[n][k] = *(const LAS bf16x8*)(lds + PG8_SB(b, h) + boff + n * 2048 + k * 1024); } while (0)
#define PG8_MMA(ai, bj, At, Bt) do { __builtin_amdgcn_s_setprio(1); _Pragma("unroll") for (int m = 0; m < 4; ++m) _Pragma("unroll") for (int n = 0; n < 2; ++n) _Pragma("unroll") for (int k = 0; k < 2; ++k) \
        acc[ai][bj][m][n] = __builtin_amdgcn_mfma_f32_16x16x32_bf16(Bt[n][k], At[m][k], acc[ai][bj][m][n], 0, 0, 0); __builtin_amdgcn_s_setprio(0); } while (0)
#define PG8_WAIT_V(n) asm volatile("s_waitcnt vmcnt(" #n ")" ::: "memory")
#define PG8_WAIT_L(n) asm volatile("s_waitcnt lgkmcnt(" #n ")" ::: "memory")
#define PG8_BAR __builtin_amdgcn_s_barrier()
#define PG8_SCHED __builtin_amdgcn_sched_barrier(0)
    Unit cur, nxt; int ui = 0;
    if (!S.next(0, cur)) return;
    f32x4 acc[2][2][4][2];
#pragma unroll
    for (int a = 0; a < 2; ++a)
#pragma unroll
        for (int b = 0; b < 2; ++b)
#pragma unroll
            for (int m = 0; m < 4; ++m)
#pragma unroll
                for (int n = 0; n < 2; ++n) acc[a][b][m][n] = (f32x4){0.f, 0.f, 0.f, 0.f};
    bf16x8 At[4][2], B0[2][2], B1[2][2];
    const char* cA = (const char*)g.A + (size_t)cur.pm * tstepA; const char* cB = (const char*)g.Bt + (size_t)cur.pb * tstepB;
    PG8_STAGE(PG8_SB(0, 0), cB, voffB); PG8_STAGE(PG8_SB(0, 1), cB + hstepB, voffB); PG8_STAGE(PG8_SA(0, 0), cA, voffA); PG8_STAGE(PG8_SA(0, 1), cA + hstepA, voffA);
    if (wr == 1) PG8_BAR;
    PG8_WAIT_V(2); PG8_BAR;
    PG8_STAGE(PG8_SB(1, 0), cB + kstep, voffB); PG8_STAGE(PG8_SA(1, 0), cA + kstep, voffA); PG8_STAGE(PG8_SB(1, 1), cB + hstepB + kstep, voffB);
    PG8_WAIT_V(6); PG8_BAR;
    for (;;) {
        const bool has_next = S.next(ui + 1, nxt);
        const char* nA = has_next ? (const char*)g.A + (size_t)nxt.pm * tstepA : cA; const char* nB = has_next ? (const char*)g.Bt + (size_t)nxt.pb * tstepB : cB;
#pragma nounroll
        for (int t = 0; t < nt; t += 2) {
            const bool last = (t == nt - 2);
            const char* a1 = cA + (size_t)(t + 1) * kstep;
            const char* a2 = last ? nA : cA + (size_t)(t + 2) * kstep; const char* b2 = last ? nB : cB + (size_t)(t + 2) * kstep;
            const char* a3 = a2 + kstep; const char* b3 = b2 + kstep;
            PG8_LDB(B0, 0, 0); PG8_LDB(B1, 0, 1); PG8_SCHED; PG8_LDA(At, 0, 0); PG8_STAGE(PG8_SA(1, 1), a1 + hstepA, voffA);
            PG8_WAIT_V(8); PG8_WAIT_L(0); PG8_BAR; PG8_MMA(0, 0, At, B0); PG8_MMA(0, 1, At, B1); PG8_BAR; PG8_SCHED;
            PG8_LDA(At, 0, 1); PG8_STAGE(PG8_SB(0, 0), b2, voffB); PG8_STAGE(PG8_SB(0, 1), b2 + hstepB, voffB); PG8_STAGE(PG8_SA(0, 0), a2, voffA);
            PG8_WAIT_V(8); PG8_WAIT_L(0); PG8_BAR; PG8_MMA(1, 0, At, B0); PG8_MMA(1, 1, At, B1); PG8_BAR; PG8_SCHED;
            PG8_LDB(B0, 1, 0); PG8_LDB(B1, 1, 1); PG8_SCHED; PG8_LDA(At, 1, 0); PG8_STAGE(PG8_SA(0, 1), a2 + hstepA, voffA);
            PG8_WAIT_V(8); PG8_WAIT_L(0); PG8_BAR; PG8_MMA(0, 0, At, B0); PG8_MMA(0, 1, At, B1); PG8_BAR; PG8_SCHED;
            PG8_LDA(At, 1, 1); PG8_STAGE(PG8_SB(1, 0), b3, voffB); PG8_STAGE(PG8_SB(1, 1), b3 + hstepB, voffB); PG8_STAGE(PG8_SA(1, 0), a3, voffA);
            PG8_WAIT_V(8); PG8_WAIT_L(0); PG8_BAR; PG8_MMA(1, 0, At, B0); PG8_MMA(1, 1, At, B1); PG8_BAR; PG8_SCHED;
        }
        if (wr == 0) PG8_BAR;
        E(acc, cur, wr, wc, fr, fq);
        if (!has_next) break;
#pragma unroll
        for (int a = 0; a < 2; ++a)
#pragma unroll
            for (int b = 0; b < 2; ++b)
#pragma unroll
                for (int m = 0; m < 4; ++m)
#pragma unroll
                    for (int n = 0; n < 2; ++n) acc[a][b][m][n] = (f32x4){0.f, 0.f, 0.f, 0.f};
        cur = nxt; cA = nA; cB = nB; ++ui;
        if (wr == 1) PG8_BAR;
    }
    PG8_WAIT_V(0);
    PG8_BAR;
#undef PG8_SA
#undef PG8_SB
#undef PG8_STAGE
#undef PG8_LDA
#undef PG8_LDB
#undef PG8_MMA
#undef PG8_WAIT_V
#undef PG8_WAIT_L
#undef PG8_BAR
#undef PG8_SCHED
}

template <class Epi, class Sched>
__device__ __forceinline__ void gemm_phase_gather(LAS unsigned char* lds, const Gemm g, const Sched& S, const Epi& E, const int* toks) {
    int tid_ = threadIdx.x; asm volatile("" : "+v"(tid_)); const int tid = tid_, wid = __builtin_amdgcn_readfirstlane(tid >> 6), lane = tid & 63, wr = wid >> 2, wc = wid & 3, fr = lane & 15, fq = lane >> 4;
    int K_ = g.K, lda_ = g.lda, ldb_ = g.ldb; asm volatile("" : "+s"(K_), "+s"(lda_), "+s"(ldb_)); const int K = K_, nt = K / BK;
    unsigned voffB[2]; int RA[2]; unsigned CA[2];
#pragma unroll
    for (int i = 0; i < 2; ++i) { int R, C; stage_rc(tid * 16 + i * 8192, R, C); const int Rb = Epi::PERM ? ((R & ~31) + perm32(R & 31)) : R;
        RA[i] = R; CA[i] = (unsigned)C * 2u; voffB[i] = (unsigned)(Rb * ldb_ + C) * 2u; }
    unsigned voC[2][2], voN[2][2];
#define PG8_GOFF(VO, U) do { _Pragma("unroll") for (int h_ = 0; h_ < 2; ++h_) _Pragma("unroll") for (int i_ = 0; i_ < 2; ++i_) VO[h_][i_] = (unsigned)(toks[(U).pm * BM + h_ * HALF + RA[i_]] & 0xffff) * (unsigned)(lda_ * 2) + CA[i_]; } while (0)
    const size_t kstep = (size_t)(BK * 2);
    const size_t hstepA = (size_t)HALF * lda_ * 2, hstepB = (size_t)HALF * ldb_ * 2;
    const size_t tstepA = 2 * hstepA, tstepB = 2 * hstepB;
    const unsigned ldsw = (unsigned)wid * 1024u;
    const int aoff = lds_byte(wr * 64 + fr, fq * 8), boff = lds_byte(wc * 32 + fr, fq * 8);
#define PG8_SA(b, h) (((b) * 2 + (h)) * HTB)
#define PG8_SB(b, h) ((4 + (b) * 2 + (h)) * HTB)
#define PG8_STAGE(bufoff, gbase, voff) do { _Pragma("unroll") for (int _i = 0; _i < 2; ++_i) \
        __builtin_amdgcn_global_load_lds((const unsigned*)((const char*)(gbase) + (voff)[_i]), (LAS unsigned*)(lds + (bufoff) + ldsw + _i * 8192), 16, 0, 0); } while (0)
#define PG8_LDA(dst, b, h) do { _Pragma("unroll") for (int m = 0; m < 4; ++m) _Pragma("unroll") for (int k = 0; k < 2; ++k) dst[m][k] = *(const LAS bf16x8*)(lds + PG8_SA(b, h) + aoff + m * 2048 + k * 1024); } while (0)
#define PG8_LDB(dst, b, h) do { _Pragma("unroll") for (int n = 0; n < 2; ++n) _Pragma("unroll") for (int k = 0; k < 2; ++k) dst[n][k] = *(const LAS bf16x8*)(lds + PG8_SB(b, h) + boff + n * 2048 + k * 1024); } while (0)
#define PG8_MMA(ai, bj, At, Bt) do { __builtin_amdgcn_s_setprio(1); _Pragma("unroll") for (int m = 0; m < 4; ++m) _Pragma("unroll") for (int n = 0; n < 2; ++n) _Pragma("unroll") for (int k = 0; k < 2; ++k) \
        acc[ai][bj][m][n] = __builtin_amdgcn_mfma_f32_16x16x32_bf16(Bt[n][k], At[m][k], acc[ai][bj][m][n], 0, 0, 0); __builtin_amdgcn_s_setprio(0); } while (0)
#define PG8_WAIT_V(n) asm volatile("s_waitcnt vmcnt(" #n ")" ::: "memory")
#define PG8_WAIT_L(n) asm volatile("s_waitcnt lgkmcnt(" #n ")" ::: "memory")
#define PG8_BAR __builtin_amdgcn_s_barrier()
#define PG8_SCHED __builtin_amdgcn_sched_barrier(0)
    Unit cur, nxt; int ui = 0;
    if (!S.next(0, cur)) return;
    f32x4 acc[2][2][4][2];
#pragma unroll
    for (int a = 0; a < 2; ++a)
#pragma unroll
        for (int b = 0; b < 2; ++b)
#pragma unroll
            for (int m = 0; m < 4; ++m)
#pragma unroll
                for (int n = 0; n < 2; ++n) acc[a][b][m][n] = (f32x4){0.f, 0.f, 0.f, 0.f};
    bf16x8 At[4][2], B0[2][2], B1[2][2];
    const char* const kA = (const char*)g.A; const char* cB = (const char*)g.Bt + (size_t)cur.pb * tstepB;
    PG8_GOFF(voC, cur);
    PG8_STAGE(PG8_SB(0, 0), cB, voffB); PG8_STAGE(PG8_SB(0, 1), cB + hstepB, voffB); PG8_STAGE(PG8_SA(0, 0), kA, voC[0]); PG8_STAGE(PG8_SA(0, 1), kA, voC[1]);
    if (wr == 1) PG8_BAR;
    PG8_WAIT_V(2); PG8_BAR;
    PG8_STAGE(PG8_SB(1, 0), cB + kstep, voffB); PG8_STAGE(PG8_SA(1, 0), kA + kstep, voC[0]); PG8_STAGE(PG8_SB(1, 1), cB + hstepB + kstep, voffB);
    PG8_WAIT_V(6); PG8_BAR;
    for (;;) {
        const bool has_next = S.next(ui + 1, nxt);
        const char* nB = has_next ? (const char*)g.Bt + (size_t)nxt.pb * tstepB : cB;
        if (has_next) PG8_GOFF(voN, nxt); else { _Pragma("unroll") for (int h_ = 0; h_ < 2; ++h_) _Pragma("unroll") for (int i_ = 0; i_ < 2; ++i_) voN[h_][i_] = voC[h_][i_]; }
#pragma nounroll
        for (int t = 0; t < nt; t += 2) {
            const bool last = (t == nt - 2);
            const char* a1 = kA + (size_t)(t + 1) * kstep;
            const char* a2 = last ? kA : kA + (size_t)(t + 2) * kstep; const char* b2 = last ? nB : cB + (size_t)(t + 2) * kstep;
            unsigned vo2[2][2];
#pragma unroll
            for (int h_ = 0; h_ < 2; ++h_)
#pragma unroll
                for (int i_ = 0; i_ < 2; ++i_) vo2[h_][i_] = last ? voN[h_][i_] : voC[h_][i_];
            const char* a3 = a2 + kstep; const char* b3 = b2 + kstep;
            PG8_LDB(B0, 0, 0); PG8_LDB(B1, 0, 1); PG8_SCHED; PG8_LDA(At, 0, 0); PG8_STAGE(PG8_SA(1, 1), a1, voC[1]);
            PG8_WAIT_V(8); PG8_WAIT_L(0); PG8_BAR; PG8_MMA(0, 0, At, B0); PG8_MMA(0, 1, At, B1); PG8_BAR; PG8_SCHED;
            PG8_LDA(At, 0, 1); PG8_STAGE(PG8_SB(0, 0), b2, voffB); PG8_STAGE(PG8_SB(0, 1), b2 + hstepB, voffB); PG8_STAGE(PG8_SA(0, 0), a2, vo2[0]);
            PG8_WAIT_V(8); PG8_WAIT_L(0); PG8_BAR; PG8_MMA(1, 0, At, B0); PG8_MMA(1, 1, At, B1); PG8_BAR; PG8_SCHED;
            PG8_LDB(B0, 1, 0); PG8_LDB(B1, 1, 1); PG8_SCHED; PG8_LDA(At, 1, 0); PG8_STAGE(PG8_SA(0, 1), a2, vo2[1]);
            PG8_WAIT_V(8); PG8_WAIT_L(0); PG8_BAR; PG8_MMA(0, 0, At, B0); PG8_MMA(0, 1, At, B1); PG8_BAR; PG8_SCHED;
            PG8_LDA(At, 1, 1); PG8_STAGE(PG8_SB(1, 0), b3, voffB); PG8_STAGE(PG8_SB(1, 1), b3 + hstepB, voffB); PG8_STAGE(PG8_SA(1, 0), a3, vo2[0]);
            PG8_WAIT_V(8); PG8_WAIT_L(0); PG8_BAR; PG8_MMA(1, 0, At, B0); PG8_MMA(1, 1, At, B1); PG8_BAR; PG8_SCHED;
        }
        if (wr == 0) PG8_BAR;
        E(acc, cur, wr, wc, fr, fq);
        if (!has_next) break;
#pragma unroll
        for (int a = 0; a < 2; ++a)
#pragma unroll
            for (int b = 0; b < 2; ++b)
#pragma unroll
                for (int m = 0; m < 4; ++m)
#pragma unroll
                    for (int n = 0; n < 2; ++n) acc[a][b][m][n] = (f32x4){0.f, 0.f, 0.f, 0.f};
        cur = nxt; cB = nB; ++ui;
#pragma unroll
        for (int h_ = 0; h_ < 2; ++h_)
#pragma unroll
            for (int i_ = 0; i_ < 2; ++i_) voC[h_][i_] = voN[h_][i_];
        if (wr == 1) PG8_BAR;
    }
    PG8_WAIT_V(0);
    PG8_BAR;
#undef PG8_GOFF
#undef PG8_SA
#undef PG8_SB
#undef PG8_STAGE
#undef PG8_LDA
#undef PG8_LDB
#undef PG8_MMA
#undef PG8_WAIT_V
#undef PG8_WAIT_L
#undef PG8_BAR
#undef PG8_SCHED
}


struct EpiBf16 {
    static constexpr bool PERM = true;
    bf16_t* O; int ldc; unsigned silu_mask; unsigned fg_mask; const float* lbt;
    __device__ __forceinline__ void operator()(const f32x4 (&acc)[2][2][4][2], const Unit& u, int wr, int wc, int fr, int fq) const {
        const int row0 = u.pm * BM + wr * 64 + fr, col0 = u.pn * BM + wc * 32 + 8 * fq;
        const bool act = (silu_mask >> u.pn) & 1u, fgm = (fg_mask >> u.pn) & 1u;
#pragma unroll
        for (int bj = 0; bj < 2; ++bj) {
            f32x4 l0 = (f32x4){0.f, 0.f, 0.f, 0.f}, l1 = l0;
            if (fgm) { const int cc = (col0 & 1023) + bj * HALF; l0 = *(const f32x4*)(lbt + cc); l1 = *(const f32x4*)(lbt + cc + 4); }
#pragma unroll
            for (int ai = 0; ai < 2; ++ai)
#pragma unroll
                for (int m = 0; m < 4; ++m) { bf16_t* rowp = O + (size_t)(row0 + ai * HALF + m * 16) * ldc + col0;
                    f32x4 v0 = acc[ai][bj][m][0], v1 = acc[ai][bj][m][1];
                    if (act) {
#pragma unroll
                        for (int j = 0; j < 4; ++j) { v0[j] = siluf_(v0[j]); v1[j] = siluf_(v1[j]); } }
                    if (fgm) {
#pragma unroll
                        for (int j = 0; j < 4; ++j) { v0[j] = l0[j] + (1.0f - l0[j]) * sigmoidf_(v0[j]); v1[j] = l1[j] + (1.0f - l1[j]) * sigmoidf_(v1[j]); } }
                    u32x4 w; w.x = cvt_pk_bf16(v0[0], v0[1]); w.y = cvt_pk_bf16(v0[2], v0[3]); w.z = cvt_pk_bf16(v1[0], v1[1]); w.w = cvt_pk_bf16(v1[2], v1[3]);
                    *(u32x4*)(rowp + bj * HALF) = w; }
        }
    }
};
struct EpiGate {
    static constexpr bool PERM = true;
    const bf16_t* h2; const bf16_t* pp; float* xout; bf16_t* xb;
    __device__ __forceinline__ void operator()(const f32x4 (&acc)[2][2][4][2], const Unit& u, int wr, int wc, int fr, int fq) const {
        const int row0 = u.pm * BM + wr * 64 + fr, col0 = u.pn * BM + wc * 32 + 8 * fq;
#pragma unroll
        for (int ai = 0; ai < 2; ++ai)
#pragma unroll
            for (int m = 0; m < 4; ++m) { const size_t off = (size_t)(row0 + ai * HALF + m * 16) * D + col0;
#pragma unroll
                for (int bj = 0; bj < 2; ++bj) { const size_t o = off + bj * HALF;
                    const u32x4 hw = *(const u32x4*)(h2 + o), pw = *(const u32x4*)(pp + o); const f32x4 a0 = acc[ai][bj][m][0], a1 = acc[ai][bj][m][1];
                    f32x4 r0, r1;
                    r0[0] = bflo(hw.x) + sigmoidf_(a0[0]) * bflo(pw.x); r0[1] = bfhi(hw.x) + sigmoidf_(a0[1]) * bfhi(pw.x); r0[2] = bflo(hw.y) + sigmoidf_(a0[2]) * bflo(pw.y); r0[3] = bfhi(hw.y) + sigmoidf_(a0[3]) * bfhi(pw.y);
                    r1[0] = bflo(hw.z) + sigmoidf_(a1[0]) * bflo(pw.z); r1[1] = bfhi(hw.z) + sigmoidf_(a1[1]) * bfhi(pw.z); r1[2] = bflo(hw.w) + sigmoidf_(a1[2]) * bflo(pw.w); r1[3] = bfhi(hw.w) + sigmoidf_(a1[3]) * bfhi(pw.w);
                    if (xout) { *(f32x4*)(xout + o) = r0; *(f32x4*)(xout + o + 4) = r1; }
                    else *(u32x4*)(xb + o) = (u32x4){cvt_pk_bf16(r0[0], r0[1]), cvt_pk_bf16(r0[2], r0[3]), cvt_pk_bf16(r1[0], r1[1]), cvt_pk_bf16(r1[2], r1[3])}; }
                asm volatile("" ::: "memory"); }
    }
};
struct EpiPre {
    static constexpr bool PERM = true;
    const float* xf; const bf16_t* xh; bf16_t* pre;
    __device__ __forceinline__ void operator()(const f32x4 (&acc)[2][2][4][2], const Unit& u, int wr, int wc, int fr, int fq) const {
        const int row0 = u.pm * BM + wr * 64 + fr, col0 = u.pn * BM + wc * 32 + 8 * fq;
#pragma unroll
        for (int ai = 0; ai < 2; ++ai)
#pragma unroll
            for (int m = 0; m < 4; ++m) { const size_t off = (size_t)(row0 + ai * HALF + m * 16) * D + col0;
#pragma unroll
                for (int bj = 0; bj < 2; ++bj) { const size_t o = off + bj * HALF; f32x4 x0, x1;
                    if (xf) { x0 = *(const f32x4*)(xf + o); x1 = *(const f32x4*)(xf + o + 4); }
                    else { const u32x4 w = *(const u32x4*)(xh + o); x0 = (f32x4){bflo(w.x), bfhi(w.x), bflo(w.y), bfhi(w.y)}; x1 = (f32x4){bflo(w.z), bfhi(w.z), bflo(w.w), bfhi(w.w)}; }
                    const f32x4 r0 = x0 * DN_ALPHA + acc[ai][bj][m][0], r1 = x1 * DN_ALPHA + acc[ai][bj][m][1];
                    *(u32x4*)(pre + o) = (u32x4){cvt_pk_bf16(r0[0], r0[1]), cvt_pk_bf16(r0[2], r0[3]), cvt_pk_bf16(r1[0], r1[1]), cvt_pk_bf16(r1[2], r1[3])}; }
                asm volatile("" ::: "memory"); }
    }
};
struct EpiMoe1 {
    static constexpr bool PERM = true;
    bf16_t* hid;
    __device__ __forceinline__ void operator()(const f32x4 (&acc)[2][2][4][2], const Unit& u, int wr, int wc, int fr, int fq) const {
        const int row0 = u.pm * BM + wr * 64 + fr, col0 = u.pn * HALF + wc * 32 + 8 * fq;
#pragma unroll
        for (int ai = 0; ai < 2; ++ai)
#pragma unroll
            for (int m = 0; m < 4; ++m) { bf16_t* rowp = hid + (size_t)(row0 + ai * HALF + m * 16) * MOE_H + col0;
                f32x4 v0, v1;
#pragma unroll
                for (int j = 0; j < 4; ++j) { v0[j] = siluf_(acc[ai][0][m][0][j]) * acc[ai][1][m][0][j]; v1[j] = siluf_(acc[ai][0][m][1][j]) * acc[ai][1][m][1][j]; }
                u32x4 w; w.x = cvt_pk_bf16(v0[0], v0[1]); w.y = cvt_pk_bf16(v0[2], v0[3]); w.z = cvt_pk_bf16(v1[0], v1[1]); w.w = cvt_pk_bf16(v1[2], v1[3]);
                *(u32x4*)rowp = w; }
    }
};
struct EpiLora {
    static constexpr bool PERM = true;
    const float* w0; const float* a0; float* dec; bf16_t* aa; bf16_t* gg;
    __device__ __forceinline__ void operator()(const f32x4 (&acc)[2][2][4][2], const Unit& u, int wr, int wc, int fr, int fq) const {
        const int row0 = u.pm * BM + wr * 64 + fr, seg = u.pn >> 1, c0 = (u.pn & 1) * BM + wc * 32 + 8 * fq;
#pragma unroll
        for (int bj = 0; bj < 2; ++bj) {
            const int c = c0 + bj * HALF;
            f32x4 b0 = (f32x4){0.f, 0.f, 0.f, 0.f}, b1 = b0;
            if (seg == 0) { b0 = *(const f32x4*)(w0 + c); b1 = *(const f32x4*)(w0 + c + 4); } else if (seg == 1) { b0 = *(const f32x4*)(a0 + c); b1 = *(const f32x4*)(a0 + c + 4); }
#pragma unroll
            for (int ai = 0; ai < 2; ++ai)
#pragma unroll
                for (int m = 0; m < 4; ++m) { const size_t o = (size_t)(row0 + ai * HALF + m * 16) * 512 + c;
                    f32x4 v0 = acc[ai][bj][m][0] + b0, v1 = acc[ai][bj][m][1] + b1;
                    if (seg == 0) {
#pragma unroll
                        for (int j = 0; j < 4; ++j) { v0[j] = __expf(-0.60653066f * sigmoidf_(v0[j])); v1[j] = __expf(-0.60653066f * sigmoidf_(v1[j])); }
                        *(f32x4*)(dec + o) = v0; *(f32x4*)(dec + o + 4) = v1;
                    } else {
                        if (seg == 1) {
#pragma unroll
                            for (int j = 0; j < 4; ++j) { v0[j] = sigmoidf_(v0[j]); v1[j] = sigmoidf_(v1[j]); } }
                        u32x4 w; w.x = cvt_pk_bf16(v0[0], v0[1]); w.y = cvt_pk_bf16(v0[2], v0[3]); w.z = cvt_pk_bf16(v1[0], v1[1]); w.w = cvt_pk_bf16(v1[2], v1[3]);
                        if (seg == 1) *(u32x4*)(aa + o) = w; else *(u32x4*)(gg + o) = w;
                    } }
        }
    }
};
struct EpiF32 {
    static constexpr bool PERM = false;
    float* C; int ldc;
    __device__ __forceinline__ void operator()(const f32x4 (&acc)[2][2][4][2], const Unit& u, int wr, int wc, int fr, int fq) const {
        const int row0 = u.pm * BM + wr * 64 + fr, col0 = u.pn * BM + wc * 32 + 4 * fq;
#pragma unroll
        for (int ai = 0; ai < 2; ++ai)
#pragma unroll
            for (int m = 0; m < 4; ++m) { float* rowp = C + (size_t)(row0 + ai * HALF + m * 16) * ldc + col0;
#pragma unroll
                for (int bj = 0; bj < 2; ++bj)
#pragma unroll
                    for (int n = 0; n < 2; ++n) *(f32x4*)(rowp + bj * HALF + n * 16) = acc[ai][bj][m][n]; }
    }
};
struct CmpOrder {
    int G, c;
    __device__ bool next(int i, Unit& u) const { const int L = i * G + c; if (L >= 64) return false; u.pm = L; u.pn = 0; u.pb = L >> 5; return true; }
};
struct EpiLogit {
    static constexpr bool PERM = false;
    float* LG;
    __device__ __forceinline__ void operator()(const f32x4 (&acc)[2][2][4][2], const Unit& u, int wr, int wc, int fr, int fq) const {
        if (wc >= 2) return;
        const int row0 = u.pm * BM + wr * 64 + fr, col0 = wc * 32 + 4 * fq;
#pragma unroll
        for (int ai = 0; ai < 2; ++ai)
#pragma unroll
            for (int m = 0; m < 4; ++m) { float* rowp = LG + (size_t)(row0 + ai * HALF + m * 16) * 64 + col0;
#pragma unroll
                for (int n = 0; n < 2; ++n) *(f32x4*)(rowp + n * 16) = acc[ai][0][m][n]; }
    }
};

typedef int i32x8 __attribute__((ext_vector_type(8)));
typedef int i32x4_ __attribute__((ext_vector_type(4)));
__device__ __forceinline__ i32x8 f8cat(const bf16x8& a, const bf16x8& b) { return __builtin_shufflevector(__builtin_bit_cast(i32x4_, a), __builtin_bit_cast(i32x4_, b), 0, 1, 2, 3, 4, 5, 6, 7); }
template <int MODE>
__device__ __forceinline__ void gemm_f8_phase(LAS unsigned char* lds, const unsigned char* A8, const unsigned char* B8, int Kb, const MoeOrder& S, const int* toks, unsigned char* hid8, bf16_t* Y) {
    int tid_ = threadIdx.x; asm volatile("" : "+v"(tid_)); const int tid = tid_, wid = __builtin_amdgcn_readfirstlane(tid >> 6), lane = tid & 63, wr = wid >> 2, wc = wid & 3, fr = lane & 15, fq = lane >> 4;
    int Kb_ = Kb; asm volatile("" : "+s"(Kb_)); const int nt = Kb_ >> 7;
    constexpr int BUFB = 49152, EST = (MODE == 0 ? 4 : 8), NRN = (MODE == 0 ? 4 : 0);
    int RA[2]; unsigned CA[2], voffB[2];
#pragma unroll
    for (int i = 0; i < 2; ++i) { int R, C; stage_rc(tid * 16 + i * 8192, R, C); RA[i] = R; CA[i] = (unsigned)C * 2u; voffB[i] = (unsigned)(((R & ~31) + perm32(R & 31)) * Kb_) + (unsigned)C * 2u; }
    const unsigned ldsw = (unsigned)wid * 1024u;
    const int aoff = lds_byte(wr * 64 + fr, fq * 8), boff = lds_byte(wc * 32 + fr, fq * 8);
    const size_t hstepB = (size_t)HALF * Kb_, tstepB = 2 * hstepB;
#define F8_ROWS(RO, U) do { _Pragma("unroll") for (int h_ = 0; h_ < 2; ++h_) _Pragma("unroll") for (int i_ = 0; i_ < 2; ++i_) { const int r_ = (U).pm * BM + h_ * HALF + RA[i_]; \
        RO[h_][i_] = (unsigned)(MODE == 0 ? (toks[r_] & 0xffff) : r_) * (unsigned)Kb_ + CA[i_]; } } while (0)
#define F8_DMA(dst, base, voff) __builtin_amdgcn_global_load_lds((const unsigned*)((const char*)(base) + (voff)), (LAS unsigned*)(lds + (dst)), 16, 0, 0)
#define F8_STAGE(U, RO, q, sb) do { const int h_ = (q) >= nt ? 1 : 0; const size_t ko_ = (size_t)((q) - h_ * nt) * 128; const char* bb_ = (const char*)B8 + (size_t)(U).pb * tstepB + ko_; const unsigned d_ = (unsigned)(sb) * BUFB + ldsw; \
        _Pragma("unroll") for (int i_ = 0; i_ < 2; ++i_) { F8_DMA(d_ + i_ * 8192, (const char*)A8 + ko_, RO[h_][i_]); F8_DMA(d_ + 16384 + i_ * 8192, bb_, voffB[i_]); F8_DMA(d_ + 32768 + i_ * 8192, bb_ + hstepB, voffB[i_]); } } while (0)
#define F8_WAIT(n) asm volatile("s_waitcnt vmcnt(" #n ")" ::: "memory")
    constexpr int ULIST = 3 * BUFB, UCAP = 512;
    { i32x4_ e = (i32x4_){0, 0, 0, 0}; const int i = tid;
      if ((S.G & 7) == 0) { const int x = S.c & 7, r = S.c >> 3, w = S.G >> 3, k = i * w + r, q = k >> 2, t = q * 8 + x; if (t < S.ntiles) e = (i32x4_){t, k & 3, S.tile_e[t] * 4 + (k & 3), 1}; }
      else { const long L = (long)i * S.G + S.c; if (L < (long)S.ntiles * 4) e = (i32x4_){(int)(L >> 2), (int)(L & 3), S.tile_e[(int)(L >> 2)] * 4 + (int)(L & 3), 1}; }
      if (i < UCAP) *(LAS i32x4_*)(lds + ULIST + i * 16) = e; }
    __syncthreads();
#define F8_UNIT(k, U, ok) do { i32x4_ e_ = (i32x4_){0, 0, 0, 0}; if ((k) < UCAP) e_ = *(const LAS i32x4_*)(lds + ULIST + (k) * 16); (U).pm = __builtin_amdgcn_readfirstlane(e_.x); (U).pn = __builtin_amdgcn_readfirstlane(e_.y); \
        (U).pb = __builtin_amdgcn_readfirstlane(e_.z); ok = __builtin_amdgcn_readfirstlane(e_.w) != 0; } while (0)
    Unit cur, nxt; int ui = 0; bool ok0;
    F8_UNIT(0, cur, ok0);
    if (!ok0) return;
    unsigned ro[2][2], rn[2][2];
    F8_ROWS(ro, cur);
    F8_STAGE(cur, ro, 0, 0); F8_STAGE(cur, ro, 1, 1);
    f32x4 acc[2][4][2];
#pragma unroll
    for (int b = 0; b < 2; ++b)
#pragma unroll
        for (int m = 0; m < 4; ++m)
#pragma unroll
            for (int n = 0; n < 2; ++n) acc[b][m][n] = (f32x4){0.f, 0.f, 0.f, 0.f};
    int buf = 0; bool after_epi = false, first = true;
    for (;;) {
        bool has_next; F8_UNIT(ui + 1, nxt, has_next);
        int raw[2][2];
#pragma unroll
        for (int h_ = 0; h_ < 2; ++h_)
#pragma unroll
            for (int i_ = 0; i_ < 2; ++i_) { raw[h_][i_] = 0;
                if (MODE == 0) { const int* p_ = toks + (has_next ? nxt.pm : cur.pm) * BM + h_ * HALF + RA[i_]; asm volatile("global_load_dword %0, %1, off" : "=v"(raw[h_][i_]) : "v"(p_) : "memory"); } }
        bool unit_start = !first && NRN != 0;
        if (first && NRN != 0) { F8_WAIT(0); }
        first = false;
#pragma nounroll
        for (int g = 0; g < 2 * nt; ++g) {
            const bool more = (g + 1 < 2 * nt) || has_next;
            if (!more) F8_WAIT(0);
            else if (after_epi && unit_start) { if (EST == 4) F8_WAIT(14); else F8_WAIT(18); }
            else if (after_epi) { if (EST == 4) F8_WAIT(10); else F8_WAIT(14); }
            else if (unit_start) F8_WAIT(10);
            else F8_WAIT(6);
            after_epi = false; unit_start = false;
            __builtin_amdgcn_s_barrier();
            if (g == 1) {
                asm volatile("" : "+v"(raw[0][0]), "+v"(raw[0][1]), "+v"(raw[1][0]), "+v"(raw[1][1]));
#pragma unroll
                for (int h_ = 0; h_ < 2; ++h_)
#pragma unroll
                    for (int i_ = 0; i_ < 2; ++i_) rn[h_][i_] = (unsigned)(MODE == 0 ? (raw[h_][i_] & 0xffff) : (has_next ? nxt.pm : cur.pm) * BM + h_ * HALF + RA[i_]) * (unsigned)Kb_ + CA[i_];
            }
            const int sb = buf >= 1 ? buf - 1 : 2;
            if (g + 2 < 2 * nt) F8_STAGE(cur, ro, g + 2, sb); else if (has_next) F8_STAGE(nxt, rn, g + 2 - 2 * nt, sb);
            bf16x8 At[4][2], B0[2][2], B1[2][2];
            const LAS unsigned char* tb = lds + buf * BUFB;
#pragma unroll
            for (int n = 0; n < 2; ++n)
#pragma unroll
                for (int k = 0; k < 2; ++k) { B0[n][k] = *(const LAS bf16x8*)(tb + 16384 + boff + n * 2048 + k * 1024); B1[n][k] = *(const LAS bf16x8*)(tb + 32768 + boff + n * 2048 + k * 1024); }
#pragma unroll
            for (int m = 0; m < 4; ++m)
#pragma unroll
                for (int k = 0; k < 2; ++k) At[m][k] = *(const LAS bf16x8*)(tb + aoff + m * 2048 + k * 1024);
            __builtin_amdgcn_s_setprio(1);
#pragma unroll
            for (int m = 0; m < 4; ++m)
#pragma unroll
                for (int n = 0; n < 2; ++n) {
                    acc[0][m][n] = __builtin_amdgcn_mfma_scale_f32_16x16x128_f8f6f4(f8cat(B0[n][0], B0[n][1]), f8cat(At[m][0], At[m][1]), acc[0][m][n], 0, 0, 0, 0, 0, 0);
                    acc[1][m][n] = __builtin_amdgcn_mfma_scale_f32_16x16x128_f8f6f4(f8cat(B1[n][0], B1[n][1]), f8cat(At[m][0], At[m][1]), acc[1][m][n], 0, 0, 0, 0, 0, 0); }
            __builtin_amdgcn_s_setprio(0);
            buf = buf == 2 ? 0 : buf + 1;
            if (g == nt - 1 || g == 2 * nt - 1) {
                const int ai = g >= nt ? 1 : 0, row0 = cur.pm * BM + ai * HALF + wr * 64 + fr;
                if (MODE == 0) { const int col0 = cur.pn * HALF + wc * 32 + 8 * fq;
#pragma unroll
                    for (int m = 0; m < 4; ++m) { f32x4 v0, v1;
#pragma unroll
                        for (int j = 0; j < 4; ++j) { v0[j] = siluf_(acc[0][m][0][j]) * acc[1][m][0][j]; v1[j] = siluf_(acc[0][m][1][j]) * acc[1][m][1][j]; }
                        *(u32x2*)(hid8 + (size_t)(row0 + m * 16) * MOE_H + col0) = (u32x2){cvt_pk4_fp8_sat(v0[0], v0[1], v0[2], v0[3]), cvt_pk4_fp8_sat(v1[0], v1[1], v1[2], v1[3])}; }
                } else { const int col0 = cur.pn * BM + wc * 32 + 8 * fq;
#pragma unroll
                    for (int b = 0; b < 2; ++b)
#pragma unroll
                        for (int m = 0; m < 4; ++m) { const f32x4 v0 = acc[b][m][0], v1 = acc[b][m][1];
                            *(u32x4*)(Y + (size_t)(row0 + m * 16) * D + col0 + b * HALF) = (u32x4){cvt_pk_bf16(v0[0], v0[1]), cvt_pk_bf16(v0[2], v0[3]), cvt_pk_bf16(v1[0], v1[1]), cvt_pk_bf16(v1[2], v1[3])}; }
                }
#pragma unroll
                for (int b = 0; b < 2; ++b)
#pragma unroll
                    for (int m = 0; m < 4; ++m)
#pragma unroll
                        for (int n = 0; n < 2; ++n) acc[b][m][n] = (f32x4){0.f, 0.f, 0.f, 0.f};
                after_epi = true;
            }
        }
        if (!has_next) break;
        cur = nxt; ++ui;
#pragma unroll
        for (int h_ = 0; h_ < 2; ++h_)
#pragma unroll
            for (int i_ = 0; i_ < 2; ++i_) ro[h_][i_] = rn[h_][i_];
    }
    F8_WAIT(0);
    __builtin_amdgcn_s_barrier();
#undef F8_ROWS
#undef F8_UNIT
#undef F8_DMA
#undef F8_STAGE
#undef F8_WAIT
}
}

#define XB_TMO      128
#define XB_XCNT(j)  (256  + 64 * (j))
#define XB_XSUB(j)  (1280 + 64 * (j))
#define XB_XGEN(j)  (2304 + 64 * (j))
#define XB_TOP      3328
#define XB_TOPGEN   3392
#define XCD_BAR_WORDS 3456
#define XB_SPIN_CAP (1u << 18)
__device__ __forceinline__ unsigned xb_ld(unsigned* p)              { return __hip_atomic_load(p, __ATOMIC_RELAXED, __HIP_MEMORY_SCOPE_AGENT); }
__device__ __forceinline__ unsigned xb_add(unsigned* p, unsigned v) { return __hip_atomic_fetch_add(p, v, __ATOMIC_RELAXED, __HIP_MEMORY_SCOPE_AGENT); }
__device__ __forceinline__ unsigned xb_xcc_id() { return (unsigned)__builtin_amdgcn_s_getreg((3 << 11) | 20) & 0xFu; }
#define XB_SPIN(cond, bar) do { unsigned _sp = 0; while (cond) { __builtin_amdgcn_s_sleep(1); \
    if ((++_sp & 255u) == 0u) { if (xb_ld(&(bar)[XB_TMO])) break; if (_sp > XB_SPIN_CAP) { atomicAdd(&(bar)[XB_TMO], 1u); break; } } } } while (0)
struct XcdBarrier { unsigned* bar; unsigned x; volatile LAS unsigned* st; };
__device__ __forceinline__ XcdBarrier xcd_barrier_post(unsigned* bar, volatile LAS unsigned* st) {
    XcdBarrier b; b.bar = bar; b.x = xb_xcc_id(); b.st = st;
    if (threadIdx.x == 0) (void)xb_add(&bar[XB_XCNT(b.x)], 1u);
    return b;
}
__device__ __forceinline__ void xcd_barrier_complete(unsigned* bar, unsigned x, unsigned& nloc, unsigned& nx) {
    const unsigned G = gridDim.x * gridDim.y * gridDim.z;
    unsigned sum, cnt, mine, sp = 0u;
    for (;;) {
        sum = 0u; cnt = 0u; mine = 0u;
#pragma unroll
        for (unsigned j = 0; j < 16; ++j) { const unsigned c = xb_ld(&bar[XB_XCNT(j)]); sum += c; cnt += (c > 0u) ? 1u : 0u; mine = (j == x) ? c : mine; }
        if (sum == G) break;
        __builtin_amdgcn_s_sleep(1);
        if ((++sp & 255u) == 0u) { if (xb_ld(&bar[XB_TMO])) break; if (sp > XB_SPIN_CAP) { atomicAdd(&bar[XB_TMO], 1u); break; } }
    }
    nloc = mine > 0u ? mine : 1u; nx = cnt > 0u ? cnt : 1u;
}
__device__ __forceinline__ void xcd_barrier(const XcdBarrier& b) {
    asm volatile("s_waitcnt vmcnt(0)" ::: "memory");
    __syncthreads();
    if (threadIdx.x == 0) {
        unsigned* bar = b.bar;
        __builtin_amdgcn_s_waitcnt(0);
        unsigned nloc = b.st[0], nx = b.st[1];
        if (nloc == 0u) { xcd_barrier_complete(bar, b.x, nloc, nx); b.st[0] = nloc; b.st[1] = nx; }
        const unsigned old = xb_add(&bar[XB_XSUB(b.x)], 1u);
        const unsigned gen = old / nloc;
        if (old + 1u == (gen + 1u) * nloc) {
            __builtin_amdgcn_fence(__ATOMIC_RELEASE, "agent");
            asm volatile("s_waitcnt vmcnt(0)" ::: "memory");
            const unsigned og = xb_add(&bar[XB_TOP], 1u);
            const unsigned tg = og / nx;
            if (og + 1u == (tg + 1u) * nx) xb_add(&bar[XB_TOPGEN], 1u);
            else XB_SPIN(xb_ld(&bar[XB_TOPGEN]) == tg, bar);
            __builtin_amdgcn_fence(__ATOMIC_ACQUIRE, "agent");
            xb_add(&bar[XB_XGEN(b.x)], 1u);
            asm volatile("s_waitcnt vmcnt(0)" ::: "memory");
        } else {
            XB_SPIN(xb_ld(&bar[XB_XGEN(b.x)]) == gen, bar);
            __builtin_amdgcn_fence(__ATOMIC_ACQUIRE, "agent");
            asm volatile("s_waitcnt vmcnt(0)" ::: "memory");
        }
    }
    __syncthreads();
}


typedef float f32x16 __attribute__((ext_vector_type(16)));
#define MFMA32(a, b, c) __builtin_amdgcn_mfma_f32_32x32x16_bf16((a), (b), (c), 0, 0, 0)
__device__ __forceinline__ int crow(int reg, int h) { return (reg & 3) + 8 * (reg >> 2) + 4 * h; }
constexpr int HG_LQE = 0, HG_LKE = HG_LQE + 64 * 272, HG_LKTT = HG_LKE + 64 * 272, HG_LVT = HG_LKTT + 128 * 144, HG_LAT = HG_LVT + 128 * 144, HG_LST = HG_LAT + 64 * 144,
              HG_LO = HG_LST + 128 * 272, HG_LBL = HG_LO + 64 * 528, HG_LPART = HG_LBL + 512, HG_LEND = HG_LPART + 4096;
static_assert(HG_LEND <= 163840 - 512, "hgrn lds");
__device__ __forceinline__ void hgrn_phase(LAS unsigned char* lds, const bf16_t* Z, const float* hg_lb, const float* norm_g, bf16_t* OG, int G, int bx) {
    const int tid = pinned_tid(), lane = tid & 63, wave = __builtin_amdgcn_readfirstlane(tid >> 6), half = lane >> 5, l32 = lane & 31;
    const int d = 2 * (tid & 63), jq = tid >> 6;
    for (int unit = bx; unit < NB * 8; unit += G) {
        const int b = unit >> 3, h = unit & 7;
        for (int i = tid; i < 128 * 272 / 4; i += NTHR) ((LAS unsigned*)(lds + HG_LST))[i] = 0u;
        f32x16 S0, S1;
#pragma unroll
        for (int r = 0; r < 16; ++r) { S0[r] = 0.f; S1[r] = 0.f; }
        __syncthreads();
        unsigned qn[8], fn[8], vn[8];
#define HG_LOAD(n_) do { const bf16_t* zr_ = Z + ((size_t)(b * T + (n_) * 64 + jq * 8)) * 4096 + h * 128 + d; \
            _Pragma("unroll") for (int jj = 0; jj < 8; ++jj) { qn[jj] = *(const unsigned*)(zr_ + (size_t)jj * 4096); fn[jj] = *(const unsigned*)(zr_ + (size_t)jj * 4096 + 1024); vn[jj] = *(const unsigned*)(zr_ + (size_t)jj * 4096 + 2048); } } while (0)
        u32x4 gc0, gc1, gn0, gn1;
#define HG_LOADG(n_, A_, B_) do { const bf16_t* gp_ = Z + (size_t)(b * T + (n_) * 64 + (tid >> 3)) * 4096 + 3072 + h * 128 + (tid & 7) * 16; A_ = *(const u32x4*)gp_; B_ = *(const u32x4*)(gp_ + 8); } while (0)
        HG_LOAD(0); HG_LOADG(0, gc0, gc1);
        for (int n = 0; n < T / 64; ++n) {
            float q0[8], q1[8], k0[8], k1[8], p0[8], p1[8]; unsigned vr[8];
            float run0 = 1.f, run1 = 1.f;
#pragma unroll
            for (int jj = 0; jj < 8; ++jj) { const float fg0 = bflo(fn[jj]), fg1 = bfhi(fn[jj]); run0 *= fg0; run1 *= fg1; p0[jj] = run0; p1[jj] = run1; k0[jj] = 1.0f - fg0; k1[jj] = 1.0f - fg1;
                q0[jj] = bflo(qn[jj]); q1[jj] = bfhi(qn[jj]); vr[jj] = vn[jj]; }
            *(LAS f32x2*)(lds + HG_LPART + (jq * 128 + d) * 4) = (f32x2){run0, run1};
            __syncthreads();
            float pre0 = 1.f, pre1 = 1.f, tot0 = 1.f, tot1 = 1.f;
#pragma unroll
            for (int q = 0; q < 8; ++q) { const f32x2 pq = *(const LAS f32x2*)(lds + HG_LPART + (q * 128 + d) * 4); tot0 *= pq[0]; tot1 *= pq[1]; if (q < jq) { pre0 *= pq[0]; pre1 *= pq[1]; } }
            if (jq == 0) *(LAS f32x2*)(lds + HG_LBL + d * 4) = (f32x2){tot0, tot1};
            unsigned kt0[4], kt1[4], vt0[4], vt1[4];
#pragma unroll
            for (int jj = 0; jj < 8; ++jj) {
                const float e0 = p0[jj] * pre0, e1 = p1[jj] * pre1, r0 = __builtin_amdgcn_rcpf(e0), r1 = __builtin_amdgcn_rcpf(e1);
                const int j = jq * 8 + jj;
                *(LAS unsigned*)(lds + HG_LQE + j * 272 + d * 2) = cvt_pk_bf16(q0[jj] * e0, q1[jj] * e1);
                *(LAS unsigned*)(lds + HG_LKE + j * 272 + d * 2) = cvt_pk_bf16(k0[jj] * r0, k1[jj] * r1);
                const float t0 = k0[jj] * r0 * tot0, t1 = k1[jj] * r1 * tot1;
                if (jj & 1) { kt0[jj >> 1] = cvt_pk_bf16(p0[jj - 1], t0); kt1[jj >> 1] = cvt_pk_bf16(p1[jj - 1], t1); vt0[jj >> 1] = (vr[jj - 1] & 0xffffu) | (vr[jj] << 16); vt1[jj >> 1] = (vr[jj - 1] >> 16) | (vr[jj] & 0xffff0000u); }
                else { p0[jj] = t0; p1[jj] = t1; }
            }
            *(LAS u32x4*)(lds + HG_LKTT + d * 144 + jq * 16) = (u32x4){kt0[0], kt0[1], kt0[2], kt0[3]}; *(LAS u32x4*)(lds + HG_LKTT + (d + 1) * 144 + jq * 16) = (u32x4){kt1[0], kt1[1], kt1[2], kt1[3]};
            *(LAS u32x4*)(lds + HG_LVT + d * 144 + jq * 16) = (u32x4){vt0[0], vt0[1], vt0[2], vt0[3]}; *(LAS u32x4*)(lds + HG_LVT + (d + 1) * 144 + jq * 16) = (u32x4){vt1[0], vt1[1], vt1[2], vt1[3]};
            __syncthreads();
            if (n + 1 < T / 64) { HG_LOAD(n + 1); HG_LOADG(n + 1, gn0, gn1); }
            if (wave < 4) {
                const int tj = wave >> 1, ti = wave & 1;
                f32x16 acc;
#pragma unroll
                for (int r = 0; r < 16; ++r) acc[r] = 0.f;
                if (tj <= ti) {
#pragma unroll
                    for (int s = 0; s < 8; ++s) {
                        const bf16x8 a = *(const LAS bf16x8*)(lds + HG_LKE + (32 * tj + l32) * 272 + (16 * s + 8 * half) * 2);
                        const bf16x8 bq = *(const LAS bf16x8*)(lds + HG_LQE + (32 * ti + l32) * 272 + (16 * s + 8 * half) * 2);
                        acc = MFMA32(a, bq, acc);
                    }
                }
                const int ig = 32 * ti + l32;
#pragma unroll
                for (int g4 = 0; g4 < 4; ++g4) {
                    const int j0 = 32 * tj + 8 * g4 + 4 * half;
                    float v0 = acc[4 * g4], v1 = acc[4 * g4 + 1], v2 = acc[4 * g4 + 2], v3 = acc[4 * g4 + 3];
                    v0 = (j0 <= ig) ? v0 : 0.f; v1 = (j0 + 1 <= ig) ? v1 : 0.f; v2 = (j0 + 2 <= ig) ? v2 : 0.f; v3 = (j0 + 3 <= ig) ? v3 : 0.f;
                    *(LAS u32x2*)(lds + HG_LAT + ig * 144 + j0 * 2) = (u32x2){cvt_pk_bf16(v0, v1), cvt_pk_bf16(v2, v3)};
                }
            }
            {
                const int td = wave & 3, tc0 = (wave >> 2) * 2;
#pragma unroll
                for (int r = 0; r < 16; ++r) { const float sc = ((LAS float*)(lds + HG_LBL))[32 * td + crow(r, half)]; S0[r] *= sc; S1[r] *= sc; }
#pragma unroll
                for (int s = 0; s < 4; ++s) {
                    const bf16x8 a = *(const LAS bf16x8*)(lds + HG_LKTT + (32 * td + l32) * 144 + (16 * s + 8 * half) * 2);
                    const bf16x8 b0 = *(const LAS bf16x8*)(lds + HG_LVT + (32 * tc0 + l32) * 144 + (16 * s + 8 * half) * 2);
                    const bf16x8 b1 = *(const LAS bf16x8*)(lds + HG_LVT + (32 * (tc0 + 1) + l32) * 144 + (16 * s + 8 * half) * 2);
                    S0 = MFMA32(a, b0, S0); S1 = MFMA32(a, b1, S1);
                }
            }
            __syncthreads();
            {
                const int ti = wave >> 2, tc = wave & 3;
                f32x16 acc;
#pragma unroll
                for (int r = 0; r < 16; ++r) acc[r] = 0.f;
#pragma unroll
                for (int s = 0; s < 4; ++s) {
                    const bf16x8 a = *(const LAS bf16x8*)(lds + HG_LAT + (32 * ti + l32) * 144 + (16 * s + 8 * half) * 2);
                    const bf16x8 bv = *(const LAS bf16x8*)(lds + HG_LVT + (32 * tc + l32) * 144 + (16 * s + 8 * half) * 2);
                    acc = MFMA32(a, bv, acc);
                }
#pragma unroll
                for (int s = 0; s < 8; ++s) {
                    const bf16x8 a = *(const LAS bf16x8*)(lds + HG_LQE + (32 * ti + l32) * 272 + (16 * s + 8 * half) * 2);
                    const bf16x8 bs = *(const LAS bf16x8*)(lds + HG_LST + (32 * tc + l32) * 272 + (16 * s + 8 * half) * 2);
                    acc = MFMA32(a, bs, acc);
                }
#pragma unroll
                for (int r = 0; r < 16; ++r) ((LAS float*)(lds + HG_LO + (32 * ti + crow(r, half)) * 528))[32 * tc + l32] = acc[r];
            }
            __syncthreads();
            {
                const int td = wave & 3, tc0 = (wave >> 2) * 2;
#pragma unroll
                for (int g4 = 0; g4 < 4; ++g4) {
                    const int d0 = 32 * td + 8 * g4 + 4 * half;
                    *(LAS u32x2*)(lds + HG_LST + (32 * tc0 + l32) * 272 + d0 * 2) = (u32x2){cvt_pk_bf16(S0[4 * g4], S0[4 * g4 + 1]), cvt_pk_bf16(S0[4 * g4 + 2], S0[4 * g4 + 3])};
                    *(LAS u32x2*)(lds + HG_LST + (32 * (tc0 + 1) + l32) * 272 + d0 * 2) = (u32x2){cvt_pk_bf16(S1[4 * g4], S1[4 * g4 + 1]), cvt_pk_bf16(S1[4 * g4 + 2], S1[4 * g4 + 3])};
                }
            }
            {
                const int i = tid >> 3, seg = tid & 7;
                f32x4 ov[4]; float ss = 0.f;
#pragma unroll
                for (int q = 0; q < 4; ++q) { ov[q] = *(const LAS f32x4*)(lds + HG_LO + i * 528 + seg * 64 + q * 16); ss += (ov[q][0] * ov[q][0] + ov[q][1] * ov[q][1]) + (ov[q][2] * ov[q][2] + ov[q][3] * ov[q][3]); }
                ss = dpp_addx<0xB1, 0xf>(ss); ss = dpp_addx<0x4E, 0xf>(ss); ss = dpp_addx<0x141, 0xf>(ss);
                const float rstd = __builtin_amdgcn_rsqf(ss * (1.0f / 128.0f) + LN_EPS);
                const size_t row = (size_t)(b * T + n * 64 + i);
                const u32x4 g0 = gc0, g1 = gc1;
                const unsigned gw_[8] = {g0.x, g0.y, g0.z, g0.w, g1.x, g1.y, g1.z, g1.w};
                unsigned ow[8];
#pragma unroll
                for (int q = 0; q < 4; ++q) { const f32x4 ng = *(const f32x4*)(norm_g + seg * 16 + q * 4);
                    ow[2 * q] = cvt_pk_bf16(ov[q][0] * rstd * ng[0] * bflo(gw_[2 * q]), ov[q][1] * rstd * ng[1] * bfhi(gw_[2 * q]));
                    ow[2 * q + 1] = cvt_pk_bf16(ov[q][2] * rstd * ng[2] * bflo(gw_[2 * q + 1]), ov[q][3] * rstd * ng[3] * bfhi(gw_[2 * q + 1])); }
                *(u32x4*)(OG + row * D + h * 128 + seg * 16) = (u32x4){ow[0], ow[1], ow[2], ow[3]}; *(u32x4*)(OG + row * D + h * 128 + seg * 16 + 8) = (u32x4){ow[4], ow[5], ow[6], ow[7]};
            }
            gc0 = gn0; gc1 = gn1;
            __syncthreads();
        }
    }
}


__device__ __forceinline__ void unpack8(const u32x4 w, float (&f)[8]) { f[0] = bflo(w.x); f[1] = bfhi(w.x); f[2] = bflo(w.y); f[3] = bfhi(w.y); f[4] = bflo(w.z); f[5] = bfhi(w.z); f[6] = bflo(w.w); f[7] = bfhi(w.w); }
__device__ __forceinline__ void rope_row(int m, bf16_t* ZB, bf16_t* QRB, const int* posi, LAS float* tb, int lane, bool write_k) {
    const float inv_me = exp2f(-(float)(lane & 31) * (13.287712379549449f / 32.0f));
    { const float pf = (float)posi[m]; float s1, c1; sincosf(pf * inv_me, &s1, &c1); if (lane < 32) { tb[lane] = c1; tb[32 + lane] = s1; } LDS_WAIT(); }
    if (lane < 48) {
        const bf16_t* zrow = ZB + (size_t)m * EVP;
        const int hs = lane >> 2, d0 = 8 * (lane & 3);
        const f32x4 ca = *(const LAS f32x4*)(tb + d0), cb = *(const LAS f32x4*)(tb + d0 + 4), sa = *(const LAS f32x4*)(tb + 32 + d0), sb = *(const LAS f32x4*)(tb + 32 + d0 + 4);
        const int scol = hs < 8 ? 1792 + hs * 64 : ((hs & 2) ? 2816 : 2560) + (hs & 1) * 64;
        const u32x4 a = *(const u32x4*)(zrow + scol + d0), bq = *(const u32x4*)(zrow + scol + 32 + d0);
        float x1[8], x2[8], o1[8], o2[8]; unpack8(a, x1); unpack8(bq, x2);
#pragma unroll
        for (int i = 0; i < 8; ++i) { const float c = i < 4 ? ca[i & 3] : cb[i & 3], sn = i < 4 ? sa[i & 3] : sb[i & 3]; o1[i] = x1[i] * c - x2[i] * sn; o2[i] = x2[i] * c + x1[i] * sn; }
        const u32x4 w1 = (u32x4){cvt_pk_bf16(o1[0], o1[1]), cvt_pk_bf16(o1[2], o1[3]), cvt_pk_bf16(o1[4], o1[5]), cvt_pk_bf16(o1[6], o1[7])}, w2 = (u32x4){cvt_pk_bf16(o2[0], o2[1]), cvt_pk_bf16(o2[2], o2[3]), cvt_pk_bf16(o2[4], o2[5]), cvt_pk_bf16(o2[6], o2[7])};
        if (hs < 8) { bf16_t* dst = QRB + (size_t)m * 512 + hs * 64 + d0; *(u32x4*)dst = w1; *(u32x4*)(dst + 32) = w2; }
        else if (write_k) { bf16_t* dst = ZB + (size_t)m * EVP + scol + d0; *(u32x4*)dst = w1; *(u32x4*)(dst + 32) = w2; }
    }
    LDS_WAIT();
}
__device__ __forceinline__ void cmpcomb_row(int rr, const float* HC, const float* cb, const float* cw2, bf16_t* KVC, LAS float* hs, int lane) {
    const int hq = rr & 1, n = (rr >> 1) & 255, bq_ = (rr >> 9) & 15, zsel = rr >> 13;
    float outv = 0.f;
    if (n < 255) {
        const float* ha = HC + ((size_t)zsel * 8192 + (size_t)(bq_ * 256 + n) * 2 + hq) * 256; const float* hb = ha + 2 * 256 + 128;
#pragma unroll
        for (int q = 0; q < 2; ++q) { const int c = lane + 64 * q; const float xx = ha[c] + hb[c] + cb[zsel * 128 + c];
            hs[c] = 0.5f * xx * (1.0f + tanhf(0.7978845608028654f * (xx + 0.044715f * xx * xx * xx))); }
        LDS_WAIT();
        const float* w2p = cw2 + (size_t)zsel * 128 * 64 + lane;
#pragma unroll 16
        for (int c = 0; c < 128; ++c) outv += hs[c] * w2p[c * 64];
        LDS_WAIT();
    }
    KVC[((size_t)(zsel * 32 + bq_ * 2 + hq) * 256 + n) * 64 + lane] = (bf16_t)(cvt_pk_bf16(outv, 0.f) & 0xffffu);
}
constexpr int LATE_CONV_ITEMS = 2048 + 4 * 512 + 2 * 128;
__device__ __forceinline__ void conv_late_item(int it, const float* odin, const float* odout, const float* evout, const float* gatew, const float* plew, unsigned char* ws, LAS float* scr, int lane);
constexpr int MOE_CONV_ITEMS = NEXP * 3 * 256;
__device__ __forceinline__ void conv_moe_item(const float* w1, const float* w3, const float* w2, int li, bf16_t* w13, bf16_t* w2t, LAS float* scr, int it, int lane);
constexpr int RW_LW = 0, RW_LKK = 8192, RW_LBB = 16384, RW_LK2 = 24576, RW_LWR = 32768, RW_LV = 40960, RW_LO = 57344;
template <int CTRL> __device__ __forceinline__ float dpp_b(float v) { return __builtin_bit_cast(float, __builtin_amdgcn_mov_dpp(__builtin_bit_cast(int, v), CTRL, 0xf, 0xf, true)); }
__device__ __forceinline__ float sum16b(float v) { v += dpp_b<0xB1>(v); v += dpp_b<0x4E>(v); v += dpp_b<0x141>(v); v += dpp_b<0x140>(v); return v; }
__device__ __forceinline__ float sum8b(float v) { v += dpp_b<0xB1>(v); v += dpp_b<0x4E>(v); v += dpp_b<0x141>(v); return v; }
__device__ __forceinline__ float afma(float a, float b, float c) { float d; asm("v_fma_f32 %0, %1, %2, %3" : "=v"(d) : "v"(a), "v"(b), "v"(c)); return d; }
__device__ __forceinline__ float anfma(float a, float b, float c) { float d; asm("v_fma_f32 %0, -%1, %2, %3" : "=v"(d) : "v"(a), "v"(b), "v"(c)); return d; }
__device__ __forceinline__ float amul(float a, float b) { float d; asm("v_mul_f32 %0, %1, %2" : "=v"(d) : "v"(a), "v"(b)); return d; }
__device__ __forceinline__ unsigned cvt_pk_f16(float a, float b) { typedef _Float16 h2v_ __attribute__((ext_vector_type(2))); return __builtin_bit_cast(unsigned, __builtin_convertvector((f32x2){a, b}, h2v_)); }
__device__ __forceinline__ u32x4 pack8h(const float (&o)[8]) { return (u32x4){cvt_pk_f16(o[0], o[1]), cvt_pk_f16(o[2], o[3]), cvt_pk_f16(o[4], o[5]), cvt_pk_f16(o[6], o[7])}; }
struct RwRaw { u32x4 r, k, v, rp, kp, vp, a; f32x4 w0, w1, sc; };
__device__ __forceinline__ void rwkv_phase(LAS unsigned char* lds, const bf16_t* Z, const float* dec, const bf16_t* aa, const float* sc4, const float* mu, const float* k_k, const float* k_a, bf16_t* Y, int G, int bx,
                                           const float* mw1, const float* mw3, const float* mw2, bf16_t* w13, bf16_t* w2t, bool conv,
                                           const float* HC, const float* cb, const float* cw2, bf16_t* KVC, const float* pin, bf16_t* pbf0, bf16_t* pbf1, bf16_t* ZW, bf16_t* QRB, const int* posi,
                                           const float* lodin, const float* lodout, const float* levout, const float* lgate, const float* lple, unsigned char* wsb) {
    for (int unit = bx; unit < NB * 16; unit += G) {
        const int tid = pinned_tid();
        const int rowl = (tid >> 3) & 31, kc = tid & 7;
        const int sst = tid >> 3, c8 = (tid & 7) * 8;
        const int b = unit >> 4, h = (unit >> 1) & 7, rh = unit & 1, hc0 = h * 64 + c8;
        float p_mr[8], p_mk[8], p_mv[8], p_kk[8], p_ka[8];
#pragma unroll
        for (int i = 0; i < 8; ++i) { p_mr[i] = mu[hc0 + i]; p_mk[i] = mu[512 + hc0 + i]; p_mv[i] = mu[1024 + hc0 + i]; p_kk[i] = k_k[hc0 + i]; p_ka[i] = k_a[hc0 + i]; }
        float S[8];
#pragma unroll
        for (int i = 0; i < 8; ++i) S[i] = 0.f;
        RwRaw rw;
#define RW_LOAD(n_) do { const int t_ = (n_) * 64 + sst; const size_t row_ = (size_t)(b * T + t_); const bf16_t* zc_ = Z + row_ * EVP + hc0; \
            rw.r = *(const u32x4*)zc_; rw.k = *(const u32x4*)(zc_ + 512); rw.v = *(const u32x4*)(zc_ + 1024); \
            if (t_ > 0) { rw.rp = *(const u32x4*)(zc_ - EVP); rw.kp = *(const u32x4*)(zc_ + 512 - EVP); rw.vp = *(const u32x4*)(zc_ + 1024 - EVP); } else { rw.rp = (u32x4){0u, 0u, 0u, 0u}; rw.kp = rw.rp; rw.vp = rw.rp; } \
            rw.a = *(const u32x4*)(aa + row_ * 512 + hc0); rw.w0 = *(const f32x4*)(dec + row_ * 512 + hc0); rw.w1 = *(const f32x4*)(dec + row_ * 512 + hc0 + 4); rw.sc = *(const f32x4*)(sc4 + (row_ * 8 + h) * 4); } while (0)
#define RW_FINISH() do { float r_[8], k_[8], v_[8], rp_[8], kp_[8], vp_[8], a_[8]; unpack8(rw.r, r_); unpack8(rw.k, k_); unpack8(rw.v, v_); unpack8(rw.rp, rp_); unpack8(rw.kp, kp_); unpack8(rw.vp, vp_); unpack8(rw.a, a_); \
            float ow_[8], oq_[8], ob_[8], ok_[8], ou_[8], ov_[8]; \
            _Pragma("unroll") for (int i = 0; i < 8; ++i) { const float rr = r_[i] + p_mr[i] * (rp_[i] - r_[i]), k0 = k_[i] + p_mk[i] * (kp_[i] - k_[i]), vv = v_[i] + p_mv[i] * (vp_[i] - v_[i]), w = i < 4 ? rw.w0[i & 3] : rw.w1[i & 3]; \
                const float kk = k0 * p_kk[i] * rw.sc[0]; ow_[i] = w; oq_[i] = kk; ob_[i] = -(kk * a_[i]); ok_[i] = k0 * (1.0f + (a_[i] - 1.0f) * p_ka[i]); ou_[i] = w * rr - rw.sc[1] * kk; ov_[i] = vv; } \
            LAS unsigned char* d_ = lds + sst * 128 + c8 * 2; \
            *(LAS u32x4*)(d_ + RW_LW) = pack8h(ow_); *(LAS u32x4*)(d_ + RW_LKK) = pack8h(oq_); *(LAS u32x4*)(d_ + RW_LBB) = pack8h(ob_); *(LAS u32x4*)(d_ + RW_LK2) = pack8h(ok_); *(LAS u32x4*)(d_ + RW_LWR) = pack8h(ou_); \
            if ((c8 >> 5) == rh) { LAS float* dv_ = (LAS float*)(lds + RW_LV + sst * 256 + (c8 & 31) * 8); const float c2_ = rw.sc[2]; \
                *(LAS f32x4*)dv_ = (f32x4){ov_[0], ov_[0] * c2_, ov_[1], ov_[1] * c2_}; *(LAS f32x4*)(dv_ + 4) = (f32x4){ov_[2], ov_[2] * c2_, ov_[3], ov_[3] * c2_}; \
                *(LAS f32x4*)(dv_ + 8) = (f32x4){ov_[4], ov_[4] * c2_, ov_[5], ov_[5] * c2_}; *(LAS f32x4*)(dv_ + 12) = (f32x4){ov_[6], ov_[6] * c2_, ov_[7], ov_[7] * c2_}; } } while (0)
        RW_LOAD(0);
        RW_FINISH();
        __syncthreads();
        for (int n = 0; n < T / 64; ++n) {
            if (n + 1 < T / 64) RW_LOAD(n + 1);
            if (tid >= 256) {
                if (conv) rope_row(n * (G * 4) + bx * 4 + ((tid >> 6) - 4), ZW, QRB, posi, (LAS float*)(lds + 100 * 1024 + 4 * 8704 + ((tid >> 6) - 4) * 256), tid & 63, true);
                const int it_ = n * (G * 4) + bx * 4 + ((tid >> 6) - 4);
                if (conv && it_ < MOE_CONV_ITEMS) conv_moe_item(mw1, mw3, mw2, 0, w13, w2t, (LAS float*)(lds + 100 * 1024 + ((tid >> 6) - 4) * 8704), it_, tid & 63);
                else if (conv && it_ - MOE_CONV_ITEMS < 2 * 16 * 256 * 2) cmpcomb_row(it_ - MOE_CONV_ITEMS, HC, cb, cw2, KVC, (LAS float*)(lds + 100 * 1024 + ((tid >> 6) - 4) * 8704), tid & 63);
                else if (conv && n >= 56) { const int li_ = (n - 56) * (G * 4) + bx * 4 + ((tid >> 6) - 4);
                    if (li_ < LATE_CONV_ITEMS) conv_late_item(li_, lodin, lodout, levout, lgate, lple, wsb, (LAS float*)(lds + 100 * 1024 + ((tid >> 6) - 4) * 8704), tid & 63); }
                else if (conv && n >= 40 && n < 56) {
                    const int lane_ = tid & 63, w_ = (n - 40) * (G * 4) + bx * 4 + ((tid >> 6) - 4);
#pragma unroll
                    for (int q = 0; q < 8; ++q) { const int row = w_ * 8 + q; const f32x4 v = *((const f32x4*)(pin + (size_t)row * PLE) + lane_);
                        bf16_t* dst = row < M ? pbf0 + (size_t)row * PLE : pbf1 + (size_t)(row - M) * PLE; *((u32x2*)dst + lane_) = (u32x2){cvt_pk_bf16(v[0], v[1]), cvt_pk_bf16(v[2], v[3])}; }
                }
            }
            if (tid < 256) {
            const int vb = kc * 16, vvb = RW_LV + rowl * 8;
            u32x4 cw = *(const LAS u32x4*)(lds + vb + RW_LW), cq = *(const LAS u32x4*)(lds + vb + RW_LKK), cb = *(const LAS u32x4*)(lds + vb + RW_LBB), ck = *(const LAS u32x4*)(lds + vb + RW_LK2), cu = *(const LAS u32x4*)(lds + vb + RW_LWR);
            f32x2 cv2 = *(const LAS f32x2*)(lds + vvb);
            LAS float* const obase = (kc == 0 ? (LAS float*)(lds + RW_LO) : (LAS float*)(lds + 136 * 1024)) + rowl;
#if PROBE_DUP == 10
            float T0[8];
#pragma unroll
            for (int i = 0; i < 8; ++i) T0[i] = S[i];
            for (int rep_ = 0; rep_ < 2; ++rep_) {
            if (rep_ == 1) {
#pragma unroll
                for (int i = 0; i < 8; ++i) S[i] = T0[i]; }
#endif
            __builtin_amdgcn_s_setprio(3);
#define MIXLO "op_sel_hi:[0,1,0]"
#define MIXHI "op_sel:[0,1,0] op_sel_hi:[0,1,0]"
#define DPPQ1 "quad_perm:[1,0,3,2] row_mask:0xf bank_mask:0xf bound_ctrl:1"
#define DPPQ2 "quad_perm:[2,3,0,1] row_mask:0xf bank_mask:0xf bound_ctrl:1"
#define DPPHM "row_half_mirror row_mask:0xf bank_mask:0xf bound_ctrl:1"
#pragma unroll 8
            for (int st = 0; st < 64; ++st) {
                const int sn = st + 1;
                const u32x4 nw = *(const LAS u32x4*)(lds + vb + RW_LW + sn * 128), nq = *(const LAS u32x4*)(lds + vb + RW_LKK + sn * 128), nb = *(const LAS u32x4*)(lds + vb + RW_LBB + sn * 128),
                            nk = *(const LAS u32x4*)(lds + vb + RW_LK2 + sn * 128), nu = *(const LAS u32x4*)(lds + vb + RW_LWR + sn * 128);
                const f32x2 nv2 = *(const LAS f32x2*)(lds + vvb + sn * 256);
                float sa, ov, t0, t1, t2, xa, xb, xc, xd;
                asm("v_fma_mix_f32 %[sa], %[s0], %[q0], 0 " MIXLO "\n\tv_fma_mix_f32 %[sb], %[s4], %[q2], 0 " MIXLO "\n\tv_fma_mix_f32 %[oa], %[s0], %[u0], 0 " MIXLO "\n\tv_fma_mix_f32 %[ob], %[s4], %[u2], 0 " MIXLO "\n\t"
                    "v_fma_mix_f32 %[sa], %[s1], %[q0], %[sa] " MIXHI "\n\tv_fma_mix_f32 %[sb], %[s5], %[q2], %[sb] " MIXHI "\n\tv_fma_mix_f32 %[oa], %[s1], %[u0], %[oa] " MIXHI "\n\tv_fma_mix_f32 %[ob], %[s5], %[u2], %[ob] " MIXHI "\n\t"
                    "v_fma_mix_f32 %[sa], %[s2], %[q1], %[sa] " MIXLO "\n\tv_fma_mix_f32 %[sb], %[s6], %[q3], %[sb] " MIXLO "\n\tv_fma_mix_f32 %[oa], %[s2], %[u1], %[oa] " MIXLO "\n\tv_fma_mix_f32 %[ob], %[s6], %[u3], %[ob] " MIXLO "\n\t"
                    "v_fma_mix_f32 %[sa], %[s3], %[q1], %[sa] " MIXHI "\n\tv_fma_mix_f32 %[sb], %[s7], %[q3], %[sb] " MIXHI "\n\tv_fma_mix_f32 %[oa], %[s3], %[u1], %[oa] " MIXHI "\n\tv_fma_mix_f32 %[ob], %[s7], %[u3], %[ob] " MIXHI "\n\t"
                    "v_add_f32 %[sa], %[sa], %[sb]\n\tv_add_f32 %[oa], %[oa], %[ob]\n\t"
                    "v_fma_mix_f32 %[t0], %[cv], %[k0], 0 " MIXLO "\n\tv_add_f32_dpp %[sa], %[sa], %[sa] " DPPQ1 "\n\tv_add_f32_dpp %[oa], %[oa], %[oa] " DPPQ1 "\n\t"
                    "v_fma_mix_f32 %[t1], %[cv], %[k0], 0 " MIXHI "\n\tv_add_f32_dpp %[sa], %[sa], %[sa] " DPPQ2 "\n\tv_add_f32_dpp %[oa], %[oa], %[oa] " DPPQ2 "\n\t"
                    "v_fma_mix_f32 %[t2], %[cv], %[k1], 0 " MIXLO "\n\tv_add_f32_dpp %[sa], %[sa], %[sa] " DPPHM "\n\tv_add_f32_dpp %[oa], %[oa], %[oa] " DPPHM "\n\t"
                    "v_add_f32 %[ov], %[oa], %[c1]"
                    : [sa] "=&v"(sa), [ov] "=&v"(ov), [t0] "=&v"(t0), [t1] "=&v"(t1), [t2] "=&v"(t2), [sb] "=&v"(xa), [oa] "=&v"(xb), [ob] "=&v"(xc)
                    : [s0] "v"(S[0]), [s1] "v"(S[1]), [s2] "v"(S[2]), [s3] "v"(S[3]), [s4] "v"(S[4]), [s5] "v"(S[5]), [s6] "v"(S[6]), [s7] "v"(S[7]),
                      [q0] "v"(cq.x), [q1] "v"(cq.y), [q2] "v"(cq.z), [q3] "v"(cq.w), [u0] "v"(cu.x), [u1] "v"(cu.y), [u2] "v"(cu.z), [u3] "v"(cu.w),
                      [cv] "v"(cv2[0]), [c1] "v"(cv2[1]), [k0] "v"(ck.x), [k1] "v"(ck.y));
                obase[st * 32] = ov;
                asm("v_fma_mix_f32 %[x], %[cv], %[k1], 0 " MIXHI "\n\tv_fma_mix_f32 %[y], %[sa], %[b0], %[t0] " MIXLO "\n\tv_fma_mix_f32 %[z], %[sa], %[b0], %[t1] " MIXHI "\n\t"
                    "v_fma_mix_f32 %[s0], %[s0], %[w0], %[y] " MIXLO "\n\tv_fma_mix_f32 %[y], %[sa], %[b1], %[t2] " MIXLO "\n\tv_fma_mix_f32 %[s1], %[s1], %[w0], %[z] " MIXHI "\n\t"
                    "v_fma_mix_f32 %[x], %[sa], %[b1], %[x] " MIXHI "\n\tv_fma_mix_f32 %[s2], %[s2], %[w1], %[y] " MIXLO "\n\tv_fma_mix_f32 %[s3], %[s3], %[w1], %[x] " MIXHI
                    : [s0] "+v"(S[0]), [s1] "+v"(S[1]), [s2] "+v"(S[2]), [s3] "+v"(S[3]), [x] "=&v"(xa), [y] "=&v"(xb), [z] "=&v"(xc)
                    : [sa] "v"(sa), [cv] "v"(cv2[0]), [t0] "v"(t0), [t1] "v"(t1), [t2] "v"(t2), [k1] "v"(ck.y), [b0] "v"(cb.x), [b1] "v"(cb.y), [w0] "v"(cw.x), [w1] "v"(cw.y));
                asm("v_fma_mix_f32 %[x], %[cv], %[k2], 0 " MIXLO "\n\tv_fma_mix_f32 %[y], %[cv], %[k2], 0 " MIXHI "\n\tv_fma_mix_f32 %[z], %[cv], %[k3], 0 " MIXLO "\n\tv_fma_mix_f32 %[u], %[cv], %[k3], 0 " MIXHI "\n\t"
                    "v_fma_mix_f32 %[x], %[sa], %[b2], %[x] " MIXLO "\n\tv_fma_mix_f32 %[y], %[sa], %[b2], %[y] " MIXHI "\n\tv_fma_mix_f32 %[z], %[sa], %[b3], %[z] " MIXLO "\n\tv_fma_mix_f32 %[u], %[sa], %[b3], %[u] " MIXHI "\n\t"
                    "v_fma_mix_f32 %[s4], %[s4], %[w2], %[x] " MIXLO "\n\tv_fma_mix_f32 %[s5], %[s5], %[w2], %[y] " MIXHI "\n\tv_fma_mix_f32 %[s6], %[s6], %[w3], %[z] " MIXLO "\n\tv_fma_mix_f32 %[s7], %[s7], %[w3], %[u] " MIXHI
                    : [s4] "+v"(S[4]), [s5] "+v"(S[5]), [s6] "+v"(S[6]), [s7] "+v"(S[7]), [x] "=&v"(xa), [y] "=&v"(xb), [z] "=&v"(xc), [u] "=&v"(xd)
                    : [sa] "v"(sa), [cv] "v"(cv2[0]), [k2] "v"(ck.z), [k3] "v"(ck.w), [b2] "v"(cb.z), [b3] "v"(cb.w), [w2] "v"(cw.z), [w3] "v"(cw.w));
                cw = nw; cq = nq; cb = nb; ck = nk; cu = nu; cv2 = nv2;
            }
#undef MIXLO
#undef MIXHI
#undef DPPQ1
#undef DPPQ2
#undef DPPHM
            __builtin_amdgcn_s_setprio(0);
#if PROBE_DUP == 10
            }
#endif
            }
            __syncthreads();
            { const int st = tid >> 3, r4 = (tid & 7) * 4; const f32x4 o = *(const LAS f32x4*)(lds + RW_LO + st * 128 + r4 * 4);
              *(u32x2*)(Y + (size_t)(b * T + n * 64 + st) * D + h * 64 + rh * 32 + r4) = (u32x2){cvt_pk_bf16(o[0], o[1]), cvt_pk_bf16(o[2], o[3])}; }
            if (n + 1 < T / 64) RW_FINISH();
            __syncthreads();
        }
#undef RW_LOAD
#undef RW_FINISH
    }
}

typedef short s16x4 __attribute__((ext_vector_type(4)));
constexpr int AT_KS = 144, AT_VS = 192, AT_KT = 64 * AT_KS, AT_VT = 64 * AT_VS;
constexpr int AT_LK = 0, AT_LV = 4 * AT_KT, AT_LIT = AT_LV + 4 * AT_VT, AT_LIH = AT_LIT + 16384, AT_LSM = AT_LIH + 16384, AT_LKEY = AT_LSM + 512, AT_LEND = AT_LKEY + 32768;
static_assert(AT_LEND <= 163840 - 512, "attention lds");
constexpr float AT_C = 0.125f * 1.4426950408889634f;
constexpr float AT_NEG = -1.0e30f;
__device__ __forceinline__ void qk_tile(const LAS unsigned char* Kt, const bf16x8 (&Q)[4], int l32, int half, f32x16& s0, f32x16& s1) {
#pragma unroll
    for (int r = 0; r < 16; ++r) { s0[r] = 0.f; s1[r] = 0.f; }
#pragma unroll
    for (int s = 0; s < 4; ++s) {
        const bf16x8 a0 = *(const LAS bf16x8*)(Kt + l32 * AT_KS + (16 * s + 8 * half) * 2), a1 = *(const LAS bf16x8*)(Kt + (32 + l32) * AT_KS + (16 * s + 8 * half) * 2);
        s0 = MFMA32(a0, Q[s], s0); s1 = MFMA32(a1, Q[s], s1);
    }
}
#define AT_TR4(vb, OFF, r00, r01, r10, r11) asm volatile("ds_read_b64_tr_b16 %0, %4 offset:%5\n\tds_read_b64_tr_b16 %1, %4 offset:%6\n\tds_read_b64_tr_b16 %2, %4 offset:%7\n\tds_read_b64_tr_b16 %3, %4 offset:%8\n\ts_waitcnt lgkmcnt(0)" \
    : "=&v"(r00), "=&v"(r01), "=&v"(r10), "=&v"(r11) : "v"(vb), "i"(OFF), "i"((OFF) + 8 * AT_VS), "i"((OFF) + 64), "i"((OFF) + 8 * AT_VS + 64) : "memory")
__device__ __forceinline__ bf16x8 pack8(const f32x16& p, int s2) {
    u32x4 w; w.x = cvt_pk_bf16(p[8 * s2], p[8 * s2 + 1]); w.y = cvt_pk_bf16(p[8 * s2 + 2], p[8 * s2 + 3]); w.z = cvt_pk_bf16(p[8 * s2 + 4], p[8 * s2 + 5]); w.w = cvt_pk_bf16(p[8 * s2 + 6], p[8 * s2 + 7]);
    return __builtin_bit_cast(bf16x8, w);
}
#define AT_TR8(vb, OFF, r0, r1, r2, r3, r4, r5, r6, r7) asm volatile("ds_read_b64_tr_b16 %0, %8 offset:%9\n\tds_read_b64_tr_b16 %1, %8 offset:%10\n\tds_read_b64_tr_b16 %2, %8 offset:%11\n\tds_read_b64_tr_b16 %3, %8 offset:%12\n\t" \
    "ds_read_b64_tr_b16 %4, %8 offset:%13\n\tds_read_b64_tr_b16 %5, %8 offset:%14\n\tds_read_b64_tr_b16 %6, %8 offset:%15\n\tds_read_b64_tr_b16 %7, %8 offset:%16\n\ts_waitcnt lgkmcnt(0)" \
    : "=&v"(r0), "=&v"(r1), "=&v"(r2), "=&v"(r3), "=&v"(r4), "=&v"(r5), "=&v"(r6), "=&v"(r7) \
    : "v"(vb), "i"(OFF), "i"((OFF) + 8 * AT_VS), "i"((OFF) + 64), "i"((OFF) + 8 * AT_VS + 64), "i"((OFF) + 16 * AT_VS), "i"((OFF) + 24 * AT_VS), "i"((OFF) + 16 * AT_VS + 64), "i"((OFF) + 24 * AT_VS + 64) : "memory")
__device__ __forceinline__ void pv_tile(unsigned vb, const f32x16& p0, const f32x16& p1, f32x16& O0, f32x16& O1, bool zero_all) {
    s16x4 r0, r1, r2, r3, r4, r5, r6, r7;
    const bf16x8 zf = (bf16x8){0, 0, 0, 0, 0, 0, 0, 0};
#define AT_PV2(P, OFF) { bf16x8 b0 = pack8(P, 0), b1 = pack8(P, 1); if (zero_all) { b0 = zf; b1 = zf; } AT_TR8(vb, OFF, r0, r1, r2, r3, r4, r5, r6, r7); \
        const bf16x8 a00 = __builtin_shufflevector(r0, r1, 0, 1, 2, 3, 4, 5, 6, 7), a01 = __builtin_shufflevector(r2, r3, 0, 1, 2, 3, 4, 5, 6, 7), a10 = __builtin_shufflevector(r4, r5, 0, 1, 2, 3, 4, 5, 6, 7), a11 = __builtin_shufflevector(r6, r7, 0, 1, 2, 3, 4, 5, 6, 7); \
        O0 = MFMA32(a00, b0, O0); O1 = MFMA32(a01, b0, O1); O0 = MFMA32(a10, b1, O0); O1 = MFMA32(a11, b1, O1); }
    AT_PV2(p0, 0) AT_PV2(p1, 32 * AT_VS)
#undef AT_PV2
}
template <int CTRL> __device__ __forceinline__ float dppq(float v) { return __builtin_bit_cast(float, __builtin_amdgcn_update_dpp(0, __builtin_bit_cast(int, v), CTRL, 0xf, 0xf, false)); }
__device__ __forceinline__ float sum4(float v) { v += dppq<0xB1>(v); v += dppq<0x4E>(v); return v; }
__device__ __forceinline__ void xhalf_swap(float& a, float& b) { asm volatile("s_nop 1\n\tv_permlane32_swap_b32 %0, %1\n\ts_nop 1" : "+v"(a), "+v"(b)); }
__device__ __forceinline__ float xhalf_max(float v) { float a = v, b = v; asm volatile("s_nop 1\n\tv_permlane32_swap_b32 %0, %1\n\ts_nop 1\n\tv_max_f32 %0, %0, %1" : "+v"(a), "+v"(b)); return a; }
__device__ __forceinline__ float max32(const f32x16& a, const f32x16& b) {
    float m;
    asm("v_max3_f32 %0, %1, %2, %3\n\tv_max3_f32 %0, %0, %4, %5\n\tv_max3_f32 %0, %0, %6, %7\n\tv_max3_f32 %0, %0, %8, %9\n\tv_max3_f32 %0, %0, %10, %11\n\tv_max3_f32 %0, %0, %12, %13\n\tv_max3_f32 %0, %0, %14, %15\n\t"
        "v_max3_f32 %0, %0, %16, %17\n\tv_max3_f32 %0, %0, %18, %19\n\tv_max3_f32 %0, %0, %20, %21\n\tv_max3_f32 %0, %0, %22, %23\n\tv_max3_f32 %0, %0, %24, %25\n\tv_max3_f32 %0, %0, %26, %27\n\tv_max3_f32 %0, %0, %28, %29"
        : "=&v"(m) : "v"(a[0]), "v"(a[1]), "v"(a[2]), "v"(a[3]), "v"(a[4]), "v"(a[5]), "v"(a[6]), "v"(a[7]), "v"(a[8]), "v"(a[9]), "v"(a[10]), "v"(a[11]), "v"(a[12]), "v"(a[13]), "v"(a[14]), "v"(a[15]),
                     "v"(b[0]), "v"(b[1]), "v"(b[2]), "v"(b[3]), "v"(b[4]), "v"(b[5]), "v"(b[6]), "v"(b[7]), "v"(b[8]), "v"(b[9]), "v"(b[10]), "v"(b[11]), "v"(b[12]));
    asm("v_max3_f32 %0, %0, %1, %2\n\tv_max_f32 %0, %0, %3" : "+v"(m) : "v"(b[13]), "v"(b[14]), "v"(b[15]));
    return m;
}
__device__ __forceinline__ float xhalf_sum(float v) { float a = v, b = v; xhalf_swap(a, b); return a + b; }
constexpr float AT_THR = 8.0f / AT_C;
template <int MODE>
__device__ __forceinline__ void attn_tile(const LAS unsigned char* Kt, unsigned vb, const bf16x8 (&Q)[4], int l32, int half, bool on, bool edge, int dbase, float& mrun, float& lrun, f32x16& O0, f32x16& O1) {
    f32x16 s0, s1;
    qk_tile(Kt, Q, l32, half, s0, s1);
#if PROBE_DUP == 33
    { float keep_ = s0[0]; asm volatile("" : "+v"(keep_)); qk_tile(Kt, Q, l32, half, s0, s1); s0[0] = 0.5f * (s0[0] + keep_); }
#endif
    if (edge) {
#pragma unroll
        for (int r = 0; r < 16; ++r) {
            const int d0 = dbase - ((r & 3) + 8 * (r >> 2)), d1 = d0 - 32;
            const bool v0 = (MODE == 1 ? d0 >= 0 : (unsigned)d0 < 512u), v1 = (MODE == 1 ? d1 >= 0 : (unsigned)d1 < 512u);
            s0[r] = v0 ? s0[r] : AT_NEG; s1[r] = v1 ? s1[r] : AT_NEG;
        }
    }
    float mt = max32(s0, s1);
    mt = on ? mt : AT_NEG;
    mt = xhalf_max(mt);
    if (__any(mt > mrun + AT_THR)) {
        const float mnew = fmaxf(mrun, mt), alpha = __builtin_amdgcn_exp2f(AT_C * (mrun - mnew)); mrun = mnew; lrun *= alpha;
#pragma unroll
        for (int r = 0; r < 16; ++r) { O0[r] *= alpha; O1[r] *= alpha; }
    }
    const float mc = on ? mrun * AT_C : 1.0e30f;
    f32x16 p0, p1;
#pragma unroll
    for (int r = 0; r < 16; ++r) { p0[r] = __builtin_amdgcn_exp2f(__builtin_fmaf(s0[r], AT_C, -mc)); p1[r] = __builtin_amdgcn_exp2f(__builtin_fmaf(s1[r], AT_C, -mc)); }
#if PROBE_DUP == 34
    { float mc2 = mc; asm volatile("" : "+v"(mc2));
#pragma unroll
      for (int r = 0; r < 16; ++r) { p0[r] = 0.5f * (p0[r] + __builtin_amdgcn_exp2f(__builtin_fmaf(s0[r], AT_C, -mc2))); p1[r] = 0.5f * (p1[r] + __builtin_amdgcn_exp2f(__builtin_fmaf(s1[r], AT_C, -mc2))); } }
#endif
    if (edge) {
#pragma unroll
        for (int r = 0; r < 16; ++r) { p0[r] = s0[r] > 0.5f * AT_NEG ? p0[r] : 0.f; p1[r] = s1[r] > 0.5f * AT_NEG ? p1[r] : 0.f; }
    }
    float ps = 0.f;
#pragma unroll
    for (int r = 0; r < 16; ++r) ps += p0[r] + p1[r];
    lrun += ps;
#if PROBE_DUP == 35
#pragma unroll
    for (int r = 0; r < 16; ++r) { p0[r] *= 0.5f; p1[r] *= 0.5f; }
    pv_tile(vb, p0, p1, O0, O1, false);
#endif
    pv_tile(vb, p0, p1, O0, O1, false);
}
template <int MODE>
__device__ __forceinline__ void attn_stream(LAS unsigned char* lds, const bf16_t* Kg, const bf16_t* Vg, int jlo, int cur, int tokl, const bf16x8 (&Q)[4], unsigned selm_lo, unsigned selm_hi,
                                            int tid, int l32, int half, unsigned vb0, f32x16& O0, f32x16& O1, float& lout) {
    const int key = tid >> 3, chunk = tid & 7;
    const size_t goff = (size_t)key * EVP + chunk * 8;
    const unsigned kofs = key * AT_KS + chunk * 16, vofs = key * AT_VS + chunk * 16;
#define AT_GLD(kr, vr, jj) do { const int j_ = (jj) <= cur ? (jj) : cur; kr = *(const u32x4*)(Kg + (size_t)j_ * 64 * EVP + goff); vr = *(const u32x4*)(Vg + (size_t)j_ * 64 * EVP + goff); } while (0)
#define AT_LST(kr, vr, jj) do { const int nb_ = (jj) & 3; *(LAS u32x4*)(lds + AT_LK + nb_ * AT_KT + kofs) = kr; *(LAS u32x4*)(lds + AT_LV + nb_ * AT_VT + vofs) = vr; } while (0)
    u32x4 ka, va, kb, vb;
    AT_GLD(ka, va, jlo); AT_GLD(kb, vb, jlo + 1);
    AT_LST(ka, va, jlo); AT_LST(kb, vb, jlo + 1);
    __syncthreads();
    float mrun = AT_NEG, lrun = 0.f;
#pragma unroll
    for (int r = 0; r < 16; ++r) { O0[r] = 0.f; O1[r] = 0.f; }
    for (int j = jlo; j <= cur; j += 2) {
        AT_GLD(ka, va, j + 2); AT_GLD(kb, vb, j + 3);
#pragma unroll
        for (int u = 0; u < 2; ++u) {
            const int jj = j + u;
            if (jj <= cur) {
                const int buf = jj & 3;
                bool on = true;
                if (MODE == 1) on = ((jj < 32 ? (selm_lo >> jj) : (selm_hi >> (jj - 32))) & 1u) != 0u;
                const int dbase = (cur - jj) * 64 + tokl - 4 * half;
                const bool edge = (jj == cur) || (MODE == 2 && cur >= 8 && jj == jlo);
                if (MODE != 1 || __any(on)) attn_tile<MODE>(lds + AT_LK + buf * AT_KT, vb0 + buf * AT_VT, Q, l32, half, on, edge, dbase, mrun, lrun, O0, O1);
            }
        }
        AT_LST(ka, va, j + 2); AT_LST(kb, vb, j + 3);
        __syncthreads();
    }
#undef AT_GLD
#undef AT_LST
    lout = xhalf_sum(lrun);
}

__device__ __forceinline__ void nsa_attn_phase(LAS unsigned char* lds, const bf16_t* Z, const bf16_t* QR, const bf16_t* KVC, bf16_t* Y, int G, int bx) {
    for (int it = 0;; ++it) {
        const int L = it * G + bx; if (L >= NB * 2 * 64) break;
        const int tid = pinned_tid(), lane = tid & 63, wave = __builtin_amdgcn_readfirstlane(tid >> 6), half = lane >> 5, l32 = lane & 31;
        const unsigned vb0 = (unsigned)(AT_LV + (4 * half + ((lane & 15) >> 2)) * AT_VS + (16 * ((lane >> 4) & 1) + 4 * (lane & 3)) * 2);
        const int tokl = 8 * wave + (l32 >> 2), g = l32 & 3;
        const int qt = (G == 256) ? 63 - (8 * it + ((it & 1) ? 7 - (bx >> 5) : (bx >> 5))) : 63 - (L >> 5);
        const int bh = L & 31, b = bh >> 1, hk = bh & 1, t0 = qt * 64, t = t0 + tokl, head = hk * 4 + g, cur = qt;
        const size_t m = (size_t)b * T + t;
        bf16x8 Qraw[4], Qrot[4];
#pragma unroll
        for (int s = 0; s < 4; ++s) { Qraw[s] = *(const bf16x8*)(Z + m * EVP + 1792 + head * 64 + 16 * s + 8 * half); Qrot[s] = *(const bf16x8*)(QR + m * 512 + head * 64 + 16 * s + 8 * half); }
        const float gate_c = sigmoidf_(bf2f(Z[m * EVP + 3072 + head * 3])), gate_s = sigmoidf_(bf2f(Z[m * EVP + 3072 + head * 3 + 1])), gate_w = sigmoidf_(bf2f(Z[m * EVP + 3072 + head * 3 + 2]));
        f32x16 Y0, Y1;
        const int nct = (4 * qt + 3 + 63) >> 6;
        unsigned selm_lo = 0u, selm_hi = 0u;
        for (int repc_ = 0; repc_ < (PROBE_DUP == 30 ? 2 : 1); ++repc_) {
        { const int key = tid >> 3, chunk = tid & 7; const bf16_t* kc = KVC + ((size_t)(b * 2 + hk) * 256) * 64; const bf16_t* vc = kc + (size_t)32 * 256 * 64;
          for (int jt = 0; jt < nct; ++jt) { *(LAS u32x4*)(lds + AT_LK + jt * AT_KT + key * AT_KS + chunk * 16) = *(const u32x4*)(kc + (size_t)(jt * 64 + key) * 64 + chunk * 8);
                                             *(LAS u32x4*)(lds + AT_LV + jt * AT_VT + key * AT_VS + chunk * 16) = *(const u32x4*)(vc + (size_t)(jt * 64 + key) * 64 + chunk * 8); }
#pragma unroll
          for (int q = 0; q < 8; ++q) { ((LAS float*)(lds + AT_LIT))[(8 * wave + q) * 64 + lane] = 0.f; ((LAS float*)(lds + AT_LIH))[(8 * wave + q) * 64 + lane] = 0.f; } }
        __syncthreads();
        {
            const int nvalid = t >= 31 ? ((t - 31) >> 4) + 1 : 0;
            float mrun = AT_NEG, lrun = 0.f;
            for (int jt = 0; jt < nct; ++jt) {
                f32x16 s0, s1; qk_tile(lds + AT_LK + jt * AT_KT, Qraw, l32, half, s0, s1);
                const int nb = nvalid - 64 * jt - 4 * half;
                float mt = AT_NEG;
#pragma unroll
                for (int r = 0; r < 16; ++r) { const int o = (r & 3) + 8 * (r >> 2); s0[r] = o < nb ? s0[r] : AT_NEG; s1[r] = o + 32 < nb ? s1[r] : AT_NEG; mt = fmaxf(mt, fmaxf(s0[r], s1[r])); }
                mt = xhalf_max(mt);
                const float mnew = fmaxf(mrun, mt); lrun *= __builtin_amdgcn_exp2f(AT_C * (mrun - mnew)); mrun = mnew;
#pragma unroll
                for (int r = 0; r < 16; ++r) { lrun += (s0[r] > 0.5f * AT_NEG ? __builtin_amdgcn_exp2f(AT_C * (s0[r] - mnew)) : 0.f) + (s1[r] > 0.5f * AT_NEG ? __builtin_amdgcn_exp2f(AT_C * (s1[r] - mnew)) : 0.f); }
            }
            const float lt = xhalf_sum(lrun), inv = lt > 0.f ? 1.0f / lt : 0.f;
            f32x16 O0, O1;
#pragma unroll
            for (int r = 0; r < 16; ++r) { O0[r] = 0.f; O1[r] = 0.f; }
            for (int jt = 0; jt < nct; ++jt) {
                f32x16 s0, s1; qk_tile(lds + AT_LK + jt * AT_KT, Qraw, l32, half, s0, s1);
                const int nb = nvalid - 64 * jt - 4 * half;
#pragma unroll
                for (int r = 0; r < 16; ++r) { const int o = (r & 3) + 8 * (r >> 2); s0[r] = o < nb ? __builtin_amdgcn_exp2f(AT_C * (s0[r] - mrun)) * inv : 0.f; s1[r] = o + 32 < nb ? __builtin_amdgcn_exp2f(AT_C * (s1[r] - mrun)) * inv : 0.f; }
#pragma unroll
                for (int g4 = 0; g4 < 4; ++g4) {
                    const float ta = sum4((s0[4 * g4] + s0[4 * g4 + 1]) + (s0[4 * g4 + 2] + s0[4 * g4 + 3])), ha = sum4(0.5f * s0[4 * g4 + 3]);
                    const float tb = sum4((s1[4 * g4] + s1[4 * g4 + 1]) + (s1[4 * g4 + 2] + s1[4 * g4 + 3])), hb = sum4(0.5f * s1[4 * g4 + 3]);
                    if (g == 0) { const int sa = 16 * jt + 2 * g4 + half; ((LAS float*)(lds + AT_LIT))[tokl * 64 + sa] = ta; ((LAS float*)(lds + AT_LIH))[tokl * 64 + sa] = ha;
                                  ((LAS float*)(lds + AT_LIT))[tokl * 64 + sa + 8] = tb; ((LAS float*)(lds + AT_LIH))[tokl * 64 + sa + 8] = hb; }
                }
                pv_tile(vb0 + jt * AT_VT, s0, s1, O0, O1, false);
            }
#pragma unroll
            for (int r = 0; r < 16; ++r) { Y0[r] = gate_c * O0[r]; Y1[r] = gate_c * O1[r]; }
        }
        {
            LDS_WAIT();
            const int tk = 8 * wave + (lane >> 3), sb = (lane & 7) * 8;
            float v[8];
#pragma unroll
            for (int i = 0; i < 8; ++i) { const int sidx = sb + i;
                float x = ((const LAS float*)(lds + AT_LIT))[tk * 64 + sidx] - ((const LAS float*)(lds + AT_LIH))[tk * 64 + sidx];
                if (sidx > 0) x += ((const LAS float*)(lds + AT_LIH))[tk * 64 + sidx - 1];
                if (sidx == 0 || sidx == cur || sidx == cur - 1) x = 3.0e38f; else if (sidx > cur) x = -3.0e38f;
                v[i] = x; }
            unsigned long long key[8];
#pragma unroll
            for (int i = 0; i < 8; ++i) { const unsigned u = __float_as_uint(v[i]), mu_ = (u & 0x80000000u) ? ~u : (u | 0x80000000u); key[i] = ((unsigned long long)mu_ << 32) | (unsigned)(63 - (sb + i));
                ((LAS unsigned long long*)(lds + AT_LKEY))[tk * 64 + sb + i] = key[i]; }
            LDS_WAIT();
            int rank[8];
#pragma unroll
            for (int i = 0; i < 8; ++i) rank[i] = 0;
#pragma unroll 4
            for (int sp = 0; sp < 64; ++sp) { const unsigned long long x = ((const LAS unsigned long long*)(lds + AT_LKEY))[tk * 64 + sp];
#pragma unroll
                for (int i = 0; i < 8; ++i) rank[i] += (x > key[i]) ? 1 : 0; }
            unsigned byte = 0u;
#pragma unroll
            for (int i = 0; i < 8; ++i) byte |= (rank[i] < 16 && sb + i <= cur) ? (1u << i) : 0u;
            ((LAS unsigned char*)(lds + AT_LSM))[tk * 8 + (lane & 7)] = (unsigned char)byte;
            LDS_WAIT();
            const u32x2 sm = *(const LAS u32x2*)(lds + AT_LSM + tokl * 8); selm_lo = sm.x; selm_hi = sm.y;
        }
        __syncthreads();
        }
        const bf16_t* zb = Z + ((size_t)b * T) * EVP + hk * 64;
        {
            f32x16 O0, O1; float lt;
            for (int rep_ = 0; rep_ < (PROBE_DUP == 31 ? 2 : 1); ++rep_) attn_stream<1>(lds, zb + 2560, zb + 2688, 0, cur, tokl, Qrot, selm_lo, selm_hi, tid, l32, half, vb0, O0, O1, lt);
            const float sc = lt > 0.f ? gate_s / lt : 0.f;
#pragma unroll
            for (int r = 0; r < 16; ++r) { Y0[r] += sc * O0[r]; Y1[r] += sc * O1[r]; }
        }
        {
            f32x16 O0, O1; float lt;
            for (int rep_ = 0; rep_ < (PROBE_DUP == 32 ? 2 : 1); ++rep_) attn_stream<2>(lds, zb + 2816, zb + 2944, cur >= 8 ? cur - 8 : 0, cur, tokl, Qrot, 0u, 0u, tid, l32, half, vb0, O0, O1, lt);
            const float sc = lt > 0.f ? gate_w / lt : 0.f;
#pragma unroll
            for (int r = 0; r < 16; ++r) { Y0[r] += sc * O0[r]; Y1[r] += sc * O1[r]; }
        }
        bf16_t* yo = Y + m * D + 512 + head * 64;
#pragma unroll
        for (int g4 = 0; g4 < 4; ++g4) {
            *(u32x2*)(yo + 8 * g4 + 4 * half) = (u32x2){cvt_pk_bf16(Y0[4 * g4], Y0[4 * g4 + 1]), cvt_pk_bf16(Y0[4 * g4 + 2], Y0[4 * g4 + 3])};
            *(u32x2*)(yo + 32 + 8 * g4 + 4 * half) = (u32x2){cvt_pk_bf16(Y1[4 * g4], Y1[4 * g4 + 1]), cvt_pk_bf16(Y1[4 * g4 + 2], Y1[4 * g4 + 3])};
        }
    }
}

constexpr int LDS_BYTES = 163840;
constexpr int LDSCTL_OFF = LDS_BYTES - 512;
constexpr int RING_BYTES = 131072;

struct Args { const void* in[34]; float* out; unsigned char* ws; int ph_lo, ph_hi; };

enum { I_X = 0, I_P, I_POS, I_EVWIN, I_EVWOUT, I_MU, I_W0, I_W2, I_A0, I_A2, I_G2, I_KK, I_KA, I_RK, I_GNG, I_GNB, I_CPOS, I_CW1, I_CW2, I_ODWIN, I_ODWOUT,
       I_HGLB, I_HGNG, I_WRG, I_BRG, I_WRE, I_BRE, I_MW1, I_MW3, I_MW2, I_LNG, I_LNB, I_PLEW, I_PLEGW };

__device__ __forceinline__ void transpose_item(const float* W, int ldw, int k0, int n0, int nvalid, bf16_t* WT, int ldt, int drow0, int dcol0, LAS float* scr, int lane) {
    const int nl = lane & 31; const bool ok = (n0 + nl) < nvalid;
#pragma unroll 8
    for (int i = 0; i < 32; ++i) { const int kk = 2 * i + (lane >> 5); scr[kk * 33 + nl] = ok ? W[(size_t)(k0 + kk) * ldw + n0 + nl] : 0.f; }
    LDS_WAIT(); asm volatile("" ::: "memory");
    const int c = lane & 7;
#pragma unroll
    for (int j = 0; j < 4; ++j) { const int n = (lane >> 3) + 8 * j; const LAS float* s = scr + (8 * c) * 33 + n;
        u32x4 o; o.x = cvt_pk_bf16(s[0 * 33], s[1 * 33]); o.y = cvt_pk_bf16(s[2 * 33], s[3 * 33]); o.z = cvt_pk_bf16(s[4 * 33], s[5 * 33]); o.w = cvt_pk_bf16(s[6 * 33], s[7 * 33]);
        *(u32x4*)(WT + (size_t)(drow0 + n) * ldt + dcol0 + k0 + 8 * c) = o; }
    LDS_WAIT(); asm volatile("" ::: "memory");
}
__device__ __forceinline__ void transpose_item_f8(const float* W, int ldw, int k0, int n0, unsigned char* WT, int ldt, int drow0, LAS float* scr, int lane) {
    const int nl = lane & 31;
#pragma unroll 8
    for (int i = 0; i < 32; ++i) { const int kk = 2 * i + (lane >> 5); scr[kk * 33 + nl] = W[(size_t)(k0 + kk) * ldw + n0 + nl]; }
    LDS_WAIT(); asm volatile("" ::: "memory");
    const int c = lane & 7;
#pragma unroll
    for (int j = 0; j < 4; ++j) { const int n = (lane >> 3) + 8 * j; const LAS float* sp = scr + (8 * c) * 33 + n;
        *(u32x2*)(WT + (size_t)(drow0 + n) * ldt + k0 + 8 * c) = (u32x2){cvt_pk4_fp8(sp[0 * 33], sp[1 * 33], sp[2 * 33], sp[3 * 33]), cvt_pk4_fp8(sp[4 * 33], sp[5 * 33], sp[6 * 33], sp[7 * 33])}; }
    LDS_WAIT(); asm volatile("" ::: "memory");
}
__device__ __forceinline__ void conv_late_item(int it, const float* odin, const float* odout, const float* evout, const float* gatew, const float* plew, unsigned char* ws, LAS float* scr, int lane) {
    const float* W; bf16_t* WT; int K = D, N = D, q = it;
    if (it < 2048) { W = odin; WT = (bf16_t*)(ws + WS_WODIN); N = 4 * D; }
    else if (it < 2560) { q = it - 2048; W = odout; WT = (bf16_t*)(ws + WS_WODOUT); }
    else if (it < 3072) { q = it - 2560; W = evout; WT = (bf16_t*)(ws + WS_WEVOUT); }
    else if (it < 4096) { q = it - 3072; const int l_ = q >> 9; q &= 511; W = gatew + (size_t)l_ * D * D; WT = (bf16_t*)(ws + WS_WGATE) + (size_t)l_ * D * D; }
    else { q = it - 4096; const int l_ = q >> 7; q &= 127; K = PLE; W = plew + (size_t)l_ * PLE * D; WT = (bf16_t*)(ws + WS_WPLE) + (size_t)l_ * D * PLE; }
    const int nblk = N / 32, kb = q / nblk, nb = q % nblk;
    transpose_item(W, N, 64 * kb, 32 * nb, N, WT, K, 32 * nb, 0, scr, lane);
}
__device__ __forceinline__ void conv_matrix(const float* W, int K, int N, int npad, bf16_t* WT, LAS float* scr, int gw, int ngw, int lane) {
    const int nblk = npad / 32, nitems = (K / 64) * nblk;
    for (int it = gw; it < nitems; it += ngw) { const int kb = it / nblk, nb = it % nblk; transpose_item(W, N, 64 * kb, 32 * nb, N, WT, K, 32 * nb, 0, scr, lane); }
}
__device__ __forceinline__ void row_to_bf16(const float* xrow, bf16_t* orow, int lane) {
    const f32x4* xr = (const f32x4*)xrow + lane; u32x2* o8 = (u32x2*)orow + lane;
#pragma unroll
    for (int j = 0; j < 4; ++j) { const f32x4 v = xr[64 * j]; u32x2 w; w.x = cvt_pk_bf16(v[0], v[1]); w.y = cvt_pk_bf16(v[2], v[3]); o8[64 * j] = w; }
}
__device__ __forceinline__ void conv_moe_item(const float* w1, const float* w3, const float* w2, int li, bf16_t* w13, bf16_t* w2t, LAS float* scr, int it, int lane) {
    constexpr int I13 = (1024 / 64) * (512 / 32), I2 = (512 / 64) * (1024 / 32);
    if (it < NEXP * 2 * I13) {
        const int e = it / (2 * I13), r = it % (2 * I13), which = r / I13, q = r % I13, kb = q / 16, nb = q % 16, n0 = 32 * nb;
        const float* W = (which ? w3 : w1) + ((size_t)(li * NEXP + e)) * 1024 * 512;
        transpose_item_f8(W, 512, 64 * kb, n0, (unsigned char*)w13, 1024, e * 1024 + (n0 >> 7) * 256 + which * 128 + (n0 & 127), scr, lane);
    } else {
        const int it2 = it - NEXP * 2 * I13, e = it2 / I2, q = it2 % I2, kb = q / 32, nb = q % 32;
        transpose_item_f8(w2 + ((size_t)(li * NEXP + e)) * 512 * 1024, 1024, 64 * kb, 32 * nb, (unsigned char*)w2t, 512, e * 1024 + 32 * nb, scr, lane);
    }
}
__device__ __forceinline__ void conv_moe_weights(const float* w1, const float* w3, const float* w2, int li, bf16_t* w13, bf16_t* w2t, LAS float* scr, int gw, int ngw, int lane, int parts = 3) {
    constexpr int I13 = (1024 / 64) * (512 / 32);
    if (parts & 1) for (int it = gw; it < NEXP * 2 * I13; it += ngw) {
        const int e = it / (2 * I13), r = it % (2 * I13), which = r / I13, q = r % I13, kb = q / 16, nb = q % 16, n0 = 32 * nb;
        const float* W = (which ? w3 : w1) + ((size_t)(li * NEXP + e)) * 1024 * 512;
        transpose_item_f8(W, 512, 64 * kb, n0, (unsigned char*)w13, 1024, e * 1024 + (n0 >> 7) * 256 + which * 128 + (n0 & 127), scr, lane);
    }
    constexpr int I2 = (512 / 64) * (1024 / 32);
    if (parts & 2) for (int it = gw; it < NEXP * I2; it += ngw) {
        const int e = it / I2, q = it % I2, kb = q / 32, nb = q % 32;
        transpose_item_f8(w2 + ((size_t)(li * NEXP + e)) * 512 * 1024, 1024, 64 * kb, 32 * nb, (unsigned char*)w2t, 512, e * 1024 + 32 * nb, scr, lane);
    }
}

__device__ __forceinline__ int row_elem(int lane, int j) { return (j < 2 ? 0 : 512) + 8 * lane + 4 * (j & 1); }
__device__ __forceinline__ void load_row_bf16(const bf16_t* row, f32x4 (&v)[4], int lane) {
    const u32x4 a = *((const u32x4*)row + lane), b = *((const u32x4*)row + 64 + lane);
    v[0] = (f32x4){bflo(a.x), bfhi(a.x), bflo(a.y), bfhi(a.y)}; v[1] = (f32x4){bflo(a.z), bfhi(a.z), bflo(a.w), bfhi(a.w)};
    v[2] = (f32x4){bflo(b.x), bfhi(b.x), bflo(b.y), bfhi(b.y)}; v[3] = (f32x4){bflo(b.z), bfhi(b.z), bflo(b.w), bfhi(b.w)};
}
__device__ __forceinline__ void store_row_bf16(bf16_t* row, const f32x4 (&v)[4], int lane) {
    *((u32x4*)row + lane) = (u32x4){cvt_pk_bf16(v[0][0], v[0][1]), cvt_pk_bf16(v[0][2], v[0][3]), cvt_pk_bf16(v[1][0], v[1][1]), cvt_pk_bf16(v[1][2], v[1][3])};
    *((u32x4*)row + 64 + lane) = (u32x4){cvt_pk_bf16(v[2][0], v[2][1]), cvt_pk_bf16(v[2][2], v[2][3]), cvt_pk_bf16(v[3][0], v[3][1]), cvt_pk_bf16(v[3][2], v[3][3])};
}
__device__ __forceinline__ void ln_row(f32x4 (&v)[4], const float* g, const float* b, int lane) {
    float s = 0.f;
#pragma unroll
    for (int j = 0; j < 4; ++j) s += (v[j][0] + v[j][1]) + (v[j][2] + v[j][3]);
    const float mean = wave_sum(s) * (1.f / D); float s2 = 0.f;
#pragma unroll
    for (int j = 0; j < 4; ++j) { v[j] = v[j] - mean; s2 += (v[j][0] * v[j][0] + v[j][1] * v[j][1]) + (v[j][2] * v[j][2] + v[j][3] * v[j][3]); }
    const float rstd = __builtin_amdgcn_rsqf(wave_sum(s2) * (1.f / D) + LN_EPS);
#pragma unroll
    for (int j = 0; j < 4; ++j) { const f32x4 gg = *(const f32x4*)(g + row_elem(lane, j)), bb = *(const f32x4*)(b + row_elem(lane, j)); v[j] = v[j] * rstd * gg + bb; }
}

__device__ __forceinline__ const void* ptab_get(LAS unsigned char* lds, int i) {
    const unsigned long long v = ((const volatile LAS unsigned long long*)(lds + 163840 - 512 + 64))[i];
    const unsigned lo = __builtin_amdgcn_readfirstlane((unsigned)v), hi = __builtin_amdgcn_readfirstlane((unsigned)(v >> 32));
    return (const void*)(const GAS char*)(((unsigned long long)hi << 32) | lo);
}
#define INF(i) ((const float*)ptab_get(lds, (i)))
#define WSB ((unsigned char*)ptab_get(lds, 35))
#define OUTP ((float*)ptab_get(lds, 34))
__global__ void __launch_bounds__(NTHR, 2) fwd(Args args) {
    extern __shared__ __attribute__((aligned(16))) unsigned char lds_raw[];
    LAS unsigned char* lds = (LAS unsigned char*)lds_raw;
    const int G = gridDim.x, bx = blockIdx.x;
    const int vcu = (G % 8 == 0) ? (bx % 8) * (G / 8) + bx / 8 : bx;
    const int ngw = G * NWAVES;
#define PH_LOCALS const int tid = pinned_tid(), lane = tid & 63, wave = __builtin_amdgcn_readfirstlane(tid >> 6), gw = vcu * NWAVES + wave; (void)tid; (void)lane; (void)gw;
    LAS unsigned long long* ptab = (LAS unsigned long long*)(lds + LDSCTL_OFF + 64);
    for (int u = threadIdx.x; u < (LDS_BYTES - LDSCTL_OFF) / 4; u += NTHR) ((LAS unsigned*)(lds + LDSCTL_OFF))[u] = 0u;
    __syncthreads();
    if (threadIdx.x == 0) {
#define PT_(i) ptab[i] = (unsigned long long)args.in[i];
        PT_(0) PT_(1) PT_(2) PT_(3) PT_(4) PT_(5) PT_(6) PT_(7) PT_(8) PT_(9) PT_(10) PT_(11) PT_(12) PT_(13) PT_(14) PT_(15) PT_(16) PT_(17) PT_(18) PT_(19) PT_(20) PT_(21) PT_(22) PT_(23) PT_(24) PT_(25) PT_(26) PT_(27) PT_(28) PT_(29) PT_(30) PT_(31) PT_(32) PT_(33)
#undef PT_
        ptab[34] = (unsigned long long)args.out; ptab[35] = (unsigned long long)args.ws;
    }
    __syncthreads();
    XcdBarrier bar = xcd_barrier_post((unsigned*)(args.ws + WS_CTL) + CW_BAR, (volatile LAS unsigned*)(lds + LDSCTL_OFF + 32));
    const int lo = args.ph_lo, hi = args.ph_hi;
    int pc = 0;
#define PH_PTRS unsigned char* const ws = WSB; (void)ws; \
    bf16_t* const W_evin = (bf16_t*)(ws + WS_WEVIN); bf16_t* const W_evout = (bf16_t*)(ws + WS_WEVOUT); bf16_t* const W_odin = (bf16_t*)(ws + WS_WODIN); bf16_t* const W_odout = (bf16_t*)(ws + WS_WODOUT); \
    bf16_t* const W_gate = (bf16_t*)(ws + WS_WGATE); bf16_t* const W_ple = (bf16_t*)(ws + WS_WPLE); bf16_t* const W_m13 = (bf16_t*)(ws + WS_WMOE13); bf16_t* const W_m2 = (bf16_t*)(ws + WS_WMOE2); \
    bf16_t* const pbf = (bf16_t*)(ws + WS_PBF); bf16_t* const XB = (bf16_t*)(ws + WS_XB); bf16_t* const Hb = (bf16_t*)(ws + A_H); bf16_t* const PP = (bf16_t*)(ws + A_XBUF); bf16_t* const XB1 = (bf16_t*)OUTP; bf16_t* const PBF1 = (bf16_t*)OUTP + (size_t)M * D; bf16_t* const PP1 = (bf16_t*)(ws + A_PP1); bf16_t* const ZB = (bf16_t*)(ws + WS_ARENA); \
    (void)W_evin; (void)W_evout; (void)W_odin; (void)W_odout; (void)W_gate; (void)W_ple; (void)W_m13; (void)W_m2; (void)pbf; (void)XB; (void)Hb; (void)PP; (void)XB1; (void)PBF1; (void)PP1; (void)ZB;
#define PH_RUN (pc >= lo && pc < hi)
#define PH_END do { if (pc >= lo && pc + 1 < hi) xcd_barrier(bar); ++pc; } while (0)

    if (PH_RUN) for (int rep_ = 0; rep_ < (PROBE_DUP == 20 ? 2 : 1); ++rep_) { PH_PTRS PH_LOCALS
        LAS float* scr = (LAS float*)(lds + wave * 16384);
        conv_matrix(INF(I_EVWIN), D, EVN, EVP, W_evin, scr, gw, ngw, lane);
        if (G != NB * 16) {
        conv_matrix(INF(I_EVWOUT), D, D, D, W_evout, scr, gw, ngw, lane);
        conv_matrix(INF(I_ODWIN), D, 4 * D, 4 * D, W_odin, scr, gw, ngw, lane);
        conv_matrix(INF(I_ODWOUT), D, D, D, W_odout, scr, gw, ngw, lane);
        for (int li = 0; li < DEPTH; ++li) {
            conv_matrix(INF(I_PLEGW) + (size_t)li * D * D, D, D, D, W_gate + (size_t)li * D * D, scr, gw, ngw, lane);
            conv_matrix(INF(I_PLEW) + (size_t)li * PLE * D, PLE, D, D, W_ple + (size_t)li * D * PLE, scr, gw, ngw, lane);
        }
        }
        { const float* w2 = INF(I_W2); const float* a2 = INF(I_A2); const float* g2 = INF(I_G2); bf16_t* WL = (bf16_t*)(ws + WS_WLORA);
          for (int idx = gw * 64 + lane; idx < 1536 * 256; idx += ngw * 64) { const int n = idx >> 8, k = idx & 255; float v = 0.f;
              if (n < 512) { if (k < 64) v = w2[k * 512 + n]; } else if (n < 1024) { if (k >= 64 && k < 128) v = a2[(k - 64) * 512 + (n - 512)]; } else { if (k >= 128) v = g2[(k - 128) * 512 + (n - 1024)]; }
              WL[idx] = (bf16_t)(cvt_pk_bf16(v, 0.f) & 0xffffu); } }
        { const float* cw1 = INF(I_CW1); bf16_t* WC = (bf16_t*)(ws + WS_WCMP);
          for (int it = gw; it < 4 * 64; it += ngw) { const int zh = it >> 6, q = it & 63, kb = q >> 2, nb = q & 3;
              transpose_item(cw1 + (size_t)zh * 1024 * 128, 128, 64 * kb, 32 * nb, 128, WC, 1024, zh * 128 + 32 * nb, 0, scr, lane); }
          const float* cpos = INF(I_CPOS); float* cb = (float*)(ws + MISC_CMPB);
          for (int o = gw; o < 256; o += ngw) { const int zz = o >> 7, c = o & 127; float a = 0.f; for (int i = lane; i < 2048; i += 64) a += cpos[zz * 2048 + i] * cw1[((size_t)zz * 2048 + i) * 128 + c]; a = wave_sum(a); if (lane == 0) cb[o] = a; } }
        { bf16_t* WRB = (bf16_t*)(ws + WS_WRB); const float* wrg = INF(I_WRG); const float* wre = INF(I_WRE);
          for (int idx = gw * 64 + lane; idx < DEPTH * 256 * 1024; idx += ngw * 64) { const int l_ = idx >> 18, n = (idx >> 10) & 255, k = idx & 1023;
              const float v = n < 4 ? wrg[((size_t)l_ * D + k) * 4 + n] : n < 36 ? wre[((size_t)l_ * D + k) * NEXP + (n - 4)] : 0.f; WRB[idx] = (bf16_t)(cvt_pk_bf16(v, 0.f) & 0xffffu); } }
        { const float* hl = INF(I_HGLB); float* lbt = (float*)(ws + MISC_LBT);
          for (int c = gw * 64 + lane; c < D; c += ngw * 64) { const float a0 = hl[c], a1 = hl[D + c], mx = fmaxf(a0, a1), e0 = __expf(a0 - mx), e1 = __expf(a1 - mx); lbt[c] = e1 / (e0 + e1); } }
        const float* xin_ = INF(I_X);
        for (int m = gw; m < M; m += 4 * ngw) {
            f32x4 v[4][4];
#pragma unroll
            for (int r = 0; r < 4; ++r)
#pragma unroll
                for (int j = 0; j < 4; ++j) v[r][j] = *(const f32x4*)(xin_ + (size_t)(m + r * ngw) * D + row_elem(lane, j));
#pragma unroll
            for (int r = 0; r < 4; ++r) store_row_bf16(XB + (size_t)(m + r * ngw) * D, v[r], lane);
        }
    }
    PH_END;

    for (int li = 0; li < DEPTH; ++li) {
                if (li == 0) {
            if (PH_RUN) { PH_PTRS
                pg8::Gemm g{XB, W_evin, D, D, D}; pg8::DenseOrder S; S.init(M, EVP, G, bx);
                pg8::EpiBf16 E{ZB, EVP, 0u, 0u, nullptr};
                for (int rep_ = 0; rep_ < (PROBE_DUP == 4 ? 2 : 1); ++rep_) pg8::gemm_phase<pg8::EpiBf16, pg8::DenseOrder>(lds, g, S, E);
            }
            PH_END;
            if (PH_RUN) for (int rep_ = 0; rep_ < (PROBE_DUP == 21 ? 2 : 1); ++rep_) { PH_PTRS PH_LOCALS const bool dry_ = (PROBE_DUP == 21 && rep_ == 0);
                const float* mu = INF(I_MU); bf16_t* ACT = (bf16_t*)(ws + A_ACT); const int* posi = (const int*)INF(I_POS); bf16_t* QRB = (bf16_t*)((unsigned char*)OUTP + DOUT_QR); bf16_t* SEGB = (bf16_t*)((unsigned char*)OUTP + DOUT_SEG);
                const float inv_me = exp2f(-(float)(lane & 31) * (13.287712379549449f / 32.0f));
                f32x4 mu8a = (f32x4){0.f, 0.f, 0.f, 0.f}, mu8b = mu8a; if (lane < 32) { mu8a = *(const f32x4*)(mu + 1536 + 8 * lane); mu8b = *(const f32x4*)(mu + 1536 + 8 * lane + 4); }
                LAS float* tb = (LAS float*)(lds + wave * 256);
                for (int m = gw; m < M; m += ngw) {
                    const bf16_t* zrow = ZB + (size_t)m * EVP;
                    if (lane < 32) {
                        const u32x4 zc = *(const u32x4*)(zrow + 1536 + 8 * lane); u32x4 zp = (u32x4){0u, 0u, 0u, 0u};
                        if ((m & (T - 1)) != 0) zp = *(const u32x4*)(zrow - EVP + 1536 + 8 * lane);
                        float v[8], pv[8]; unpack8(zc, v); unpack8(zp, pv);
#pragma unroll
                        for (int j = 0; j < 8; ++j) { v[j] += (j < 4 ? mu8a[j & 3] : mu8b[j & 3]) * (pv[j] - v[j]); if (lane < 8) { const float e2 = __expf(2.0f * fminf(fmaxf(v[j], -15.0f), 15.0f)); v[j] = (e2 - 1.0f) * __builtin_amdgcn_rcpf(e2 + 1.0f); } else if (lane >= 16) v[j] = sigmoidf_(v[j]); }
                        *(u32x4*)(ACT + (size_t)m * 256 + 8 * lane) = (u32x4){cvt_pk_bf16(v[0], v[1]), cvt_pk_bf16(v[2], v[3]), cvt_pk_bf16(v[4], v[5]), cvt_pk_bf16(v[6], v[7])};
                    }
                    if (G != NB * 16) rope_row(m, ZB, QRB, posi, tb, lane, !dry_);
                    if (lane < 48) {
                    } else {
                        const int bq_ = m >> 12, tt = m & (T - 1), jj = tt >> 4, ll = tt & 15;
#pragma unroll
                        for (int q = 0; q < 2; ++q) { const int idx = (lane - 48) * 2 + q, piece = idx >> 3, ch = idx & 7, zsel = piece >> 1, hq = piece & 1;
                            *(u32x4*)(SEGB + ((size_t)zsel * 8192 + (size_t)(bq_ * 256 + jj) * 2 + hq) * 1024 + ll * 64 + ch * 8) = *(const u32x4*)(zrow + 2304 + zsel * 128 + hq * 64 + ch * 8); }
                    }
                    LDS_WAIT();
                }
            }
            PH_END;
            if (PH_RUN) { PH_PTRS
                pg8::Gemm g{(const bf16_t*)(ws + A_ACT), (const bf16_t*)(ws + WS_WLORA), 256, 256, 256}; pg8::DenseOrder S; S.init(M, 1536, G, bx);
                pg8::EpiLora E{INF(I_W0), INF(I_A0), (float*)(ws + A_DEC), (bf16_t*)(ws + A_AA), (bf16_t*)(ws + A_GG)};
                for (int rep_ = 0; rep_ < ((PROBE_DUP == 4 || PROBE_DUP == 42) ? 2 : 1); ++rep_) pg8::gemm_phase<pg8::EpiLora, pg8::DenseOrder>(lds, g, S, E);
            }
            PH_END;
            if (PH_RUN) { PH_PTRS
              if (G > 64 && bx < 64) {
                pg8::Gemm g{(const bf16_t*)((unsigned char*)OUTP + DOUT_SEG), (const bf16_t*)(ws + WS_WCMP), 1024, 1024, 1024}; pg8::CmpOrder S{G, bx};
                pg8::EpiF32 E{(float*)(ws + A_HC2), 256};
                pg8::gemm_phase<pg8::EpiF32, pg8::CmpOrder>(lds, g, S, E);
              } else { PH_LOCALS
                const int gwp = G > 64 ? (bx - 64) * NWAVES + wave : gw, ngwp = G > 64 ? (G - 64) * NWAVES : ngw;
                const float* mu = INF(I_MU); const float* kkp = INF(I_KK); const float* kap = INF(I_KA); const float* rkp = INF(I_RK); const bf16_t* AAp = (const bf16_t*)(ws + A_AA); float* sc4 = (float*)(ws + A_SC4);
                float p_mr[8], p_mk[8], p_kk[8], p_ka[8], p_rk[8];
#pragma unroll
                for (int i = 0; i < 8; ++i) { p_mr[i] = mu[8 * lane + i]; p_mk[i] = mu[512 + 8 * lane + i]; p_kk[i] = kkp[8 * lane + i]; p_ka[i] = kap[8 * lane + i]; p_rk[i] = rkp[8 * lane + i]; }
                for (int m = gwp; m < M; m += ngwp) {
                    const bf16_t* zc = ZB + (size_t)m * EVP + 8 * lane;
                    const u32x4 rw_ = *(const u32x4*)zc, kw_ = *(const u32x4*)(zc + 512), aw_ = *(const u32x4*)(AAp + (size_t)m * 512 + 8 * lane); u32x4 rpw = (u32x4){0u, 0u, 0u, 0u}, kpw = rpw;
                    if ((m & (T - 1)) != 0) { rpw = *(const u32x4*)(zc - EVP); kpw = *(const u32x4*)(zc + 512 - EVP); }
                    float r_[8], k_[8], rp_[8], kp_[8], a_[8]; unpack8(rw_, r_); unpack8(kw_, k_); unpack8(rpw, rp_); unpack8(kpw, kp_); unpack8(aw_, a_);
                    float n2 = 0.f, c1 = 0.f, c2 = 0.f, bc = 0.f;
#pragma unroll
                    for (int i = 0; i < 8; ++i) { const float rr = r_[i] + p_mr[i] * (rp_[i] - r_[i]), k0 = k_[i] + p_mk[i] * (kp_[i] - k_[i]), kk = k0 * p_kk[i], k2 = k0 * (1.0f + (a_[i] - 1.0f) * p_ka[i]);
                        n2 += kk * kk; c1 += kk * a_[i] * rr; c2 += k2 * rr; bc += rr * k2 * p_rk[i]; }
                    n2 = sum8b(n2); c1 = sum8b(c1); c2 = sum8b(c2); bc = sum8b(bc);
                    const float inv = __builtin_amdgcn_rsqf(fmaxf(n2, 1e-24f));
                    if ((lane & 7) == 0) *(f32x4*)(sc4 + ((size_t)m * 8 + (lane >> 3)) * 4) = (f32x4){inv, c1 * inv, c2, bc};
                }
            }
              if (G <= 64) { __syncthreads(); pg8::Gemm g{(const bf16_t*)((unsigned char*)OUTP + DOUT_SEG), (const bf16_t*)(ws + WS_WCMP), 1024, 1024, 1024}; pg8::CmpOrder S{G, bx}; pg8::EpiF32 E{(float*)(ws + A_HC2), 256}; pg8::gemm_phase<pg8::EpiF32, pg8::CmpOrder>(lds, g, S, E); }
            }
            PH_END;
            if (PH_RUN) for (int rep_ = 0; rep_ < (PROBE_DUP == 1 ? 2 : 1); ++rep_) { PH_PTRS rwkv_phase(lds, ZB, (const float*)(ws + A_DEC), (const bf16_t*)(ws + A_AA), (const float*)(ws + A_SC4), INF(I_MU), INF(I_KK), INF(I_KA), XB, G, bx, INF(I_MW1), INF(I_MW3), INF(I_MW2), W_m13, W_m2, G == NB * 16 && PROBE_DUP != 1,
                                   (const float*)(ws + A_HC2), (const float*)(ws + MISC_CMPB), INF(I_CW2), (bf16_t*)(ws + A_KVC2), INF(I_P), pbf, PBF1, ZB, (bf16_t*)((unsigned char*)OUTP + DOUT_QR), (const int*)INF(I_POS),
                                   INF(I_ODWIN), INF(I_ODWOUT), INF(I_EVWOUT), INF(I_PLEGW), INF(I_PLEW), ws); }
            PH_END;
            if (PH_RUN) for (int rep_ = 0; rep_ < (PROBE_DUP == 23 ? 2 : 1); ++rep_) { PH_PTRS PH_LOCALS bf16_t* yout_ = (PROBE_DUP == 23 && rep_ == 0) ? (bf16_t*)(ws + A_DEC) : XB;
                const float* mu = INF(I_MU); const float* gng = INF(I_GNG); const float* gnb = INF(I_GNB); const bf16_t* GGp = (const bf16_t*)(ws + A_GG); const float* sc4 = (const float*)(ws + A_SC4);
                float p_mv[8], p_g[8], p_b[8];
#pragma unroll
                for (int i = 0; i < 8; ++i) { p_mv[i] = mu[1024 + 8 * lane + i]; p_g[i] = gng[8 * lane + i]; p_b[i] = gnb[8 * lane + i]; }
                for (int m = gw; m < M; m += ngw) {
                    const bf16_t* zc = ZB + (size_t)m * EVP + 1024 + 8 * lane;
                    const u32x4 vw_ = *(const u32x4*)zc, ow_ = *(const u32x4*)(XB + (size_t)m * D + 8 * lane), gw_ = *(const u32x4*)(GGp + (size_t)m * 512 + 8 * lane); u32x4 vpw = (u32x4){0u, 0u, 0u, 0u};
                    if ((m & (T - 1)) != 0) vpw = *(const u32x4*)(zc - EVP);
                    const float bc = sc4[((size_t)m * 8 + (lane >> 3)) * 4 + 3];
                    float v_[8], vp_[8], o_[8], g_[8]; unpack8(vw_, v_); unpack8(vpw, vp_); unpack8(ow_, o_); unpack8(gw_, g_);
                    float s1 = 0.f;
#pragma unroll
                    for (int i = 0; i < 8; ++i) s1 += o_[i];
                    const float mean = sum8b(s1) * (1.0f / 64.0f); float s2 = 0.f;
#pragma unroll
                    for (int i = 0; i < 8; ++i) { o_[i] -= mean; s2 += o_[i] * o_[i]; }
                    const float rstd = __builtin_amdgcn_rsqf(sum8b(s2) * (1.0f / 64.0f) + 64e-5f);
                    float y_[8];
#pragma unroll
                    for (int i = 0; i < 8; ++i) { const float vv = v_[i] + p_mv[i] * (vp_[i] - v_[i]); y_[i] = (o_[i] * rstd * p_g[i] + p_b[i] + bc * vv) * g_[i]; }
                    *(u32x4*)(yout_ + (size_t)m * (yout_ == XB ? D : 512) + 8 * lane) = (u32x4){cvt_pk_bf16(y_[0], y_[1]), cvt_pk_bf16(y_[2], y_[3]), cvt_pk_bf16(y_[4], y_[5]), cvt_pk_bf16(y_[6], y_[7])};
                }
            }
            if (PH_RUN && !(G == NB * 16 && PROBE_DUP != 1)) { PH_PTRS PH_LOCALS
                LAS float* w2s = (LAS float*)lds; LAS float* hs = (LAS float*)(lds + 65536 + wave * 512);
                { const float* cw2 = INF(I_CW2); for (int i = tid; i < 2 * 128 * 64; i += NTHR) w2s[i] = cw2[i]; }
                __syncthreads();
                const float* HC = (const float*)(ws + A_HC2); const float* cb = (const float*)(ws + MISC_CMPB); bf16_t* KVC = (bf16_t*)(ws + A_KVC2);
                for (int rr = gw; rr < 2 * 16 * 256 * 2; rr += ngw) {
                    const int hq = rr & 1, n = (rr >> 1) & 255, bq_ = (rr >> 9) & 15, zsel = rr >> 13;
                    float outv = 0.f;
                    if (n < 255) {
                        const float* ha = HC + ((size_t)zsel * 8192 + (size_t)(bq_ * 256 + n) * 2 + hq) * 256; const float* hb = ha + 2 * 256 + 128;
#pragma unroll
                        for (int q = 0; q < 2; ++q) { const int c = lane + 64 * q; const float xx = ha[c] + hb[c] + cb[zsel * 128 + c];
                            hs[c] = 0.5f * xx * (1.0f + tanhf(0.7978845608028654f * (xx + 0.044715f * xx * xx * xx))); }
                        LDS_WAIT();
                        for (int c = 0; c < 128; ++c) outv += hs[c] * w2s[(zsel * 128 + c) * 64 + lane];
                        LDS_WAIT();
                    }
                    KVC[((size_t)(zsel * 32 + bq_ * 2 + hq) * 256 + n) * 64 + lane] = (bf16_t)(cvt_pk_bf16(outv, 0.f) & 0xffffu);
                }
            }
            PH_END;
            if (PH_RUN) for (int rep_ = 0; rep_ < (PROBE_DUP == 2 ? 2 : 1); ++rep_) { PH_PTRS nsa_attn_phase(lds, ZB, (const bf16_t*)((unsigned char*)OUTP + DOUT_QR), (const bf16_t*)(ws + A_KVC2), XB, G, bx); }
            PH_END;
            if (PH_RUN) { PH_PTRS
                pg8::Gemm g{XB, W_evout, D, D, D}; pg8::DenseOrder S; S.init(M, D, G, bx);
                pg8::EpiPre E{INF(I_X), nullptr, Hb};
                for (int rep_ = 0; rep_ < (PROBE_DUP == 4 ? 2 : 1); ++rep_) pg8::gemm_phase<pg8::EpiPre, pg8::DenseOrder>(lds, g, S, E);
            }
            PH_END;
        }
        if (li == 1) {
            if (PH_RUN) { PH_PTRS
                pg8::Gemm g{XB1, W_odin, D, D, D}; pg8::DenseOrder S; S.init(M, 4 * D, G, bx);
                pg8::EpiBf16 E{ZB, 4 * D, 0xF00Fu, 0x00F0u, (const float*)(ws + MISC_LBT)};
                for (int rep_ = 0; rep_ < (PROBE_DUP == 7 ? 2 : 1); ++rep_) pg8::gemm_phase<pg8::EpiBf16, pg8::DenseOrder>(lds, g, S, E);
            }
            PH_END;
            if (PH_RUN) for (int rep_ = 0; rep_ < (PROBE_DUP == 3 ? 2 : 1); ++rep_) { PH_PTRS
                if (G > NB * 8 && bx >= NB * 8) {
                    { pg8::Gemm g{PBF1, W_ple + (size_t)D * PLE, PLE, PLE, PLE}; pg8::DenseOrder S; S.init(M, D, G - NB * 8, bx - NB * 8);
                      pg8::EpiBf16 E{PP1, D, 0u, 0u, nullptr};
                      pg8::gemm_phase<pg8::EpiBf16, pg8::DenseOrder>(lds, g, S, E); }
                    __syncthreads();
                    { PH_LOCALS
                      const int gwi = (bx - NB * 8) * NWAVES + wave, ngwi = (G - NB * 8) * NWAVES;
                      LAS float* scr = (LAS float*)(lds + wave * 8704);
                      conv_moe_weights(INF(I_MW1), INF(I_MW3), INF(I_MW2), 1, W_m13, W_m2, scr, gwi, ngwi, lane, 3); }
                } else hgrn_phase(lds, ZB, INF(I_HGLB), INF(I_HGNG), XB, G, bx); }
            PH_END;
            if (PH_RUN) { PH_PTRS
                pg8::Gemm g{XB, W_odout, D, D, D}; pg8::DenseOrder S; S.init(M, D, G, bx);
                pg8::EpiPre E{nullptr, XB1, Hb};
                for (int rep_ = 0; rep_ < (PROBE_DUP == 7 ? 2 : 1); ++rep_) pg8::gemm_phase<pg8::EpiPre, pg8::DenseOrder>(lds, g, S, E);
            }
            PH_END;
        }
        if (PH_RUN) for (int rep_ = 0; rep_ < (PROBE_DUP == 25 ? 2 : 1); ++rep_) { PH_PTRS PH_LOCALS bf16_t* hout_ = (PROBE_DUP == 25 && rep_ == 0) ? (bf16_t*)(ws + A_XBUF) : Hb;
            const float* lng = INF(I_LNG) + (size_t)li * 2 * D; const float* lnb = INF(I_LNB) + (size_t)li * 2 * D;
            for (int m = gw; m < M; m += 4 * ngw) {
                f32x4 v[4][4];
#pragma unroll
                for (int r = 0; r < 4; ++r) load_row_bf16(Hb + (size_t)(m + r * ngw) * D, v[r], lane);
#pragma unroll
                for (int r = 0; r < 4; ++r) { ln_row(v[r], lng, lnb, lane); store_row_bf16(hout_ + (size_t)(m + r * ngw) * D, v[r], lane);
                    unsigned char* h8 = ws + A_H8 + (size_t)(m + r * ngw) * D + 8 * lane;
                    *(u32x2*)h8 = (u32x2){cvt_pk4_fp8_sat(v[r][0][0], v[r][0][1], v[r][0][2], v[r][0][3]), cvt_pk4_fp8_sat(v[r][1][0], v[r][1][1], v[r][1][2], v[r][1][3])};
                    *(u32x2*)(h8 + 512) = (u32x2){cvt_pk4_fp8_sat(v[r][2][0], v[r][2][1], v[r][2][2], v[r][2][3]), cvt_pk4_fp8_sat(v[r][3][0], v[r][3][1], v[r][3][2], v[r][3][3])}; }
            }
        }
        PH_END;
        if (PH_RUN) { PH_PTRS
            pg8::Gemm g{Hb, (const bf16_t*)(ws + WS_WRB) + (size_t)li * 256 * D, D, D, D}; pg8::DenseOrder S; S.init(M, 256, G, bx);
            pg8::EpiLogit E{(float*)(ws + A_XBUF)};
            pg8::gemm_phase<pg8::EpiLogit, pg8::DenseOrder>(lds, g, S, E);
        }
        PH_END;
        if (PH_RUN) { PH_PTRS PH_LOCALS
            LAS int* hist = (LAS int*)lds;
            if (tid < NEXP) hist[tid] = 0;
            __syncthreads();
            const float* brg = INF(I_BRG) + li * 4; const float* bre = INF(I_BRE) + li * NEXP; const float* LG = (const float*)(ws + A_XBUF);
            int* eid_o = (int*)(ws + MISC_EID); float* gate_o = (float*)(ws + MISC_GATE);
            const int npair = M / 2 / ngw;
            for (int q0 = 0; q0 < npair; q0 += 32) {
                const int q = q0 + (lane >> 1);
                if (q < npair) {
                    const int m = 2 * (gw + q * ngw) + (lane & 1);
                    float lg[36];
#pragma unroll
                    for (int c = 0; c < 9; ++c) { const f32x4 t = *(const f32x4*)(LG + (size_t)m * 64 + 4 * c); lg[4 * c] = t[0]; lg[4 * c + 1] = t[1]; lg[4 * c + 2] = t[2]; lg[4 * c + 3] = t[3]; }
                    float g0 = lg[0] + brg[0], g1 = lg[1] + brg[1], g2 = lg[2] + brg[2], g3 = lg[3] + brg[3];
                    int gs = 0; float gm = g0; if (g1 > gm) { gm = g1; gs = 1; } if (g2 > gm) { gm = g2; gs = 2; } if (g3 > gm) { gm = g3; gs = 3; }
                    const float pg = __builtin_amdgcn_rcpf(__expf(g0 - gm) + __expf(g1 - gm) + __expf(g2 - gm) + __expf(g3 - gm));
                    float le[8];
#pragma unroll
                    for (int e = 0; e < 8; ++e) { const float a = gs == 0 ? lg[4 + e] : gs == 1 ? lg[12 + e] : gs == 2 ? lg[20 + e] : lg[28 + e]; le[e] = a + bre[gs * 8 + e]; }
                    int i1 = 0; float v1 = le[0];
#pragma unroll
                    for (int e = 1; e < 8; ++e) if (le[e] > v1) { v1 = le[e]; i1 = e; }
                    int i2 = -1; float v2 = -3.0e38f;
#pragma unroll
                    for (int e = 0; e < 8; ++e) if (e != i1 && le[e] > v2) { v2 = le[e]; i2 = e; }
                    const float e2 = __expf(v2 - v1), den = __builtin_amdgcn_rcpf(1.0f + e2);
                    const int ea = gs * 8 + i1, eb = gs * 8 + i2;
                    *(int2*)(eid_o + 2 * (size_t)m) = make_int2(ea, eb); *(float2*)(gate_o + 2 * (size_t)m) = make_float2(pg * den, pg * e2 * den);
                    __hip_atomic_fetch_add(&hist[ea], 1, __ATOMIC_RELAXED, __HIP_MEMORY_SCOPE_WORKGROUP); __hip_atomic_fetch_add(&hist[eb], 1, __ATOMIC_RELAXED, __HIP_MEMORY_SCOPE_WORKGROUP);
                }
            }
            __syncthreads();
            if (tid < NEXP) ((int*)(ws + MISC_BCNT))[vcu * NEXP + tid] = hist[tid];
        }
        PH_END;
        if (PH_RUN) for (int rep_ = 0; rep_ < (PROBE_DUP == 26 ? 2 : 1); ++rep_) { PH_PTRS PH_LOCALS
            __syncthreads();
            LAS int* tot = (LAS int*)lds; LAS int* prt = tot + 16 * NEXP; LAS int* cursor = prt + 16 * NEXP; LAS int* startv = cursor + NEXP; LAS int* padv = startv + NEXP;
            const int* bcnt = (const int*)(ws + MISC_BCNT);
            { const int e = tid & 31, part = tid >> 5; int a = 0, p = 0; for (int w = part; w < G; w += 16) { const int c = bcnt[w * NEXP + e]; a += c; if (w < vcu) p += c; } tot[part * NEXP + e] = a; prt[part * NEXP + e] = p; }
            __syncthreads();
            if (tid < NEXP) { int a = 0, p = 0; for (int q = 0; q < 16; ++q) { a += tot[q * NEXP + tid]; p += prt[q * NEXP + tid]; } padv[tid] = (a + 255) & ~255; cursor[tid] = p; }
            __syncthreads();
            if (tid == 0) { int run = 0;
#pragma nounroll
                for (int e = 0; e < NEXP; ++e) { startv[e] = run; run += padv[e]; } }
            __syncthreads();
            if (tid < NEXP) cursor[tid] += startv[tid];
            if (bx == 0) { int* te = (int*)(ws + MISC_TILEE); const int ntl = (startv[NEXP - 1] + padv[NEXP - 1]) >> 8; if (tid == 0) te[0] = ntl;
                for (int t = tid; t < ntl; t += NTHR) { int e = 0;
#pragma nounroll
                    for (int q = 0; q < NEXP; ++q) e += ((startv[q] + padv[q]) <= 256 * t) ? 1 : 0;
                    te[1 + t] = e; } }
            __syncthreads();
            const int* eid_i = (const int*)(ws + MISC_EID); int* slot_o = (int*)(ws + MISC_SLOT); int* toks_o = (int*)(ws + WS_TOKS);
            for (int mm = 2 * gw; mm < M; mm += 2 * ngw) for (int m = mm; m < mm + 2; ++m) {
                int s0 = 0, s1 = 0;
                if (lane == 0) { const int2 ee = *(const int2*)(eid_i + 2 * (size_t)m); s0 = __hip_atomic_fetch_add(&cursor[ee.x], 1, __ATOMIC_RELAXED, __HIP_MEMORY_SCOPE_WORKGROUP); s1 = __hip_atomic_fetch_add(&cursor[ee.y], 1, __ATOMIC_RELAXED, __HIP_MEMORY_SCOPE_WORKGROUP); *(int2*)(slot_o + 2 * (size_t)m) = make_int2(s0, s1); }
                s0 = __builtin_amdgcn_readfirstlane(s0); s1 = __builtin_amdgcn_readfirstlane(s1);
                if (lane == 0) { toks_o[s0] = m; toks_o[s1] = m; }
            }
            { LAS float* scr = (LAS float*)(lds + 16384 + wave * 8704);
              const bool shadow = (G > NB * 8);
              const int parts_ = (li == 1 && shadow) ? 0 : ((li == 0 && G == NB * 16) ? 0 : 3);
              if (parts_) conv_moe_weights(INF(I_MW1), INF(I_MW3), INF(I_MW2), li, W_m13, W_m2, scr, gw, ngw, lane, parts_);
              const int np = (li == 1 && shadow) ? 0 : ((li == 0 && G == NB * 16) ? 0 : ((li == 0 && shadow) ? 2 : 1));
              for (int q = 0; q < np; ++q) { const float* pl = INF(I_P) + (size_t)(li + q) * M * PLE; bf16_t* pd = q ? PBF1 : pbf;
                for (int m = gw; m < M; m += 4 * ngw) { f32x4 v[4];
#pragma unroll
                    for (int r = 0; r < 4; ++r) v[r] = *((const f32x4*)(pl + (size_t)(m + r * ngw) * PLE) + lane);
#pragma unroll
                    for (int r = 0; r < 4; ++r) *((u32x2*)(pd + (size_t)(m + r * ngw) * PLE) + lane) = (u32x2){cvt_pk_bf16(v[r][0], v[r][1]), cvt_pk_bf16(v[r][2], v[r][3])}; } } }
        }
        PH_END;
        if (PH_RUN) { PH_PTRS
            const int* te = (const int*)(ws + MISC_TILEE);
            pg8::MoeOrder S{te + 1, __builtin_amdgcn_readfirstlane(te[0]), G, bx};
            for (int rep_ = 0; rep_ < (PROBE_DUP == 5 ? 2 : 1); ++rep_) pg8::gemm_f8_phase<0>(lds, ws + A_H8, (const unsigned char*)W_m13, D, S, (const int*)(ws + WS_TOKS), ws + A_HID, nullptr);
        }
        PH_END;
        if (PH_RUN) { PH_PTRS
            const int* te = (const int*)(ws + MISC_TILEE);
            pg8::MoeOrder S{te + 1, __builtin_amdgcn_readfirstlane(te[0]), G, bx};
            for (int rep_ = 0; rep_ < (PROBE_DUP == 5 ? 2 : 1); ++rep_) pg8::gemm_f8_phase<1>(lds, ws + A_HID, (const unsigned char*)W_m2, MOE_H, S, nullptr, nullptr, (bf16_t*)(ws + A_XBUF));
        }
        PH_END;
        if (PH_RUN) for (int rep_ = 0; rep_ < (PROBE_DUP == 27 ? 2 : 1); ++rep_) { PH_PTRS PH_LOCALS bf16_t* hout_ = (PROBE_DUP == 27 && rep_ == 0) ? (bf16_t*)OUTP : XB;
            const float* lng = INF(I_LNG) + (size_t)li * 2 * D; const float* lnb = INF(I_LNB) + (size_t)li * 2 * D;
            const int* slot_i = (const int*)(ws + MISC_SLOT); const float* gate_i = (const float*)(ws + MISC_GATE); const bf16_t* ybuf = (const bf16_t*)(ws + A_XBUF);
            for (int m0 = gw; m0 < M; m0 += 2 * ngw) {
                int2 sl[2]; float2 gt[2]; u32x4 hw_[2][2], y0[2][2], y1[2][2];
#pragma unroll
                for (int r = 0; r < 2; ++r) { const int m = m0 + r * ngw; sl[r] = *(const int2*)(slot_i + 2 * (size_t)m); gt[r] = *(const float2*)(gate_i + 2 * (size_t)m); }
#pragma unroll
                for (int r = 0; r < 2; ++r) { const int m = m0 + r * ngw;
#pragma unroll
                    for (int q = 0; q < 2; ++q) { hw_[r][q] = *((const u32x4*)(Hb + (size_t)m * D) + lane + 64 * q); y0[r][q] = *((const u32x4*)(ybuf + (size_t)sl[r].x * D) + lane + 64 * q); y1[r][q] = *((const u32x4*)(ybuf + (size_t)sl[r].y * D) + lane + 64 * q); } }
#pragma unroll
                for (int r = 0; r < 2; ++r) { const int m = m0 + r * ngw; f32x4 v[4];
#pragma unroll
                    for (int q = 0; q < 2; ++q) { const unsigned hh_[4] = {hw_[r][q].x, hw_[r][q].y, hw_[r][q].z, hw_[r][q].w}, ya[4] = {y0[r][q].x, y0[r][q].y, y0[r][q].z, y0[r][q].w}, yb[4] = {y1[r][q].x, y1[r][q].y, y1[r][q].z, y1[r][q].w};
#pragma unroll
                        for (int e = 0; e < 4; ++e) { v[2 * q + (e >> 1)][2 * (e & 1)] = bflo(hh_[e]) * DN_ALPHA + (gt[r].x * bflo(ya[e]) + gt[r].y * bflo(yb[e])); v[2 * q + (e >> 1)][2 * (e & 1) + 1] = bfhi(hh_[e]) * DN_ALPHA + (gt[r].x * bfhi(ya[e]) + gt[r].y * bfhi(yb[e])); } }
                    ln_row(v, lng + D, lnb + D, lane);
                    store_row_bf16(hout_ + (size_t)m * D, v, lane); }
            }
        }
        PH_END;
        if (!(li == 1 && G > NB * 8)) {
        if (PH_RUN) { PH_PTRS PH_LOCALS
            pg8::Gemm g{pbf, W_ple + (size_t)li * D * PLE, PLE, PLE, PLE}; pg8::DenseOrder S; S.init(M, D, G, bx);
            pg8::EpiBf16 E{PP, D, 0u, 0u, nullptr};
            for (int rep_ = 0; rep_ < ((PROBE_DUP == 6 || PROBE_DUP == 41) ? 2 : 1); ++rep_) pg8::gemm_phase<pg8::EpiBf16, pg8::DenseOrder>(lds, g, S, E);
        }
        PH_END;
        }
        if (PH_RUN) { PH_PTRS PH_LOCALS
            pg8::Gemm g{XB, W_gate + (size_t)li * D * D, D, D, D}; pg8::DenseOrder S; S.init(M, D, G, bx);
            pg8::EpiGate E{XB, (li == 1 && G > NB * 8) ? PP1 : PP, li == DEPTH - 1 ? OUTP : nullptr, XB1};
            for (int rep_ = 0; rep_ < (PROBE_DUP == 6 ? 2 : 1); ++rep_) pg8::gemm_phase<pg8::EpiGate, pg8::DenseOrder>(lds, g, S, E);
        }
        PH_END;
    }
#undef PH_RUN
#undef PH_END
}
constexpr int TOTAL_PHASES = 1 + 8 + 9 + 3 + 8;

extern "C" void kernel_launch(void* const* d_in, const int* in_sizes, int n_in, void* d_out, int out_size, void* d_ws, size_t ws_size, hipStream_t stream) {
    static int grid = 0;
    if (grid == 0) {
        if (n_in != 34 || in_sizes[0] != M * D || out_size != M * D || ws_size < WS_END) { fprintf(stderr, "kernel_launch: unexpected shapes: n_in %d in0 %d out %d ws %zu (need %zu)\n", n_in, n_in > 0 ? in_sizes[0] : -1, out_size, ws_size, (size_t)WS_END); grid = -1; return; }
        int dev = 0, cus = 0, per_cu = 0;
        if (hipGetDevice(&dev) != hipSuccess || hipDeviceGetAttribute(&cus, hipDeviceAttributeMultiprocessorCount, dev) != hipSuccess) { grid = -1; return; }
        if (hipFuncSetAttribute((const void*)fwd, hipFuncAttributeMaxDynamicSharedMemorySize, LDS_BYTES) != hipSuccess) { fprintf(stderr, "kernel_launch: hipFuncSetAttribute failed\n"); grid = -1; return; }
        if (hipOccupancyMaxActiveBlocksPerMultiprocessor(&per_cu, (const void*)fwd, NTHR, LDS_BYTES) != hipSuccess || per_cu < 1) fprintf(stderr, "kernel_launch: occupancy query reports %d\n", per_cu);
        (void)hipGetLastError();
        grid = cus;
    }
    if (grid < 0) return;
    if (hipMemsetAsync((char*)d_ws + WS_CTL, 0, CTL_ZERO_BYTES, stream) != hipSuccess) return;
    Args a{};
    for (int i = 0; i < 34; ++i) a.in[i] = d_in[i];
    a.out = (float*)d_out; a.ws = (unsigned char*)d_ws; a.ph_lo = 0; a.ph_hi = TOTAL_PHASES;
    hipLaunchKernelGGL(fwd, dim3(grid), dim3(NTHR), LDS_BYTES, stream, a);
}
```

```cpp
#include <hip/hip_runtime.h>
#ifndef PROBE_DUP
#define PROBE_DUP 0
#endif
#include <cstdio>
#include <cstdint>

#define LAS __attribute__((address_space(3)))
#define GAS __attribute__((address_space(1)))
typedef unsigned short bf16_t;
typedef short bf16x8 __attribute__((ext_vector_type(8)));
typedef float f32x4 __attribute__((ext_vector_type(4)));
typedef float f32x2 __attribute__((ext_vector_type(2)));
typedef unsigned u32x4 __attribute__((ext_vector_type(4)));
typedef unsigned u32x2 __attribute__((ext_vector_type(2)));

constexpr int NB = 16, T = 4096, M = NB * T, D = 1024, PLE = 256, DEPTH = 2;
constexpr float DN_ALPHA = 1.41421356237f;
constexpr float LN_EPS = 1e-5f;
constexpr int EVN = 3096, EVP = 3328;
constexpr int NEXP = 32, MOE_H = 512, MOE_BLK = 256, MOE_A = 2 * M, MOE_P = MOE_A + NEXP * MOE_BLK, MOE_TILES = MOE_P / 256;

constexpr size_t MiB = 1u << 20;
constexpr size_t WS_CTL = 0, CTL_ZERO_BYTES = 1 * MiB;
constexpr size_t WS_WEVIN = 1 * MiB, WS_WEVOUT = 8 * MiB, WS_WODIN = 10 * MiB, WS_WODOUT = 18 * MiB, WS_WGATE = 20 * MiB, WS_WPLE = 24 * MiB, WS_WLORA = 25 * MiB, WS_WCMP = 26 * MiB;
constexpr size_t WS_MISC = 27 * MiB;
constexpr size_t WS_WMOE13 = 33 * MiB, WS_WMOE2 = 97 * MiB, WS_PBF = 129 * MiB, WS_XB = 161 * MiB, WS_ARENA = 289 * MiB;
constexpr size_t A_H = WS_ARENA, A_HID = WS_ARENA + 128 * MiB, A_H8 = A_HID + 68 * MiB, A_XBUF = WS_ARENA + 264 * MiB, A_PP1 = WS_ARENA + 536 * MiB;
static_assert((size_t)MOE_P * MOE_H <= 68 * MiB && A_H8 + (size_t)M * D <= A_XBUF, "e4m3 buffers");
constexpr size_t A_UNUSED_ = 0;
constexpr size_t A_ACT = WS_ARENA + 416 * MiB, A_DEC = A_ACT + 32 * MiB, A_AA = A_DEC + 128 * MiB, A_GG = A_AA + 64 * MiB;
constexpr size_t A_SC4 = A_ACT;
constexpr size_t DOUT_QR = 160 * MiB, DOUT_SEG = 224 * MiB;
constexpr size_t A_HC2 = WS_ARENA + 704 * MiB, A_KVC2 = A_HC2 + 16 * MiB;
static_assert(A_KVC2 + 2 * MiB <= 1024 * MiB && A_GG + 64 * MiB <= A_HC2, "arena map");
static_assert(A_PP1 + 128 * MiB <= 1024 * MiB && A_PP1 >= WS_ARENA + 512 * MiB && A_XBUF + 272 * MiB <= A_PP1 && A_HID + 136 * MiB <= A_XBUF, "post-mixer arena map");
constexpr size_t WS_END = 1024 * MiB;
constexpr size_t WS_WRB = 29 * MiB;
constexpr size_t MISC_LBT = 31 * MiB;
constexpr size_t WS_TOKS = 30 * MiB;
constexpr size_t MISC_EID = WS_MISC, MISC_GATE = WS_MISC + 512 * 1024, MISC_SLOT = WS_MISC + 1024 * 1024, MISC_BCNT = WS_MISC + 1536 * 1024, MISC_TILEE = MISC_BCNT + 64 * 1024, MISC_CMPB = MISC_TILEE + 4096;
constexpr int CW_BAR = 4096;

constexpr int NWAVES = 8, NTHR = 512;
typedef __bf16 bf16x2_t __attribute__((ext_vector_type(2)));
__device__ __forceinline__ unsigned cvt_pk_bf16(float lo, float hi) { f32x2 v = {lo, hi}; return __builtin_bit_cast(unsigned, __builtin_convertvector(v, bf16x2_t)); }
__device__ __forceinline__ float bf2f(unsigned short b) { return __uint_as_float(((unsigned)b) << 16); }
__device__ __forceinline__ unsigned cvt_pk4_fp8(float a, float b, float c, float d) { int w = __builtin_amdgcn_cvt_pk_fp8_f32(a, b, 0, false); return (unsigned)__builtin_amdgcn_cvt_pk_fp8_f32(c, d, w, true); }
__device__ __forceinline__ float f8clamp(float x) { return __builtin_amdgcn_fmed3f(x, -448.0f, 448.0f); }
__device__ __forceinline__ unsigned cvt_pk4_fp8_sat(float a, float b, float c, float d) { return cvt_pk4_fp8(f8clamp(a), f8clamp(b), f8clamp(c), f8clamp(d)); }
__device__ __forceinline__ float bflo(unsigned w) { return __uint_as_float(w << 16); }
__device__ __forceinline__ float bfhi(unsigned w) { return __uint_as_float(w & 0xffff0000u); }
template <int CTRL, int RM> __device__ __forceinline__ float dpp_addx(float v) { return v + __builtin_bit_cast(float, __builtin_amdgcn_update_dpp(0, __builtin_bit_cast(int, v), CTRL, RM, 0xf, false)); }
__device__ __forceinline__ float wave_sum(float v) {
    v = dpp_addx<0xB1, 0xf>(v); v = dpp_addx<0x4E, 0xf>(v); v = dpp_addx<0x141, 0xf>(v); v = dpp_addx<0x140, 0xf>(v);
    v = dpp_addx<0x142, 0xa>(v); v = dpp_addx<0x143, 0xc>(v);
    return __builtin_bit_cast(float, __builtin_amdgcn_readlane(__builtin_bit_cast(int, v), 63));
}
__device__ __forceinline__ float sigmoidf_(float x) { return __builtin_amdgcn_rcpf(1.0f + __expf(-x)); }
__device__ __forceinline__ float siluf_(float x) { return x * __builtin_amdgcn_rcpf(1.0f + __expf(-x)); }
__device__ __forceinline__ int pinned_tid() { int t = threadIdx.x; asm volatile("" : "+v"(t)); return t; }
#define LDS_WAIT() asm volatile("s_waitcnt lgkmcnt(0)" ::: "memory")
#define VM_WAIT() asm volatile("s_waitcnt vmcnt(0)" ::: "memory")

namespace pg8 {
constexpr int BM = 256, BK = 64, HALF = 128, HTB = HALF * BK * 2, STAGE_BYTES = 8 * HTB, NXCD = 8, WGM = 8;
__host__ __device__ __forceinline__ int lds_byte(int r, int c) { const int st = (r >> 4) * 2 + (c >> 5), rr = r & 15, cc = c & 31, ob = rr * 64 + cc * 2; return st * 1024 + (ob ^ (((ob >> 9) & 1) << 5)); }
__host__ __device__ __forceinline__ void stage_rc(int b, int& R, int& C) { const int st = b / 1024, sb = b % 1024, swz = sb ^ (((sb >> 9) & 1) << 5); R = (st >> 1) * 16 + swz / 64; C = (st & 1) * 32 + (swz % 64) / 2; }
__host__ __device__ __forceinline__ int perm32(int rho) { const int n = rho >> 4, i = rho & 15; return 8 * (i >> 2) + 4 * n + (i & 3); }

struct Unit { int pm, pn, pb; };
struct Gemm { const bf16_t* A; const bf16_t* Bt; int lda, ldb, K; };

struct DenseOrder {
    int nM, nN, nwg, G, c;
    __device__ void init(int M_, int N_, int G_, int c_) { nM = M_ / BM; nN = N_ / BM; nwg = nM * nN; G = G_; c = c_; }
    __device__ bool next(int i, Unit& u) const {
        const long L = (long)i * G + c; if (L >= nwg) return false;
        int wgid = (int)L; { const int q = nwg / NXCD, r = nwg % NXCD, xcd = wgid % NXCD, off = wgid / NXCD; wgid = (xcd < r ? xcd * (q + 1) : r * (q + 1) + (xcd - r) * q) + off; }
        const int nig = WGM * nN, gid = wgid / nig, fm = gid * WGM, gsz = (nM - fm) < WGM ? (nM - fm) : WGM;
        u.pm = fm + ((wgid % nig) % gsz); u.pn = (wgid % nig) / gsz; u.pb = u.pn; return true;
    }
};
struct MoeOrder {
    const int* tile_e; int ntiles, G, c;
    __device__ bool next(int i, Unit& u) const {
        if ((G & 7) == 0) {
            const int x = c & 7, r = c >> 3, w = G >> 3, k = i * w + r, q = k >> 2, t = q * 8 + x;
            if (t >= ntiles) return false;
            u.pm = t; u.pn = k & 3; u.pb = __builtin_amdgcn_readfirstlane(tile_e[t]) * 4 + u.pn; return true;
        }
        const long L = (long)i * G + c; if (L >= (long)ntiles * 4) return false;
        u.pm = (int)(L >> 2); u.pn = (int)(L & 3); u.pb = __builtin_amdgcn_readfirstlane(tile_e[u.pm]) * 4 + u.pn; return true;
    }
};

template <class Epi, class Sched>
__device__ __forceinline__ void gemm_phase(LAS unsigned char* lds, const Gemm g, const Sched& S, const Epi& E) {
    int tid_ = threadIdx.x; asm volatile("" : "+v"(tid_)); const int tid = tid_, wid = __builtin_amdgcn_readfirstlane(tid >> 6), lane = tid & 63, wr = wid >> 2, wc = wid & 3, fr = lane & 15, fq = lane >> 4;
    int K_ = g.K, lda_ = g.lda, ldb_ = g.ldb; asm volatile("" : "+s"(K_), "+s"(lda_), "+s"(ldb_)); const int K = K_, nt = K / BK;
    unsigned voffA[2], voffB[2];
#pragma unroll
    for (int i = 0; i < 2; ++i) { int R, C; stage_rc(tid * 16 + i * 8192, R, C); const int Rb = Epi::PERM ? ((R & ~31) + perm32(R & 31)) : R;
        voffA[i] = (unsigned)(R * lda_ + C) * 2u; voffB[i] = (unsigned)(Rb * ldb_ + C) * 2u; }
    const size_t kstep = (size_t)(BK * 2);
    const size_t hstepA = (size_t)HALF * lda_ * 2, hstepB = (size_t)HALF * ldb_ * 2;
    const size_t tstepA = 2 * hstepA, tstepB = 2 * hstepB;
    const unsigned ldsw = (unsigned)wid * 1024u;
    const int aoff = lds_byte(wr * 64 + fr, fq * 8), boff = lds_byte(wc * 32 + fr, fq * 8);
#define PG8_SA(b, h) (((b) * 2 + (h)) * HTB)
#define PG8_SB(b, h) ((4 + (b) * 2 + (h)) * HTB)
#define PG8_STAGE(bufoff, gbase, voff) do { _Pragma("unroll") for (int _i = 0; _i < 2; ++_i) \
        __builtin_amdgcn_global_load_lds((const unsigned*)((const char*)(gbase) + (voff)[_i]), (LAS unsigned*)(lds + (bufoff) + ldsw + _i * 8192), 16, 0, 0); } while (0)
#define PG8_LDA(dst, b, h) do { _Pragma("unroll") for (int m = 0; m < 4; ++m) _Pragma("unroll") for (int k = 0; k < 2; ++k) dst[m][k] = *(const LAS bf16x8*)(lds + PG8_SA(b, h) + aoff + m * 2048 + k * 1024); } while (0)
#define PG8_LDB(dst, b, h) do { _Pragma("unroll") for (int n = 0; n < 2; ++n) _Pragma("unroll") for (int k = 0; k < 2; ++k) dst[n][k] = *(const LAS bf16x8*)(lds + PG8_SB(b, h) + boff + n * 2048 + k * 1024); } while (0)
#define PG8_MMA(ai, bj, At, Bt) do { __builtin_amdgcn_s_setprio(1); _Pragma("unroll") for (int m = 0; m < 4; ++m) _Pragma("unroll") for (int n = 0; n < 2; ++n) _Pragma("unroll") for (int k = 0; k < 2; ++k) \
        acc[ai][bj][m][n] = __builtin_amdgcn_mfma_f32_16x16x32_bf16(Bt[n][k], At[m][k], acc[ai][bj][m][n], 0, 0, 0); __builtin_amdgcn_s_setprio(0); } while (0)
#define PG8_WAIT_V(n) asm volatile("s_waitcnt vmcnt(" #n ")" ::: "memory")
#define PG8_WAIT_L(n) asm volatile("s_waitcnt lgkmcnt(" #n ")" ::: "memory")
#define PG8_BAR __builtin_amdgcn_s_barrier()
#define PG8_SCHED __builtin_amdgcn_sched_barrier(0)
    Unit cur, nxt; int ui = 0;
    if (!S.next(0, cur)) return;
    f32x4 acc[2][2][4][2];
#pragma unroll
    for (int a = 0; a < 2; ++a)
#pragma unroll
        for (int b = 0; b < 2; ++b)
#pragma unroll
            for (int m = 0; m < 4; ++m)
#pragma unroll
                for (int n = 0; n < 2; ++n) acc[a][b][m][n] = (f32x4){0.f, 0.f, 0.f, 0.f};
    bf16x8 At[4][2], B0[2][2], B1[2][2];
    const char* cA = (const char*)g.A + (size_t)cur.pm * tstepA; const char* cB = (const char*)g.Bt + (size_t)cur.pb * tstepB;
    PG8_STAGE(PG8_SB(0, 0), cB, voffB); PG8_STAGE(PG8_SB(0, 1), cB + hstepB, voffB); PG8_STAGE(PG8_SA(0, 0), cA, voffA); PG8_STAGE(PG8_SA(0, 1), cA + hstepA, voffA);
    if (wr == 1) PG8_BAR;
    PG8_WAIT_V(2); PG8_BAR;
    PG8_STAGE(PG8_SB(1, 0), cB + kstep, voffB); PG8_STAGE(PG8_SA(1, 0), cA + kstep, voffA); PG8_STAGE(PG8_SB(1, 1), cB + hstepB + kstep, voffB);
    PG8_WAIT_V(6); PG8_BAR;
    for (;;) {
        const bool has_next = S.next(ui + 1, nxt);
        const char* nA = has_next ? (const char*)g.A + (size_t)nxt.pm * tstepA : cA; const char* nB = has_next ? (const char*)g.Bt + (size_t)nxt.pb * tstepB : cB;
#pragma nounroll
        for (int t = 0; t < nt; t += 2) {
            const bool last = (t == nt - 2);
            const char* a1 = cA + (size_t)(t + 1) * kstep;
            const char* a2 = last ? nA : cA + (size_t)(t + 2) * kstep; const char* b2 = last ? nB : cB + (size_t)(t + 2) * kstep;
            const char* a3 = a2 + kstep; const char* b3 = b2 + kstep;
            PG8_LDB(B0, 0, 0); PG8_LDB(B1, 0, 1); PG8_SCHED; PG8_LDA(At, 0, 0); PG8_STAGE(PG8_SA(1, 1), a1 + hstepA, voffA);
            PG8_WAIT_V(8); PG8_WAIT_L(0); PG8_BAR; PG8_MMA(0, 0, At, B0); PG8_MMA(0, 1, At, B1); PG8_BAR; PG8_SCHED;
            PG8_LDA(At, 0, 1); PG8_STAGE(PG8_SB(0, 0), b2, voffB); PG8_STAGE(PG8_SB(0, 1), b2 + hstepB, voffB); PG8_STAGE(PG8_SA(0, 0), a2, voffA);
            PG8_WAIT_V(8); PG8_WAIT_L(0); PG8_BAR; PG8_MMA(1, 0, At, B0); PG8_MMA(1, 1, At, B1); PG8_BAR; PG8_SCHED;
            PG8_LDB(B0, 1, 0); PG8_LDB(B1, 1, 1); PG8_SCHED; PG8_LDA(At, 1, 0); PG8_STAGE(PG8_SA(0, 1), a2 + hstepA, voffA);
            PG8_WAIT_V(8); PG8_WAIT_L(0); PG8_BAR; PG8_MMA(0, 0, At, B0); PG8_MMA(0, 1, At, B1); PG8_BAR; PG8_SCHED;
            PG8_LDA(At, 1, 1); PG8_STAGE(PG8_SB(1, 0), b3, voffB); PG8_STAGE(PG8_SB(1, 1), b3 + hstepB, voffB); PG8_STAGE(PG8_SA(1, 0), a3, voffA);
            PG8_WAIT_V(8); PG8_WAIT_L(0); PG8_BAR; PG8_MMA(1, 0, At, B0); PG8_MMA(1, 1, At, B1); PG8_BAR; PG8_SCHED;
        }
        if (wr == 0) PG8_BAR;
        E(acc, cur, wr, wc, fr, fq);
        if (!has_next) break;
#pragma unroll
        for (int a = 0; a < 2; ++a)
#pragma unroll
            for (int b = 0; b < 2; ++b)
#pragma unroll
                for (int m = 0; m < 4; ++m)
#pragma unroll
                    for (int n = 0; n < 2; ++n) acc[a][b][m][n] = (f32x4){0.f, 0.f, 0.f, 0.f};
        cur = nxt; cA = nA; cB = nB; ++ui;
        if (wr == 1) PG8_BAR;
    }
    PG8_WAIT_V(0);
    PG8_BAR;
#undef PG8_SA
#undef PG8_SB
#undef PG8_STAGE
#undef PG8_LDA
#undef PG8_LDB
#undef PG8_MMA
#undef PG8_WAIT_V
#undef PG8_WAIT_L
#undef PG8_BAR
#undef PG8_SCHED
}

template <class Epi, class Sched>
__device__ __forceinline__ void gemm_phase_gather(LAS unsigned char* lds, const Gemm g, const Sched& S, const Epi& E, const int* toks) {
    int tid_ = threadIdx.x; asm volatile("" : "+v"(tid_)); const int tid = tid_, wid = __builtin_amdgcn_readfirstlane(tid >> 6), lane = tid & 63, wr = wid >> 2, wc = wid & 3, fr = lane & 15, fq = lane >> 4;
    int K_ = g.K, lda_ = g.lda, ldb_ = g.ldb; asm volatile("" : "+s"(K_), "+s"(lda_), "+s"(ldb_)); const int K = K_, nt = K / BK;
    unsigned voffB[2]; int RA[2]; unsigned CA[2];
#pragma unroll
    for (int i = 0; i < 2; ++i) { int R, C; stage_rc(tid * 16 + i * 8192, R, C); const int Rb = Epi::PERM ? ((R & ~31) + perm32(R & 31)) : R;
        RA[i] = R; CA[i] = (unsigned)C * 2u; voffB[i] = (unsigned)(Rb * ldb_ + C) * 2u; }
    unsigned voC[2][2], voN[2][2];
#define PG8_GOFF(VO, U) do { _Pragma("unroll") for (int h_ = 0; h_ < 2; ++h_) _Pragma("unroll") for (int i_ = 0; i_ < 2; ++i_) VO[h_][i_] = (unsigned)(toks[(U).pm * BM + h_ * HALF + RA[i_]] & 0xffff) * (unsigned)(lda_ * 2) + CA[i_]; } while (0)
    const size_t kstep = (size_t)(BK * 2);
    const size_t hstepA = (size_t)HALF * lda_ * 2, hstepB = (size_t)HALF * ldb_ * 2;
    const size_t tstepA = 2 * hstepA, tstepB = 2 * hstepB;
    const unsigned ldsw = (unsigned)wid * 1024u;
    const int aoff = lds_byte(wr * 64 + fr, fq * 8), boff = lds_byte(wc * 32 + fr, fq * 8);
#define PG8_SA(b, h) (((b) * 2 + (h)) * HTB)
#define PG8_SB(b, h) ((4 + (b) * 2 + (h)) * HTB)
#define PG8_STAGE(bufoff, gbase, voff) do { _Pragma("unroll") for (int _i = 0; _i < 2; ++_i) \
        __builtin_amdgcn_global_load_lds((const unsigned*)((const char*)(gbase) + (voff)[_i]), (LAS unsigned*)(lds + (bufoff) + ldsw + _i * 8192), 16, 0, 0); } while (0)
#define PG8_LDA(dst, b, h) do { _Pragma("unroll") for (int m = 0; m < 4; ++m) _Pragma("unroll") for (int k = 0; k < 2; ++k) dst[m][k] = *(const LAS bf16x8*)(lds + PG8_SA(b, h) + aoff + m * 2048 + k * 1024); } while (0)
#define PG8_LDB(dst, b, h) do { _Pragma("unroll") for (int n = 0; n < 2; ++n) _Pragma("unroll") for (int k = 0; k < 2; ++k) dst[n][k] = *(const LAS bf16x8*)(lds + PG8_SB(b, h) + boff + n * 2048 + k * 1024); } while (0)
#define PG8_MMA(ai, bj, At, Bt) do { __builtin_amdgcn_s_setprio(1); _Pragma("unroll") for (int m = 0; m < 4; ++m) _Pragma("unroll") for (int n = 0; n < 2; ++n) _Pragma("unroll") for (int k = 0; k < 2; ++k) \
        acc[ai][bj][m][n] = __builtin_amdgcn_mfma_f32_16x16x32_bf16(Bt[n][k], At[m][k], acc[ai][bj][m][n], 0, 0, 0); __builtin_amdgcn_s_setprio(0); } while (0)
#define PG8_WAIT_V(n) asm volatile("s_waitcnt vmcnt(" #n ")" ::: "memory")
#define PG8_WAIT_L(n) asm volatile("s_waitcnt lgkmcnt(" #n ")" ::: "memory")
#define PG8_BAR __builtin_amdgcn_s_barrier()
#define PG8_SCHED __builtin_amdgcn_sched_barrier(0)
    Unit cur, nxt; int ui = 0;
    if (!S.next(0, cur)) return;
    f32x4 acc[2][2][4][2];
#pragma unroll
    for (int a = 0; a < 2; ++a)
#pragma unroll
        for (int b = 0; b < 2; ++b)
#pragma unroll
            for (int m = 0; m < 4; ++m)
#pragma unroll
                for (int n = 0; n < 2; ++n) acc[a][b][m][n] = (f32x4){0.f, 0.f, 0.f, 0.f};
    bf16x8 At[4][2], B0[2][2], B1[2][2];
    const char* const kA = (const char*)g.A; const char* cB = (const char*)g.Bt + (size_t)cur.pb * tstepB;
    PG8_GOFF(voC, cur);
    PG8_STAGE(PG8_SB(0, 0), cB, voffB); PG8_STAGE(PG8_SB(0, 1), cB + hstepB, voffB); PG8_STAGE(PG8_SA(0, 0), kA, voC[0]); PG8_STAGE(PG8_SA(0, 1), kA, voC[1]);
    if (wr == 1) PG8_BAR;
    PG8_WAIT_V(2); PG8_BAR;
    PG8_STAGE(PG8_SB(1, 0), cB + kstep, voffB); PG8_STAGE(PG8_SA(1, 0), kA + kstep, voC[0]); PG8_STAGE(PG8_SB(1, 1), cB + hstepB + kstep, voffB);
    PG8_WAIT_V(6); PG8_BAR;
    for (;;) {
        const bool has_next = S.next(ui + 1, nxt);
        const char* nB = has_next ? (const char*)g.Bt + (size_t)nxt.pb * tstepB : cB;
        if (has_next) PG8_GOFF(voN, nxt); else { _Pragma("unroll") for (int h_ = 0; h_ < 2; ++h_) _Pragma("unroll") for (int i_ = 0; i_ < 2; ++i_) voN[h_][i_] = voC[h_][i_]; }
#pragma nounroll
        for (int t = 0; t < nt; t += 2) {
            const bool last = (t == nt - 2);
            const char* a1 = kA + (size_t)(t + 1) * kstep;
            const char* a2 = last ? kA : kA + (size_t)(t + 2) * kstep; const char* b2 = last ? nB : cB + (size_t)(t + 2) * kstep;
            unsigned vo2[2][2];
#pragma unroll
            for (int h_ = 0; h_ < 2; ++h_)
#pragma unroll
                for (int i_ = 0; i_ < 2; ++i_) vo2[h_][i_] = last ? voN[h_][i_] : voC[h_][i_];
            const char* a3 = a2 + kstep; const char* b3 = b2 + kstep;
            PG8_LDB(B0, 0, 0); PG8_LDB(B1, 0, 1); PG8_SCHED; PG8_LDA(At, 0, 0); PG8_STAGE(PG8_SA(1, 1), a1, voC[1]);
            PG8_WAIT_V(8); PG8_WAIT_L(0); PG8_BAR; PG8_MMA(0, 0, At, B0); PG8_MMA(0, 1, At, B1); PG8_BAR; PG8_SCHED;
            PG8_LDA(At, 0, 1); PG8_STAGE(PG8_SB(0, 0), b2, voffB); PG8_STAGE(PG8_SB(0, 1), b2 + hstepB, voffB); PG8_STAGE(PG8_SA(0, 0), a2, vo2[0]);
            PG8_WAIT_V(8); PG8_WAIT_L(0); PG8_BAR; PG8_MMA(1, 0, At, B0); PG8_MMA(1, 1, At, B1); PG8_BAR; PG8_SCHED;
            PG8_LDB(B0, 1, 0); PG8_LDB(B1, 1, 1); PG8_SCHED; PG8_LDA(At, 1, 0); PG8_STAGE(PG8_SA(0, 1), a2, vo2[1]);
            PG8_WAIT_V(8); PG8_WAIT_L(0); PG8_BAR; PG8_MMA(0, 0, At, B0); PG8_MMA(0, 1, At, B1); PG8_BAR; PG8_SCHED;
            PG8_LDA(At, 1, 1); PG8_STAGE(PG8_SB(1, 0), b3, voffB); PG8_STAGE(PG8_SB(1, 1), b3 + hstepB, voffB); PG8_STAGE(PG8_SA(1, 0), a3, vo2[0]);
            PG8_WAIT_V(8); PG8_WAIT_L(0); PG8_BAR; PG8_MMA(1, 0, At, B0); PG8_MMA(1, 1, At, B1); PG8_BAR; PG8_SCHED;
        }
        if (wr == 0) PG8_BAR;
        E(acc, cur, wr, wc, fr, fq);
        if (!has_next) break;
#pragma unroll
        for (int a = 0; a < 2; ++a)
#pragma unroll
            for (int b = 0; b < 2; ++b)
#pragma unroll
                for (int m = 0; m < 4; ++m)
#pragma unroll
                    for (int n = 0; n < 2; ++n) acc[a][b][m][n] = (f32x4){0.f, 0.f, 0.f, 0.f};
        cur = nxt; cB = nB; ++ui;
#pragma unroll
        for (int h_ = 0; h_ < 2; ++h_)
#pragma unroll
            for (int i_ = 0; i_ < 2; ++i_) voC[h_][i_] = voN[h_][i_];
        if (wr == 1) PG8_BAR;
    }
    PG8_WAIT_V(0);
    PG8_BAR;
#undef PG8_GOFF
#undef PG8_SA
#undef PG8_SB
#undef PG8_STAGE
#undef PG8_LDA
#undef PG8_LDB
#undef PG8_MMA
#undef PG8_WAIT_V
#undef PG8_WAIT_L
#undef PG8_BAR
#undef PG8_SCHED
}


struct EpiBf16 {
    static constexpr bool PERM = true;
    bf16_t* O; int ldc; unsigned silu_mask; unsigned fg_mask; const float* lbt;
    __device__ __forceinline__ void operator()(const f32x4 (&acc)[2][2][4][2], const Unit& u, int wr, int wc, int fr, int fq) const {
        const int row0 = u.pm * BM + wr * 64 + fr, col0 = u.pn * BM + wc * 32 + 8 * fq;
        const bool act = (silu_mask >> u.pn) & 1u, fgm = (fg_mask >> u.pn) & 1u;
#pragma unroll
        for (int bj = 0; bj < 2; ++bj) {
            f32x4 l0 = (f32x4){0.f, 0.f, 0.f, 0.f}, l1 = l0;
            if (fgm) { const int cc = (col0 & 1023) + bj * HALF; l0 = *(const f32x4*)(lbt + cc); l1 = *(const f32x4*)(lbt + cc + 4); }
#pragma unroll
            for (int ai = 0; ai < 2; ++ai)
#pragma unroll
                for (int m = 0; m < 4; ++m) { bf16_t* rowp = O + (size_t)(row0 + ai * HALF + m * 16) * ldc + col0;
                    f32x4 v0 = acc[ai][bj][m][0], v1 = acc[ai][bj][m][1];
                    if (act) {
#pragma unroll
                        for (int j = 0; j < 4; ++j) { v0[j] = siluf_(v0[j]); v1[j] = siluf_(v1[j]); } }
                    if (fgm) {
#pragma unroll
                        for (int j = 0; j < 4; ++j) { v0[j] = l0[j] + (1.0f - l0[j]) * sigmoidf_(v0[j]); v1[j] = l1[j] + (1.0f - l1[j]) * sigmoidf_(v1[j]); } }
                    u32x4 w; w.x = cvt_pk_bf16(v0[0], v0[1]); w.y = cvt_pk_bf16(v0[2], v0[3]); w.z = cvt_pk_bf16(v1[0], v1[1]); w.w = cvt_pk_bf16(v1[2], v1[3]);
                    *(u32x4*)(rowp + bj * HALF) = w; }
        }
    }
};
struct EpiGate {
    static constexpr bool PERM = true;
    const bf16_t* h2; const bf16_t* pp; float* xout; bf16_t* xb;
    __device__ __forceinline__ void operator()(const f32x4 (&acc)[2][2][4][2], const Unit& u, int wr, int wc, int fr, int fq) const {
        const int row0 = u.pm * BM + wr * 64 + fr, col0 = u.pn * BM + wc * 32 + 8 * fq;
#pragma unroll
        for (int ai = 0; ai < 2; ++ai)
#pragma unroll
            for (int m = 0; m < 4; ++m) { const size_t off = (size_t)(row0 + ai * HALF + m * 16) * D + col0;
#pragma unroll
                for (int bj = 0; bj < 2; ++bj) { const size_t o = off + bj * HALF;
                    const u32x4 hw = *(const u32x4*)(h2 + o), pw = *(const u32x4*)(pp + o); const f32x4 a0 = acc[ai][bj][m][0], a1 = acc[ai][bj][m][1];
                    f32x4 r0, r1;
                    r0[0] = bflo(hw.x) + sigmoidf_(a0[0]) * bflo(pw.x); r0[1] = bfhi(hw.x) + sigmoidf_(a0[1]) * bfhi(pw.x); r0[2] = bflo(hw.y) + sigmoidf_(a0[2]) * bflo(pw.y); r0[3] = bfhi(hw.y) + sigmoidf_(a0[3]) * bfhi(pw.y);
                    r1[0] = bflo(hw.z) + sigmoidf_(a1[0]) * bflo(pw.z); r1[1] = bfhi(hw.z) + sigmoidf_(a1[1]) * bfhi(pw.z); r1[2] = bflo(hw.w) + sigmoidf_(a1[2]) * bflo(pw.w); r1[3] = bfhi(hw.w) + sigmoidf_(a1[3]) * bfhi(pw.w);
                    if (xout) { *(f32x4*)(xout + o) = r0; *(f32x4*)(xout + o + 4) = r1; }
                    else *(u32x4*)(xb + o) = (u32x4){cvt_pk_bf16(r0[0], r0[1]), cvt_pk_bf16(r0[2], r0[3]), cvt_pk_bf16(r1[0], r1[1]), cvt_pk_bf16(r1[2], r1[3])}; }
                asm volatile("" ::: "memory"); }
    }
};
struct EpiPre {
    static constexpr bool PERM = true;
    const float* xf; const bf16_t* xh; bf16_t* pre;
    __device__ __forceinline__ void operator()(const f32x4 (&acc)[2][2][4][2], const Unit& u, int wr, int wc, int fr, int fq) const {
        const int row0 = u.pm * BM + wr * 64 + fr, col0 = u.pn * BM + wc * 32 + 8 * fq;
#pragma unroll
        for (int ai = 0; ai < 2; ++ai)
#pragma unroll
            for (int m = 0; m < 4; ++m) { const size_t off = (size_t)(row0 + ai * HALF + m * 16) * D + col0;
#pragma unroll
                for (int bj = 0; bj < 2; ++bj) { const size_t o = off + bj * HALF; f32x4 x0, x1;
                    if (xf) { x0 = *(const f32x4*)(xf + o); x1 = *(const f32x4*)(xf + o + 4); }
                    else { const u32x4 w = *(const u32x4*)(xh + o); x0 = (f32x4){bflo(w.x), bfhi(w.x), bflo(w.y), bfhi(w.y)}; x1 = (f32x4){bflo(w.z), bfhi(w.z), bflo(w.w), bfhi(w.w)}; }
                    const f32x4 r0 = x0 * DN_ALPHA + acc[ai][bj][m][0], r1 = x1 * DN_ALPHA + acc[ai][bj][m][1];
                    *(u32x4*)(pre + o) = (u32x4){cvt_pk_bf16(r0[0], r0[1]), cvt_pk_bf16(r0[2], r0[3]), cvt_pk_bf16(r1[0], r1[1]), cvt_pk_bf16(r1[2], r1[3])}; }
                asm volatile("" ::: "memory"); }
    }
};
struct EpiMoe1 {
    static constexpr bool PERM = true;
    bf16_t* hid;
    __device__ __forceinline__ void operator()(const f32x4 (&acc)[2][2][4][2], const Unit& u, int wr, int wc, int fr, int fq) const {
        const int row0 = u.pm * BM + wr * 64 + fr, col0 = u.pn * HALF + wc * 32 + 8 * fq;
#pragma unroll
        for (int ai = 0; ai < 2; ++ai)
#pragma unroll
            for (int m = 0; m < 4; ++m) { bf16_t* rowp = hid + (size_t)(row0 + ai * HALF + m * 16) * MOE_H + col0;
                f32x4 v0, v1;
#pragma unroll
                for (int j = 0; j < 4; ++j) { v0[j] = siluf_(acc[ai][0][m][0][j]) * acc[ai][1][m][0][j]; v1[j] = siluf_(acc[ai][0][m][1][j]) * acc[ai][1][m][1][j]; }
                u32x4 w; w.x = cvt_pk_bf16(v0[0], v0[1]); w.y = cvt_pk_bf16(v0[2], v0[3]); w.z = cvt_pk_bf16(v1[0], v1[1]); w.w = cvt_pk_bf16(v1[2], v1[3]);
                *(u32x4*)rowp = w; }
    }
};
struct EpiLora {
    static constexpr bool PERM = true;
    const float* w0; const float* a0; float* dec; bf16_t* aa; bf16_t* gg;
    __device__ __forceinline__ void operator()(const f32x4 (&acc)[2][2][4][2], const Unit& u, int wr, int wc, int fr, int fq) const {
        const int row0 = u.pm * BM + wr * 64 + fr, seg = u.pn >> 1, c0 = (u.pn & 1) * BM + wc * 32 + 8 * fq;
#pragma unroll
        for (int bj = 0; bj < 2; ++bj) {
            const int c = c0 + bj * HALF;
            f32x4 b0 = (f32x4){0.f, 0.f, 0.f, 0.f}, b1 = b0;
            if (seg == 0) { b0 = *(const f32x4*)(w0 + c); b1 = *(const f32x4*)(w0 + c + 4); } else if (seg == 1) { b0 = *(const f32x4*)(a0 + c); b1 = *(const f32x4*)(a0 + c + 4); }
#pragma unroll
            for (int ai = 0; ai < 2; ++ai)
#pragma unroll
                for (int m = 0; m < 4; ++m) { const size_t o = (size_t)(row0 + ai * HALF + m * 16) * 512 + c;
                    f32x4 v0 = acc[ai][bj][m][0] + b0, v1 = acc[ai][bj][m][1] + b1;
                    if (seg == 0) {
#pragma unroll
                        for (int j = 0; j < 4; ++j) { v0[j] = __expf(-0.60653066f * sigmoidf_(v0[j])); v1[j] = __expf(-0.60653066f * sigmoidf_(v1[j])); }
                        *(f32x4*)(dec + o) = v0; *(f32x4*)(dec + o + 4) = v1;
                    } else {
                        if (seg == 1) {
#pragma unroll
                            for (int j = 0; j < 4; ++j) { v0[j] = sigmoidf_(v0[j]); v1[j] = sigmoidf_(v1[j]); } }
                        u32x4 w; w.x = cvt_pk_bf16(v0[0], v0[1]); w.y = cvt_pk_bf16(v0[2], v0[3]); w.z = cvt_pk_bf16(v1[0], v1[1]); w.w = cvt_pk_bf16(v1[2], v1[3]);
                        if (seg == 1) *(u32x4*)(aa + o) = w; else *(u32x4*)(gg + o) = w;
                    } }
        }
    }
};
struct EpiF32 {
    static constexpr bool PERM = false;
    float* C; int ldc;
    __device__ __forceinline__ void operator()(const f32x4 (&acc)[2][2][4][2], const Unit& u, int wr, int wc, int fr, int fq) const {
        const int row0 = u.pm * BM + wr * 64 + fr, col0 = u.pn * BM + wc * 32 + 4 * fq;
#pragma unroll
        for (int ai = 0; ai < 2; ++ai)
#pragma unroll
            for (int m = 0; m < 4; ++m) { float* rowp = C + (size_t)(row0 + ai * HALF + m * 16) * ldc + col0;
#pragma unroll
                for (int bj = 0; bj < 2; ++bj)
#pragma unroll
                    for (int n = 0; n < 2; ++n) *(f32x4*)(rowp + bj * HALF + n * 16) = acc[ai][bj][m][n]; }
    }
};
struct CmpOrder {
    int G, c;
    __device__ bool next(int i, Unit& u) const { const int L = i * G + c; if (L >= 64) return false; u.pm = L; u.pn = 0; u.pb = L >> 5; return true; }
};
struct EpiLogit {
    static constexpr bool PERM = false;
    float* LG;
    __device__ __forceinline__ void operator()(const f32x4 (&acc)[2][2][4][2], const Unit& u, int wr, int wc, int fr, int fq) const {
        if (wc >= 2) return;
        const int row0 = u.pm * BM + wr * 64 + fr, col0 = wc * 32 + 4 * fq;
#pragma unroll
        for (int ai = 0; ai < 2; ++ai)
#pragma unroll
            for (int m = 0; m < 4; ++m) { float* rowp = LG + (size_t)(row0 + ai * HALF + m * 16) * 64 + col0;
#pragma unroll
                for (int n = 0; n < 2; ++n) *(f32x4*)(rowp + n * 16) = acc[ai][0][m][n]; }
    }
};

typedef int i32x8 __attribute__((ext_vector_type(8)));
typedef int i32x4_ __attribute__((ext_vector_type(4)));
__device__ __forceinline__ i32x8 f8cat(const bf16x8& a, const bf16x8& b) { return __builtin_shufflevector(__builtin_bit_cast(i32x4_, a), __builtin_bit_cast(i32x4_, b), 0, 1, 2, 3, 4, 5, 6, 7); }
template <int MODE>
__device__ __forceinline__ void gemm_f8_phase(LAS unsigned char* lds, const unsigned char* A8, const unsigned char* B8, int Kb, const MoeOrder& S, const int* toks, unsigned char* hid8, bf16_t* Y) {
    int tid_ = threadIdx.x; asm volatile("" : "+v"(tid_)); const int tid = tid_, wid = __builtin_amdgcn_readfirstlane(tid >> 6), lane = tid & 63, wr = wid >> 2, wc = wid & 3, fr = lane & 15, fq = lane >> 4;
    int Kb_ = Kb; asm volatile("" : "+s"(Kb_)); const int nt = Kb_ >> 7;
    constexpr int BUFB = 49152, EST = (MODE == 0 ? 4 : 8), NRN = (MODE == 0 ? 4 : 0);
    int RA0; unsigned CA0, voffB0;
    { int R, C; stage_rc(tid * 16, R, C); RA0 = R; CA0 = (unsigned)C * 2u; voffB0 = (unsigned)(((R & ~31) + perm32(R & 31)) * Kb_) + (unsigned)C * 2u; }
    const size_t r64 = (size_t)64 * Kb_;
    const unsigned ldsw = (unsigned)wid * 1024u;
    const int aoff = lds_byte(wr * 64 + fr, fq * 8), boff = lds_byte(wc * 32 + fr, fq * 8);
    const size_t hstepB = (size_t)HALF * Kb_, tstepB = 2 * hstepB;
#define F8_ROWS(RO, U) do { _Pragma("unroll") for (int h_ = 0; h_ < 2; ++h_) _Pragma("unroll") for (int i_ = 0; i_ < 2; ++i_) { const int r_ = (U).pm * BM + h_ * HALF + RA0 + 64 * i_; \
        RO[h_][i_] = (unsigned)(MODE == 0 ? (toks[r_] & 0xffff) : r_) * (unsigned)Kb_ + CA0; } } while (0)
#define F8_DMA(dst, base, voff) __builtin_amdgcn_global_load_lds((const unsigned*)((const char*)(base) + (voff)), (LAS unsigned*)(lds + (dst)), 16, 0, 0)
#define F8_STAGE(U, RO, q, sb) do { const int h_ = (q) >= nt ? 1 : 0; const size_t ko_ = (size_t)((q) - h_ * nt) * 128; const char* bb_ = (const char*)B8 + (size_t)(U).pb * tstepB + ko_; const unsigned d_ = (unsigned)(sb) * BUFB + ldsw; \
        _Pragma("unroll") for (int i_ = 0; i_ < 2; ++i_) { F8_DMA(d_ + i_ * 8192, (const char*)A8 + ko_, RO[h_][i_]); F8_DMA(d_ + 16384 + i_ * 8192, bb_ + i_ * r64, voffB0); F8_DMA(d_ + 32768 + i_ * 8192, bb_ + hstepB + i_ * r64, voffB0); } } while (0)
#define F8_WAIT(n) asm volatile("s_waitcnt vmcnt(" #n ")" ::: "memory")
    constexpr int ULIST = 3 * BUFB, UCAP = 512;
    { i32x4_ e = (i32x4_){0, 0, 0, 0}; const int i = tid;
      if ((S.G & 7) == 0) { const int x = S.c & 7, r = S.c >> 3, w = S.G >> 3, k = i * w + r, q = k >> 2, t = q * 8 + x; if (t < S.ntiles) e = (i32x4_){t, k & 3, S.tile_e[t] * 4 + (k & 3), 1}; }
      else { const long L = (long)i * S.G + S.c; if (L < (long)S.ntiles * 4) e = (i32x4_){(int)(L >> 2), (int)(L & 3), S.tile_e[(int)(L >> 2)] * 4 + (int)(L & 3), 1}; }
      if (i < UCAP) *(LAS i32x4_*)(lds + ULIST + i * 16) = e; }
    __syncthreads();
#define F8_UNIT(k, U, ok) do { i32x4_ e_ = (i32x4_){0, 0, 0, 0}; if ((k) < UCAP) e_ = *(const LAS i32x4_*)(lds + ULIST + (k) * 16); (U).pm = __builtin_amdgcn_readfirstlane(e_.x); (U).pn = __builtin_amdgcn_readfirstlane(e_.y); \
        (U).pb = __builtin_amdgcn_readfirstlane(e_.z); ok = __builtin_amdgcn_readfirstlane(e_.w) != 0; } while (0)
    Unit cur, nxt; int ui = 0; bool ok0;
    F8_UNIT(0, cur, ok0);
    if (!ok0) return;
    unsigned ro[2][2], rn[2][2];
    F8_ROWS(ro, cur);
    F8_STAGE(cur, ro, 0, 0); F8_STAGE(cur, ro, 1, 1);
    f32x4 acc[2][4][2];
#pragma unroll
    for (int b = 0; b < 2; ++b)
#pragma unroll
        for (int m = 0; m < 4; ++m)
#pragma unroll
            for (int n = 0; n < 2; ++n) acc[b][m][n] = (f32x4){0.f, 0.f, 0.f, 0.f};
    F8_STAGE(cur, ro, 2, 2);
    bf16x8 AtX[4][2], B0X[2][2], B1X[2][2], AtY[4][2], B0Y[2][2], B1Y[2][2];
#define F8_READ_B(B0, B1, slot) do { const LAS unsigned char* tb_ = lds + (slot) * BUFB; \
        _Pragma("unroll") for (int n = 0; n < 2; ++n) _Pragma("unroll") for (int k = 0; k < 2; ++k) { B0[n][k] = *(const LAS bf16x8*)(tb_ + 16384 + boff + n * 2048 + k * 1024); B1[n][k] = *(const LAS bf16x8*)(tb_ + 32768 + boff + n * 2048 + k * 1024); } } while (0)
#define F8_READ_A(At, slot) do { const LAS unsigned char* tb_ = lds + (slot) * BUFB; \
        _Pragma("unroll") for (int m = 0; m < 4; ++m) _Pragma("unroll") for (int k = 0; k < 2; ++k) At[m][k] = *(const LAS bf16x8*)(tb_ + aoff + m * 2048 + k * 1024); } while (0)
#define F8_READ(At, B0, B1, slot) do { F8_READ_B(B0, B1, slot); F8_READ_A(At, slot); } while (0)
#define F8_MMA(At, B0, B1, M0, M1) do { __builtin_amdgcn_s_setprio(1); _Pragma("unroll") for (int m = M0; m < M1; ++m) _Pragma("unroll") for (int n = 0; n < 2; ++n) { \
        acc[0][m][n] = __builtin_amdgcn_mfma_scale_f32_16x16x128_f8f6f4(f8cat(B0[n][0], B0[n][1]), f8cat(At[m][0], At[m][1]), acc[0][m][n], 0, 0, 0, 0, 0, 0); \
        acc[1][m][n] = __builtin_amdgcn_mfma_scale_f32_16x16x128_f8f6f4(f8cat(B1[n][0], B1[n][1]), f8cat(At[m][0], At[m][1]), acc[1][m][n], 0, 0, 0, 0, 0, 0); } __builtin_amdgcn_s_setprio(0); } while (0)
#define F8_STEP(g, AtC, B0C, B1C, AtL, B0L, B1L) do { \
        const bool ex1_ = ((g) + 1 < 2 * nt) || has_next, ex2_ = ((g) + 2 < 2 * nt) || has_next; \
        if (ex1_) { if (!ex2_) F8_WAIT(0); \
            else if (after_epi && unit_start) { if (EST == 4) F8_WAIT(14); else F8_WAIT(18); } \
            else if (after_epi) { if (EST == 4) F8_WAIT(10); else F8_WAIT(14); } \
            else if (unit_start) F8_WAIT(10); \
            else F8_WAIT(6); } \
        after_epi = false; unit_start = false; \
        asm volatile("s_waitcnt lgkmcnt(0)" ::: "memory"); \
          \
        asm volatile("" : "+v"(AtC[0][0]), "+v"(AtC[0][1]), "+v"(AtC[1][0]), "+v"(AtC[1][1]), "+v"(AtC[2][0]), "+v"(AtC[2][1]), "+v"(AtC[3][0]), "+v"(AtC[3][1])); \
        asm volatile("" : "+v"(B0C[0][0]), "+v"(B0C[0][1]), "+v"(B0C[1][0]), "+v"(B0C[1][1]), "+v"(B1C[0][0]), "+v"(B1C[0][1]), "+v"(B1C[1][0]), "+v"(B1C[1][1])); \
        __builtin_amdgcn_s_barrier(); \
        if ((g) == 1) { asm volatile("" : "+v"(rn[0][0]), "+v"(rn[0][1]), "+v"(rn[1][0]), "+v"(rn[1][1])); \
            _Pragma("unroll") for (int h_ = 0; h_ < 2; ++h_) _Pragma("unroll") for (int i_ = 0; i_ < 2; ++i_) \
                rn[h_][i_] = (unsigned)(MODE == 0 ? (int)(rn[h_][i_] & 0xffffu) : (has_next ? nxt.pm : cur.pm) * BM + h_ * HALF + RA0 + 64 * i_) * (unsigned)Kb_ + CA0; } \
        if ((g) + 3 < 2 * nt) F8_STAGE(cur, ro, (g) + 3, buf); else if (has_next) F8_STAGE(nxt, rn, (g) + 3 - 2 * nt, buf); \
        buf = buf == 2 ? 0 : buf + 1; \
          \
          \
        F8_READ_B(B0L, B1L, buf); __builtin_amdgcn_sched_barrier(0); F8_MMA(AtC, B0C, B1C, 0, 2); __builtin_amdgcn_sched_barrier(0); \
        F8_READ_A(AtL, buf); __builtin_amdgcn_sched_barrier(0); F8_MMA(AtC, B0C, B1C, 2, 4); } while (0)
    int buf = 0; bool after_epi = false, first = true;
    for (;;) {
        bool has_next; F8_UNIT(ui + 1, nxt, has_next);
#pragma unroll
        for (int h_ = 0; h_ < 2; ++h_)
#pragma unroll
            for (int i_ = 0; i_ < 2; ++i_) {
                if (MODE == 0) { const int* p_ = toks + (has_next ? nxt.pm : cur.pm) * BM + h_ * HALF + RA0 + 64 * i_; asm volatile("global_load_dword %0, %1, off" : "=v"(rn[h_][i_]) : "v"(p_) : "memory"); } }
        bool unit_start = !first && NRN != 0;
        if (first) { F8_WAIT(0); __builtin_amdgcn_s_barrier(); F8_READ(AtX, B0X, B1X, 0); }
        first = false;
#pragma nounroll
        for (int g = 0; g < 2 * nt; g += 2) {
            F8_STEP(g, AtX, B0X, B1X, AtY, B0Y, B1Y);
            F8_STEP(g + 1, AtY, B0Y, B1Y, AtX, B0X, B1X);
            if (g + 1 == nt - 1 || g + 1 == 2 * nt - 1) {
                const int ai = g + 1 >= nt ? 1 : 0, row0 = cur.pm * BM + ai * HALF + wr * 64 + fr;
                if (MODE == 0) { const int col0 = cur.pn * HALF + wc * 32 + 8 * fq;
#pragma unroll
                    for (int m = 0; m < 4; ++m) { f32x4 v0, v1;
#pragma unroll
                        for (int j = 0; j < 4; ++j) { v0[j] = siluf_(acc[0][m][0][j]) * acc[1][m][0][j]; v1[j] = siluf_(acc[0][m][1][j]) * acc[1][m][1][j]; }
                        *(u32x2*)(hid8 + (size_t)(row0 + m * 16) * MOE_H + col0) = (u32x2){cvt_pk4_fp8_sat(v0[0], v0[1], v0[2], v0[3]), cvt_pk4_fp8_sat(v1[0], v1[1], v1[2], v1[3])}; }
                } else { const int col0 = cur.pn * BM + wc * 32 + 8 * fq;
#pragma unroll
                    for (int b = 0; b < 2; ++b)
#pragma unroll
                        for (int m = 0; m < 4; ++m) { const f32x4 v0 = acc[b][m][0], v1 = acc[b][m][1];
                            *(u32x4*)(Y + (size_t)(row0 + m * 16) * D + col0 + b * HALF) = (u32x4){cvt_pk_bf16(v0[0], v0[1]), cvt_pk_bf16(v0[2], v0[3]), cvt_pk_bf16(v1[0], v1[1]), cvt_pk_bf16(v1[2], v1[3])}; }
                }
#pragma unroll
                for (int b = 0; b < 2; ++b)
#pragma unroll
                    for (int m = 0; m < 4; ++m)
#pragma unroll
                        for (int n = 0; n < 2; ++n) acc[b][m][n] = (f32x4){0.f, 0.f, 0.f, 0.f};
                after_epi = true;
            }
        }
        if (!has_next) break;
        cur = nxt; ++ui;
#pragma unroll
        for (int h_ = 0; h_ < 2; ++h_)
#pragma unroll
            for (int i_ = 0; i_ < 2; ++i_) ro[h_][i_] = rn[h_][i_];
    }
#undef F8_READ
#undef F8_MMA
#undef F8_STEP
    F8_WAIT(0);
    __builtin_amdgcn_s_barrier();
#undef F8_ROWS
#undef F8_UNIT
#undef F8_DMA
#undef F8_STAGE
#undef F8_WAIT
}
}

#define XB_TMO      128
#define XB_XCNT(j)  (256  + 64 * (j))
#define XB_XSUB(j)  (1280 + 64 * (j))
#define XB_XGEN(j)  (2304 + 64 * (j))
#define XB_TOP      3328
#define XB_TOPGEN   3392
#define XCD_BAR_WORDS 3456
#define XB_SPIN_CAP (1u << 18)
__device__ __forceinline__ unsigned xb_ld(unsigned* p)              { return __hip_atomic_load(p, __ATOMIC_RELAXED, __HIP_MEMORY_SCOPE_AGENT); }
__device__ __forceinline__ unsigned xb_add(unsigned* p, unsigned v) { return __hip_atomic_fetch_add(p, v, __ATOMIC_RELAXED, __HIP_MEMORY_SCOPE_AGENT); }
__device__ __forceinline__ unsigned xb_xcc_id() { return (unsigned)__builtin_amdgcn_s_getreg((3 << 11) | 20) & 0xFu; }
#define XB_SPIN(cond, bar) do { unsigned _sp = 0; while (cond) { __builtin_amdgcn_s_sleep(1); \
    if ((++_sp & 255u) == 0u) { if (xb_ld(&(bar)[XB_TMO])) break; if (_sp > XB_SPIN_CAP) { atomicAdd(&(bar)[XB_TMO], 1u); break; } } } } while (0)
struct XcdBarrier { unsigned* bar; unsigned x; volatile LAS unsigned* st; };
__device__ __forceinline__ XcdBarrier xcd_barrier_post(unsigned* bar, volatile LAS unsigned* st) {
    XcdBarrier b; b.bar = bar; b.x = xb_xcc_id(); b.st = st;
    if (threadIdx.x == 0) (void)xb_add(&bar[XB_XCNT(b.x)], 1u);
    return b;
}
__device__ __forceinline__ void xcd_barrier_complete(unsigned* bar, unsigned x, unsigned& nloc, unsigned& nx) {
    const unsigned G = gridDim.x * gridDim.y * gridDim.z;
    unsigned sum, cnt, mine, sp = 0u;
    for (;;) {
        sum = 0u; cnt = 0u; mine = 0u;
#pragma unroll
        for (unsigned j = 0; j < 16; ++j) { const unsigned c = xb_ld(&bar[XB_XCNT(j)]); sum += c; cnt += (c > 0u) ? 1u : 0u; mine = (j == x) ? c : mine; }
        if (sum == G) break;
        __builtin_amdgcn_s_sleep(1);
        if ((++sp & 255u) == 0u) { if (xb_ld(&bar[XB_TMO])) break; if (sp > XB_SPIN_CAP) { atomicAdd(&bar[XB_TMO], 1u); break; } }
    }
    nloc = mine > 0u ? mine : 1u; nx = cnt > 0u ? cnt : 1u;
}
__device__ __forceinline__ void xcd_barrier(const XcdBarrier& b) {
    asm volatile("s_waitcnt vmcnt(0)" ::: "memory");
    __syncthreads();
    if (threadIdx.x == 0) {
        unsigned* bar = b.bar;
        __builtin_amdgcn_s_waitcnt(0);
        unsigned nloc = b.st[0], nx = b.st[1];
        if (nloc == 0u) { xcd_barrier_complete(bar, b.x, nloc, nx); b.st[0] = nloc; b.st[1] = nx; }
        const unsigned old = xb_add(&bar[XB_XSUB(b.x)], 1u);
        const unsigned gen = old / nloc;
        if (old + 1u == (gen + 1u) * nloc) {
            __builtin_amdgcn_fence(__ATOMIC_RELEASE, "agent");
            asm volatile("s_waitcnt vmcnt(0)" ::: "memory");
            const unsigned og = xb_add(&bar[XB_TOP], 1u);
            const unsigned tg = og / nx;
            if (og + 1u == (tg + 1u) * nx) xb_add(&bar[XB_TOPGEN], 1u);
            else XB_SPIN(xb_ld(&bar[XB_TOPGEN]) == tg, bar);
            __builtin_amdgcn_fence(__ATOMIC_ACQUIRE, "agent");
            xb_add(&bar[XB_XGEN(b.x)], 1u);
            asm volatile("s_waitcnt vmcnt(0)" ::: "memory");
        } else {
            XB_SPIN(xb_ld(&bar[XB_XGEN(b.x)]) == gen, bar);
            __builtin_amdgcn_fence(__ATOMIC_ACQUIRE, "agent");
            asm volatile("s_waitcnt vmcnt(0)" ::: "memory");
        }
    }
    __syncthreads();
}


typedef float f32x16 __attribute__((ext_vector_type(16)));
#define MFMA32(a, b, c) __builtin_amdgcn_mfma_f32_32x32x16_bf16((a), (b), (c), 0, 0, 0)
__device__ __forceinline__ int crow(int reg, int h) { return (reg & 3) + 8 * (reg >> 2) + 4 * h; }
constexpr int HG_LQE = 0, HG_LKE = HG_LQE + 64 * 272, HG_LKTT = HG_LKE + 64 * 272, HG_LVT = HG_LKTT + 128 * 144, HG_LAT = HG_LVT + 128 * 144, HG_LST = HG_LAT + 64 * 144,
              HG_LO = HG_LST + 128 * 272, HG_LBL = HG_LO + 64 * 528, HG_LPART = HG_LBL + 512, HG_LEND = HG_LPART + 4096;
static_assert(HG_LEND <= 163840 - 512, "hgrn lds");
__device__ __forceinline__ void hgrn_phase(LAS unsigned char* lds, const bf16_t* Z, const float* hg_lb, const float* norm_g, bf16_t* OG, int G, int bx) {
    const int tid = pinned_tid(), lane = tid & 63, wave = __builtin_amdgcn_readfirstlane(tid >> 6), half = lane >> 5, l32 = lane & 31;
    const int d = 2 * (tid & 63), jq = tid >> 6;
    for (int unit = bx; unit < NB * 8; unit += G) {
        const int b = unit >> 3, h = unit & 7;
        for (int i = tid; i < 128 * 272 / 4; i += NTHR) ((LAS unsigned*)(lds + HG_LST))[i] = 0u;
        f32x16 S0, S1;
#pragma unroll
        for (int r = 0; r < 16; ++r) { S0[r] = 0.f; S1[r] = 0.f; }
        __syncthreads();
        unsigned qn[8], fn[8], vn[8];
#define HG_LOAD(n_) do { const bf16_t* zr_ = Z + ((size_t)(b * T + (n_) * 64 + jq * 8)) * 4096 + h * 128 + d; \
            _Pragma("unroll") for (int jj = 0; jj < 8; ++jj) { qn[jj] = *(const unsigned*)(zr_ + (size_t)jj * 4096); fn[jj] = *(const unsigned*)(zr_ + (size_t)jj * 4096 + 1024); vn[jj] = *(const unsigned*)(zr_ + (size_t)jj * 4096 + 2048); } } while (0)
        u32x4 gc0, gc1, gn0, gn1;
#define HG_LOADG(n_, A_, B_) do { const bf16_t* gp_ = Z + (size_t)(b * T + (n_) * 64 + (tid >> 3)) * 4096 + 3072 + h * 128 + (tid & 7) * 16; A_ = *(const u32x4*)gp_; B_ = *(const u32x4*)(gp_ + 8); } while (0)
        HG_LOAD(0); HG_LOADG(0, gc0, gc1);
        for (int n = 0; n < T / 64; ++n) {
            float q0[8], q1[8], k0[8], k1[8], p0[8], p1[8]; unsigned vr[8];
            float run0 = 1.f, run1 = 1.f;
#pragma unroll
            for (int jj = 0; jj < 8; ++jj) { const float fg0 = bflo(fn[jj]), fg1 = bfhi(fn[jj]); run0 *= fg0; run1 *= fg1; p0[jj] = run0; p1[jj] = run1; k0[jj] = 1.0f - fg0; k1[jj] = 1.0f - fg1;
                q0[jj] = bflo(qn[jj]); q1[jj] = bfhi(qn[jj]); vr[jj] = vn[jj]; }
            *(LAS f32x2*)(lds + HG_LPART + (jq * 128 + d) * 4) = (f32x2){run0, run1};
            __syncthreads();
            float pre0 = 1.f, pre1 = 1.f, tot0 = 1.f, tot1 = 1.f;
#pragma unroll
            for (int q = 0; q < 8; ++q) { const f32x2 pq = *(const LAS f32x2*)(lds + HG_LPART + (q * 128 + d) * 4); tot0 *= pq[0]; tot1 *= pq[1]; if (q < jq) { pre0 *= pq[0]; pre1 *= pq[1]; } }
            if (jq == 0) *(LAS f32x2*)(lds + HG_LBL + d * 4) = (f32x2){tot0, tot1};
            unsigned kt0[4], kt1[4], vt0[4], vt1[4];
#pragma unroll
            for (int jj = 0; jj < 8; ++jj) {
                const float e0 = p0[jj] * pre0, e1 = p1[jj] * pre1, r0 = __builtin_amdgcn_rcpf(e0), r1 = __builtin_amdgcn_rcpf(e1);
                const int j = jq * 8 + jj;
                *(LAS unsigned*)(lds + HG_LQE + j * 272 + d * 2) = cvt_pk_bf16(q0[jj] * e0, q1[jj] * e1);
                *(LAS unsigned*)(lds + HG_LKE + j * 272 + d * 2) = cvt_pk_bf16(k0[jj] * r0, k1[jj] * r1);
                const float t0 = k0[jj] * r0 * tot0, t1 = k1[jj] * r1 * tot1;
                if (jj & 1) { kt0[jj >> 1] = cvt_pk_bf16(p0[jj - 1], t0); kt1[jj >> 1] = cvt_pk_bf16(p1[jj - 1], t1); vt0[jj >> 1] = (vr[jj - 1] & 0xffffu) | (vr[jj] << 16); vt1[jj >> 1] = (vr[jj - 1] >> 16) | (vr[jj] & 0xffff0000u); }
                else { p0[jj] = t0; p1[jj] = t1; }
            }
            *(LAS u32x4*)(lds + HG_LKTT + d * 144 + jq * 16) = (u32x4){kt0[0], kt0[1], kt0[2], kt0[3]}; *(LAS u32x4*)(lds + HG_LKTT + (d + 1) * 144 + jq * 16) = (u32x4){kt1[0], kt1[1], kt1[2], kt1[3]};
            *(LAS u32x4*)(lds + HG_LVT + d * 144 + jq * 16) = (u32x4){vt0[0], vt0[1], vt0[2], vt0[3]}; *(LAS u32x4*)(lds + HG_LVT + (d + 1) * 144 + jq * 16) = (u32x4){vt1[0], vt1[1], vt1[2], vt1[3]};
            __syncthreads();
            if (n + 1 < T / 64) { HG_LOAD(n + 1); HG_LOADG(n + 1, gn0, gn1); }
            if (wave < 4) {
                const int tj = wave >> 1, ti = wave & 1;
                f32x16 acc;
#pragma unroll
                for (int r = 0; r < 16; ++r) acc[r] = 0.f;
                if (tj <= ti) {
#pragma unroll
                    for (int s = 0; s < 8; ++s) {
                        const bf16x8 a = *(const LAS bf16x8*)(lds + HG_LKE + (32 * tj + l32) * 272 + (16 * s + 8 * half) * 2);
                        const bf16x8 bq = *(const LAS bf16x8*)(lds + HG_LQE + (32 * ti + l32) * 272 + (16 * s + 8 * half) * 2);
                        acc = MFMA32(a, bq, acc);
                    }
                }
                const int ig = 32 * ti + l32;
#pragma unroll
                for (int g4 = 0; g4 < 4; ++g4) {
                    const int j0 = 32 * tj + 8 * g4 + 4 * half;
                    float v0 = acc[4 * g4], v1 = acc[4 * g4 + 1], v2 = acc[4 * g4 + 2], v3 = acc[4 * g4 + 3];
                    v0 = (j0 <= ig) ? v0 : 0.f; v1 = (j0 + 1 <= ig) ? v1 : 0.f; v2 = (j0 + 2 <= ig) ? v2 : 0.f; v3 = (j0 + 3 <= ig) ? v3 : 0.f;
                    *(LAS u32x2*)(lds + HG_LAT + ig * 144 + j0 * 2) = (u32x2){cvt_pk_bf16(v0, v1), cvt_pk_bf16(v2, v3)};
                }
            }
            {
                const int td = wave & 3, tc0 = (wave >> 2) * 2;
#pragma unroll
                for (int r = 0; r < 16; ++r) { const float sc = ((LAS float*)(lds + HG_LBL))[32 * td + crow(r, half)]; S0[r] *= sc; S1[r] *= sc; }
#pragma unroll
                for (int s = 0; s < 4; ++s) {
                    const bf16x8 a = *(const LAS bf16x8*)(lds + HG_LKTT + (32 * td + l32) * 144 + (16 * s + 8 * half) * 2);
                    const bf16x8 b0 = *(const LAS bf16x8*)(lds + HG_LVT + (32 * tc0 + l32) * 144 + (16 * s + 8 * half) * 2);
                    const bf16x8 b1 = *(const LAS bf16x8*)(lds + HG_LVT + (32 * (tc0 + 1) + l32) * 144 + (16 * s + 8 * half) * 2);
                    S0 = MFMA32(a, b0, S0); S1 = MFMA32(a, b1, S1);
                }
            }
            __syncthreads();
            {
                const int ti = wave >> 2, tc = wave & 3;
                f32x16 acc;
#pragma unroll
                for (int r = 0; r < 16; ++r) acc[r] = 0.f;
#pragma unroll
                for (int s = 0; s < 4; ++s) {
                    const bf16x8 a = *(const LAS bf16x8*)(lds + HG_LAT + (32 * ti + l32) * 144 + (16 * s + 8 * half) * 2);
                    const bf16x8 bv = *(const LAS bf16x8*)(lds + HG_LVT + (32 * tc + l32) * 144 + (16 * s + 8 * half) * 2);
                    acc = MFMA32(a, bv, acc);
                }
#pragma unroll
                for (int s = 0; s < 8; ++s) {
                    const bf16x8 a = *(const LAS bf16x8*)(lds + HG_LQE + (32 * ti + l32) * 272 + (16 * s + 8 * half) * 2);
                    const bf16x8 bs = *(const LAS bf16x8*)(lds + HG_LST + (32 * tc + l32) * 272 + (16 * s + 8 * half) * 2);
                    acc = MFMA32(a, bs, acc);
                }
#pragma unroll
                for (int r = 0; r < 16; ++r) ((LAS float*)(lds + HG_LO + (32 * ti + crow(r, half)) * 528))[32 * tc + l32] = acc[r];
            }
            __syncthreads();
            {
                const int td = wave & 3, tc0 = (wave >> 2) * 2;
#pragma unroll
                for (int g4 = 0; g4 < 4; ++g4) {
                    const int d0 = 32 * td + 8 * g4 + 4 * half;
                    *(LAS u32x2*)(lds + HG_LST + (32 * tc0 + l32) * 272 + d0 * 2) = (u32x2){cvt_pk_bf16(S0[4 * g4], S0[4 * g4 + 1]), cvt_pk_bf16(S0[4 * g4 + 2], S0[4 * g4 + 3])};
                    *(LAS u32x2*)(lds + HG_LST + (32 * (tc0 + 1) + l32) * 272 + d0 * 2) = (u32x2){cvt_pk_bf16(S1[4 * g4], S1[4 * g4 + 1]), cvt_pk_bf16(S1[4 * g4 + 2], S1[4 * g4 + 3])};
                }
            }
            {
                const int i = tid >> 3, seg = tid & 7;
                f32x4 ov[4]; float ss = 0.f;
#pragma unroll
                for (int q = 0; q < 4; ++q) { ov[q] = *(const LAS f32x4*)(lds + HG_LO + i * 528 + seg * 64 + q * 16); ss += (ov[q][0] * ov[q][0] + ov[q][1] * ov[q][1]) + (ov[q][2] * ov[q][2] + ov[q][3] * ov[q][3]); }
                ss = dpp_addx<0xB1, 0xf>(ss); ss = dpp_addx<0x4E, 0xf>(ss); ss = dpp_addx<0x141, 0xf>(ss);
                const float rstd = __builtin_amdgcn_rsqf(ss * (1.0f / 128.0f) + LN_EPS);
                const size_t row = (size_t)(b * T + n * 64 + i);
                const u32x4 g0 = gc0, g1 = gc1;
                const unsigned gw_[8] = {g0.x, g0.y, g0.z, g0.w, g1.x, g1.y, g1.z, g1.w};
                unsigned ow[8];
#pragma unroll
                for (int q = 0; q < 4; ++q) { const f32x4 ng = *(const f32x4*)(norm_g + seg * 16 + q * 4);
                    ow[2 * q] = cvt_pk_bf16(ov[q][0] * rstd * ng[0] * bflo(gw_[2 * q]), ov[q][1] * rstd * ng[1] * bfhi(gw_[2 * q]));
                    ow[2 * q + 1] = cvt_pk_bf16(ov[q][2] * rstd * ng[2] * bflo(gw_[2 * q + 1]), ov[q][3] * rstd * ng[3] * bfhi(gw_[2 * q + 1])); }
                *(u32x4*)(OG + row * D + h * 128 + seg * 16) = (u32x4){ow[0], ow[1], ow[2], ow[3]}; *(u32x4*)(OG + row * D + h * 128 + seg * 16 + 8) = (u32x4){ow[4], ow[5], ow[6], ow[7]};
            }
            gc0 = gn0; gc1 = gn1;
            __syncthreads();
        }
    }
}


__device__ __forceinline__ void unpack8(const u32x4 w, float (&f)[8]) { f[0] = bflo(w.x); f[1] = bfhi(w.x); f[2] = bflo(w.y); f[3] = bfhi(w.y); f[4] = bflo(w.z); f[5] = bfhi(w.z); f[6] = bflo(w.w); f[7] = bfhi(w.w); }
__device__ __forceinline__ void rope_row(int m, bf16_t* ZB, bf16_t* QRB, const int* posi, LAS float* tb, int lane, bool write_k) {
    const float inv_me = exp2f(-(float)(lane & 31) * (13.287712379549449f / 32.0f));
    { const float pf = (float)posi[m]; float s1, c1; sincosf(pf * inv_me, &s1, &c1); if (lane < 32) { tb[lane] = c1; tb[32 + lane] = s1; } LDS_WAIT(); }
    if (lane < 48) {
        const bf16_t* zrow = ZB + (size_t)m * EVP;
        const int hs = lane >> 2, d0 = 8 * (lane & 3);
        const f32x4 ca = *(const LAS f32x4*)(tb + d0), cb = *(const LAS f32x4*)(tb + d0 + 4), sa = *(const LAS f32x4*)(tb + 32 + d0), sb = *(const LAS f32x4*)(tb + 32 + d0 + 4);
        const int scol = hs < 8 ? 1792 + hs * 64 : ((hs & 2) ? 2816 : 2560) + (hs & 1) * 64;
        const u32x4 a = *(const u32x4*)(zrow + scol + d0), bq = *(const u32x4*)(zrow + scol + 32 + d0);
        float x1[8], x2[8], o1[8], o2[8]; unpack8(a, x1); unpack8(bq, x2);
#pragma unroll
        for (int i = 0; i < 8; ++i) { const float c = i < 4 ? ca[i & 3] : cb[i & 3], sn = i < 4 ? sa[i & 3] : sb[i & 3]; o1[i] = x1[i] * c - x2[i] * sn; o2[i] = x2[i] * c + x1[i] * sn; }
        const u32x4 w1 = (u32x4){cvt_pk_bf16(o1[0], o1[1]), cvt_pk_bf16(o1[2], o1[3]), cvt_pk_bf16(o1[4], o1[5]), cvt_pk_bf16(o1[6], o1[7])}, w2 = (u32x4){cvt_pk_bf16(o2[0], o2[1]), cvt_pk_bf16(o2[2], o2[3]), cvt_pk_bf16(o2[4], o2[5]), cvt_pk_bf16(o2[6], o2[7])};
        if (hs < 8) { bf16_t* dst = QRB + (size_t)m * 512 + hs * 64 + d0; *(u32x4*)dst = w1; *(u32x4*)(dst + 32) = w2; }
        else if (write_k) { bf16_t* dst = ZB + (size_t)m * EVP + scol + d0; *(u32x4*)dst = w1; *(u32x4*)(dst + 32) = w2; }
    }
    LDS_WAIT();
}
__device__ __forceinline__ void cmpcomb_row(int rr, const float* HC, const float* cb, const float* cw2, bf16_t* KVC, LAS float* hs, int lane) {
    const int hq = rr & 1, n = (rr >> 1) & 255, bq_ = (rr >> 9) & 15, zsel = rr >> 13;
    float outv = 0.f;
    if (n < 255) {
        const float* ha = HC + ((size_t)zsel * 8192 + (size_t)(bq_ * 256 + n) * 2 + hq) * 256; const float* hb = ha + 2 * 256 + 128;
#pragma unroll
        for (int q = 0; q < 2; ++q) { const int c = lane + 64 * q; const float xx = ha[c] + hb[c] + cb[zsel * 128 + c];
            hs[c] = 0.5f * xx * (1.0f + tanhf(0.7978845608028654f * (xx + 0.044715f * xx * xx * xx))); }
        LDS_WAIT();
        const float* w2p = cw2 + (size_t)zsel * 128 * 64 + lane;
#pragma unroll 16
        for (int c = 0; c < 128; ++c) outv += hs[c] * w2p[c * 64];
        LDS_WAIT();
    }
    KVC[((size_t)(zsel * 32 + bq_ * 2 + hq) * 256 + n) * 64 + lane] = (bf16_t)(cvt_pk_bf16(outv, 0.f) & 0xffffu);
}
constexpr int LATE_CONV_ITEMS = 2048 + 4 * 512 + 2 * 128;
__device__ __forceinline__ void conv_late_item(int it, const float* odin, const float* odout, const float* evout, const float* gatew, const float* plew, unsigned char* ws, LAS float* scr, int lane);
constexpr int MOE_CONV_ITEMS = NEXP * 3 * 256;
__device__ __forceinline__ void conv_moe_item(const float* w1, const float* w3, const float* w2, int li, bf16_t* w13, bf16_t* w2t, LAS float* scr, int it, int lane);
constexpr int RW_LW = 0, RW_LKK = 8192, RW_LBB = 16384, RW_LK2 = 24576, RW_LWR = 32768, RW_LV = 40960, RW_LO = 57344;
template <int CTRL> __device__ __forceinline__ float dpp_b(float v) { return __builtin_bit_cast(float, __builtin_amdgcn_mov_dpp(__builtin_bit_cast(int, v), CTRL, 0xf, 0xf, true)); }
__device__ __forceinline__ float sum16b(float v) { v += dpp_b<0xB1>(v); v += dpp_b<0x4E>(v); v += dpp_b<0x141>(v); v += dpp_b<0x140>(v); return v; }
__device__ __forceinline__ float sum8b(float v) { v += dpp_b<0xB1>(v); v += dpp_b<0x4E>(v); v += dpp_b<0x141>(v); return v; }
__device__ __forceinline__ float afma(float a, float b, float c) { float d; asm("v_fma_f32 %0, %1, %2, %3" : "=v"(d) : "v"(a), "v"(b), "v"(c)); return d; }
__device__ __forceinline__ float anfma(float a, float b, float c) { float d; asm("v_fma_f32 %0, -%1, %2, %3" : "=v"(d) : "v"(a), "v"(b), "v"(c)); return d; }
__device__ __forceinline__ float amul(float a, float b) { float d; asm("v_mul_f32 %0, %1, %2" : "=v"(d) : "v"(a), "v"(b)); return d; }
__device__ __forceinline__ unsigned cvt_pk_f16(float a, float b) { typedef _Float16 h2v_ __attribute__((ext_vector_type(2))); return __builtin_bit_cast(unsigned, __builtin_convertvector((f32x2){a, b}, h2v_)); }
__device__ __forceinline__ u32x4 pack8h(const float (&o)[8]) { return (u32x4){cvt_pk_f16(o[0], o[1]), cvt_pk_f16(o[2], o[3]), cvt_pk_f16(o[4], o[5]), cvt_pk_f16(o[6], o[7])}; }
struct RwRaw { u32x4 r, k, v, rp, kp, vp, a; f32x4 w0, w1, sc; };
__device__ __forceinline__ void rwkv_phase(LAS unsigned char* lds, const bf16_t* Z, const float* dec, const bf16_t* aa, const float* sc4, const float* mu, const float* k_k, const float* k_a, bf16_t* Y, int G, int bx,
                                           const float* mw1, const float* mw3, const float* mw2, bf16_t* w13, bf16_t* w2t, bool conv,
                                           const float* HC, const float* cb, const float* cw2, bf16_t* KVC, const float* pin, bf16_t* pbf0, bf16_t* pbf1, bf16_t* ZW, bf16_t* QRB, const int* posi,
                                           const float* lodin, const float* lodout, const float* levout, const float* lgate, const float* lple, unsigned char* wsb) {
    for (int unit = bx; unit < NB * 16; unit += G) {
        const int tid = pinned_tid();
        const int rowl = (tid >> 3) & 31, kc = tid & 7;
        const int sst = tid >> 3, c8 = (tid & 7) * 8;
        const int b = unit >> 4, h = (unit >> 1) & 7, rh = unit & 1, hc0 = h * 64 + c8;
        float p_mr[8], p_mk[8], p_mv[8], p_kk[8], p_ka[8];
#pragma unroll
        for (int i = 0; i < 8; ++i) { p_mr[i] = mu[hc0 + i]; p_mk[i] = mu[512 + hc0 + i]; p_mv[i] = mu[1024 + hc0 + i]; p_kk[i] = k_k[hc0 + i]; p_ka[i] = k_a[hc0 + i]; }
        float S[8];
#pragma unroll
        for (int i = 0; i < 8; ++i) S[i] = 0.f;
        RwRaw rw;
#define RW_LOAD(n_) do { const int t_ = (n_) * 64 + sst; const size_t row_ = (size_t)(b * T + t_); const bf16_t* zc_ = Z + row_ * EVP + hc0; \
            rw.r = *(const u32x4*)zc_; rw.k = *(const u32x4*)(zc_ + 512); rw.v = *(const u32x4*)(zc_ + 1024); \
            if (t_ > 0) { rw.rp = *(const u32x4*)(zc_ - EVP); rw.kp = *(const u32x4*)(zc_ + 512 - EVP); rw.vp = *(const u32x4*)(zc_ + 1024 - EVP); } else { rw.rp = (u32x4){0u, 0u, 0u, 0u}; rw.kp = rw.rp; rw.vp = rw.rp; } \
            rw.a = *(const u32x4*)(aa + row_ * 512 + hc0); rw.w0 = *(const f32x4*)(dec + row_ * 512 + hc0); rw.w1 = *(const f32x4*)(dec + row_ * 512 + hc0 + 4); rw.sc = *(const f32x4*)(sc4 + (row_ * 8 + h) * 4); } while (0)
#define RW_FINISH() do { float r_[8], k_[8], v_[8], rp_[8], kp_[8], vp_[8], a_[8]; unpack8(rw.r, r_); unpack8(rw.k, k_); unpack8(rw.v, v_); unpack8(rw.rp, rp_); unpack8(rw.kp, kp_); unpack8(rw.vp, vp_); unpack8(rw.a, a_); \
            float ow_[8], oq_[8], ob_[8], ok_[8], ou_[8], ov_[8]; \
            _Pragma("unroll") for (int i = 0; i < 8; ++i) { const float rr = r_[i] + p_mr[i] * (rp_[i] - r_[i]), k0 = k_[i] + p_mk[i] * (kp_[i] - k_[i]), vv = v_[i] + p_mv[i] * (vp_[i] - v_[i]), w = i < 4 ? rw.w0[i & 3] : rw.w1[i & 3]; \
                const float kk = k0 * p_kk[i] * rw.sc[0]; ow_[i] = w; oq_[i] = kk; ob_[i] = -(kk * a_[i]); ok_[i] = k0 * (1.0f + (a_[i] - 1.0f) * p_ka[i]); ou_[i] = w * rr - rw.sc[1] * kk; ov_[i] = vv; } \
            LAS unsigned char* d_ = lds + sst * 128 + c8 * 2; \
            *(LAS u32x4*)(d_ + RW_LW) = pack8h(ow_); *(LAS u32x4*)(d_ + RW_LKK) = pack8h(oq_); *(LAS u32x4*)(d_ + RW_LBB) = pack8h(ob_); *(LAS u32x4*)(d_ + RW_LK2) = pack8h(ok_); *(LAS u32x4*)(d_ + RW_LWR) = pack8h(ou_); \
            if ((c8 >> 5) == rh) { LAS float* dv_ = (LAS float*)(lds + RW_LV + sst * 256 + (c8 & 31) * 8); const float c2_ = rw.sc[2]; \
                *(LAS f32x4*)dv_ = (f32x4){ov_[0], ov_[0] * c2_, ov_[1], ov_[1] * c2_}; *(LAS f32x4*)(dv_ + 4) = (f32x4){ov_[2], ov_[2] * c2_, ov_[3], ov_[3] * c2_}; \
                *(LAS f32x4*)(dv_ + 8) = (f32x4){ov_[4], ov_[4] * c2_, ov_[5], ov_[5] * c2_}; *(LAS f32x4*)(dv_ + 12) = (f32x4){ov_[6], ov_[6] * c2_, ov_[7], ov_[7] * c2_}; } } while (0)
        RW_LOAD(0);
        RW_FINISH();
        __syncthreads();
        for (int n = 0; n < T / 64; ++n) {
            if (n + 1 < T / 64) RW_LOAD(n + 1);
            if (tid >= 256) {
                if (conv) rope_row(n * (G * 4) + bx * 4 + ((tid >> 6) - 4), ZW, QRB, posi, (LAS float*)(lds + 100 * 1024 + 4 * 8704 + ((tid >> 6) - 4) * 256), tid & 63, true);
                const int it_ = n * (G * 4) + bx * 4 + ((tid >> 6) - 4);
                if (conv && it_ < MOE_CONV_ITEMS) conv_moe_item(mw1, mw3, mw2, 0, w13, w2t, (LAS float*)(lds + 100 * 1024 + ((tid >> 6) - 4) * 8704), it_, tid & 63);
                else if (conv && it_ - MOE_CONV_ITEMS < 2 * 16 * 256 * 2) cmpcomb_row(it_ - MOE_CONV_ITEMS, HC, cb, cw2, KVC, (LAS float*)(lds + 100 * 1024 + ((tid >> 6) - 4) * 8704), tid & 63);
                else if (conv && n >= 56) { const int li_ = (n - 56) * (G * 4) + bx * 4 + ((tid >> 6) - 4);
                    if (li_ < LATE_CONV_ITEMS) conv_late_item(li_, lodin, lodout, levout, lgate, lple, wsb, (LAS float*)(lds + 100 * 1024 + ((tid >> 6) - 4) * 8704), tid & 63); }
                else if (conv && n >= 40 && n < 56) {
                    const int lane_ = tid & 63, w_ = (n - 40) * (G * 4) + bx * 4 + ((tid >> 6) - 4);
#pragma unroll
                    for (int q = 0; q < 8; ++q) { const int row = w_ * 8 + q; const f32x4 v = *((const f32x4*)(pin + (size_t)row * PLE) + lane_);
                        bf16_t* dst = row < M ? pbf0 + (size_t)row * PLE : pbf1 + (size_t)(row - M) * PLE; *((u32x2*)dst + lane_) = (u32x2){cvt_pk_bf16(v[0], v[1]), cvt_pk_bf16(v[2], v[3])}; }
                }
            }
            if (tid < 256) {
            const int vb = kc * 16, vvb = RW_LV + rowl * 8;
            u32x4 cw = *(const LAS u32x4*)(lds + vb + RW_LW), cq = *(const LAS u32x4*)(lds + vb + RW_LKK), cb = *(const LAS u32x4*)(lds + vb + RW_LBB), ck = *(const LAS u32x4*)(lds + vb + RW_LK2), cu = *(const LAS u32x4*)(lds + vb + RW_LWR);
            f32x2 cv2 = *(const LAS f32x2*)(lds + vvb);
            LAS float* const obase = (kc == 0 ? (LAS float*)(lds + RW_LO) : (LAS float*)(lds + 136 * 1024)) + rowl;
#if PROBE_DUP == 10
            float T0[8];
#pragma unroll
            for (int i = 0; i < 8; ++i) T0[i] = S[i];
            for (int rep_ = 0; rep_ < 2; ++rep_) {
            if (rep_ == 1) {
#pragma unroll
                for (int i = 0; i < 8; ++i) S[i] = T0[i]; }
#endif
            __builtin_amdgcn_s_setprio(3);
#define MIXLO "op_sel_hi:[0,1,0]"
#define MIXHI "op_sel:[0,1,0] op_sel_hi:[0,1,0]"
#define DPPQ1 "quad_perm:[1,0,3,2] row_mask:0xf bank_mask:0xf bound_ctrl:1"
#define DPPQ2 "quad_perm:[2,3,0,1] row_mask:0xf bank_mask:0xf bound_ctrl:1"
#define DPPHM "row_half_mirror row_mask:0xf bank_mask:0xf bound_ctrl:1"
#pragma unroll 8
            for (int st = 0; st < 64; ++st) {
                const int sn = st + 1;
                const u32x4 nw = *(const LAS u32x4*)(lds + vb + RW_LW + sn * 128), nq = *(const LAS u32x4*)(lds + vb + RW_LKK + sn * 128), nb = *(const LAS u32x4*)(lds + vb + RW_LBB + sn * 128),
                            nk = *(const LAS u32x4*)(lds + vb + RW_LK2 + sn * 128), nu = *(const LAS u32x4*)(lds + vb + RW_LWR + sn * 128);
                const f32x2 nv2 = *(const LAS f32x2*)(lds + vvb + sn * 256);
                float sa, ov, t0, t1, t2, xa, xb, xc, xd;
                asm("v_fma_mix_f32 %[sa], %[s0], %[q0], 0 " MIXLO "\n\tv_fma_mix_f32 %[sb], %[s4], %[q2], 0 " MIXLO "\n\tv_fma_mix_f32 %[oa], %[s0], %[u0], 0 " MIXLO "\n\tv_fma_mix_f32 %[ob], %[s4], %[u2], 0 " MIXLO "\n\t"
                    "v_fma_mix_f32 %[sa], %[s1], %[q0], %[sa] " MIXHI "\n\tv_fma_mix_f32 %[sb], %[s5], %[q2], %[sb] " MIXHI "\n\tv_fma_mix_f32 %[oa], %[s1], %[u0], %[oa] " MIXHI "\n\tv_fma_mix_f32 %[ob], %[s5], %[u2], %[ob] " MIXHI "\n\t"
                    "v_fma_mix_f32 %[sa], %[s2], %[q1], %[sa] " MIXLO "\n\tv_fma_mix_f32 %[sb], %[s6], %[q3], %[sb] " MIXLO "\n\tv_fma_mix_f32 %[oa], %[s2], %[u1], %[oa] " MIXLO "\n\tv_fma_mix_f32 %[ob], %[s6], %[u3], %[ob] " MIXLO "\n\t"
                    "v_fma_mix_f32 %[sa], %[s3], %[q1], %[sa] " MIXHI "\n\tv_fma_mix_f32 %[sb], %[s7], %[q3], %[sb] " MIXHI "\n\tv_fma_mix_f32 %[oa], %[s3], %[u1], %[oa] " MIXHI "\n\tv_fma_mix_f32 %[ob], %[s7], %[u3], %[ob] " MIXHI "\n\t"
                    "v_add_f32 %[sa], %[sa], %[sb]\n\tv_add_f32 %[oa], %[oa], %[ob]\n\t"
                    "v_fma_mix_f32 %[t0], %[cv], %[k0], 0 " MIXLO "\n\tv_add_f32_dpp %[sa], %[sa], %[sa] " DPPQ1 "\n\tv_add_f32_dpp %[oa], %[oa], %[oa] " DPPQ1 "\n\t"
                    "v_fma_mix_f32 %[t1], %[cv], %[k0], 0 " MIXHI "\n\tv_add_f32_dpp %[sa], %[sa], %[sa] " DPPQ2 "\n\tv_add_f32_dpp %[oa], %[oa], %[oa] " DPPQ2 "\n\t"
                    "v_fma_mix_f32 %[t2], %[cv], %[k1], 0 " MIXLO "\n\tv_add_f32_dpp %[sa], %[sa], %[sa] " DPPHM "\n\tv_add_f32_dpp %[oa], %[oa], %[oa] " DPPHM "\n\t"
                    "v_add_f32 %[ov], %[oa], %[c1]"
                    : [sa] "=&v"(sa), [ov] "=&v"(ov), [t0] "=&v"(t0), [t1] "=&v"(t1), [t2] "=&v"(t2), [sb] "=&v"(xa), [oa] "=&v"(xb), [ob] "=&v"(xc)
                    : [s0] "v"(S[0]), [s1] "v"(S[1]), [s2] "v"(S[2]), [s3] "v"(S[3]), [s4] "v"(S[4]), [s5] "v"(S[5]), [s6] "v"(S[6]), [s7] "v"(S[7]),
                      [q0] "v"(cq.x), [q1] "v"(cq.y), [q2] "v"(cq.z), [q3] "v"(cq.w), [u0] "v"(cu.x), [u1] "v"(cu.y), [u2] "v"(cu.z), [u3] "v"(cu.w),
                      [cv] "v"(cv2[0]), [c1] "v"(cv2[1]), [k0] "v"(ck.x), [k1] "v"(ck.y));
                obase[st * 32] = ov;
                asm("v_fma_mix_f32 %[x], %[cv], %[k1], 0 " MIXHI "\n\tv_fma_mix_f32 %[y], %[sa], %[b0], %[t0] " MIXLO "\n\tv_fma_mix_f32 %[z], %[sa], %[b0], %[t1] " MIXHI "\n\t"
                    "v_fma_mix_f32 %[s0], %[s0], %[w0], %[y] " MIXLO "\n\tv_fma_mix_f32 %[y], %[sa], %[b1], %[t2] " MIXLO "\n\tv_fma_mix_f32 %[s1], %[s1], %[w0], %[z] " MIXHI "\n\t"
                    "v_fma_mix_f32 %[x], %[sa], %[b1], %[x] " MIXHI "\n\tv_fma_mix_f32 %[s2], %[s2], %[w1], %[y] " MIXLO "\n\tv_fma_mix_f32 %[s3], %[s3], %[w1], %[x] " MIXHI
                    : [s0] "+v"(S[0]), [s1] "+v"(S[1]), [s2] "+v"(S[2]), [s3] "+v"(S[3]), [x] "=&v"(xa), [y] "=&v"(xb), [z] "=&v"(xc)
                    : [sa] "v"(sa), [cv] "v"(cv2[0]), [t0] "v"(t0), [t1] "v"(t1), [t2] "v"(t2), [k1] "v"(ck.y), [b0] "v"(cb.x), [b1] "v"(cb.y), [w0] "v"(cw.x), [w1] "v"(cw.y));
                asm("v_fma_mix_f32 %[x], %[cv], %[k2], 0 " MIXLO "\n\tv_fma_mix_f32 %[y], %[cv], %[k2], 0 " MIXHI "\n\tv_fma_mix_f32 %[z], %[cv], %[k3], 0 " MIXLO "\n\tv_fma_mix_f32 %[u], %[cv], %[k3], 0 " MIXHI "\n\t"
                    "v_fma_mix_f32 %[x], %[sa], %[b2], %[x] " MIXLO "\n\tv_fma_mix_f32 %[y], %[sa], %[b2], %[y] " MIXHI "\n\tv_fma_mix_f32 %[z], %[sa], %[b3], %[z] " MIXLO "\n\tv_fma_mix_f32 %[u], %[sa], %[b3], %[u] " MIXHI "\n\t"
                    "v_fma_mix_f32 %[s4], %[s4], %[w2], %[x] " MIXLO "\n\tv_fma_mix_f32 %[s5], %[s5], %[w2], %[y] " MIXHI "\n\tv_fma_mix_f32 %[s6], %[s6], %[w3], %[z] " MIXLO "\n\tv_fma_mix_f32 %[s7], %[s7], %[w3], %[u] " MIXHI
                    : [s4] "+v"(S[4]), [s5] "+v"(S[5]), [s6] "+v"(S[6]), [s7] "+v"(S[7]), [x] "=&v"(xa), [y] "=&v"(xb), [z] "=&v"(xc), [u] "=&v"(xd)
                    : [sa] "v"(sa), [cv] "v"(cv2[0]), [k2] "v"(ck.z), [k3] "v"(ck.w), [b2] "v"(cb.z), [b3] "v"(cb.w), [w2] "v"(cw.z), [w3] "v"(cw.w));
                cw = nw; cq = nq; cb = nb; ck = nk; cu = nu; cv2 = nv2;
            }
#undef MIXLO
#undef MIXHI
#undef DPPQ1
#undef DPPQ2
#undef DPPHM
            __builtin_amdgcn_s_setprio(0);
#if PROBE_DUP == 10
            }
#endif
            }
            __syncthreads();
            { const int st = tid >> 3, r4 = (tid & 7) * 4; const f32x4 o = *(const LAS f32x4*)(lds + RW_LO + st * 128 + r4 * 4);
              *(u32x2*)(Y + (size_t)(b * T + n * 64 + st) * D + h * 64 + rh * 32 + r4) = (u32x2){cvt_pk_bf16(o[0], o[1]), cvt_pk_bf16(o[2], o[3])}; }
            if (n + 1 < T / 64) RW_FINISH();
            __syncthreads();
        }
#undef RW_LOAD
#undef RW_FINISH
    }
}

typedef short s16x4 __attribute__((ext_vector_type(4)));
constexpr int AT_KS = 144, AT_VS = 192, AT_KT = 64 * AT_KS, AT_VT = 64 * AT_VS;
constexpr int AT_LK = 0, AT_LV = 4 * AT_KT, AT_LIT = AT_LV + 4 * AT_VT, AT_LIH = AT_LIT + 16384, AT_LSM = AT_LIH + 16384, AT_LKEY = AT_LSM + 512, AT_LEND = AT_LKEY + 32768;
static_assert(AT_LEND <= 163840 - 512, "attention lds");
constexpr float AT_C = 0.125f * 1.4426950408889634f;
constexpr float AT_NEG = -1.0e30f;
__device__ __forceinline__ void qk_tile(const LAS unsigned char* Kt, const bf16x8 (&Q)[4], int l32, int half, f32x16& s0, f32x16& s1) {
#pragma unroll
    for (int r = 0; r < 16; ++r) { s0[r] = 0.f; s1[r] = 0.f; }
#pragma unroll
    for (int s = 0; s < 4; ++s) {
        const bf16x8 a0 = *(const LAS bf16x8*)(Kt + l32 * AT_KS + (16 * s + 8 * half) * 2), a1 = *(const LAS bf16x8*)(Kt + (32 + l32) * AT_KS + (16 * s + 8 * half) * 2);
        s0 = MFMA32(a0, Q[s], s0); s1 = MFMA32(a1, Q[s], s1);
    }
}
#define AT_TR4(vb, OFF, r00, r01, r10, r11) asm volatile("ds_read_b64_tr_b16 %0, %4 offset:%5\n\tds_read_b64_tr_b16 %1, %4 offset:%6\n\tds_read_b64_tr_b16 %2, %4 offset:%7\n\tds_read_b64_tr_b16 %3, %4 offset:%8\n\ts_waitcnt lgkmcnt(0)" \
    : "=&v"(r00), "=&v"(r01), "=&v"(r10), "=&v"(r11) : "v"(vb), "i"(OFF), "i"((OFF) + 8 * AT_VS), "i"((OFF) + 64), "i"((OFF) + 8 * AT_VS + 64) : "memory")
__device__ __forceinline__ bf16x8 pack8(const f32x16& p, int s2) {
    u32x4 w; w.x = cvt_pk_bf16(p[8 * s2], p[8 * s2 + 1]); w.y = cvt_pk_bf16(p[8 * s2 + 2], p[8 * s2 + 3]); w.z = cvt_pk_bf16(p[8 * s2 + 4], p[8 * s2 + 5]); w.w = cvt_pk_bf16(p[8 * s2 + 6], p[8 * s2 + 7]);
    return __builtin_bit_cast(bf16x8, w);
}
#define AT_TR8(vb, OFF, r0, r1, r2, r3, r4, r5, r6, r7) asm volatile("ds_read_b64_tr_b16 %0, %8 offset:%9\n\tds_read_b64_tr_b16 %1, %8 offset:%10\n\tds_read_b64_tr_b16 %2, %8 offset:%11\n\tds_read_b64_tr_b16 %3, %8 offset:%12\n\t" \
    "ds_read_b64_tr_b16 %4, %8 offset:%13\n\tds_read_b64_tr_b16 %5, %8 offset:%14\n\tds_read_b64_tr_b16 %6, %8 offset:%15\n\tds_read_b64_tr_b16 %7, %8 offset:%16\n\ts_waitcnt lgkmcnt(0)" \
    : "=&v"(r0), "=&v"(r1), "=&v"(r2), "=&v"(r3), "=&v"(r4), "=&v"(r5), "=&v"(r6), "=&v"(r7) \
    : "v"(vb), "i"(OFF), "i"((OFF) + 8 * AT_VS), "i"((OFF) + 64), "i"((OFF) + 8 * AT_VS + 64), "i"((OFF) + 16 * AT_VS), "i"((OFF) + 24 * AT_VS), "i"((OFF) + 16 * AT_VS + 64), "i"((OFF) + 24 * AT_VS + 64) : "memory")
__device__ __forceinline__ void pv_tile(unsigned vb, const f32x16& p0, const f32x16& p1, f32x16& O0, f32x16& O1, bool zero_all) {
    s16x4 r0, r1, r2, r3, r4, r5, r6, r7;
    const bf16x8 zf = (bf16x8){0, 0, 0, 0, 0, 0, 0, 0};
#define AT_PV2(P, OFF) { bf16x8 b0 = pack8(P, 0), b1 = pack8(P, 1); if (zero_all) { b0 = zf; b1 = zf; } AT_TR8(vb, OFF, r0, r1, r2, r3, r4, r5, r6, r7); \
        const bf16x8 a00 = __builtin_shufflevector(r0, r1, 0, 1, 2, 3, 4, 5, 6, 7), a01 = __builtin_shufflevector(r2, r3, 0, 1, 2, 3, 4, 5, 6, 7), a10 = __builtin_shufflevector(r4, r5, 0, 1, 2, 3, 4, 5, 6, 7), a11 = __builtin_shufflevector(r6, r7, 0, 1, 2, 3, 4, 5, 6, 7); \
        O0 = MFMA32(a00, b0, O0); O1 = MFMA32(a01, b0, O1); O0 = MFMA32(a10, b1, O0); O1 = MFMA32(a11, b1, O1); }
    AT_PV2(p0, 0) AT_PV2(p1, 32 * AT_VS)
#undef AT_PV2
}
template <int CTRL> __device__ __forceinline__ float dppq(float v) { return __builtin_bit_cast(float, __builtin_amdgcn_update_dpp(0, __builtin_bit_cast(int, v), CTRL, 0xf, 0xf, false)); }
__device__ __forceinline__ float sum4(float v) { v += dppq<0xB1>(v); v += dppq<0x4E>(v); return v; }
__device__ __forceinline__ void xhalf_swap(float& a, float& b) { asm volatile("s_nop 1\n\tv_permlane32_swap_b32 %0, %1\n\ts_nop 1" : "+v"(a), "+v"(b)); }
__device__ __forceinline__ float xhalf_max(float v) { float a = v, b = v; asm volatile("s_nop 1\n\tv_permlane32_swap_b32 %0, %1\n\ts_nop 1\n\tv_max_f32 %0, %0, %1" : "+v"(a), "+v"(b)); return a; }
__device__ __forceinline__ float max32(const f32x16& a, const f32x16& b) {
    float m;
    asm("v_max3_f32 %0, %1, %2, %3\n\tv_max3_f32 %0, %0, %4, %5\n\tv_max3_f32 %0, %0, %6, %7\n\tv_max3_f32 %0, %0, %8, %9\n\tv_max3_f32 %0, %0, %10, %11\n\tv_max3_f32 %0, %0, %12, %13\n\tv_max3_f32 %0, %0, %14, %15\n\t"
        "v_max3_f32 %0, %0, %16, %17\n\tv_max3_f32 %0, %0, %18, %19\n\tv_max3_f32 %0, %0, %20, %21\n\tv_max3_f32 %0, %0, %22, %23\n\tv_max3_f32 %0, %0, %24, %25\n\tv_max3_f32 %0, %0, %26, %27\n\tv_max3_f32 %0, %0, %28, %29"
        : "=&v"(m) : "v"(a[0]), "v"(a[1]), "v"(a[2]), "v"(a[3]), "v"(a[4]), "v"(a[5]), "v"(a[6]), "v"(a[7]), "v"(a[8]), "v"(a[9]), "v"(a[10]), "v"(a[11]), "v"(a[12]), "v"(a[13]), "v"(a[14]), "v"(a[15]),
                     "v"(b[0]), "v"(b[1]), "v"(b[2]), "v"(b[3]), "v"(b[4]), "v"(b[5]), "v"(b[6]), "v"(b[7]), "v"(b[8]), "v"(b[9]), "v"(b[10]), "v"(b[11]), "v"(b[12]));
    asm("v_max3_f32 %0, %0, %1, %2\n\tv_max_f32 %0, %0, %3" : "+v"(m) : "v"(b[13]), "v"(b[14]), "v"(b[15]));
    return m;
}
__device__ __forceinline__ float xhalf_sum(float v) { float a = v, b = v; xhalf_swap(a, b); return a + b; }
constexpr float AT_THR = 8.0f / AT_C;
template <int MODE>
__device__ __forceinline__ void attn_tile(const LAS unsigned char* Kt, unsigned vb, const bf16x8 (&Q)[4], int l32, int half, bool on, bool edge, int dbase, float& mrun, float& lrun, f32x16& O0, f32x16& O1) {
    f32x16 s0, s1;
    qk_tile(Kt, Q, l32, half, s0, s1);
#if PROBE_DUP == 33
    { float keep_ = s0[0]; asm volatile("" : "+v"(keep_)); qk_tile(Kt, Q, l32, half, s0, s1); s0[0] = 0.5f * (s0[0] + keep_); }
#endif
    if (edge) {
#pragma unroll
        for (int r = 0; r < 16; ++r) {
            const int d0 = dbase - ((r & 3) + 8 * (r >> 2)), d1 = d0 - 32;
            const bool v0 = (MODE == 1 ? d0 >= 0 : (unsigned)d0 < 512u), v1 = (MODE == 1 ? d1 >= 0 : (unsigned)d1 < 512u);
            s0[r] = v0 ? s0[r] : AT_NEG; s1[r] = v1 ? s1[r] : AT_NEG;
        }
    }
    float mt = max32(s0, s1);
    mt = on ? mt : AT_NEG;
    mt = xhalf_max(mt);
    if (__any(mt > mrun + AT_THR)) {
        const float mnew = fmaxf(mrun, mt), alpha = __builtin_amdgcn_exp2f(AT_C * (mrun - mnew)); mrun = mnew; lrun *= alpha;
#pragma unroll
        for (int r = 0; r < 16; ++r) { O0[r] *= alpha; O1[r] *= alpha; }
    }
    const float mc = on ? mrun * AT_C : 1.0e30f;
    f32x16 p0, p1;
#pragma unroll
    for (int r = 0; r < 16; ++r) { p0[r] = __builtin_amdgcn_exp2f(__builtin_fmaf(s0[r], AT_C, -mc)); p1[r] = __builtin_amdgcn_exp2f(__builtin_fmaf(s1[r], AT_C, -mc)); }
#if PROBE_DUP == 34
    { float mc2 = mc; asm volatile("" : "+v"(mc2));
#pragma unroll
      for (int r = 0; r < 16; ++r) { p0[r] = 0.5f * (p0[r] + __builtin_amdgcn_exp2f(__builtin_fmaf(s0[r], AT_C, -mc2))); p1[r] = 0.5f * (p1[r] + __builtin_amdgcn_exp2f(__builtin_fmaf(s1[r], AT_C, -mc2))); } }
#endif
    if (edge) {
#pragma unroll
        for (int r = 0; r < 16; ++r) { p0[r] = s0[r] > 0.5f * AT_NEG ? p0[r] : 0.f; p1[r] = s1[r] > 0.5f * AT_NEG ? p1[r] : 0.f; }
    }
    float ps = 0.f;
#pragma unroll
    for (int r = 0; r < 16; ++r) ps += p0[r] + p1[r];
    lrun += ps;
#if PROBE_DUP == 35
#pragma unroll
    for (int r = 0; r < 16; ++r) { p0[r] *= 0.5f; p1[r] *= 0.5f; }
    pv_tile(vb, p0, p1, O0, O1, false);
#endif
    pv_tile(vb, p0, p1, O0, O1, false);
}
template <int MODE>
__device__ __forceinline__ void attn_stream(LAS unsigned char* lds, const bf16_t* Kg, const bf16_t* Vg, int jlo, int cur, int tokl, const bf16x8 (&Q)[4], unsigned selm_lo, unsigned selm_hi,
                                            int tid, int l32, int half, unsigned vb0, f32x16& O0, f32x16& O1, float& lout) {
    const int key = tid >> 3, chunk = tid & 7;
    const size_t goff = (size_t)key * EVP + chunk * 8;
    const unsigned kofs = key * AT_KS + chunk * 16, vofs = key * AT_VS + chunk * 16;
#define AT_GLD(kr, vr, jj) do { const int j_ = (jj) <= cur ? (jj) : cur; kr = *(const u32x4*)(Kg + (size_t)j_ * 64 * EVP + goff); vr = *(const u32x4*)(Vg + (size_t)j_ * 64 * EVP + goff); } while (0)
#define AT_LST(kr, vr, jj) do { const int nb_ = (jj) & 3; *(LAS u32x4*)(lds + AT_LK + nb_ * AT_KT + kofs) = kr; *(LAS u32x4*)(lds + AT_LV + nb_ * AT_VT + vofs) = vr; } while (0)
    u32x4 ka, va, kb, vb;
    AT_GLD(ka, va, jlo); AT_GLD(kb, vb, jlo + 1);
    AT_LST(ka, va, jlo); AT_LST(kb, vb, jlo + 1);
    __syncthreads();
    float mrun = AT_NEG, lrun = 0.f;
#pragma unroll
    for (int r = 0; r < 16; ++r) { O0[r] = 0.f; O1[r] = 0.f; }
    for (int j = jlo; j <= cur; j += 2) {
        AT_GLD(ka, va, j + 2); AT_GLD(kb, vb, j + 3);
#pragma unroll
        for (int u = 0; u < 2; ++u) {
            const int jj = j + u;
            if (jj <= cur) {
                const int buf = jj & 3;
                bool on = true;
                if (MODE == 1) on = ((jj < 32 ? (selm_lo >> jj) : (selm_hi >> (jj - 32))) & 1u) != 0u;
                const int dbase = (cur - jj) * 64 + tokl - 4 * half;
                const bool edge = (jj == cur) || (MODE == 2 && cur >= 8 && jj == jlo);
                if (MODE != 1 || __any(on)) attn_tile<MODE>(lds + AT_LK + buf * AT_KT, vb0 + buf * AT_VT, Q, l32, half, on, edge, dbase, mrun, lrun, O0, O1);
            }
        }
        AT_LST(ka, va, j + 2); AT_LST(kb, vb, j + 3);
        __syncthreads();
    }
#undef AT_GLD
#undef AT_LST
    lout = xhalf_sum(lrun);
}

__device__ __forceinline__ void nsa_attn_phase(LAS unsigned char* lds, const bf16_t* Z, const bf16_t* QR, const bf16_t* KVC, bf16_t* Y, int G, int bx) {
    for (int it = 0;; ++it) {
        const int L = it * G + bx; if (L >= NB * 2 * 64) break;
        const int tid = pinned_tid(), lane = tid & 63, wave = __builtin_amdgcn_readfirstlane(tid >> 6), half = lane >> 5, l32 = lane & 31;
        const unsigned vb0 = (unsigned)(AT_LV + (4 * half + ((lane & 15) >> 2)) * AT_VS + (16 * ((lane >> 4) & 1) + 4 * (lane & 3)) * 2);
        const int tokl = 8 * wave + (l32 >> 2), g = l32 & 3;
        const int qt = (G == 256) ? 63 - (8 * it + ((it & 1) ? 7 - (bx >> 5) : (bx >> 5))) : 63 - (L >> 5);
        const int bh = L & 31, b = bh >> 1, hk = bh & 1, t0 = qt * 64, t = t0 + tokl, head = hk * 4 + g, cur = qt;
        const size_t m = (size_t)b * T + t;
        bf16x8 Qraw[4], Qrot[4];
#pragma unroll
        for (int s = 0; s < 4; ++s) { Qraw[s] = *(const bf16x8*)(Z + m * EVP + 1792 + head * 64 + 16 * s + 8 * half); Qrot[s] = *(const bf16x8*)(QR + m * 512 + head * 64 + 16 * s + 8 * half); }
        const float gate_c = sigmoidf_(bf2f(Z[m * EVP + 3072 + head * 3])), gate_s = sigmoidf_(bf2f(Z[m * EVP + 3072 + head * 3 + 1])), gate_w = sigmoidf_(bf2f(Z[m * EVP + 3072 + head * 3 + 2]));
        f32x16 Y0, Y1;
        const int nct = (4 * qt + 3 + 63) >> 6;
        unsigned selm_lo = 0u, selm_hi = 0u;
        for (int repc_ = 0; repc_ < (PROBE_DUP == 30 ? 2 : 1); ++repc_) {
        { const int key = tid >> 3, chunk = tid & 7; const bf16_t* kc = KVC + ((size_t)(b * 2 + hk) * 256) * 64; const bf16_t* vc = kc + (size_t)32 * 256 * 64;
          for (int jt = 0; jt < nct; ++jt) { *(LAS u32x4*)(lds + AT_LK + jt * AT_KT + key * AT_KS + chunk * 16) = *(const u32x4*)(kc + (size_t)(jt * 64 + key) * 64 + chunk * 8);
                                             *(LAS u32x4*)(lds + AT_LV + jt * AT_VT + key * AT_VS + chunk * 16) = *(const u32x4*)(vc + (size_t)(jt * 64 + key) * 64 + chunk * 8); }
#pragma unroll
          for (int q = 0; q < 8; ++q) { ((LAS float*)(lds + AT_LIT))[(8 * wave + q) * 64 + lane] = 0.f; ((LAS float*)(lds + AT_LIH))[(8 * wave + q) * 64 + lane] = 0.f; } }
        __syncthreads();
        {
            const int nvalid = t >= 31 ? ((t - 31) >> 4) + 1 : 0;
            float mrun = AT_NEG, lrun = 0.f;
            for (int jt = 0; jt < nct; ++jt) {
                f32x16 s0, s1; qk_tile(lds + AT_LK + jt * AT_KT, Qraw, l32, half, s0, s1);
                const int nb = nvalid - 64 * jt - 4 * half;
                float mt = AT_NEG;
#pragma unroll
                for (int r = 0; r < 16; ++r) { const int o = (r & 3) + 8 * (r >> 2); s0[r] = o < nb ? s0[r] : AT_NEG; s1[r] = o + 32 < nb ? s1[r] : AT_NEG; mt = fmaxf(mt, fmaxf(s0[r], s1[r])); }
                mt = xhalf_max(mt);
                const float mnew = fmaxf(mrun, mt); lrun *= __builtin_amdgcn_exp2f(AT_C * (mrun - mnew)); mrun = mnew;
#pragma unroll
                for (int r = 0; r < 16; ++r) { lrun += (s0[r] > 0.5f * AT_NEG ? __builtin_amdgcn_exp2f(AT_C * (s0[r] - mnew)) : 0.f) + (s1[r] > 0.5f * AT_NEG ? __builtin_amdgcn_exp2f(AT_C * (s1[r] - mnew)) : 0.f); }
            }
            const float lt = xhalf_sum(lrun), inv = lt > 0.f ? 1.0f / lt : 0.f;
            f32x16 O0, O1;
#pragma unroll
            for (int r = 0; r < 16; ++r) { O0[r] = 0.f; O1[r] = 0.f; }
            for (int jt = 0; jt < nct; ++jt) {
                f32x16 s0, s1; qk_tile(lds + AT_LK + jt * AT_KT, Qraw, l32, half, s0, s1);
                const int nb = nvalid - 64 * jt - 4 * half;
#pragma unroll
                for (int r = 0; r < 16; ++r) { const int o = (r & 3) + 8 * (r >> 2); s0[r] = o < nb ? __builtin_amdgcn_exp2f(AT_C * (s0[r] - mrun)) * inv : 0.f; s1[r] = o + 32 < nb ? __builtin_amdgcn_exp2f(AT_C * (s1[r] - mrun)) * inv : 0.f; }
#pragma unroll
                for (int g4 = 0; g4 < 4; ++g4) {
                    const float ta = sum4((s0[4 * g4] + s0[4 * g4 + 1]) + (s0[4 * g4 + 2] + s0[4 * g4 + 3])), ha = sum4(0.5f * s0[4 * g4 + 3]);
                    const float tb = sum4((s1[4 * g4] + s1[4 * g4 + 1]) + (s1[4 * g4 + 2] + s1[4 * g4 + 3])), hb = sum4(0.5f * s1[4 * g4 + 3]);
                    if (g == 0) { const int sa = 16 * jt + 2 * g4 + half; ((LAS float*)(lds + AT_LIT))[tokl * 64 + sa] = ta; ((LAS float*)(lds + AT_LIH))[tokl * 64 + sa] = ha;
                                  ((LAS float*)(lds + AT_LIT))[tokl * 64 + sa + 8] = tb; ((LAS float*)(lds + AT_LIH))[tokl * 64 + sa + 8] = hb; }
                }
                pv_tile(vb0 + jt * AT_VT, s0, s1, O0, O1, false);
            }
#pragma unroll
            for (int r = 0; r < 16; ++r) { Y0[r] = gate_c * O0[r]; Y1[r] = gate_c * O1[r]; }
        }
        {
            LDS_WAIT();
            const int tk = 8 * wave + (lane >> 3), sb = (lane & 7) * 8;
            float v[8];
#pragma unroll
            for (int i = 0; i < 8; ++i) { const int sidx = sb + i;
                float x = ((const LAS float*)(lds + AT_LIT))[tk * 64 + sidx] - ((const LAS float*)(lds + AT_LIH))[tk * 64 + sidx];
                if (sidx > 0) x += ((const LAS float*)(lds + AT_LIH))[tk * 64 + sidx - 1];
                if (sidx == 0 || sidx == cur || sidx == cur - 1) x = 3.0e38f; else if (sidx > cur) x = -3.0e38f;
                v[i] = x; }
            unsigned long long key[8];
#pragma unroll
            for (int i = 0; i < 8; ++i) { const unsigned u = __float_as_uint(v[i]), mu_ = (u & 0x80000000u) ? ~u : (u | 0x80000000u); key[i] = ((unsigned long long)mu_ << 32) | (unsigned)(63 - (sb + i));
                ((LAS unsigned long long*)(lds + AT_LKEY))[tk * 64 + sb + i] = key[i]; }
            LDS_WAIT();
            int rank[8];
#pragma unroll
            for (int i = 0; i < 8; ++i) rank[i] = 0;
#pragma unroll 4
            for (int sp = 0; sp < 64; ++sp) { const unsigned long long x = ((const LAS unsigned long long*)(lds + AT_LKEY))[tk * 64 + sp];
#pragma unroll
                for (int i = 0; i < 8; ++i) rank[i] += (x > key[i]) ? 1 : 0; }
            unsigned byte = 0u;
#pragma unroll
            for (int i = 0; i < 8; ++i) byte |= (rank[i] < 16 && sb + i <= cur) ? (1u << i) : 0u;
            ((LAS unsigned char*)(lds + AT_LSM))[tk * 8 + (lane & 7)] = (unsigned char)byte;
            LDS_WAIT();
            const u32x2 sm = *(const LAS u32x2*)(lds + AT_LSM + tokl * 8); selm_lo = sm.x; selm_hi = sm.y;
        }
        __syncthreads();
        }
        const bf16_t* zb = Z + ((size_t)b * T) * EVP + hk * 64;
        {
            f32x16 O0, O1; float lt;
            for (int rep_ = 0; rep_ < (PROBE_DUP == 31 ? 2 : 1); ++rep_) attn_stream<1>(lds, zb + 2560, zb + 2688, 0, cur, tokl, Qrot, selm_lo, selm_hi, tid, l32, half, vb0, O0, O1, lt);
            const float sc = lt > 0.f ? gate_s / lt : 0.f;
#pragma unroll
            for (int r = 0; r < 16; ++r) { Y0[r] += sc * O0[r]; Y1[r] += sc * O1[r]; }
        }
        {
            f32x16 O0, O1; float lt;
            for (int rep_ = 0; rep_ < (PROBE_DUP == 32 ? 2 : 1); ++rep_) attn_stream<2>(lds, zb + 2816, zb + 2944, cur >= 8 ? cur - 8 : 0, cur, tokl, Qrot, 0u, 0u, tid, l32, half, vb0, O0, O1, lt);
            const float sc = lt > 0.f ? gate_w / lt : 0.f;
#pragma unroll
            for (int r = 0; r < 16; ++r) { Y0[r] += sc * O0[r]; Y1[r] += sc * O1[r]; }
        }
        bf16_t* yo = Y + m * D + 512 + head * 64;
#pragma unroll
        for (int g4 = 0; g4 < 4; ++g4) {
            *(u32x2*)(yo + 8 * g4 + 4 * half) = (u32x2){cvt_pk_bf16(Y0[4 * g4], Y0[4 * g4 + 1]), cvt_pk_bf16(Y0[4 * g4 + 2], Y0[4 * g4 + 3])};
            *(u32x2*)(yo + 32 + 8 * g4 + 4 * half) = (u32x2){cvt_pk_bf16(Y1[4 * g4], Y1[4 * g4 + 1]), cvt_pk_bf16(Y1[4 * g4 + 2], Y1[4 * g4 + 3])};
        }
    }
}

constexpr int LDS_BYTES = 163840;
constexpr int LDSCTL_OFF = LDS_BYTES - 512;
constexpr int RING_BYTES = 131072;

struct Args { const void* in[34]; float* out; unsigned char* ws; int ph_lo, ph_hi; };

enum { I_X = 0, I_P, I_POS, I_EVWIN, I_EVWOUT, I_MU, I_W0, I_W2, I_A0, I_A2, I_G2, I_KK, I_KA, I_RK, I_GNG, I_GNB, I_CPOS, I_CW1, I_CW2, I_ODWIN, I_ODWOUT,
       I_HGLB, I_HGNG, I_WRG, I_BRG, I_WRE, I_BRE, I_MW1, I_MW3, I_MW2, I_LNG, I_LNB, I_PLEW, I_PLEGW };

__device__ __forceinline__ void transpose_item(const float* W, int ldw, int k0, int n0, int nvalid, bf16_t* WT, int ldt, int drow0, int dcol0, LAS float* scr, int lane) {
    const int nl = lane & 31; const bool ok = (n0 + nl) < nvalid;
#pragma unroll 8
    for (int i = 0; i < 32; ++i) { const int kk = 2 * i + (lane >> 5); scr[kk * 33 + nl] = ok ? W[(size_t)(k0 + kk) * ldw + n0 + nl] : 0.f; }
    LDS_WAIT(); asm volatile("" ::: "memory");
    const int c = lane & 7;
#pragma unroll
    for (int j = 0; j < 4; ++j) { const int n = (lane >> 3) + 8 * j; const LAS float* s = scr + (8 * c) * 33 + n;
        u32x4 o; o.x = cvt_pk_bf16(s[0 * 33], s[1 * 33]); o.y = cvt_pk_bf16(s[2 * 33], s[3 * 33]); o.z = cvt_pk_bf16(s[4 * 33], s[5 * 33]); o.w = cvt_pk_bf16(s[6 * 33], s[7 * 33]);
        *(u32x4*)(WT + (size_t)(drow0 + n) * ldt + dcol0 + k0 + 8 * c) = o; }
    LDS_WAIT(); asm volatile("" ::: "memory");
}
__device__ __forceinline__ void transpose_item_f8(const float* W, int ldw, int k0, int n0, unsigned char* WT, int ldt, int drow0, LAS float* scr, int lane) {
    const int nl = lane & 31;
#pragma unroll 8
    for (int i = 0; i < 32; ++i) { const int kk = 2 * i + (lane >> 5); scr[kk * 33 + nl] = W[(size_t)(k0 + kk) * ldw + n0 + nl]; }
    LDS_WAIT(); asm volatile("" ::: "memory");
    const int c = lane & 7;
#pragma unroll
    for (int j = 0; j < 4; ++j) { const int n = (lane >> 3) + 8 * j; const LAS float* sp = scr + (8 * c) * 33 + n;
        *(u32x2*)(WT + (size_t)(drow0 + n) * ldt + k0 + 8 * c) = (u32x2){cvt_pk4_fp8(sp[0 * 33], sp[1 * 33], sp[2 * 33], sp[3 * 33]), cvt_pk4_fp8(sp[4 * 33], sp[5 * 33], sp[6 * 33], sp[7 * 33])}; }
    LDS_WAIT(); asm volatile("" ::: "memory");
}
__device__ __forceinline__ void conv_late_item(int it, const float* odin, const float* odout, const float* evout, const float* gatew, const float* plew, unsigned char* ws, LAS float* scr, int lane) {
    const float* W; bf16_t* WT; int K = D, N = D, q = it;
    if (it < 2048) { W = odin; WT = (bf16_t*)(ws + WS_WODIN); N = 4 * D; }
    else if (it < 2560) { q = it - 2048; W = odout; WT = (bf16_t*)(ws + WS_WODOUT); }
    else if (it < 3072) { q = it - 2560; W = evout; WT = (bf16_t*)(ws + WS_WEVOUT); }
    else if (it < 4096) { q = it - 3072; const int l_ = q >> 9; q &= 511; W = gatew + (size_t)l_ * D * D; WT = (bf16_t*)(ws + WS_WGATE) + (size_t)l_ * D * D; }
    else { q = it - 4096; const int l_ = q >> 7; q &= 127; K = PLE; W = plew + (size_t)l_ * PLE * D; WT = (bf16_t*)(ws + WS_WPLE) + (size_t)l_ * D * PLE; }
    const int nblk = N / 32, kb = q / nblk, nb = q % nblk;
    transpose_item(W, N, 64 * kb, 32 * nb, N, WT, K, 32 * nb, 0, scr, lane);
}
__device__ __forceinline__ void conv_matrix(const float* W, int K, int N, int npad, bf16_t* WT, LAS float* scr, int gw, int ngw, int lane) {
    const int nblk = npad / 32, nitems = (K / 64) * nblk;
    for (int it = gw; it < nitems; it += ngw) { const int kb = it / nblk, nb = it % nblk; transpose_item(W, N, 64 * kb, 32 * nb, N, WT, K, 32 * nb, 0, scr, lane); }
}
__device__ __forceinline__ void row_to_bf16(const float* xrow, bf16_t* orow, int lane) {
    const f32x4* xr = (const f32x4*)xrow + lane; u32x2* o8 = (u32x2*)orow + lane;
#pragma unroll
    for (int j = 0; j < 4; ++j) { const f32x4 v = xr[64 * j]; u32x2 w; w.x = cvt_pk_bf16(v[0], v[1]); w.y = cvt_pk_bf16(v[2], v[3]); o8[64 * j] = w; }
}
__device__ __forceinline__ void conv_moe_item(const float* w1, const float* w3, const float* w2, int li, bf16_t* w13, bf16_t* w2t, LAS float* scr, int it, int lane) {
    constexpr int I13 = (1024 / 64) * (512 / 32), I2 = (512 / 64) * (1024 / 32);
    if (it < NEXP * 2 * I13) {
        const int e = it / (2 * I13), r = it % (2 * I13), which = r / I13, q = r % I13, kb = q / 16, nb = q % 16, n0 = 32 * nb;
        const float* W = (which ? w3 : w1) + ((size_t)(li * NEXP + e)) * 1024 * 512;
        transpose_item_f8(W, 512, 64 * kb, n0, (unsigned char*)w13, 1024, e * 1024 + (n0 >> 7) * 256 + which * 128 + (n0 & 127), scr, lane);
    } else {
        const int it2 = it - NEXP * 2 * I13, e = it2 / I2, q = it2 % I2, kb = q / 32, nb = q % 32;
        transpose_item_f8(w2 + ((size_t)(li * NEXP + e)) * 512 * 1024, 1024, 64 * kb, 32 * nb, (unsigned char*)w2t, 512, e * 1024 + 32 * nb, scr, lane);
    }
}
__device__ __forceinline__ void conv_moe_weights(const float* w1, const float* w3, const float* w2, int li, bf16_t* w13, bf16_t* w2t, LAS float* scr, int gw, int ngw, int lane, int parts = 3) {
    constexpr int I13 = (1024 / 64) * (512 / 32);
    if (parts & 1) for (int it = gw; it < NEXP * 2 * I13; it += ngw) {
        const int e = it / (2 * I13), r = it % (2 * I13), which = r / I13, q = r % I13, kb = q / 16, nb = q % 16, n0 = 32 * nb;
        const float* W = (which ? w3 : w1) + ((size_t)(li * NEXP + e)) * 1024 * 512;
        transpose_item_f8(W, 512, 64 * kb, n0, (unsigned char*)w13, 1024, e * 1024 + (n0 >> 7) * 256 + which * 128 + (n0 & 127), scr, lane);
    }
    constexpr int I2 = (512 / 64) * (1024 / 32);
    if (parts & 2) for (int it = gw; it < NEXP * I2; it += ngw) {
        const int e = it / I2, q = it % I2, kb = q / 32, nb = q % 32;
        transpose_item_f8(w2 + ((size_t)(li * NEXP + e)) * 512 * 1024, 1024, 64 * kb, 32 * nb, (unsigned char*)w2t, 512, e * 1024 + 32 * nb, scr, lane);
    }
}

__device__ __forceinline__ int row_elem(int lane, int j) { return (j < 2 ? 0 : 512) + 8 * lane + 4 * (j & 1); }
__device__ __forceinline__ void load_row_bf16(const bf16_t* row, f32x4 (&v)[4], int lane) {
    const u32x4 a = *((const u32x4*)row + lane), b = *((const u32x4*)row + 64 + lane);
    v[0] = (f32x4){bflo(a.x), bfhi(a.x), bflo(a.y), bfhi(a.y)}; v[1] = (f32x4){bflo(a.z), bfhi(a.z), bflo(a.w), bfhi(a.w)};
    v[2] = (f32x4){bflo(b.x), bfhi(b.x), bflo(b.y), bfhi(b.y)}; v[3] = (f32x4){bflo(b.z), bfhi(b.z), bflo(b.w), bfhi(b.w)};
}
__device__ __forceinline__ void store_row_bf16(bf16_t* row, const f32x4 (&v)[4], int lane) {
    *((u32x4*)row + lane) = (u32x4){cvt_pk_bf16(v[0][0], v[0][1]), cvt_pk_bf16(v[0][2], v[0][3]), cvt_pk_bf16(v[1][0], v[1][1]), cvt_pk_bf16(v[1][2], v[1][3])};
    *((u32x4*)row + 64 + lane) = (u32x4){cvt_pk_bf16(v[2][0], v[2][1]), cvt_pk_bf16(v[2][2], v[2][3]), cvt_pk_bf16(v[3][0], v[3][1]), cvt_pk_bf16(v[3][2], v[3][3])};
}
__device__ __forceinline__ void ln_row(f32x4 (&v)[4], const float* g, const float* b, int lane) {
    float s = 0.f;
#pragma unroll
    for (int j = 0; j < 4; ++j) s += (v[j][0] + v[j][1]) + (v[j][2] + v[j][3]);
    const float mean = wave_sum(s) * (1.f / D); float s2 = 0.f;
#pragma unroll
    for (int j = 0; j < 4; ++j) { v[j] = v[j] - mean; s2 += (v[j][0] * v[j][0] + v[j][1] * v[j][1]) + (v[j][2] * v[j][2] + v[j][3] * v[j][3]); }
    const float rstd = __builtin_amdgcn_rsqf(wave_sum(s2) * (1.f / D) + LN_EPS);
#pragma unroll
    for (int j = 0; j < 4; ++j) { const f32x4 gg = *(const f32x4*)(g + row_elem(lane, j)), bb = *(const f32x4*)(b + row_elem(lane, j)); v[j] = v[j] * rstd * gg + bb; }
}

__device__ __forceinline__ const void* ptab_get(LAS unsigned char* lds, int i) {
    const unsigned long long v = ((const volatile LAS unsigned long long*)(lds + 163840 - 512 + 64))[i];
    const unsigned lo = __builtin_amdgcn_readfirstlane((unsigned)v), hi = __builtin_amdgcn_readfirstlane((unsigned)(v >> 32));
    return (const void*)(const GAS char*)(((unsigned long long)hi << 32) | lo);
}
#define INF(i) ((const float*)ptab_get(lds, (i)))
#define WSB ((unsigned char*)ptab_get(lds, 35))
#define OUTP ((float*)ptab_get(lds, 34))
__global__ void __launch_bounds__(NTHR, 2) fwd(Args args) {
    extern __shared__ __attribute__((aligned(16))) unsigned char lds_raw[];
    LAS unsigned char* lds = (LAS unsigned char*)lds_raw;
    const int G = gridDim.x, bx = blockIdx.x;
    const int vcu = (G % 8 == 0) ? (bx % 8) * (G / 8) + bx / 8 : bx;
    const int ngw = G * NWAVES;
#define PH_LOCALS const int tid = pinned_tid(), lane = tid & 63, wave = __builtin_amdgcn_readfirstlane(tid >> 6), gw = vcu * NWAVES + wave; (void)tid; (void)lane; (void)gw;
    LAS unsigned long long* ptab = (LAS unsigned long long*)(lds + LDSCTL_OFF + 64);
    for (int u = threadIdx.x; u < (LDS_BYTES - LDSCTL_OFF) / 4; u += NTHR) ((LAS unsigned*)(lds + LDSCTL_OFF))[u] = 0u;
    __syncthreads();
    if (threadIdx.x == 0) {
#define PT_(i) ptab[i] = (unsigned long long)args.in[i];
        PT_(0) PT_(1) PT_(2) PT_(3) PT_(4) PT_(5) PT_(6) PT_(7) PT_(8) PT_(9) PT_(10) PT_(11) PT_(12) PT_(13) PT_(14) PT_(15) PT_(16) PT_(17) PT_(18) PT_(19) PT_(20) PT_(21) PT_(22) PT_(23) PT_(24) PT_(25) PT_(26) PT_(27) PT_(28) PT_(29) PT_(30) PT_(31) PT_(32) PT_(33)
#undef PT_
        ptab[34] = (unsigned long long)args.out; ptab[35] = (unsigned long long)args.ws;
    }
    __syncthreads();
    XcdBarrier bar = xcd_barrier_post((unsigned*)(args.ws + WS_CTL) + CW_BAR, (volatile LAS unsigned*)(lds + LDSCTL_OFF + 32));
    const int lo = args.ph_lo, hi = args.ph_hi;
    int pc = 0;
#define PH_PTRS unsigned char* const ws = WSB; (void)ws; \
    bf16_t* const W_evin = (bf16_t*)(ws + WS_WEVIN); bf16_t* const W_evout = (bf16_t*)(ws + WS_WEVOUT); bf16_t* const W_odin = (bf16_t*)(ws + WS_WODIN); bf16_t* const W_odout = (bf16_t*)(ws + WS_WODOUT); \
    bf16_t* const W_gate = (bf16_t*)(ws + WS_WGATE); bf16_t* const W_ple = (bf16_t*)(ws + WS_WPLE); bf16_t* const W_m13 = (bf16_t*)(ws + WS_WMOE13); bf16_t* const W_m2 = (bf16_t*)(ws + WS_WMOE2); \
    bf16_t* const pbf = (bf16_t*)(ws + WS_PBF); bf16_t* const XB = (bf16_t*)(ws + WS_XB); bf16_t* const Hb = (bf16_t*)(ws + A_H); bf16_t* const PP = (bf16_t*)(ws + A_XBUF); bf16_t* const XB1 = (bf16_t*)OUTP; bf16_t* const PBF1 = (bf16_t*)OUTP + (size_t)M * D; bf16_t* const PP1 = (bf16_t*)(ws + A_PP1); bf16_t* const ZB = (bf16_t*)(ws + WS_ARENA); \
    (void)W_evin; (void)W_evout; (void)W_odin; (void)W_odout; (void)W_gate; (void)W_ple; (void)W_m13; (void)W_m2; (void)pbf; (void)XB; (void)Hb; (void)PP; (void)XB1; (void)PBF1; (void)PP1; (void)ZB;
#define PH_RUN (pc >= lo && pc < hi)
#define PH_END do { if (pc >= lo && pc + 1 < hi) xcd_barrier(bar); ++pc; } while (0)

    if (PH_RUN) for (int rep_ = 0; rep_ < (PROBE_DUP == 20 ? 2 : 1); ++rep_) { PH_PTRS PH_LOCALS
        LAS float* scr = (LAS float*)(lds + wave * 16384);
        conv_matrix(INF(I_EVWIN), D, EVN, EVP, W_evin, scr, gw, ngw, lane);
        if (G != NB * 16) {
        conv_matrix(INF(I_EVWOUT), D, D, D, W_evout, scr, gw, ngw, lane);
        conv_matrix(INF(I_ODWIN), D, 4 * D, 4 * D, W_odin, scr, gw, ngw, lane);
        conv_matrix(INF(I_ODWOUT), D, D, D, W_odout, scr, gw, ngw, lane);
        for (int li = 0; li < DEPTH; ++li) {
            conv_matrix(INF(I_PLEGW) + (size_t)li * D * D, D, D, D, W_gate + (size_t)li * D * D, scr, gw, ngw, lane);
            conv_matrix(INF(I_PLEW) + (size_t)li * PLE * D, PLE, D, D, W_ple + (size_t)li * D * PLE, scr, gw, ngw, lane);
        }
        }
        { const float* w2 = INF(I_W2); const float* a2 = INF(I_A2); const float* g2 = INF(I_G2); bf16_t* WL = (bf16_t*)(ws + WS_WLORA);
          for (int idx = gw * 64 + lane; idx < 1536 * 256; idx += ngw * 64) { const int n = idx >> 8, k = idx & 255; float v = 0.f;
              if (n < 512) { if (k < 64) v = w2[k * 512 + n]; } else if (n < 1024) { if (k >= 64 && k < 128) v = a2[(k - 64) * 512 + (n - 512)]; } else { if (k >= 128) v = g2[(k - 128) * 512 + (n - 1024)]; }
              WL[idx] = (bf16_t)(cvt_pk_bf16(v, 0.f) & 0xffffu); } }
        { const float* cw1 = INF(I_CW1); bf16_t* WC = (bf16_t*)(ws + WS_WCMP);
          for (int it = gw; it < 4 * 64; it += ngw) { const int zh = it >> 6, q = it & 63, kb = q >> 2, nb = q & 3;
              transpose_item(cw1 + (size_t)zh * 1024 * 128, 128, 64 * kb, 32 * nb, 128, WC, 1024, zh * 128 + 32 * nb, 0, scr, lane); }
          const float* cpos = INF(I_CPOS); float* cb = (float*)(ws + MISC_CMPB);
          for (int o = gw; o < 256; o += ngw) { const int zz = o >> 7, c = o & 127; float a = 0.f; for (int i = lane; i < 2048; i += 64) a += cpos[zz * 2048 + i] * cw1[((size_t)zz * 2048 + i) * 128 + c]; a = wave_sum(a); if (lane == 0) cb[o] = a; } }
        { bf16_t* WRB = (bf16_t*)(ws + WS_WRB); const float* wrg = INF(I_WRG); const float* wre = INF(I_WRE);
          for (int idx = gw * 64 + lane; idx < DEPTH * 256 * 1024; idx += ngw * 64) { const int l_ = idx >> 18, n = (idx >> 10) & 255, k = idx & 1023;
              const float v = n < 4 ? wrg[((size_t)l_ * D + k) * 4 + n] : n < 36 ? wre[((size_t)l_ * D + k) * NEXP + (n - 4)] : 0.f; WRB[idx] = (bf16_t)(cvt_pk_bf16(v, 0.f) & 0xffffu); } }
        { const float* hl = INF(I_HGLB); float* lbt = (float*)(ws + MISC_LBT);
          for (int c = gw * 64 + lane; c < D; c += ngw * 64) { const float a0 = hl[c], a1 = hl[D + c], mx = fmaxf(a0, a1), e0 = __expf(a0 - mx), e1 = __expf(a1 - mx); lbt[c] = e1 / (e0 + e1); } }
        const float* xin_ = INF(I_X);
        for (int m = gw; m < M; m += 4 * ngw) {
            f32x4 v[4][4];
#pragma unroll
            for (int r = 0; r < 4; ++r)
#pragma unroll
                for (int j = 0; j < 4; ++j) v[r][j] = *(const f32x4*)(xin_ + (size_t)(m + r * ngw) * D + row_elem(lane, j));
#pragma unroll
            for (int r = 0; r < 4; ++r) store_row_bf16(XB + (size_t)(m + r * ngw) * D, v[r], lane);
        }
    }
    PH_END;

    for (int li = 0; li < DEPTH; ++li) {
                if (li == 0) {
            if (PH_RUN) { PH_PTRS
                pg8::Gemm g{XB, W_evin, D, D, D}; pg8::DenseOrder S; S.init(M, EVP, G, bx);
                pg8::EpiBf16 E{ZB, EVP, 0u, 0u, nullptr};
                for (int rep_ = 0; rep_ < (PROBE_DUP == 4 ? 2 : 1); ++rep_) pg8::gemm_phase<pg8::EpiBf16, pg8::DenseOrder>(lds, g, S, E);
            }
            PH_END;
            if (PH_RUN) for (int rep_ = 0; rep_ < (PROBE_DUP == 21 ? 2 : 1); ++rep_) { PH_PTRS PH_LOCALS const bool dry_ = (PROBE_DUP == 21 && rep_ == 0);
                const float* mu = INF(I_MU); bf16_t* ACT = (bf16_t*)(ws + A_ACT); const int* posi = (const int*)INF(I_POS); bf16_t* QRB = (bf16_t*)((unsigned char*)OUTP + DOUT_QR); bf16_t* SEGB = (bf16_t*)((unsigned char*)OUTP + DOUT_SEG);
                const float inv_me = exp2f(-(float)(lane & 31) * (13.287712379549449f / 32.0f));
                f32x4 mu8a = (f32x4){0.f, 0.f, 0.f, 0.f}, mu8b = mu8a; if (lane < 32) { mu8a = *(const f32x4*)(mu + 1536 + 8 * lane); mu8b = *(const f32x4*)(mu + 1536 + 8 * lane + 4); }
                LAS float* tb = (LAS float*)(lds + wave * 256);
                for (int m = gw; m < M; m += ngw) {
                    const bf16_t* zrow = ZB + (size_t)m * EVP;
                    if (lane < 32) {
                        const u32x4 zc = *(const u32x4*)(zrow + 1536 + 8 * lane); u32x4 zp = (u32x4){0u, 0u, 0u, 0u};
                        if ((m & (T - 1)) != 0) zp = *(const u32x4*)(zrow - EVP + 1536 + 8 * lane);
                        float v[8], pv[8]; unpack8(zc, v); unpack8(zp, pv);
#pragma unroll
                        for (int j = 0; j < 8; ++j) { v[j] += (j < 4 ? mu8a[j & 3] : mu8b[j & 3]) * (pv[j] - v[j]); if (lane < 8) { const float e2 = __expf(2.0f * fminf(fmaxf(v[j], -15.0f), 15.0f)); v[j] = (e2 - 1.0f) * __builtin_amdgcn_rcpf(e2 + 1.0f); } else if (lane >= 16) v[j] = sigmoidf_(v[j]); }
                        *(u32x4*)(ACT + (size_t)m * 256 + 8 * lane) = (u32x4){cvt_pk_bf16(v[0], v[1]), cvt_pk_bf16(v[2], v[3]), cvt_pk_bf16(v[4], v[5]), cvt_pk_bf16(v[6], v[7])};
                    }
                    if (G != NB * 16) rope_row(m, ZB, QRB, posi, tb, lane, !dry_);
                    if (lane < 48) {
                    } else {
                        const int bq_ = m >> 12, tt = m & (T - 1), jj = tt >> 4, ll = tt & 15;
#pragma unroll
                        for (int q = 0; q < 2; ++q) { const int idx = (lane - 48) * 2 + q, piece = idx >> 3, ch = idx & 7, zsel = piece >> 1, hq = piece & 1;
                            *(u32x4*)(SEGB + ((size_t)zsel * 8192 + (size_t)(bq_ * 256 + jj) * 2 + hq) * 1024 + ll * 64 + ch * 8) = *(const u32x4*)(zrow + 2304 + zsel * 128 + hq * 64 + ch * 8); }
                    }
                    LDS_WAIT();
                }
            }
            PH_END;
            if (PH_RUN) { PH_PTRS
                pg8::Gemm g{(const bf16_t*)(ws + A_ACT), (const bf16_t*)(ws + WS_WLORA), 256, 256, 256}; pg8::DenseOrder S; S.init(M, 1536, G, bx);
                pg8::EpiLora E{INF(I_W0), INF(I_A0), (float*)(ws + A_DEC), (bf16_t*)(ws + A_AA), (bf16_t*)(ws + A_GG)};
                for (int rep_ = 0; rep_ < ((PROBE_DUP == 4 || PROBE_DUP == 42) ? 2 : 1); ++rep_) pg8::gemm_phase<pg8::EpiLora, pg8::DenseOrder>(lds, g, S, E);
            }
            PH_END;
            if (PH_RUN) { PH_PTRS
              if (G > 64 && bx < 64) {
                pg8::Gemm g{(const bf16_t*)((unsigned char*)OUTP + DOUT_SEG), (const bf16_t*)(ws + WS_WCMP), 1024, 1024, 1024}; pg8::CmpOrder S{G, bx};
                pg8::EpiF32 E{(float*)(ws + A_HC2), 256};
                pg8::gemm_phase<pg8::EpiF32, pg8::CmpOrder>(lds, g, S, E);
              } else { PH_LOCALS
                const int gwp = G > 64 ? (bx - 64) * NWAVES + wave : gw, ngwp = G > 64 ? (G - 64) * NWAVES : ngw;
                const float* mu = INF(I_MU); const float* kkp = INF(I_KK); const float* kap = INF(I_KA); const float* rkp = INF(I_RK); const bf16_t* AAp = (const bf16_t*)(ws + A_AA); float* sc4 = (float*)(ws + A_SC4);
                float p_mr[8], p_mk[8], p_kk[8], p_ka[8], p_rk[8];
#pragma unroll
                for (int i = 0; i < 8; ++i) { p_mr[i] = mu[8 * lane + i]; p_mk[i] = mu[512 + 8 * lane + i]; p_kk[i] = kkp[8 * lane + i]; p_ka[i] = kap[8 * lane + i]; p_rk[i] = rkp[8 * lane + i]; }
                for (int m = gwp; m < M; m += ngwp) {
                    const bf16_t* zc = ZB + (size_t)m * EVP + 8 * lane;
                    const u32x4 rw_ = *(const u32x4*)zc, kw_ = *(const u32x4*)(zc + 512), aw_ = *(const u32x4*)(AAp + (size_t)m * 512 + 8 * lane); u32x4 rpw = (u32x4){0u, 0u, 0u, 0u}, kpw = rpw;
                    if ((m & (T - 1)) != 0) { rpw = *(const u32x4*)(zc - EVP); kpw = *(const u32x4*)(zc + 512 - EVP); }
                    float r_[8], k_[8], rp_[8], kp_[8], a_[8]; unpack8(rw_, r_); unpack8(kw_, k_); unpack8(rpw, rp_); unpack8(kpw, kp_); unpack8(aw_, a_);
                    float n2 = 0.f, c1 = 0.f, c2 = 0.f, bc = 0.f;
#pragma unroll
                    for (int i = 0; i < 8; ++i) { const float rr = r_[i] + p_mr[i] * (rp_[i] - r_[i]), k0 = k_[i] + p_mk[i] * (kp_[i] - k_[i]), kk = k0 * p_kk[i], k2 = k0 * (1.0f + (a_[i] - 1.0f) * p_ka[i]);
                        n2 += kk * kk; c1 += kk * a_[i] * rr; c2 += k2 * rr; bc += rr * k2 * p_rk[i]; }
                    n2 = sum8b(n2); c1 = sum8b(c1); c2 = sum8b(c2); bc = sum8b(bc);
                    const float inv = __builtin_amdgcn_rsqf(fmaxf(n2, 1e-24f));
                    if ((lane & 7) == 0) *(f32x4*)(sc4 + ((size_t)m * 8 + (lane >> 3)) * 4) = (f32x4){inv, c1 * inv, c2, bc};
                }
            }
              if (G <= 64) { __syncthreads(); pg8::Gemm g{(const bf16_t*)((unsigned char*)OUTP + DOUT_SEG), (const bf16_t*)(ws + WS_WCMP), 1024, 1024, 1024}; pg8::CmpOrder S{G, bx}; pg8::EpiF32 E{(float*)(ws + A_HC2), 256}; pg8::gemm_phase<pg8::EpiF32, pg8::CmpOrder>(lds, g, S, E); }
            }
            PH_END;
            if (PH_RUN) for (int rep_ = 0; rep_ < (PROBE_DUP == 1 ? 2 : 1); ++rep_) { PH_PTRS rwkv_phase(lds, ZB, (const float*)(ws + A_DEC), (const bf16_t*)(ws + A_AA), (const float*)(ws + A_SC4), INF(I_MU), INF(I_KK), INF(I_KA), XB, G, bx, INF(I_MW1), INF(I_MW3), INF(I_MW2), W_m13, W_m2, G == NB * 16 && PROBE_DUP != 1,
                                   (const float*)(ws + A_HC2), (const float*)(ws + MISC_CMPB), INF(I_CW2), (bf16_t*)(ws + A_KVC2), INF(I_P), pbf, PBF1, ZB, (bf16_t*)((unsigned char*)OUTP + DOUT_QR), (const int*)INF(I_POS),
                                   INF(I_ODWIN), INF(I_ODWOUT), INF(I_EVWOUT), INF(I_PLEGW), INF(I_PLEW), ws); }
            PH_END;
            if (PH_RUN) for (int rep_ = 0; rep_ < (PROBE_DUP == 23 ? 2 : 1); ++rep_) { PH_PTRS PH_LOCALS bf16_t* yout_ = (PROBE_DUP == 23 && rep_ == 0) ? (bf16_t*)(ws + A_DEC) : XB;
                const float* mu = INF(I_MU); const float* gng = INF(I_GNG); const float* gnb = INF(I_GNB); const bf16_t* GGp = (const bf16_t*)(ws + A_GG); const float* sc4 = (const float*)(ws + A_SC4);
                float p_mv[8], p_g[8], p_b[8];
#pragma unroll
                for (int i = 0; i < 8; ++i) { p_mv[i] = mu[1024 + 8 * lane + i]; p_g[i] = gng[8 * lane + i]; p_b[i] = gnb[8 * lane + i]; }
                for (int m = gw; m < M; m += ngw) {
                    const bf16_t* zc = ZB + (size_t)m * EVP + 1024 + 8 * lane;
                    const u32x4 vw_ = *(const u32x4*)zc, ow_ = *(const u32x4*)(XB + (size_t)m * D + 8 * lane), gw_ = *(const u32x4*)(GGp + (size_t)m * 512 + 8 * lane); u32x4 vpw = (u32x4){0u, 0u, 0u, 0u};
                    if ((m & (T - 1)) != 0) vpw = *(const u32x4*)(zc - EVP);
                    const float bc = sc4[((size_t)m * 8 + (lane >> 3)) * 4 + 3];
                    float v_[8], vp_[8], o_[8], g_[8]; unpack8(vw_, v_); unpack8(vpw, vp_); unpack8(ow_, o_); unpack8(gw_, g_);
                    float s1 = 0.f;
#pragma unroll
                    for (int i = 0; i < 8; ++i) s1 += o_[i];
                    const float mean = sum8b(s1) * (1.0f / 64.0f); float s2 = 0.f;
#pragma unroll
                    for (int i = 0; i < 8; ++i) { o_[i] -= mean; s2 += o_[i] * o_[i]; }
                    const float rstd = __builtin_amdgcn_rsqf(sum8b(s2) * (1.0f / 64.0f) + 64e-5f);
                    float y_[8];
#pragma unroll
                    for (int i = 0; i < 8; ++i) { const float vv = v_[i] + p_mv[i] * (vp_[i] - v_[i]); y_[i] = (o_[i] * rstd * p_g[i] + p_b[i] + bc * vv) * g_[i]; }
                    *(u32x4*)(yout_ + (size_t)m * (yout_ == XB ? D : 512) + 8 * lane) = (u32x4){cvt_pk_bf16(y_[0], y_[1]), cvt_pk_bf16(y_[2], y_[3]), cvt_pk_bf16(y_[4], y_[5]), cvt_pk_bf16(y_[6], y_[7])};
                }
            }
            if (PH_RUN && !(G == NB * 16 && PROBE_DUP != 1)) { PH_PTRS PH_LOCALS
                LAS float* w2s = (LAS float*)lds; LAS float* hs = (LAS float*)(lds + 65536 + wave * 512);
                { const float* cw2 = INF(I_CW2); for (int i = tid; i < 2 * 128 * 64; i += NTHR) w2s[i] = cw2[i]; }
                __syncthreads();
                const float* HC = (const float*)(ws + A_HC2); const float* cb = (const float*)(ws + MISC_CMPB); bf16_t* KVC = (bf16_t*)(ws + A_KVC2);
                for (int rr = gw; rr < 2 * 16 * 256 * 2; rr += ngw) {
                    const int hq = rr & 1, n = (rr >> 1) & 255, bq_ = (rr >> 9) & 15, zsel = rr >> 13;
                    float outv = 0.f;
                    if (n < 255) {
                        const float* ha = HC + ((size_t)zsel * 8192 + (size_t)(bq_ * 256 + n) * 2 + hq) * 256; const float* hb = ha + 2 * 256 + 128;
#pragma unroll
                        for (int q = 0; q < 2; ++q) { const int c = lane + 64 * q; const float xx = ha[c] + hb[c] + cb[zsel * 128 + c];
                            hs[c] = 0.5f * xx * (1.0f + tanhf(0.7978845608028654f * (xx + 0.044715f * xx * xx * xx))); }
                        LDS_WAIT();
                        for (int c = 0; c < 128; ++c) outv += hs[c] * w2s[(zsel * 128 + c) * 64 + lane];
                        LDS_WAIT();
                    }
                    KVC[((size_t)(zsel * 32 + bq_ * 2 + hq) * 256 + n) * 64 + lane] = (bf16_t)(cvt_pk_bf16(outv, 0.f) & 0xffffu);
                }
            }
            PH_END;
            if (PH_RUN) for (int rep_ = 0; rep_ < (PROBE_DUP == 2 ? 2 : 1); ++rep_) { PH_PTRS nsa_attn_phase(lds, ZB, (const bf16_t*)((unsigned char*)OUTP + DOUT_QR), (const bf16_t*)(ws + A_KVC2), XB, G, bx); }
            PH_END;
            if (PH_RUN) { PH_PTRS
                pg8::Gemm g{XB, W_evout, D, D, D}; pg8::DenseOrder S; S.init(M, D, G, bx);
                pg8::EpiPre E{INF(I_X), nullptr, Hb};
                for (int rep_ = 0; rep_ < (PROBE_DUP == 4 ? 2 : 1); ++rep_) pg8::gemm_phase<pg8::EpiPre, pg8::DenseOrder>(lds, g, S, E);
            }
            PH_END;
        }
        if (li == 1) {
            if (PH_RUN) { PH_PTRS
                pg8::Gemm g{XB1, W_odin, D, D, D}; pg8::DenseOrder S; S.init(M, 4 * D, G, bx);
                pg8::EpiBf16 E{ZB, 4 * D, 0xF00Fu, 0x00F0u, (const float*)(ws + MISC_LBT)};
                for (int rep_ = 0; rep_ < (PROBE_DUP == 7 ? 2 : 1); ++rep_) pg8::gemm_phase<pg8::EpiBf16, pg8::DenseOrder>(lds, g, S, E);
            }
            PH_END;
            if (PH_RUN) for (int rep_ = 0; rep_ < (PROBE_DUP == 3 ? 2 : 1); ++rep_) { PH_PTRS
                if (G > NB * 8 && bx >= NB * 8) {
                    { pg8::Gemm g{PBF1, W_ple + (size_t)D * PLE, PLE, PLE, PLE}; pg8::DenseOrder S; S.init(M, D, G - NB * 8, bx - NB * 8);
                      pg8::EpiBf16 E{PP1, D, 0u, 0u, nullptr};
                      pg8::gemm_phase<pg8::EpiBf16, pg8::DenseOrder>(lds, g, S, E); }
                    __syncthreads();
                    { PH_LOCALS
                      const int gwi = (bx - NB * 8) * NWAVES + wave, ngwi = (G - NB * 8) * NWAVES;
                      LAS float* scr = (LAS float*)(lds + wave * 8704);
                      conv_moe_weights(INF(I_MW1), INF(I_MW3), INF(I_MW2), 1, W_m13, W_m2, scr, gwi, ngwi, lane, 3); }
                } else hgrn_phase(lds, ZB, INF(I_HGLB), INF(I_HGNG), XB, G, bx); }
            PH_END;
            if (PH_RUN) { PH_PTRS
                pg8::Gemm g{XB, W_odout, D, D, D}; pg8::DenseOrder S; S.init(M, D, G, bx);
                pg8::EpiPre E{nullptr, XB1, Hb};
                for (int rep_ = 0; rep_ < (PROBE_DUP == 7 ? 2 : 1); ++rep_) pg8::gemm_phase<pg8::EpiPre, pg8::DenseOrder>(lds, g, S, E);
            }
            PH_END;
        }
        if (PH_RUN) for (int rep_ = 0; rep_ < (PROBE_DUP == 25 ? 2 : 1); ++rep_) { PH_PTRS PH_LOCALS bf16_t* hout_ = (PROBE_DUP == 25 && rep_ == 0) ? (bf16_t*)(ws + A_XBUF) : Hb;
            const float* lng = INF(I_LNG) + (size_t)li * 2 * D; const float* lnb = INF(I_LNB) + (size_t)li * 2 * D;
            for (int m = gw; m < M; m += 4 * ngw) {
                f32x4 v[4][4];
#pragma unroll
                for (int r = 0; r < 4; ++r) load_row_bf16(Hb + (size_t)(m + r * ngw) * D, v[r], lane);
#pragma unroll
                for (int r = 0; r < 4; ++r) { ln_row(v[r], lng, lnb, lane); store_row_bf16(hout_ + (size_t)(m + r * ngw) * D, v[r], lane);
                    unsigned char* h8 = ws + A_H8 + (size_t)(m + r * ngw) * D + 8 * lane;
                    *(u32x2*)h8 = (u32x2){cvt_pk4_fp8_sat(v[r][0][0], v[r][0][1], v[r][0][2], v[r][0][3]), cvt_pk4_fp8_sat(v[r][1][0], v[r][1][1], v[r][1][2], v[r][1][3])};
                    *(u32x2*)(h8 + 512) = (u32x2){cvt_pk4_fp8_sat(v[r][2][0], v[r][2][1], v[r][2][2], v[r][2][3]), cvt_pk4_fp8_sat(v[r][3][0], v[r][3][1], v[r][3][2], v[r][3][3])}; }
            }
        }
        PH_END;
        if (PH_RUN) { PH_PTRS
            pg8::Gemm g{Hb, (const bf16_t*)(ws + WS_WRB) + (size_t)li * 256 * D, D, D, D}; pg8::DenseOrder S; S.init(M, 256, G, bx);
            pg8::EpiLogit E{(float*)(ws + A_XBUF)};
            pg8::gemm_phase<pg8::EpiLogit, pg8::DenseOrder>(lds, g, S, E);
        }
        PH_END;
        if (PH_RUN) { PH_PTRS PH_LOCALS
            LAS int* hist = (LAS int*)lds;
            if (tid < NEXP) hist[tid] = 0;
            __syncthreads();
            const float* brg = INF(I_BRG) + li * 4; const float* bre = INF(I_BRE) + li * NEXP; const float* LG = (const float*)(ws + A_XBUF);
            int* eid_o = (int*)(ws + MISC_EID); float* gate_o = (float*)(ws + MISC_GATE);
            const int npair = M / 2 / ngw;
            for (int q0 = 0; q0 < npair; q0 += 32) {
                const int q = q0 + (lane >> 1);
                if (q < npair) {
                    const int m = 2 * (gw + q * ngw) + (lane & 1);
                    float lg[36];
#pragma unroll
                    for (int c = 0; c < 9; ++c) { const f32x4 t = *(const f32x4*)(LG + (size_t)m * 64 + 4 * c); lg[4 * c] = t[0]; lg[4 * c + 1] = t[1]; lg[4 * c + 2] = t[2]; lg[4 * c + 3] = t[3]; }
                    float g0 = lg[0] + brg[0], g1 = lg[1] + brg[1], g2 = lg[2] + brg[2], g3 = lg[3] + brg[3];
                    int gs = 0; float gm = g0; if (g1 > gm) { gm = g1; gs = 1; } if (g2 > gm) { gm = g2; gs = 2; } if (g3 > gm) { gm = g3; gs = 3; }
                    const float pg = __builtin_amdgcn_rcpf(__expf(g0 - gm) + __expf(g1 - gm) + __expf(g2 - gm) + __expf(g3 - gm));
                    float le[8];
#pragma unroll
                    for (int e = 0; e < 8; ++e) { const float a = gs == 0 ? lg[4 + e] : gs == 1 ? lg[12 + e] : gs == 2 ? lg[20 + e] : lg[28 + e]; le[e] = a + bre[gs * 8 + e]; }
                    int i1 = 0; float v1 = le[0];
#pragma unroll
                    for (int e = 1; e < 8; ++e) if (le[e] > v1) { v1 = le[e]; i1 = e; }
                    int i2 = -1; float v2 = -3.0e38f;
#pragma unroll
                    for (int e = 0; e < 8; ++e) if (e != i1 && le[e] > v2) { v2 = le[e]; i2 = e; }
                    const float e2 = __expf(v2 - v1), den = __builtin_amdgcn_rcpf(1.0f + e2);
                    const int ea = gs * 8 + i1, eb = gs * 8 + i2;
                    *(int2*)(eid_o + 2 * (size_t)m) = make_int2(ea, eb); *(float2*)(gate_o + 2 * (size_t)m) = make_float2(pg * den, pg * e2 * den);
                    __hip_atomic_fetch_add(&hist[ea], 1, __ATOMIC_RELAXED, __HIP_MEMORY_SCOPE_WORKGROUP); __hip_atomic_fetch_add(&hist[eb], 1, __ATOMIC_RELAXED, __HIP_MEMORY_SCOPE_WORKGROUP);
                }
            }
            __syncthreads();
            if (tid < NEXP) ((int*)(ws + MISC_BCNT))[vcu * NEXP + tid] = hist[tid];
        }
        PH_END;
        if (PH_RUN) for (int rep_ = 0; rep_ < (PROBE_DUP == 26 ? 2 : 1); ++rep_) { PH_PTRS PH_LOCALS
            __syncthreads();
            LAS int* tot = (LAS int*)lds; LAS int* prt = tot + 16 * NEXP; LAS int* cursor = prt + 16 * NEXP; LAS int* startv = cursor + NEXP; LAS int* padv = startv + NEXP;
            const int* bcnt = (const int*)(ws + MISC_BCNT);
            { const int e = tid & 31, part = tid >> 5; int a = 0, p = 0; for (int w = part; w < G; w += 16) { const int c = bcnt[w * NEXP + e]; a += c; if (w < vcu) p += c; } tot[part * NEXP + e] = a; prt[part * NEXP + e] = p; }
            __syncthreads();
            if (tid < NEXP) { int a = 0, p = 0; for (int q = 0; q < 16; ++q) { a += tot[q * NEXP + tid]; p += prt[q * NEXP + tid]; } padv[tid] = (a + 255) & ~255; cursor[tid] = p; }
            __syncthreads();
            if (tid == 0) { int run = 0;
#pragma nounroll
                for (int e = 0; e < NEXP; ++e) { startv[e] = run; run += padv[e]; } }
            __syncthreads();
            if (tid < NEXP) cursor[tid] += startv[tid];
            if (bx == 0) { int* te = (int*)(ws + MISC_TILEE); const int ntl = (startv[NEXP - 1] + padv[NEXP - 1]) >> 8; if (tid == 0) te[0] = ntl;
                for (int t = tid; t < ntl; t += NTHR) { int e = 0;
#pragma nounroll
                    for (int q = 0; q < NEXP; ++q) e += ((startv[q] + padv[q]) <= 256 * t) ? 1 : 0;
                    te[1 + t] = e; } }
            __syncthreads();
            const int* eid_i = (const int*)(ws + MISC_EID); int* slot_o = (int*)(ws + MISC_SLOT); int* toks_o = (int*)(ws + WS_TOKS);
            for (int mm = 2 * gw; mm < M; mm += 2 * ngw) for (int m = mm; m < mm + 2; ++m) {
                int s0 = 0, s1 = 0;
                if (lane == 0) { const int2 ee = *(const int2*)(eid_i + 2 * (size_t)m); s0 = __hip_atomic_fetch_add(&cursor[ee.x], 1, __ATOMIC_RELAXED, __HIP_MEMORY_SCOPE_WORKGROUP); s1 = __hip_atomic_fetch_add(&cursor[ee.y], 1, __ATOMIC_RELAXED, __HIP_MEMORY_SCOPE_WORKGROUP); *(int2*)(slot_o + 2 * (size_t)m) = make_int2(s0, s1); }
                s0 = __builtin_amdgcn_readfirstlane(s0); s1 = __builtin_amdgcn_readfirstlane(s1);
                if (lane == 0) { toks_o[s0] = m; toks_o[s1] = m; }
            }
            { LAS float* scr = (LAS float*)(lds + 16384 + wave * 8704);
              const bool shadow = (G > NB * 8);
              const int parts_ = (li == 1 && shadow) ? 0 : ((li == 0 && G == NB * 16) ? 0 : 3);
              if (parts_) conv_moe_weights(INF(I_MW1), INF(I_MW3), INF(I_MW2), li, W_m13, W_m2, scr, gw, ngw, lane, parts_);
              const int np = (li == 1 && shadow) ? 0 : ((li == 0 && G == NB * 16) ? 0 : ((li == 0 && shadow) ? 2 : 1));
              for (int q = 0; q < np; ++q) { const float* pl = INF(I_P) + (size_t)(li + q) * M * PLE; bf16_t* pd = q ? PBF1 : pbf;
                for (int m = gw; m < M; m += 4 * ngw) { f32x4 v[4];
#pragma unroll
                    for (int r = 0; r < 4; ++r) v[r] = *((const f32x4*)(pl + (size_t)(m + r * ngw) * PLE) + lane);
#pragma unroll
                    for (int r = 0; r < 4; ++r) *((u32x2*)(pd + (size_t)(m + r * ngw) * PLE) + lane) = (u32x2){cvt_pk_bf16(v[r][0], v[r][1]), cvt_pk_bf16(v[r][2], v[r][3])}; } } }
        }
        PH_END;
        if (PH_RUN) { PH_PTRS
            const int* te = (const int*)(ws + MISC_TILEE);
            pg8::MoeOrder S{te + 1, __builtin_amdgcn_readfirstlane(te[0]), G, bx};
            for (int rep_ = 0; rep_ < (PROBE_DUP == 5 ? 2 : 1); ++rep_) pg8::gemm_f8_phase<0>(lds, ws + A_H8, (const unsigned char*)W_m13, D, S, (const int*)(ws + WS_TOKS), ws + A_HID, nullptr);
        }
        PH_END;
        if (PH_RUN) { PH_PTRS
            const int* te = (const int*)(ws + MISC_TILEE);
            pg8::MoeOrder S{te + 1, __builtin_amdgcn_readfirstlane(te[0]), G, bx};
            for (int rep_ = 0; rep_ < (PROBE_DUP == 5 ? 2 : 1); ++rep_) pg8::gemm_f8_phase<1>(lds, ws + A_HID, (const unsigned char*)W_m2, MOE_H, S, nullptr, nullptr, (bf16_t*)(ws + A_XBUF));
        }
        PH_END;
        if (PH_RUN) for (int rep_ = 0; rep_ < (PROBE_DUP == 27 ? 2 : 1); ++rep_) { PH_PTRS PH_LOCALS bf16_t* hout_ = (PROBE_DUP == 27 && rep_ == 0) ? (bf16_t*)OUTP : XB;
            const float* lng = INF(I_LNG) + (size_t)li * 2 * D; const float* lnb = INF(I_LNB) + (size_t)li * 2 * D;
            const int* slot_i = (const int*)(ws + MISC_SLOT); const float* gate_i = (const float*)(ws + MISC_GATE); const bf16_t* ybuf = (const bf16_t*)(ws + A_XBUF);
            for (int m0 = gw; m0 < M; m0 += 2 * ngw) {
                int2 sl[2]; float2 gt[2]; u32x4 hw_[2][2], y0[2][2], y1[2][2];
#pragma unroll
                for (int r = 0; r < 2; ++r) { const int m = m0 + r * ngw; sl[r] = *(const int2*)(slot_i + 2 * (size_t)m); gt[r] = *(const float2*)(gate_i + 2 * (size_t)m); }
#pragma unroll
                for (int r = 0; r < 2; ++r) { const int m = m0 + r * ngw;
#pragma unroll
                    for (int q = 0; q < 2; ++q) { hw_[r][q] = *((const u32x4*)(Hb + (size_t)m * D) + lane + 64 * q); y0[r][q] = *((const u32x4*)(ybuf + (size_t)sl[r].x * D) + lane + 64 * q); y1[r][q] = *((const u32x4*)(ybuf + (size_t)sl[r].y * D) + lane + 64 * q); } }
#pragma unroll
                for (int r = 0; r < 2; ++r) { const int m = m0 + r * ngw; f32x4 v[4];
#pragma unroll
                    for (int q = 0; q < 2; ++q) { const unsigned hh_[4] = {hw_[r][q].x, hw_[r][q].y, hw_[r][q].z, hw_[r][q].w}, ya[4] = {y0[r][q].x, y0[r][q].y, y0[r][q].z, y0[r][q].w}, yb[4] = {y1[r][q].x, y1[r][q].y, y1[r][q].z, y1[r][q].w};
#pragma unroll
                        for (int e = 0; e < 4; ++e) { v[2 * q + (e >> 1)][2 * (e & 1)] = bflo(hh_[e]) * DN_ALPHA + (gt[r].x * bflo(ya[e]) + gt[r].y * bflo(yb[e])); v[2 * q + (e >> 1)][2 * (e & 1) + 1] = bfhi(hh_[e]) * DN_ALPHA + (gt[r].x * bfhi(ya[e]) + gt[r].y * bfhi(yb[e])); } }
                    ln_row(v, lng + D, lnb + D, lane);
                    store_row_bf16(hout_ + (size_t)m * D, v, lane); }
            }
        }
        PH_END;
        if (!(li == 1 && G > NB * 8)) {
        if (PH_RUN) { PH_PTRS PH_LOCALS
            pg8::Gemm g{pbf, W_ple + (size_t)li * D * PLE, PLE, PLE, PLE}; pg8::DenseOrder S; S.init(M, D, G, bx);
            pg8::EpiBf16 E{PP, D, 0u, 0u, nullptr};
            for (int rep_ = 0; rep_ < ((PROBE_DUP == 6 || PROBE_DUP == 41) ? 2 : 1); ++rep_) pg8::gemm_phase<pg8::EpiBf16, pg8::DenseOrder>(lds, g, S, E);
        }
        PH_END;
        }
        if (PH_RUN) { PH_PTRS PH_LOCALS
            pg8::Gemm g{XB, W_gate + (size_t)li * D * D, D, D, D}; pg8::DenseOrder S; S.init(M, D, G, bx);
            pg8::EpiGate E{XB, (li == 1 && G > NB * 8) ? PP1 : PP, li == DEPTH - 1 ? OUTP : nullptr, XB1};
            for (int rep_ = 0; rep_ < (PROBE_DUP == 6 ? 2 : 1); ++rep_) pg8::gemm_phase<pg8::EpiGate, pg8::DenseOrder>(lds, g, S, E);
        }
        PH_END;
    }
#undef PH_RUN
#undef PH_END
}
constexpr int TOTAL_PHASES = 1 + 8 + 9 + 3 + 8;

extern "C" void kernel_launch(void* const* d_in, const int* in_sizes, int n_in, void* d_out, int out_size, void* d_ws, size_t ws_size, hipStream_t stream) {
    static int grid = 0;
    if (grid == 0) {
        if (n_in != 34 || in_sizes[0] != M * D || out_size != M * D || ws_size < WS_END) { fprintf(stderr, "kernel_launch: unexpected shapes: n_in %d in0 %d out %d ws %zu (need %zu)\n", n_in, n_in > 0 ? in_sizes[0] : -1, out_size, ws_size, (size_t)WS_END); grid = -1; return; }
        int dev = 0, cus = 0, per_cu = 0;
        if (hipGetDevice(&dev) != hipSuccess || hipDeviceGetAttribute(&cus, hipDeviceAttributeMultiprocessorCount, dev) != hipSuccess) { grid = -1; return; }
        if (hipFuncSetAttribute((const void*)fwd, hipFuncAttributeMaxDynamicSharedMemorySize, LDS_BYTES) != hipSuccess) { fprintf(stderr, "kernel_launch: hipFuncSetAttribute failed\n"); grid = -1; return; }
        if (hipOccupancyMaxActiveBlocksPerMultiprocessor(&per_cu, (const void*)fwd, NTHR, LDS_BYTES) != hipSuccess || per_cu < 1) fprintf(stderr, "kernel_launch: occupancy query reports %d\n", per_cu);
        (void)hipGetLastError();
        grid = cus;
    }
    if (grid < 0) return;
    if (hipMemsetAsync((char*)d_ws + WS_CTL, 0, CTL_ZERO_BYTES, stream) != hipSuccess) return;
    Args a{};
    for (int i = 0; i < 34; ++i) a.in[i] = d_in[i];
    a.out = (float*)d_out; a.ws = (unsigned char*)d_ws; a.ph_lo = 0; a.ph_hi = TOTAL_PHASES;
    hipLaunchKernelGGL(fwd, dim3(grid), dim3(NTHR), LDS_BYTES, stream, a);
}
```

```cpp
#include <hip/hip_runtime.h>
#ifndef PROBE_DUP
#define PROBE_DUP 0
#endif
#include <cstdio>
#include <cstdint>

#define LAS __attribute__((address_space(3)))
#define GAS __attribute__((address_space(1)))
typedef unsigned short bf16_t;
typedef short bf16x8 __attribute__((ext_vector_type(8)));
typedef float f32x4 __attribute__((ext_vector_type(4)));
typedef float f32x2 __attribute__((ext_vector_type(2)));
typedef unsigned u32x4 __attribute__((ext_vector_type(4)));
typedef unsigned u32x2 __attribute__((ext_vector_type(2)));

constexpr int NB = 16, T = 4096, M = NB * T, D = 1024, PLE = 256, DEPTH = 2;
constexpr float DN_ALPHA = 1.41421356237f;
constexpr float LN_EPS = 1e-5f;
constexpr int EVN = 3096, EVP = 3328;
constexpr int NEXP = 32, MOE_H = 512, MOE_BLK = 256, MOE_A = 2 * M, MOE_P = MOE_A + NEXP * MOE_BLK, MOE_TILES = MOE_P / 256;

constexpr size_t MiB = 1u << 20;
constexpr size_t WS_CTL = 0, CTL_ZERO_BYTES = 1 * MiB;
constexpr size_t WS_WEVIN = 1 * MiB, WS_WEVOUT = 8 * MiB, WS_WODIN = 10 * MiB, WS_WODOUT = 18 * MiB, WS_WGATE = 20 * MiB, WS_WPLE = 24 * MiB, WS_WLORA = 25 * MiB, WS_WCMP = 26 * MiB;
constexpr size_t WS_MISC = 27 * MiB;
constexpr size_t WS_WMOE13 = 33 * MiB, WS_WMOE2 = 97 * MiB, WS_PBF = 129 * MiB, WS_XB = 161 * MiB, WS_ARENA = 289 * MiB;
constexpr size_t A_H = WS_ARENA, A_HID = WS_ARENA + 128 * MiB, A_H8 = A_HID + 68 * MiB, A_XBUF = WS_ARENA + 264 * MiB, A_PP1 = WS_ARENA + 536 * MiB;
static_assert((size_t)MOE_P * MOE_H <= 68 * MiB && A_H8 + (size_t)M * D <= A_XBUF, "e4m3 buffers");
constexpr size_t A_UNUSED_ = 0;
constexpr size_t A_ACT = WS_ARENA + 416 * MiB, A_DEC = A_ACT + 32 * MiB, A_AA = A_DEC + 128 * MiB, A_GG = A_AA + 64 * MiB;
constexpr size_t A_SC4 = A_ACT;
constexpr size_t DOUT_QR = 160 * MiB, DOUT_SEG = 224 * MiB;
constexpr size_t A_HC2 = WS_ARENA + 704 * MiB, A_KVC2 = A_HC2 + 16 * MiB;
static_assert(A_KVC2 + 2 * MiB <= 1024 * MiB && A_GG + 64 * MiB <= A_HC2, "arena map");
static_assert(A_PP1 + 128 * MiB <= 1024 * MiB && A_PP1 >= WS_ARENA + 512 * MiB && A_XBUF + 272 * MiB <= A_PP1 && A_HID + 136 * MiB <= A_XBUF, "post-mixer arena map");
constexpr size_t WS_END = 1024 * MiB;
constexpr size_t WS_WRB = 29 * MiB;
constexpr size_t MISC_LBT = 31 * MiB;
constexpr size_t WS_TOKS = 30 * MiB;
constexpr size_t MISC_EID = WS_MISC, MISC_GATE = WS_MISC + 512 * 1024, MISC_SLOT = WS_MISC + 1024 * 1024, MISC_BCNT = WS_MISC + 1536 * 1024, MISC_TILEE = MISC_BCNT + 64 * 1024, MISC_CMPB = MISC_TILEE + 4096;
constexpr int CW_BAR = 4096;

constexpr int NWAVES = 8, NTHR = 512;
typedef __bf16 bf16x2_t __attribute__((ext_vector_type(2)));
__device__ __forceinline__ unsigned cvt_pk_bf16(float lo, float hi) { f32x2 v = {lo, hi}; return __builtin_bit_cast(unsigned, __builtin_convertvector(v, bf16x2_t)); }
__device__ __forceinline__ float bf2f(unsigned short b) { return __uint_as_float(((unsigned)b) << 16); }
__device__ __forceinline__ unsigned cvt_pk4_fp8(float a, float b, float c, float d) { int w = __builtin_amdgcn_cvt_pk_fp8_f32(a, b, 0, false); return (unsigned)__builtin_amdgcn_cvt_pk_fp8_f32(c, d, w, true); }
__device__ __forceinline__ float f8clamp(float x) { return __builtin_amdgcn_fmed3f(x, -448.0f, 448.0f); }
__device__ __forceinline__ unsigned cvt_pk4_fp8_sat(float a, float b, float c, float d) { return cvt_pk4_fp8(f8clamp(a), f8clamp(b), f8clamp(c), f8clamp(d)); }
__device__ __forceinline__ float bflo(unsigned w) { return __uint_as_float(w << 16); }
__device__ __forceinline__ float bfhi(unsigned w) { return __uint_as_float(w & 0xffff0000u); }
template <int CTRL, int RM> __device__ __forceinline__ float dpp_addx(float v) { return v + __builtin_bit_cast(float, __builtin_amdgcn_update_dpp(0, __builtin_bit_cast(int, v), CTRL, RM, 0xf, false)); }
__device__ __forceinline__ float wave_sum(float v) {
    v = dpp_addx<0xB1, 0xf>(v); v = dpp_addx<0x4E, 0xf>(v); v = dpp_addx<0x141, 0xf>(v); v = dpp_addx<0x140, 0xf>(v);
    v = dpp_addx<0x142, 0xa>(v); v = dpp_addx<0x143, 0xc>(v);
    return __builtin_bit_cast(float, __builtin_amdgcn_readlane(__builtin_bit_cast(int, v), 63));
}
__device__ __forceinline__ float sigmoidf_(float x) { return __builtin_amdgcn_rcpf(1.0f + __expf(-x)); }
__device__ __forceinline__ float siluf_(float x) { return x * __builtin_amdgcn_rcpf(1.0f + __expf(-x)); }
__device__ __forceinline__ int pinned_tid() { int t = threadIdx.x; asm volatile("" : "+v"(t)); return t; }
#define LDS_WAIT() asm volatile("s_waitcnt lgkmcnt(0)" ::: "memory")
#define VM_WAIT() asm volatile("s_waitcnt vmcnt(0)" ::: "memory")

namespace pg8 {
constexpr int BM = 256, BK = 64, HALF = 128, HTB = HALF * BK * 2, STAGE_BYTES = 8 * HTB, NXCD = 8, WGM = 8;
__host__ __device__ __forceinline__ int lds_byte(int r, int c) { const int st = (r >> 4) * 2 + (c >> 5), rr = r & 15, cc = c & 31, ob = rr * 64 + cc * 2; return st * 1024 + (ob ^ (((ob >> 9) & 1) << 5)); }
__host__ __device__ __forceinline__ void stage_rc(int b, int& R, int& C) { const int st = b / 1024, sb = b % 1024, swz = sb ^ (((sb >> 9) & 1) << 5); R = (st >> 1) * 16 + swz / 64; C = (st & 1) * 32 + (swz % 64) / 2; }
__host__ __device__ __forceinline__ int perm32(int rho) { const int n = rho >> 4, i = rho & 15; return 8 * (i >> 2) + 4 * n + (i & 3); }

struct Unit { int pm, pn, pb; };
struct Gemm { const bf16_t* A; const bf16_t* Bt; int lda, ldb, K; };

struct DenseOrder {
    int nM, nN, nwg, G, c;
    __device__ void init(int M_, int N_, int G_, int c_) { nM = M_ / BM; nN = N_ / BM; nwg = nM * nN; G = G_; c = c_; }
    __device__ bool next(int i, Unit& u) const {
        const long L = (long)i * G + c; if (L >= nwg) return false;
        int wgid = (int)L; { const int q = nwg / NXCD, r = nwg % NXCD, xcd = wgid % NXCD, off = wgid / NXCD; wgid = (xcd < r ? xcd * (q + 1) : r * (q + 1) + (xcd - r) * q) + off; }
        const int nig = WGM * nN, gid = wgid / nig, fm = gid * WGM, gsz = (nM - fm) < WGM ? (nM - fm) : WGM;
        u.pm = fm + ((wgid % nig) % gsz); u.pn = (wgid % nig) / gsz; u.pb = u.pn; return true;
    }
};
struct MoeOrder {
    const int* tile_e; int ntiles, G, c;
    __device__ bool next(int i, Unit& u) const {
        if ((G & 7) == 0) {
            const int x = c & 7, r = c >> 3, w = G >> 3, k = i * w + r, q = k >> 2, t = q * 8 + x;
            if (t >= ntiles) return false;
            u.pm = t; u.pn = k & 3; u.pb = __builtin_amdgcn_readfirstlane(tile_e[t]) * 4 + u.pn; return true;
        }
        const long L = (long)i * G + c; if (L >= (long)ntiles * 4) return false;
        u.pm = (int)(L >> 2); u.pn = (int)(L & 3); u.pb = __builtin_amdgcn_readfirstlane(tile_e[u.pm]) * 4 + u.pn; return true;
    }
};

template <class Epi, class Sched>
__device__ __forceinline__ void gemm_phase(LAS unsigned char* lds, const Gemm g, const Sched& S, const Epi& E) {
    int tid_ = threadIdx.x; asm volatile("" : "+v"(tid_)); const int tid = tid_, wid = __builtin_amdgcn_readfirstlane(tid >> 6), lane = tid & 63, wr = wid >> 2, wc = wid & 3, fr = lane & 15, fq = lane >> 4;
    int K_ = g.K, lda_ = g.lda, ldb_ = g.ldb; asm volatile("" : "+s"(K_), "+s"(lda_), "+s"(ldb_)); const int K = K_, nt = K / BK;
    unsigned voffA[2], voffB[2];
#pragma unroll
    for (int i = 0; i < 2; ++i) { int R, C; stage_rc(tid * 16 + i * 8192, R, C); const int Rb = Epi::PERM ? ((R & ~31) + perm32(R & 31)) : R;
        voffA[i] = (unsigned)(R * lda_ + C) * 2u; voffB[i] = (unsigned)(Rb * ldb_ + C) * 2u; }
    const size_t kstep = (size_t)(BK * 2);
    const size_t hstepA = (size_t)HALF * lda_ * 2, hstepB = (size_t)HALF * ldb_ * 2;
    const size_t tstepA = 2 * hstepA, tstepB = 2 * hstepB;
    const unsigned ldsw = (unsigned)wid * 1024u;
    const int aoff = lds_byte(wr * 64 + fr, fq * 8), boff = lds_byte(wc * 32 + fr, fq * 8);
#define PG8_SA(b, h) (((b) * 2 + (h)) * HTB)
#define PG8_SB(b, h) ((4 + (b) * 2 + (h)) * HTB)
#define PG8_STAGE(bufoff, gbase, voff) do { _Pragma("unroll") for (int _i = 0; _i < 2; ++_i) \
        __builtin_amdgcn_global_load_lds((const unsigned*)((const char*)(gbase) + (voff)[_i]), (LAS unsigned*)(lds + (bufoff) + ldsw + _i * 8192), 16, 0, 0); } while (0)
#define PG8_LDA(dst, b, h) do { _Pragma("unroll") for (int m = 0; m < 4; ++m) _Pragma("unroll") for (int k = 0; k < 2; ++k) dst[m][k] = *(const LAS bf16x8*)(lds + PG8_SA(b, h) + aoff + m * 2048 + k * 1024); } while (0)
#define PG8_LDB(dst, b, h) do { _Pragma("unroll") for (int n = 0; n < 2; ++n) _Pragma("unroll") for (int k = 0; k < 2; ++k) dst[n][k] = *(const LAS bf16x8*)(lds + PG8_SB(b, h) + boff + n * 2048 + k * 1024); } while (0)
#define PG8_MMA(ai, bj, At, Bt) do { __builtin_amdgcn_s_setprio(1); _Pragma("unroll") for (int m = 0; m < 4; ++m) _Pragma("unroll") for (int n = 0; n < 2; ++n) _Pragma("unroll") for (int k = 0; k < 2; ++k) \
        acc[ai][bj][m][n] = __builtin_amdgcn_mfma_f32_16x16x32_bf16(Bt[n][k], At[m][k], acc[ai][bj][m][n], 0, 0, 0); __builtin_amdgcn_s_setprio(0); } while (0)
#define PG8_WAIT_V(n) asm volatile("s_waitcnt vmcnt(" #n ")" ::: "memory")
#define PG8_WAIT_L(n) asm volatile("s_waitcnt lgkmcnt(" #n ")" ::: "memory")
#define PG8_BAR __builtin_amdgcn_s_barrier()
#define PG8_SCHED __builtin_amdgcn_sched_barrier(0)
    Unit cur, nxt; int ui = 0;
    if (!S.next(0, cur)) return;
    f32x4 acc[2][2][4][2];
#pragma unroll
    for (int a = 0; a < 2; ++a)
#pragma unroll
        for (int b = 0; b < 2; ++b)
#pragma unroll
            for (int m = 0; m < 4; ++m)
#pragma unroll
                for (int n = 0; n < 2; ++n) acc[a][b][m][n] = (f32x4){0.f, 0.f, 0.f, 0.f};
    bf16x8 At[4][2], B0[2][2], B1[2][2];
    const char* cA = (const char*)g.A + (size_t)cur.pm * tstepA; const char* cB = (const char*)g.Bt + (size_t)cur.pb * tstepB;
    PG8_STAGE(PG8_SB(0, 0), cB, voffB); PG8_STAGE(PG8_SB(0, 1), cB + hstepB, voffB); PG8_STAGE(PG8_SA(0, 0), cA, voffA); PG8_STAGE(PG8_SA(0, 1), cA + hstepA, voffA);
    if (wr == 1) PG8_BAR;
    PG8_WAIT_V(2); PG8_BAR;
    PG8_STAGE(PG8_SB(1, 0), cB + kstep, voffB); PG8_STAGE(PG8_SA(1, 0), cA + kstep, voffA); PG8_STAGE(PG8_SB(1, 1), cB + hstepB + kstep, voffB);
    PG8_WAIT_V(6); PG8_BAR;
    for (;;) {
        const bool has_next = S.next(ui + 1, nxt);
        const char* nA = has_next ? (const char*)g.A + (size_t)nxt.pm * tstepA : cA; const char* nB = has_next ? (const char*)g.Bt + (size_t)nxt.pb * tstepB : cB;
#pragma nounroll
        for (int t = 0; t < nt; t += 2) {
            const bool last = (t == nt - 2);
            const char* a1 = cA + (size_t)(t + 1) * kstep;
            const char* a2 = last ? nA : cA + (size_t)(t + 2) * kstep; const char* b2 = last ? nB : cB + (size_t)(t + 2) * kstep;
            const char* a3 = a2 + kstep; const char* b3 = b2 + kstep;
            PG8_LDB(B0, 0, 0); PG8_LDB(B1, 0, 1); PG8_SCHED; PG8_LDA(At, 0, 0); PG8_STAGE(PG8_SA(1, 1), a1 + hstepA, voffA);
            PG8_WAIT_V(8); PG8_WAIT_L(0); PG8_BAR; PG8_MMA(0, 0, At, B0); PG8_MMA(0, 1, At, B1); PG8_BAR; PG8_SCHED;
            PG8_LDA(At, 0, 1); PG8_STAGE(PG8_SB(0, 0), b2, voffB); PG8_STAGE(PG8_SB(0, 1), b2 + hstepB, voffB); PG8_STAGE(PG8_SA(0, 0), a2, voffA);
            PG8_WAIT_V(8); PG8_WAIT_L(0); PG8_BAR; PG8_MMA(1, 0, At, B0); PG8_MMA(1, 1, At, B1); PG8_BAR; PG8_SCHED;
            PG8_LDB(B0, 1, 0); PG8_LDB(B1, 1, 1); PG8_SCHED; PG8_LDA(At, 1, 0); PG8_STAGE(PG8_SA(0, 1), a2 + hstepA, voffA);
            PG8_WAIT_V(8); PG8_WAIT_L(0); PG8_BAR; PG8_MMA(0, 0, At, B0); PG8_MMA(0, 1, At, B1); PG8_BAR; PG8_SCHED;
            PG8_LDA(At, 1, 1); PG8_STAGE(PG8_SB(1, 0), b3, voffB); PG8_STAGE(PG8_SB(1, 1), b3 + hstepB, voffB); PG8_STAGE(PG8_SA(1, 0), a3, voffA);
            PG8_WAIT_V(8); PG8_WAIT_L(0); PG8_BAR; PG8_MMA(1, 0, At, B0); PG8_MMA(1, 1, At, B1); PG8_BAR; PG8_SCHED;
        }
        if (wr == 0) PG8_BAR;
        E(acc, cur, wr, wc, fr, fq);
        if (!has_next) break;
#pragma unroll
        for (int a = 0; a < 2; ++a)
#pragma unroll
            for (int b = 0; b < 2; ++b)
#pragma unroll
                for (int m = 0; m < 4; ++m)
#pragma unroll
                    for (int n = 0; n < 2; ++n) acc[a][b][m][n] = (f32x4){0.f, 0.f, 0.f, 0.f};
        cur = nxt; cA = nA; cB = nB; ++ui;
        if (wr == 1) PG8_BAR;
    }
    PG8_WAIT_V(0);
    PG8_BAR;
#undef PG8_SA
#undef PG8_SB
#undef PG8_STAGE
#undef PG8_LDA
#undef PG8_LDB
#undef PG8_MMA
#undef PG8_WAIT_V
#undef PG8_WAIT_L
#undef PG8_BAR
#undef PG8_SCHED
}

template <class Epi, class Sched>
__device__ __forceinline__ void gemm_phase_gather(LAS unsigned char* lds, const Gemm g, const Sched& S, const Epi& E, const int* toks) {
    int tid_ = threadIdx.x; asm volatile("" : "+v"(tid_)); const int tid = tid_, wid = __builtin_amdgcn_readfirstlane(tid >> 6), lane = tid & 63, wr = wid >> 2, wc = wid & 3, fr = lane & 15, fq = lane >> 4;
    int K_ = g.K, lda_ = g.lda, ldb_ = g.ldb; asm volatile("" : "+s"(K_), "+s"(lda_), "+s"(ldb_)); const int K = K_, nt = K / BK;
    unsigned voffB[2]; int RA[2]; unsigned CA[2];
#pragma unroll
    for (int i = 0; i < 2; ++i) { int R, C; stage_rc(tid * 16 + i * 8192, R, C); const int Rb = Epi::PERM ? ((R & ~31) + perm32(R & 31)) : R;
        RA[i] = R; CA[i] = (unsigned)C * 2u; voffB[i] = (unsigned)(Rb * ldb_ + C) * 2u; }
    unsigned voC[2][2], voN[2][2];
#define PG8_GOFF(VO, U) do { _Pragma("unroll") for (int h_ = 0; h_ < 2; ++h_) _Pragma("unroll") for (int i_ = 0; i_ < 2; ++i_) VO[h_][i_] = (unsigned)(toks[(U).pm * BM + h_ * HALF + RA[i_]] & 0xffff) * (unsigned)(lda_ * 2) + CA[i_]; } while (0)
    const size_t kstep = (size_t)(BK * 2);
    const size_t hstepA = (size_t)HALF * lda_ * 2, hstepB = (size_t)HALF * ldb_ * 2;
    const size_t tstepA = 2 * hstepA, tstepB = 2 * hstepB;
    const unsigned ldsw = (unsigned)wid * 1024u;
    const int aoff = lds_byte(wr * 64 + fr, fq * 8), boff = lds_byte(wc * 32 + fr, fq * 8);
#define PG8_SA(b, h) (((b) * 2 + (h)) * HTB)
#define PG8_SB(b, h) ((4 + (b) * 2 + (h)) * HTB)
#define PG8_STAGE(bufoff, gbase, voff) do { _Pragma("unroll") for (int _i = 0; _i < 2; ++_i) \
        __builtin_amdgcn_global_load_lds((const unsigned*)((const char*)(gbase) + (voff)[_i]), (LAS unsigned*)(lds + (bufoff) + ldsw + _i * 8192), 16, 0, 0); } while (0)
#define PG8_LDA(dst, b, h) do { _Pragma("unroll") for (int m = 0; m < 4; ++m) _Pragma("unroll") for (int k = 0; k < 2; ++k) dst[m][k] = *(const LAS bf16x8*)(lds + PG8_SA(b, h) + aoff + m * 2048 + k * 1024); } while (0)
#define PG8_LDB(dst, b, h) do { _Pragma("unroll") for (int n = 0; n < 2; ++n) _Pragma("unroll") for (int k = 0; k < 2; ++k) dst[n][k] = *(const LAS bf16x8*)(lds + PG8_SB(b, h) + boff + n * 2048 + k * 1024); } while (0)
#define PG8_MMA(ai, bj, At, Bt) do { __builtin_amdgcn_s_setprio(1); _Pragma("unroll") for (int m = 0; m < 4; ++m) _Pragma("unroll") for (int n = 0; n < 2; ++n) _Pragma("unroll") for (int k = 0; k < 2; ++k) \
        acc[ai][bj][m][n] = __builtin_amdgcn_mfma_f32_16x16x32_bf16(Bt[n][k], At[m][k], acc[ai][bj][m][n], 0, 0, 0); __builtin_amdgcn_s_setprio(0); } while (0)
#define PG8_WAIT_V(n) asm volatile("s_waitcnt vmcnt(" #n ")" ::: "memory")
#define PG8_WAIT_L(n) asm volatile("s_waitcnt lgkmcnt(" #n ")" ::: "memory")
#define PG8_BAR __builtin_amdgcn_s_barrier()
#define PG8_SCHED __builtin_amdgcn_sched_barrier(0)
    Unit cur, nxt; int ui = 0;
    if (!S.next(0, cur)) return;
    f32x4 acc[2][2][4][2];
#pragma unroll
    for (int a = 0; a < 2; ++a)
#pragma unroll
        for (int b = 0; b < 2; ++b)
#pragma unroll
            for (int m = 0; m < 4; ++m)
#pragma unroll
                for (int n = 0; n < 2; ++n) acc[a][b][m][n] = (f32x4){0.f, 0.f, 0.f, 0.f};
    bf16x8 At[4][2], B0[2][2], B1[2][2];
    const char* const kA = (const char*)g.A; const char* cB = (const char*)g.Bt + (size_t)cur.pb * tstepB;
    PG8_GOFF(voC, cur);
    PG8_STAGE(PG8_SB(0, 0), cB, voffB); PG8_STAGE(PG8_SB(0, 1), cB + hstepB, voffB); PG8_STAGE(PG8_SA(0, 0), kA, voC[0]); PG8_STAGE(PG8_SA(0, 1), kA, voC[1]);
    if (wr == 1) PG8_BAR;
    PG8_WAIT_V(2); PG8_BAR;
    PG8_STAGE(PG8_SB(1, 0), cB + kstep, voffB); PG8_STAGE(PG8_SA(1, 0), kA + kstep, voC[0]); PG8_STAGE(PG8_SB(1, 1), cB + hstepB + kstep, voffB);
    PG8_WAIT_V(6); PG8_BAR;
    for (;;) {
        const bool has_next = S.next(ui + 1, nxt);
        const char* nB = has_next ? (const char*)g.Bt + (size_t)nxt.pb * tstepB : cB;
        if (has_next) PG8_GOFF(voN, nxt); else { _Pragma("unroll") for (int h_ = 0; h_ < 2; ++h_) _Pragma("unroll") for (int i_ = 0; i_ < 2; ++i_) voN[h_][i_] = voC[h_][i_]; }
#pragma nounroll
        for (int t = 0; t < nt; t += 2) {
            const bool last = (t == nt - 2);
            const char* a1 = kA + (size_t)(t + 1) * kstep;
            const char* a2 = last ? kA : kA + (size_t)(t + 2) * kstep; const char* b2 = last ? nB : cB + (size_t)(t + 2) * kstep;
            unsigned vo2[2][2];
#pragma unroll
            for (int h_ = 0; h_ < 2; ++h_)
#pragma unroll
                for (int i_ = 0; i_ < 2; ++i_) vo2[h_][i_] = last ? voN[h_][i_] : voC[h_][i_];
            const char* a3 = a2 + kstep; const char* b3 = b2 + kstep;
            PG8_LDB(B0, 0, 0); PG8_LDB(B1, 0, 1); PG8_SCHED; PG8_LDA(At, 0, 0); PG8_STAGE(PG8_SA(1, 1), a1, voC[1]);
            PG8_WAIT_V(8); PG8_WAIT_L(0); PG8_BAR; PG8_MMA(0, 0, At, B0); PG8_MMA(0, 1, At, B1); PG8_BAR; PG8_SCHED;
            PG8_LDA(At, 0, 1); PG8_STAGE(PG8_SB(0, 0), b2, voffB); PG8_STAGE(PG8_SB(0, 1), b2 + hstepB, voffB); PG8_STAGE(PG8_SA(0, 0), a2, vo2[0]);
            PG8_WAIT_V(8); PG8_WAIT_L(0); PG8_BAR; PG8_MMA(1, 0, At, B0); PG8_MMA(1, 1, At, B1); PG8_BAR; PG8_SCHED;
            PG8_LDB(B0, 1, 0); PG8_LDB(B1, 1, 1); PG8_SCHED; PG8_LDA(At, 1, 0); PG8_STAGE(PG8_SA(0, 1), a2, vo2[1]);
            PG8_WAIT_V(8); PG8_WAIT_L(0); PG8_BAR; PG8_MMA(0, 0, At, B0); PG8_MMA(0, 1, At, B1); PG8_BAR; PG8_SCHED;
            PG8_LDA(At, 1, 1); PG8_STAGE(PG8_SB(1, 0), b3, voffB); PG8_STAGE(PG8_SB(1, 1), b3 + hstepB, voffB); PG8_STAGE(PG8_SA(1, 0), a3, vo2[0]);
            PG8_WAIT_V(8); PG8_WAIT_L(0); PG8_BAR; PG8_MMA(1, 0, At, B0); PG8_MMA(1, 1, At, B1); PG8_BAR; PG8_SCHED;
        }
        if (wr == 0) PG8_BAR;
        E(acc, cur, wr, wc, fr, fq);
        if (!has_next) break;
#pragma unroll
        for (int a = 0; a < 2; ++a)
#pragma unroll
            for (int b = 0; b < 2; ++b)
#pragma unroll
                for (int m = 0; m < 4; ++m)
#pragma unroll
                    for (int n = 0; n < 2; ++n) acc[a][b][m][n] = (f32x4){0.f, 0.f, 0.f, 0.f};
        cur = nxt; cB = nB; ++ui;
#pragma unroll
        for (int h_ = 0; h_ < 2; ++h_)
#pragma unroll
            for (int i_ = 0; i_ < 2; ++i_) voC[h_][i_] = voN[h_][i_];
        if (wr == 1) PG8_BAR;
    }
    PG8_WAIT_V(0);
    PG8_BAR;
#undef PG8_GOFF
#undef PG8_SA
#undef PG8_SB
#undef PG8_STAGE
#undef PG8_LDA
#undef PG8_LDB
#undef PG8_MMA
#undef PG8_WAIT_V
#undef PG8_WAIT_L
#undef PG8_BAR
#undef PG8_SCHED
}


struct EpiBf16 {
    static constexpr bool PERM = true;
    bf16_t* O; int ldc; unsigned silu_mask; unsigned fg_mask; const float* lbt;
    __device__ __forceinline__ void operator()(const f32x4 (&acc)[2][2][4][2], const Unit& u, int wr, int wc, int fr, int fq) const {
        const int row0 = u.pm * BM + wr * 64 + fr, col0 = u.pn * BM + wc * 32 + 8 * fq;
        const bool act = (silu_mask >> u.pn) & 1u, fgm = (fg_mask >> u.pn) & 1u;
#pragma unroll
        for (int bj = 0; bj < 2; ++bj) {
            f32x4 l0 = (f32x4){0.f, 0.f, 0.f, 0.f}, l1 = l0;
            if (fgm) { const int cc = (col0 & 1023) + bj * HALF; l0 = *(const f32x4*)(lbt + cc); l1 = *(const f32x4*)(lbt + cc + 4); }
#pragma unroll
            for (int ai = 0; ai < 2; ++ai)
#pragma unroll
                for (int m = 0; m < 4; ++m) { bf16_t* rowp = O + (size_t)(row0 + ai * HALF + m * 16) * ldc + col0;
                    f32x4 v0 = acc[ai][bj][m][0], v1 = acc[ai][bj][m][1];
                    if (act) {
#pragma unroll
                        for (int j = 0; j < 4; ++j) { v0[j] = siluf_(v0[j]); v1[j] = siluf_(v1[j]); } }
                    if (fgm) {
#pragma unroll
                        for (int j = 0; j < 4; ++j) { v0[j] = l0[j] + (1.0f - l0[j]) * sigmoidf_(v0[j]); v1[j] = l1[j] + (1.0f - l1[j]) * sigmoidf_(v1[j]); } }
                    u32x4 w; w.x = cvt_pk_bf16(v0[0], v0[1]); w.y = cvt_pk_bf16(v0[2], v0[3]); w.z = cvt_pk_bf16(v1[0], v1[1]); w.w = cvt_pk_bf16(v1[2], v1[3]);
                    *(u32x4*)(rowp + bj * HALF) = w; }
        }
    }
};
struct EpiGate {
    static constexpr bool PERM = true;
    const bf16_t* h2; const bf16_t* pp; float* xout; bf16_t* xb;
    __device__ __forceinline__ void operator()(const f32x4 (&acc)[2][2][4][2], const Unit& u, int wr, int wc, int fr, int fq) const {
        const int row0 = u.pm * BM + wr * 64 + fr, col0 = u.pn * BM + wc * 32 + 8 * fq;
#pragma unroll
        for (int ai = 0; ai < 2; ++ai)
#pragma unroll
            for (int m = 0; m < 4; ++m) { const size_t off = (size_t)(row0 + ai * HALF + m * 16) * D + col0;
#pragma unroll
                for (int bj = 0; bj < 2; ++bj) { const size_t o = off + bj * HALF;
                    const u32x4 hw = *(const u32x4*)(h2 + o), pw = *(const u32x4*)(pp + o); const f32x4 a0 = acc[ai][bj][m][0], a1 = acc[ai][bj][m][1];
                    f32x4 r0, r1;
                    r0[0] = bflo(hw.x) + sigmoidf_(a0[0]) * bflo(pw.x); r0[1] = bfhi(hw.x) + sigmoidf_(a0[1]) * bfhi(pw.x); r0[2] = bflo(hw.y) + sigmoidf_(a0[2]) * bflo(pw.y); r0[3] = bfhi(hw.y) + sigmoidf_(a0[3]) * bfhi(pw.y);
                    r1[0] = bflo(hw.z) + sigmoidf_(a1[0]) * bflo(pw.z); r1[1] = bfhi(hw.z) + sigmoidf_(a1[1]) * bfhi(pw.z); r1[2] = bflo(hw.w) + sigmoidf_(a1[2]) * bflo(pw.w); r1[3] = bfhi(hw.w) + sigmoidf_(a1[3]) * bfhi(pw.w);
                    if (xout) { *(f32x4*)(xout + o) = r0; *(f32x4*)(xout + o + 4) = r1; }
                    else *(u32x4*)(xb + o) = (u32x4){cvt_pk_bf16(r0[0], r0[1]), cvt_pk_bf16(r0[2], r0[3]), cvt_pk_bf16(r1[0], r1[1]), cvt_pk_bf16(r1[2], r1[3])}; }
                asm volatile("" ::: "memory"); }
    }
};
struct EpiPre {
    static constexpr bool PERM = true;
    const float* xf; const bf16_t* xh; bf16_t* pre;
    __device__ __forceinline__ void operator()(const f32x4 (&acc)[2][2][4][2], const Unit& u, int wr, int wc, int fr, int fq) const {
        const int row0 = u.pm * BM + wr * 64 + fr, col0 = u.pn * BM + wc * 32 + 8 * fq;
#pragma unroll
        for (int ai = 0; ai < 2; ++ai)
#pragma unroll
            for (int m = 0; m < 4; ++m) { const size_t off = (size_t)(row0 + ai * HALF + m * 16) * D + col0;
#pragma unroll
                for (int bj = 0; bj < 2; ++bj) { const size_t o = off + bj * HALF; f32x4 x0, x1;
                    if (xf) { x0 = *(const f32x4*)(xf + o); x1 = *(const f32x4*)(xf + o + 4); }
                    else { const u32x4 w = *(const u32x4*)(xh + o); x0 = (f32x4){bflo(w.x), bfhi(w.x), bflo(w.y), bfhi(w.y)}; x1 = (f32x4){bflo(w.z), bfhi(w.z), bflo(w.w), bfhi(w.w)}; }
                    const f32x4 r0 = x0 * DN_ALPHA + acc[ai][bj][m][0], r1 = x1 * DN_ALPHA + acc[ai][bj][m][1];
                    *(u32x4*)(pre + o) = (u32x4){cvt_pk_bf16(r0[0], r0[1]), cvt_pk_bf16(r0[2], r0[3]), cvt_pk_bf16(r1[0], r1[1]), cvt_pk_bf16(r1[2], r1[3])}; }
                asm volatile("" ::: "memory"); }
    }
};
struct EpiMoe1 {
    static constexpr bool PERM = true;
    bf16_t* hid;
    __device__ __forceinline__ void operator()(const f32x4 (&acc)[2][2][4][2], const Unit& u, int wr, int wc, int fr, int fq) const {
        const int row0 = u.pm * BM + wr * 64 + fr, col0 = u.pn * HALF + wc * 32 + 8 * fq;
#pragma unroll
        for (int ai = 0; ai < 2; ++ai)
#pragma unroll
            for (int m = 0; m < 4; ++m) { bf16_t* rowp = hid + (size_t)(row0 + ai * HALF + m * 16) * MOE_H + col0;
                f32x4 v0, v1;
#pragma unroll
                for (int j = 0; j < 4; ++j) { v0[j] = siluf_(acc[ai][0][m][0][j]) * acc[ai][1][m][0][j]; v1[j] = siluf_(acc[ai][0][m][1][j]) * acc[ai][1][m][1][j]; }
                u32x4 w; w.x = cvt_pk_bf16(v0[0], v0[1]); w.y = cvt_pk_bf16(v0[2], v0[3]); w.z = cvt_pk_bf16(v1[0], v1[1]); w.w = cvt_pk_bf16(v1[2], v1[3]);
                *(u32x4*)rowp = w; }
    }
};
struct EpiLora {
    static constexpr bool PERM = true;
    const float* w0; const float* a0; float* dec; bf16_t* aa; bf16_t* gg;
    __device__ __forceinline__ void operator()(const f32x4 (&acc)[2][2][4][2], const Unit& u, int wr, int wc, int fr, int fq) const {
        const int row0 = u.pm * BM + wr * 64 + fr, seg = u.pn >> 1, c0 = (u.pn & 1) * BM + wc * 32 + 8 * fq;
#pragma unroll
        for (int bj = 0; bj < 2; ++bj) {
            const int c = c0 + bj * HALF;
            f32x4 b0 = (f32x4){0.f, 0.f, 0.f, 0.f}, b1 = b0;
            if (seg == 0) { b0 = *(const f32x4*)(w0 + c); b1 = *(const f32x4*)(w0 + c + 4); } else if (seg == 1) { b0 = *(const f32x4*)(a0 + c); b1 = *(const f32x4*)(a0 + c + 4); }
#pragma unroll
            for (int ai = 0; ai < 2; ++ai)
#pragma unroll
                for (int m = 0; m < 4; ++m) { const size_t o = (size_t)(row0 + ai * HALF + m * 16) * 512 + c;
                    f32x4 v0 = acc[ai][bj][m][0] + b0, v1 = acc[ai][bj][m][1] + b1;
                    if (seg == 0) {
#pragma unroll
                        for (int j = 0; j < 4; ++j) { v0[j] = __expf(-0.60653066f * sigmoidf_(v0[j])); v1[j] = __expf(-0.60653066f * sigmoidf_(v1[j])); }
                        *(f32x4*)(dec + o) = v0; *(f32x4*)(dec + o + 4) = v1;
                    } else {
                        if (seg == 1) {
#pragma unroll
                            for (int j = 0; j < 4; ++j) { v0[j] = sigmoidf_(v0[j]); v1[j] = sigmoidf_(v1[j]); } }
                        u32x4 w; w.x = cvt_pk_bf16(v0[0], v0[1]); w.y = cvt_pk_bf16(v0[2], v0[3]); w.z = cvt_pk_bf16(v1[0], v1[1]); w.w = cvt_pk_bf16(v1[2], v1[3]);
                        if (seg == 1) *(u32x4*)(aa + o) = w; else *(u32x4*)(gg + o) = w;
                    } }
        }
    }
};
struct EpiF32 {
    static constexpr bool PERM = false;
    float* C; int ldc;
    __device__ __forceinline__ void operator()(const f32x4 (&acc)[2][2][4][2], const Unit& u, int wr, int wc, int fr, int fq) const {
        const int row0 = u.pm * BM + wr * 64 + fr, col0 = u.pn * BM + wc * 32 + 4 * fq;
#pragma unroll
        for (int ai = 0; ai < 2; ++ai)
#pragma unroll
            for (int m = 0; m < 4; ++m) { float* rowp = C + (size_t)(row0 + ai * HALF + m * 16) * ldc + col0;
#pragma unroll
                for (int bj = 0; bj < 2; ++bj)
#pragma unroll
                    for (int n = 0; n < 2; ++n) *(f32x4*)(rowp + bj * HALF + n * 16) = acc[ai][bj][m][n]; }
    }
};
struct CmpOrder {
    int G, c;
    __device__ bool next(int i, Unit& u) const { const int L = i * G + c; if (L >= 64) return false; u.pm = L; u.pn = 0; u.pb = L >> 5; return true; }
};
struct EpiLogit {
    static constexpr bool PERM = false;
    float* LG;
    __device__ __forceinline__ void operator()(const f32x4 (&acc)[2][2][4][2], const Unit& u, int wr, int wc, int fr, int fq) const {
        if (wc >= 2) return;
        const int row0 = u.pm * BM + wr * 64 + fr, col0 = wc * 32 + 4 * fq;
#pragma unroll
        for (int ai = 0; ai < 2; ++ai)
#pragma unroll
            for (int m = 0; m < 4; ++m) { float* rowp = LG + (size_t)(row0 + ai * HALF + m * 16) * 64 + col0;
#pragma unroll
                for (int n = 0; n < 2; ++n) *(f32x4*)(rowp + n * 16) = acc[ai][0][m][n]; }
    }
};

typedef int i32x8 __attribute__((ext_vector_type(8)));
typedef int i32x4_ __attribute__((ext_vector_type(4)));
__device__ __forceinline__ i32x8 f8cat(const bf16x8& a, const bf16x8& b) { return __builtin_shufflevector(__builtin_bit_cast(i32x4_, a), __builtin_bit_cast(i32x4_, b), 0, 1, 2, 3, 4, 5, 6, 7); }
template <int MODE>
__device__ __forceinline__ void gemm_f8_phase(LAS unsigned char* lds, const unsigned char* A8, const unsigned char* B8, int Kb, const MoeOrder& S, const int* toks, unsigned char* hid8, bf16_t* Y) {
    int tid_ = threadIdx.x; asm volatile("" : "+v"(tid_)); const int tid = tid_, wid = __builtin_amdgcn_readfirstlane(tid >> 6), lane = tid & 63, wr = wid >> 2, wc = wid & 3, fr = lane & 15, fq = lane >> 4;
    int Kb_ = Kb; asm volatile("" : "+s"(Kb_)); const int nt = Kb_ >> 7;
    constexpr int BUFB = 49152, EST = (MODE == 0 ? 4 : 8), NRN = (MODE == 0 ? 4 : 0);
    int RA[2]; unsigned CA[2], voffB[2];
#pragma unroll
    for (int i = 0; i < 2; ++i) { int R, C; stage_rc(tid * 16 + i * 8192, R, C); RA[i] = R; CA[i] = (unsigned)C * 2u; voffB[i] = (unsigned)(((R & ~31) + perm32(R & 31)) * Kb_) + (unsigned)C * 2u; }
    const unsigned ldsw = (unsigned)wid * 1024u;
    const int aoff = lds_byte(wr * 64 + fr, fq * 8), boff = lds_byte(wc * 32 + fr, fq * 8);
    const size_t hstepB = (size_t)HALF * Kb_, tstepB = 2 * hstepB;
#define F8_ROWS(RO, U) do { _Pragma("unroll") for (int h_ = 0; h_ < 2; ++h_) _Pragma("unroll") for (int i_ = 0; i_ < 2; ++i_) { const int r_ = (U).pm * BM + h_ * HALF + RA[i_]; \
        RO[h_][i_] = (unsigned)(MODE == 0 ? (toks[r_] & 0xffff) : r_) * (unsigned)Kb_ + CA[i_]; } } while (0)
#define F8_DMA(dst, base, voff) __builtin_amdgcn_global_load_lds((const unsigned*)((const char*)(base) + (voff)), (LAS unsigned*)(lds + (dst)), 16, 0, 0)
#define F8_STAGE(U, RO, q, sb) do { const int h_ = (q) >= nt ? 1 : 0; const size_t ko_ = (size_t)((q) - h_ * nt) * 128; const char* bb_ = (const char*)B8 + (size_t)(U).pb * tstepB + ko_; const unsigned d_ = (unsigned)(sb) * BUFB + ldsw; \
        _Pragma("unroll") for (int i_ = 0; i_ < 2; ++i_) { F8_DMA(d_ + i_ * 8192, (const char*)A8 + ko_, RO[h_][i_]); F8_DMA(d_ + 16384 + i_ * 8192, bb_, voffB[i_]); F8_DMA(d_ + 32768 + i_ * 8192, bb_ + hstepB, voffB[i_]); } } while (0)
#define F8_WAIT(n) asm volatile("s_waitcnt vmcnt(" #n ")" ::: "memory")
    constexpr int ULIST = 3 * BUFB, UCAP = 512;
    { i32x4_ e = (i32x4_){0, 0, 0, 0}; const int i = tid;
      if ((S.G & 7) == 0) { const int x = S.c & 7, r = S.c >> 3, w = S.G >> 3, k = i * w + r, q = k >> 2, t = q * 8 + x; if (t < S.ntiles) e = (i32x4_){t, k & 3, S.tile_e[t] * 4 + (k & 3), 1}; }
      else { const long L = (long)i * S.G + S.c; if (L < (long)S.ntiles * 4) e = (i32x4_){(int)(L >> 2), (int)(L & 3), S.tile_e[(int)(L >> 2)] * 4 + (int)(L & 3), 1}; }
      if (i < UCAP) *(LAS i32x4_*)(lds + ULIST + i * 16) = e; }
    __syncthreads();
#define F8_UNIT(k, U, ok) do { i32x4_ e_ = (i32x4_){0, 0, 0, 0}; if ((k) < UCAP) e_ = *(const LAS i32x4_*)(lds + ULIST + (k) * 16); (U).pm = __builtin_amdgcn_readfirstlane(e_.x); (U).pn = __builtin_amdgcn_readfirstlane(e_.y); \
        (U).pb = __builtin_amdgcn_readfirstlane(e_.z); ok = __builtin_amdgcn_readfirstlane(e_.w) != 0; } while (0)
    Unit cur, nxt; int ui = 0; bool ok0;
    F8_UNIT(0, cur, ok0);
    if (!ok0) return;
    unsigned ro[2][2], rn[2][2];
    F8_ROWS(ro, cur);
    F8_STAGE(cur, ro, 0, 0); F8_STAGE(cur, ro, 1, 1);
    f32x4 acc[2][4][2];
#pragma unroll
    for (int b = 0; b < 2; ++b)
#pragma unroll
        for (int m = 0; m < 4; ++m)
#pragma unroll
            for (int n = 0; n < 2; ++n) acc[b][m][n] = (f32x4){0.f, 0.f, 0.f, 0.f};
    int buf = 0; bool after_epi = false, first = true;
    for (;;) {
        bool has_next; F8_UNIT(ui + 1, nxt, has_next);
        int raw[2][2];
#pragma unroll
        for (int h_ = 0; h_ < 2; ++h_)
#pragma unroll
            for (int i_ = 0; i_ < 2; ++i_) { raw[h_][i_] = 0;
                if (MODE == 0) { const int* p_ = toks + (has_next ? nxt.pm : cur.pm) * BM + h_ * HALF + RA[i_]; asm volatile("global_load_dword %0, %1, off" : "=v"(raw[h_][i_]) : "v"(p_) : "memory"); } }
        bool unit_start = !first && NRN != 0;
        if (first && NRN != 0) { F8_WAIT(0); }
        first = false;
#pragma nounroll
        for (int g = 0; g < 2 * nt; ++g) {
            const bool more = (g + 1 < 2 * nt) || has_next;
            if (!more) F8_WAIT(0);
            else if (after_epi && unit_start) { if (EST == 4) F8_WAIT(14); else F8_WAIT(18); }
            else if (after_epi) { if (EST == 4) F8_WAIT(10); else F8_WAIT(14); }
            else if (unit_start) F8_WAIT(10);
            else F8_WAIT(6);
            after_epi = false; unit_start = false;
            __builtin_amdgcn_s_barrier();
            if (g == 1) {
                asm volatile("" : "+v"(raw[0][0]), "+v"(raw[0][1]), "+v"(raw[1][0]), "+v"(raw[1][1]));
#pragma unroll
                for (int h_ = 0; h_ < 2; ++h_)
#pragma unroll
                    for (int i_ = 0; i_ < 2; ++i_) rn[h_][i_] = (unsigned)(MODE == 0 ? (raw[h_][i_] & 0xffff) : (has_next ? nxt.pm : cur.pm) * BM + h_ * HALF + RA[i_]) * (unsigned)Kb_ + CA[i_];
            }
            const int sb = buf >= 1 ? buf - 1 : 2;
            const bool st_cur = g + 2 < 2 * nt, st_any = st_cur || has_next;
            const int sq = st_cur ? g + 2 : g + 2 - 2 * nt, sh = sq >= nt ? 1 : 0; const size_t sko = (size_t)(sq - sh * nt) * 128;
            const char* sbb = (const char*)B8 + (size_t)(st_cur ? cur.pb : nxt.pb) * tstepB + sko; const unsigned sd = (unsigned)sb * BUFB + ldsw;
            const unsigned sra0 = st_cur ? ro[sh][0] : rn[sh][0], sra1 = st_cur ? ro[sh][1] : rn[sh][1];
            bf16x8 At[4][2], B0[2][2], B1[2][2];
            const LAS unsigned char* tb = lds + buf * BUFB;
#pragma unroll
            for (int n = 0; n < 2; ++n)
#pragma unroll
                for (int k = 0; k < 2; ++k) { B0[n][k] = *(const LAS bf16x8*)(tb + 16384 + boff + n * 2048 + k * 1024); B1[n][k] = *(const LAS bf16x8*)(tb + 32768 + boff + n * 2048 + k * 1024); }
#pragma unroll
            for (int m = 0; m < 4; ++m)
#pragma unroll
                for (int k = 0; k < 2; ++k) At[m][k] = *(const LAS bf16x8*)(tb + aoff + m * 2048 + k * 1024);
#define F8_MMA4(m) do { __builtin_amdgcn_s_setprio(1); _Pragma("unroll") for (int n = 0; n < 2; ++n) { \
                    acc[0][m][n] = __builtin_amdgcn_mfma_scale_f32_16x16x128_f8f6f4(f8cat(B0[n][0], B0[n][1]), f8cat(At[m][0], At[m][1]), acc[0][m][n], 0, 0, 0, 0, 0, 0); \
                    acc[1][m][n] = __builtin_amdgcn_mfma_scale_f32_16x16x128_f8f6f4(f8cat(B1[n][0], B1[n][1]), f8cat(At[m][0], At[m][1]), acc[1][m][n], 0, 0, 0, 0, 0, 0); } __builtin_amdgcn_s_setprio(0); __builtin_amdgcn_sched_barrier(0); } while (0)
            __builtin_amdgcn_sched_barrier(0);
            if (st_any) F8_DMA(sd, (const char*)A8 + sko, sra0);
            __builtin_amdgcn_sched_barrier(0);
            F8_MMA4(0);
            if (st_any) { F8_DMA(sd + 16384, sbb, voffB[0]); F8_DMA(sd + 32768, sbb + hstepB, voffB[0]); }
            __builtin_amdgcn_sched_barrier(0);
            F8_MMA4(1);
            if (st_any) F8_DMA(sd + 8192, (const char*)A8 + sko, sra1);
            __builtin_amdgcn_sched_barrier(0);
            F8_MMA4(2);
            if (st_any) { F8_DMA(sd + 16384 + 8192, sbb, voffB[1]); F8_DMA(sd + 32768 + 8192, sbb + hstepB, voffB[1]); }
            __builtin_amdgcn_sched_barrier(0);
            F8_MMA4(3);
#undef F8_MMA4
            buf = buf == 2 ? 0 : buf + 1;
            if (g == nt - 1 || g == 2 * nt - 1) {
                const int ai = g >= nt ? 1 : 0, row0 = cur.pm * BM + ai * HALF + wr * 64 + fr;
                if (MODE == 0) { const int col0 = cur.pn * HALF + wc * 32 + 8 * fq;
#pragma unroll
                    for (int m = 0; m < 4; ++m) { f32x4 v0, v1;
#pragma unroll
                        for (int j = 0; j < 4; ++j) { v0[j] = siluf_(acc[0][m][0][j]) * acc[1][m][0][j]; v1[j] = siluf_(acc[0][m][1][j]) * acc[1][m][1][j]; }
                        *(u32x2*)(hid8 + (size_t)(row0 + m * 16) * MOE_H + col0) = (u32x2){cvt_pk4_fp8_sat(v0[0], v0[1], v0[2], v0[3]), cvt_pk4_fp8_sat(v1[0], v1[1], v1[2], v1[3])}; }
                } else { const int col0 = cur.pn * BM + wc * 32 + 8 * fq;
#pragma unroll
                    for (int b = 0; b < 2; ++b)
#pragma unroll
                        for (int m = 0; m < 4; ++m) { const f32x4 v0 = acc[b][m][0], v1 = acc[b][m][1];
                            *(u32x4*)(Y + (size_t)(row0 + m * 16) * D + col0 + b * HALF) = (u32x4){cvt_pk_bf16(v0[0], v0[1]), cvt_pk_bf16(v0[2], v0[3]), cvt_pk_bf16(v1[0], v1[1]), cvt_pk_bf16(v1[2], v1[3])}; }
                }
#pragma unroll
                for (int b = 0; b < 2; ++b)
#pragma unroll
                    for (int m = 0; m < 4; ++m)
#pragma unroll
                        for (int n = 0; n < 2; ++n) acc[b][m][n] = (f32x4){0.f, 0.f, 0.f, 0.f};
                after_epi = true;
            }
        }
        if (!has_next) break;
        cur = nxt; ++ui;
#pragma unroll
        for (int h_ = 0; h_ < 2; ++h_)
#pragma unroll
            for (int i_ = 0; i_ < 2; ++i_) ro[h_][i_] = rn[h_][i_];
    }
    F8_WAIT(0);
    __builtin_amdgcn_s_barrier();
#undef F8_ROWS
#undef F8_UNIT
#undef F8_DMA
#undef F8_STAGE
#undef F8_WAIT
}
}

#define XB_TMO      128
#define XB_XCNT(j)  (256  + 64 * (j))
#define XB_XSUB(j)  (1280 + 64 * (j))
#define XB_XGEN(j)  (2304 + 64 * (j))
#define XB_TOP      3328
#define XB_TOPGEN   3392
#define XCD_BAR_WORDS 3456
#define XB_SPIN_CAP (1u << 18)
__device__ __forceinline__ unsigned xb_ld(unsigned* p)              { return __hip_atomic_load(p, __ATOMIC_RELAXED, __HIP_MEMORY_SCOPE_AGENT); }
__device__ __forceinline__ unsigned xb_add(unsigned* p, unsigned v) { return __hip_atomic_fetch_add(p, v, __ATOMIC_RELAXED, __HIP_MEMORY_SCOPE_AGENT); }
__device__ __forceinline__ unsigned xb_xcc_id() { return (unsigned)__builtin_amdgcn_s_getreg((3 << 11) | 20) & 0xFu; }
#define XB_SPIN(cond, bar) do { unsigned _sp = 0; while (cond) { __builtin_amdgcn_s_sleep(1); \
    if ((++_sp & 255u) == 0u) { if (xb_ld(&(bar)[XB_TMO])) break; if (_sp > XB_SPIN_CAP) { atomicAdd(&(bar)[XB_TMO], 1u); break; } } } } while (0)
struct XcdBarrier { unsigned* bar; unsigned x; volatile LAS unsigned* st; };
__device__ __forceinline__ XcdBarrier xcd_barrier_post(unsigned* bar, volatile LAS unsigned* st) {
    XcdBarrier b; b.bar = bar; b.x = xb_xcc_id(); b.st = st;
    if (threadIdx.x == 0) (void)xb_add(&bar[XB_XCNT(b.x)], 1u);
    return b;
}
__device__ __forceinline__ void xcd_barrier_complete(unsigned* bar, unsigned x, unsigned& nloc, unsigned& nx) {
    const unsigned G = gridDim.x * gridDim.y * gridDim.z;
    unsigned sum, cnt, mine, sp = 0u;
    for (;;) {
        sum = 0u; cnt = 0u; mine = 0u;
#pragma unroll
        for (unsigned j = 0; j < 16; ++j) { const unsigned c = xb_ld(&bar[XB_XCNT(j)]); sum += c; cnt += (c > 0u) ? 1u : 0u; mine = (j == x) ? c : mine; }
        if (sum == G) break;
        __builtin_amdgcn_s_sleep(1);
        if ((++sp & 255u) == 0u) { if (xb_ld(&bar[XB_TMO])) break; if (sp > XB_SPIN_CAP) { atomicAdd(&bar[XB_TMO], 1u); break; } }
    }
    nloc = mine > 0u ? mine : 1u; nx = cnt > 0u ? cnt : 1u;
}
__device__ __forceinline__ void xcd_barrier(const XcdBarrier& b) {
    asm volatile("s_waitcnt vmcnt(0)" ::: "memory");
    __syncthreads();
    if (threadIdx.x == 0) {
        unsigned* bar = b.bar;
        __builtin_amdgcn_s_waitcnt(0);
        unsigned nloc = b.st[0], nx = b.st[1];
        if (nloc == 0u) { xcd_barrier_complete(bar, b.x, nloc, nx); b.st[0] = nloc; b.st[1] = nx; }
        const unsigned old = xb_add(&bar[XB_XSUB(b.x)], 1u);
        const unsigned gen = old / nloc;
        if (old + 1u == (gen + 1u) * nloc) {
            __builtin_amdgcn_fence(__ATOMIC_RELEASE, "agent");
            asm volatile("s_waitcnt vmcnt(0)" ::: "memory");
            const unsigned og = xb_add(&bar[XB_TOP], 1u);
            const unsigned tg = og / nx;
            if (og + 1u == (tg + 1u) * nx) xb_add(&bar[XB_TOPGEN], 1u);
            else XB_SPIN(xb_ld(&bar[XB_TOPGEN]) == tg, bar);
            __builtin_amdgcn_fence(__ATOMIC_ACQUIRE, "agent");
            xb_add(&bar[XB_XGEN(b.x)], 1u);
            asm volatile("s_waitcnt vmcnt(0)" ::: "memory");
        } else {
            XB_SPIN(xb_ld(&bar[XB_XGEN(b.x)]) == gen, bar);
            __builtin_amdgcn_fence(__ATOMIC_ACQUIRE, "agent");
            asm volatile("s_waitcnt vmcnt(0)" ::: "memory");
        }
    }
    __syncthreads();
}


typedef float f32x16 __attribute__((ext_vector_type(16)));
#define MFMA32(a, b, c) __builtin_amdgcn_mfma_f32_32x32x16_bf16((a), (b), (c), 0, 0, 0)
__device__ __forceinline__ int crow(int reg, int h) { return (reg & 3) + 8 * (reg >> 2) + 4 * h; }
constexpr int HG_LQE = 0, HG_LKE = HG_LQE + 64 * 272, HG_LKTT = HG_LKE + 64 * 272, HG_LVT = HG_LKTT + 128 * 144, HG_LAT = HG_LVT + 128 * 144, HG_LST = HG_LAT + 64 * 144,
              HG_LO = HG_LST + 128 * 272, HG_LBL = HG_LO + 64 * 528, HG_LPART = HG_LBL + 512, HG_LEND = HG_LPART + 4096;
static_assert(HG_LEND <= 163840 - 512, "hgrn lds");
__device__ __forceinline__ void hgrn_phase(LAS unsigned char* lds, const bf16_t* Z, const float* hg_lb, const float* norm_g, bf16_t* OG, int G, int bx) {
    const int tid = pinned_tid(), lane = tid & 63, wave = __builtin_amdgcn_readfirstlane(tid >> 6), half = lane >> 5, l32 = lane & 31;
    const int d = 2 * (tid & 63), jq = tid >> 6;
    for (int unit = bx; unit < NB * 8; unit += G) {
        const int b = unit >> 3, h = unit & 7;
        for (int i = tid; i < 128 * 272 / 4; i += NTHR) ((LAS unsigned*)(lds + HG_LST))[i] = 0u;
        f32x16 S0, S1;
#pragma unroll
        for (int r = 0; r < 16; ++r) { S0[r] = 0.f; S1[r] = 0.f; }
        __syncthreads();
        unsigned qn[8], fn[8], vn[8];
#define HG_LOAD(n_) do { const bf16_t* zr_ = Z + ((size_t)(b * T + (n_) * 64 + jq * 8)) * 4096 + h * 128 + d; \
            _Pragma("unroll") for (int jj = 0; jj < 8; ++jj) { qn[jj] = *(const unsigned*)(zr_ + (size_t)jj * 4096); fn[jj] = *(const unsigned*)(zr_ + (size_t)jj * 4096 + 1024); vn[jj] = *(const unsigned*)(zr_ + (size_t)jj * 4096 + 2048); } } while (0)
        u32x4 gc0, gc1, gn0, gn1;
#define HG_LOADG(n_, A_, B_) do { const bf16_t* gp_ = Z + (size_t)(b * T + (n_) * 64 + (tid >> 3)) * 4096 + 3072 + h * 128 + (tid & 7) * 16; A_ = *(const u32x4*)gp_; B_ = *(const u32x4*)(gp_ + 8); } while (0)
        HG_LOAD(0); HG_LOADG(0, gc0, gc1);
        for (int n = 0; n < T / 64; ++n) {
            float q0[8], q1[8], k0[8], k1[8], p0[8], p1[8]; unsigned vr[8];
            float run0 = 1.f, run1 = 1.f;
#pragma unroll
            for (int jj = 0; jj < 8; ++jj) { const float fg0 = bflo(fn[jj]), fg1 = bfhi(fn[jj]); run0 *= fg0; run1 *= fg1; p0[jj] = run0; p1[jj] = run1; k0[jj] = 1.0f - fg0; k1[jj] = 1.0f - fg1;
                q0[jj] = bflo(qn[jj]); q1[jj] = bfhi(qn[jj]); vr[jj] = vn[jj]; }
            *(LAS f32x2*)(lds + HG_LPART + (jq * 128 + d) * 4) = (f32x2){run0, run1};
            __syncthreads();
            float pre0 = 1.f, pre1 = 1.f, tot0 = 1.f, tot1 = 1.f;
#pragma unroll
            for (int q = 0; q < 8; ++q) { const f32x2 pq = *(const LAS f32x2*)(lds + HG_LPART + (q * 128 + d) * 4); tot0 *= pq[0]; tot1 *= pq[1]; if (q < jq) { pre0 *= pq[0]; pre1 *= pq[1]; } }
            if (jq == 0) *(LAS f32x2*)(lds + HG_LBL + d * 4) = (f32x2){tot0, tot1};
            unsigned kt0[4], kt1[4], vt0[4], vt1[4];
#pragma unroll
            for (int jj = 0; jj < 8; ++jj) {
                const float e0 = p0[jj] * pre0, e1 = p1[jj] * pre1, r0 = __builtin_amdgcn_rcpf(e0), r1 = __builtin_amdgcn_rcpf(e1);
                const int j = jq * 8 + jj;
                *(LAS unsigned*)(lds + HG_LQE + j * 272 + d * 2) = cvt_pk_bf16(q0[jj] * e0, q1[jj] * e1);
                *(LAS unsigned*)(lds + HG_LKE + j * 272 + d * 2) = cvt_pk_bf16(k0[jj] * r0, k1[jj] * r1);
                const float t0 = k0[jj] * r0 * tot0, t1 = k1[jj] * r1 * tot1;
                if (jj & 1) { kt0[jj >> 1] = cvt_pk_bf16(p0[jj - 1], t0); kt1[jj >> 1] = cvt_pk_bf16(p1[jj - 1], t1); vt0[jj >> 1] = (vr[jj - 1] & 0xffffu) | (vr[jj] << 16); vt1[jj >> 1] = (vr[jj - 1] >> 16) | (vr[jj] & 0xffff0000u); }
                else { p0[jj] = t0; p1[jj] = t1; }
            }
            *(LAS u32x4*)(lds + HG_LKTT + d * 144 + jq * 16) = (u32x4){kt0[0], kt0[1], kt0[2], kt0[3]}; *(LAS u32x4*)(lds + HG_LKTT + (d + 1) * 144 + jq * 16) = (u32x4){kt1[0], kt1[1], kt1[2], kt1[3]};
            *(LAS u32x4*)(lds + HG_LVT + d * 144 + jq * 16) = (u32x4){vt0[0], vt0[1], vt0[2], vt0[3]}; *(LAS u32x4*)(lds + HG_LVT + (d + 1) * 144 + jq * 16) = (u32x4){vt1[0], vt1[1], vt1[2], vt1[3]};
            __syncthreads();
            if (n + 1 < T / 64) { HG_LOAD(n + 1); HG_LOADG(n + 1, gn0, gn1); }
            if (wave < 4) {
                const int tj = wave >> 1, ti = wave & 1;
                f32x16 acc;
#pragma unroll
                for (int r = 0; r < 16; ++r) acc[r] = 0.f;
                if (tj <= ti) {
#pragma unroll
                    for (int s = 0; s < 8; ++s) {
                        const bf16x8 a = *(const LAS bf16x8*)(lds + HG_LKE + (32 * tj + l32) * 272 + (16 * s + 8 * half) * 2);
                        const bf16x8 bq = *(const LAS bf16x8*)(lds + HG_LQE + (32 * ti + l32) * 272 + (16 * s + 8 * half) * 2);
                        acc = MFMA32(a, bq, acc);
                    }
                }
                const int ig = 32 * ti + l32;
#pragma unroll
                for (int g4 = 0; g4 < 4; ++g4) {
                    const int j0 = 32 * tj + 8 * g4 + 4 * half;
                    float v0 = acc[4 * g4], v1 = acc[4 * g4 + 1], v2 = acc[4 * g4 + 2], v3 = acc[4 * g4 + 3];
                    v0 = (j0 <= ig) ? v0 : 0.f; v1 = (j0 + 1 <= ig) ? v1 : 0.f; v2 = (j0 + 2 <= ig) ? v2 : 0.f; v3 = (j0 + 3 <= ig) ? v3 : 0.f;
                    *(LAS u32x2*)(lds + HG_LAT + ig * 144 + j0 * 2) = (u32x2){cvt_pk_bf16(v0, v1), cvt_pk_bf16(v2, v3)};
                }
            }
            {
                const int td = wave & 3, tc0 = (wave >> 2) * 2;
#pragma unroll
                for (int r = 0; r < 16; ++r) { const float sc = ((LAS float*)(lds + HG_LBL))[32 * td + crow(r, half)]; S0[r] *= sc; S1[r] *= sc; }
#pragma unroll
                for (int s = 0; s < 4; ++s) {
                    const bf16x8 a = *(const LAS bf16x8*)(lds + HG_LKTT + (32 * td + l32) * 144 + (16 * s + 8 * half) * 2);
                    const bf16x8 b0 = *(const LAS bf16x8*)(lds + HG_LVT + (32 * tc0 + l32) * 144 + (16 * s + 8 * half) * 2);
                    const bf16x8 b1 = *(const LAS bf16x8*)(lds + HG_LVT + (32 * (tc0 + 1) + l32) * 144 + (16 * s + 8 * half) * 2);
                    S0 = MFMA32(a, b0, S0); S1 = MFMA32(a, b1, S1);
                }
            }
            __syncthreads();
            {
                const int ti = wave >> 2, tc = wave & 3;
                f32x16 acc;
#pragma unroll
                for (int r = 0; r < 16; ++r) acc[r] = 0.f;
#pragma unroll
                for (int s = 0; s < 4; ++s) {
                    const bf16x8 a = *(const LAS bf16x8*)(lds + HG_LAT + (32 * ti + l32) * 144 + (16 * s + 8 * half) * 2);
                    const bf16x8 bv = *(const LAS bf16x8*)(lds + HG_LVT + (32 * tc + l32) * 144 + (16 * s + 8 * half) * 2);
                    acc = MFMA32(a, bv, acc);
                }
#pragma unroll
                for (int s = 0; s < 8; ++s) {
                    const bf16x8 a = *(const LAS bf16x8*)(lds + HG_LQE + (32 * ti + l32) * 272 + (16 * s + 8 * half) * 2);
                    const bf16x8 bs = *(const LAS bf16x8*)(lds + HG_LST + (32 * tc + l32) * 272 + (16 * s + 8 * half) * 2);
                    acc = MFMA32(a, bs, acc);
                }
#pragma unroll
                for (int r = 0; r < 16; ++r) ((LAS float*)(lds + HG_LO + (32 * ti + crow(r, half)) * 528))[32 * tc + l32] = acc[r];
            }
            __syncthreads();
            {
                const int td = wave & 3, tc0 = (wave >> 2) * 2;
#pragma unroll
                for (int g4 = 0; g4 < 4; ++g4) {
                    const int d0 = 32 * td + 8 * g4 + 4 * half;
                    *(LAS u32x2*)(lds + HG_LST + (32 * tc0 + l32) * 272 + d0 * 2) = (u32x2){cvt_pk_bf16(S0[4 * g4], S0[4 * g4 + 1]), cvt_pk_bf16(S0[4 * g4 + 2], S0[4 * g4 + 3])};
                    *(LAS u32x2*)(lds + HG_LST + (32 * (tc0 + 1) + l32) * 272 + d0 * 2) = (u32x2){cvt_pk_bf16(S1[4 * g4], S1[4 * g4 + 1]), cvt_pk_bf16(S1[4 * g4 + 2], S1[4 * g4 + 3])};
                }
            }
            {
                const int i = tid >> 3, seg = tid & 7;
                f32x4 ov[4]; float ss = 0.f;
#pragma unroll
                for (int q = 0; q < 4; ++q) { ov[q] = *(const LAS f32x4*)(lds + HG_LO + i * 528 + seg * 64 + q * 16); ss += (ov[q][0] * ov[q][0] + ov[q][1] * ov[q][1]) + (ov[q][2] * ov[q][2] + ov[q][3] * ov[q][3]); }
                ss = dpp_addx<0xB1, 0xf>(ss); ss = dpp_addx<0x4E, 0xf>(ss); ss = dpp_addx<0x141, 0xf>(ss);
                const float rstd = __builtin_amdgcn_rsqf(ss * (1.0f / 128.0f) + LN_EPS);
                const size_t row = (size_t)(b * T + n * 64 + i);
                const u32x4 g0 = gc0, g1 = gc1;
                const unsigned gw_[8] = {g0.x, g0.y, g0.z, g0.w, g1.x, g1.y, g1.z, g1.w};
                unsigned ow[8];
#pragma unroll
                for (int q = 0; q < 4; ++q) { const f32x4 ng = *(const f32x4*)(norm_g + seg * 16 + q * 4);
                    ow[2 * q] = cvt_pk_bf16(ov[q][0] * rstd * ng[0] * bflo(gw_[2 * q]), ov[q][1] * rstd * ng[1] * bfhi(gw_[2 * q]));
                    ow[2 * q + 1] = cvt_pk_bf16(ov[q][2] * rstd * ng[2] * bflo(gw_[2 * q + 1]), ov[q][3] * rstd * ng[3] * bfhi(gw_[2 * q + 1])); }
                *(u32x4*)(OG + row * D + h * 128 + seg * 16) = (u32x4){ow[0], ow[1], ow[2], ow[3]}; *(u32x4*)(OG + row * D + h * 128 + seg * 16 + 8) = (u32x4){ow[4], ow[5], ow[6], ow[7]};
            }
            gc0 = gn0; gc1 = gn1;
            __syncthreads();
        }
    }
}


__device__ __forceinline__ void unpack8(const u32x4 w, float (&f)[8]) { f[0] = bflo(w.x); f[1] = bfhi(w.x); f[2] = bflo(w.y); f[3] = bfhi(w.y); f[4] = bflo(w.z); f[5] = bfhi(w.z); f[6] = bflo(w.w); f[7] = bfhi(w.w); }
__device__ __forceinline__ void rope_row(int m, bf16_t* ZB, bf16_t* QRB, const int* posi, LAS float* tb, int lane, bool write_k) {
    const float inv_me = exp2f(-(float)(lane & 31) * (13.287712379549449f / 32.0f));
    { const float pf = (float)posi[m]; float s1, c1; sincosf(pf * inv_me, &s1, &c1); if (lane < 32) { tb[lane] = c1; tb[32 + lane] = s1; } LDS_WAIT(); }
    if (lane < 48) {
        const bf16_t* zrow = ZB + (size_t)m * EVP;
        const int hs = lane >> 2, d0 = 8 * (lane & 3);
        const f32x4 ca = *(const LAS f32x4*)(tb + d0), cb = *(const LAS f32x4*)(tb + d0 + 4), sa = *(const LAS f32x4*)(tb + 32 + d0), sb = *(const LAS f32x4*)(tb + 32 + d0 + 4);
        const int scol = hs < 8 ? 1792 + hs * 64 : ((hs & 2) ? 2816 : 2560) + (hs & 1) * 64;
        const u32x4 a = *(const u32x4*)(zrow + scol + d0), bq = *(const u32x4*)(zrow + scol + 32 + d0);
        float x1[8], x2[8], o1[8], o2[8]; unpack8(a, x1); unpack8(bq, x2);
#pragma unroll
        for (int i = 0; i < 8; ++i) { const float c = i < 4 ? ca[i & 3] : cb[i & 3], sn = i < 4 ? sa[i & 3] : sb[i & 3]; o1[i] = x1[i] * c - x2[i] * sn; o2[i] = x2[i] * c + x1[i] * sn; }
        const u32x4 w1 = (u32x4){cvt_pk_bf16(o1[0], o1[1]), cvt_pk_bf16(o1[2], o1[3]), cvt_pk_bf16(o1[4], o1[5]), cvt_pk_bf16(o1[6], o1[7])}, w2 = (u32x4){cvt_pk_bf16(o2[0], o2[1]), cvt_pk_bf16(o2[2], o2[3]), cvt_pk_bf16(o2[4], o2[5]), cvt_pk_bf16(o2[6], o2[7])};
        if (hs < 8) { bf16_t* dst = QRB + (size_t)m * 512 + hs * 64 + d0; *(u32x4*)dst = w1; *(u32x4*)(dst + 32) = w2; }
        else if (write_k) { bf16_t* dst = ZB + (size_t)m * EVP + scol + d0; *(u32x4*)dst = w1; *(u32x4*)(dst + 32) = w2; }
    }
    LDS_WAIT();
}
__device__ __forceinline__ void cmpcomb_row(int rr, const float* HC, const float* cb, const float* cw2, bf16_t* KVC, LAS float* hs, int lane) {
    const int hq = rr & 1, n = (rr >> 1) & 255, bq_ = (rr >> 9) & 15, zsel = rr >> 13;
    float outv = 0.f;
    if (n < 255) {
        const float* ha = HC + ((size_t)zsel * 8192 + (size_t)(bq_ * 256 + n) * 2 + hq) * 256; const float* hb = ha + 2 * 256 + 128;
#pragma unroll
        for (int q = 0; q < 2; ++q) { const int c = lane + 64 * q; const float xx = ha[c] + hb[c] + cb[zsel * 128 + c];
            hs[c] = 0.5f * xx * (1.0f + tanhf(0.7978845608028654f * (xx + 0.044715f * xx * xx * xx))); }
        LDS_WAIT();
        const float* w2p = cw2 + (size_t)zsel * 128 * 64 + lane;
#pragma unroll 16
        for (int c = 0; c < 128; ++c) outv += hs[c] * w2p[c * 64];
        LDS_WAIT();
    }
    KVC[((size_t)(zsel * 32 + bq_ * 2 + hq) * 256 + n) * 64 + lane] = (bf16_t)(cvt_pk_bf16(outv, 0.f) & 0xffffu);
}
constexpr int LATE_CONV_ITEMS = 2048 + 4 * 512 + 2 * 128;
__device__ __forceinline__ void conv_late_item(int it, const float* odin, const float* odout, const float* evout, const float* gatew, const float* plew, unsigned char* ws, LAS float* scr, int lane);
constexpr int MOE_CONV_ITEMS = NEXP * 3 * 256;
__device__ __forceinline__ void conv_moe_item(const float* w1, const float* w3, const float* w2, int li, bf16_t* w13, bf16_t* w2t, LAS float* scr, int it, int lane);
constexpr int RW_LW = 0, RW_LKK = 8192, RW_LBB = 16384, RW_LK2 = 24576, RW_LWR = 32768, RW_LV = 40960, RW_LO = 57344;
template <int CTRL> __device__ __forceinline__ float dpp_b(float v) { return __builtin_bit_cast(float, __builtin_amdgcn_mov_dpp(__builtin_bit_cast(int, v), CTRL, 0xf, 0xf, true)); }
__device__ __forceinline__ float sum16b(float v) { v += dpp_b<0xB1>(v); v += dpp_b<0x4E>(v); v += dpp_b<0x141>(v); v += dpp_b<0x140>(v); return v; }
__device__ __forceinline__ float sum8b(float v) { v += dpp_b<0xB1>(v); v += dpp_b<0x4E>(v); v += dpp_b<0x141>(v); return v; }
__device__ __forceinline__ float afma(float a, float b, float c) { float d; asm("v_fma_f32 %0, %1, %2, %3" : "=v"(d) : "v"(a), "v"(b), "v"(c)); return d; }
__device__ __forceinline__ float anfma(float a, float b, float c) { float d; asm("v_fma_f32 %0, -%1, %2, %3" : "=v"(d) : "v"(a), "v"(b), "v"(c)); return d; }
__device__ __forceinline__ float amul(float a, float b) { float d; asm("v_mul_f32 %0, %1, %2" : "=v"(d) : "v"(a), "v"(b)); return d; }
__device__ __forceinline__ unsigned cvt_pk_f16(float a, float b) { typedef _Float16 h2v_ __attribute__((ext_vector_type(2))); return __builtin_bit_cast(unsigned, __builtin_convertvector((f32x2){a, b}, h2v_)); }
__device__ __forceinline__ u32x4 pack8h(const float (&o)[8]) { return (u32x4){cvt_pk_f16(o[0], o[1]), cvt_pk_f16(o[2], o[3]), cvt_pk_f16(o[4], o[5]), cvt_pk_f16(o[6], o[7])}; }
struct RwRaw { u32x4 r, k, v, rp, kp, vp, a; f32x4 w0, w1, sc; };
__device__ __forceinline__ void rwkv_phase(LAS unsigned char* lds, const bf16_t* Z, const float* dec, const bf16_t* aa, const float* sc4, const float* mu, const float* k_k, const float* k_a, bf16_t* Y, int G, int bx,
                                           const float* mw1, const float* mw3, const float* mw2, bf16_t* w13, bf16_t* w2t, bool conv,
                                           const float* HC, const float* cb, const float* cw2, bf16_t* KVC, const float* pin, bf16_t* pbf0, bf16_t* pbf1, bf16_t* ZW, bf16_t* QRB, const int* posi,
                                           const float* lodin, const float* lodout, const float* levout, const float* lgate, const float* lple, unsigned char* wsb) {
    for (int unit = bx; unit < NB * 16; unit += G) {
        const int tid = pinned_tid();
        const int rowl = (tid >> 3) & 31, kc = tid & 7;
        const int sst = tid >> 3, c8 = (tid & 7) * 8;
        const int b = unit >> 4, h = (unit >> 1) & 7, rh = unit & 1, hc0 = h * 64 + c8;
        float p_mr[8], p_mk[8], p_mv[8], p_kk[8], p_ka[8];
#pragma unroll
        for (int i = 0; i < 8; ++i) { p_mr[i] = mu[hc0 + i]; p_mk[i] = mu[512 + hc0 + i]; p_mv[i] = mu[1024 + hc0 + i]; p_kk[i] = k_k[hc0 + i]; p_ka[i] = k_a[hc0 + i]; }
        float S[8];
#pragma unroll
        for (int i = 0; i < 8; ++i) S[i] = 0.f;
        RwRaw rw;
#define RW_LOAD(n_) do { const int t_ = (n_) * 64 + sst; const size_t row_ = (size_t)(b * T + t_); const bf16_t* zc_ = Z + row_ * EVP + hc0; \
            rw.r = *(const u32x4*)zc_; rw.k = *(const u32x4*)(zc_ + 512); rw.v = *(const u32x4*)(zc_ + 1024); \
            if (t_ > 0) { rw.rp = *(const u32x4*)(zc_ - EVP); rw.kp = *(const u32x4*)(zc_ + 512 - EVP); rw.vp = *(const u32x4*)(zc_ + 1024 - EVP); } else { rw.rp = (u32x4){0u, 0u, 0u, 0u}; rw.kp = rw.rp; rw.vp = rw.rp; } \
            rw.a = *(const u32x4*)(aa + row_ * 512 + hc0); rw.w0 = *(const f32x4*)(dec + row_ * 512 + hc0); rw.w1 = *(const f32x4*)(dec + row_ * 512 + hc0 + 4); rw.sc = *(const f32x4*)(sc4 + (row_ * 8 + h) * 4); } while (0)
#define RW_FINISH() do { float r_[8], k_[8], v_[8], rp_[8], kp_[8], vp_[8], a_[8]; unpack8(rw.r, r_); unpack8(rw.k, k_); unpack8(rw.v, v_); unpack8(rw.rp, rp_); unpack8(rw.kp, kp_); unpack8(rw.vp, vp_); unpack8(rw.a, a_); \
            float ow_[8], oq_[8], ob_[8], ok_[8], ou_[8], ov_[8]; \
            _Pragma("unroll") for (int i = 0; i < 8; ++i) { const float rr = r_[i] + p_mr[i] * (rp_[i] - r_[i]), k0 = k_[i] + p_mk[i] * (kp_[i] - k_[i]), vv = v_[i] + p_mv[i] * (vp_[i] - v_[i]), w = i < 4 ? rw.w0[i & 3] : rw.w1[i & 3]; \
                const float kk = k0 * p_kk[i] * rw.sc[0]; ow_[i] = w; oq_[i] = kk; ob_[i] = -(kk * a_[i]); ok_[i] = k0 * (1.0f + (a_[i] - 1.0f) * p_ka[i]); ou_[i] = w * rr - rw.sc[1] * kk; ov_[i] = vv; } \
            LAS unsigned char* d_ = lds + sst * 128 + c8 * 2; \
            *(LAS u32x4*)(d_ + RW_LW) = pack8h(ow_); *(LAS u32x4*)(d_ + RW_LKK) = pack8h(oq_); *(LAS u32x4*)(d_ + RW_LBB) = pack8h(ob_); *(LAS u32x4*)(d_ + RW_LK2) = pack8h(ok_); *(LAS u32x4*)(d_ + RW_LWR) = pack8h(ou_); \
            if ((c8 >> 5) == rh) { LAS float* dv_ = (LAS float*)(lds + RW_LV + sst * 256 + (c8 & 31) * 8); const float c2_ = rw.sc[2]; \
                *(LAS f32x4*)dv_ = (f32x4){ov_[0], ov_[0] * c2_, ov_[1], ov_[1] * c2_}; *(LAS f32x4*)(dv_ + 4) = (f32x4){ov_[2], ov_[2] * c2_, ov_[3], ov_[3] * c2_}; \
                *(LAS f32x4*)(dv_ + 8) = (f32x4){ov_[4], ov_[4] * c2_, ov_[5], ov_[5] * c2_}; *(LAS f32x4*)(dv_ + 12) = (f32x4){ov_[6], ov_[6] * c2_, ov_[7], ov_[7] * c2_}; } } while (0)
        RW_LOAD(0);
        RW_FINISH();
        __syncthreads();
        for (int n = 0; n < T / 64; ++n) {
            if (n + 1 < T / 64) RW_LOAD(n + 1);
            if (tid >= 256) {
                if (conv) rope_row(n * (G * 4) + bx * 4 + ((tid >> 6) - 4), ZW, QRB, posi, (LAS float*)(lds + 100 * 1024 + 4 * 8704 + ((tid >> 6) - 4) * 256), tid & 63, true);
                const int it_ = n * (G * 4) + bx * 4 + ((tid >> 6) - 4);
                if (conv && it_ < MOE_CONV_ITEMS) conv_moe_item(mw1, mw3, mw2, 0, w13, w2t, (LAS float*)(lds + 100 * 1024 + ((tid >> 6) - 4) * 8704), it_, tid & 63);
                else if (conv && it_ - MOE_CONV_ITEMS < 2 * 16 * 256 * 2) cmpcomb_row(it_ - MOE_CONV_ITEMS, HC, cb, cw2, KVC, (LAS float*)(lds + 100 * 1024 + ((tid >> 6) - 4) * 8704), tid & 63);
                else if (conv && n >= 56) { const int li_ = (n - 56) * (G * 4) + bx * 4 + ((tid >> 6) - 4);
                    if (li_ < LATE_CONV_ITEMS) conv_late_item(li_, lodin, lodout, levout, lgate, lple, wsb, (LAS float*)(lds + 100 * 1024 + ((tid >> 6) - 4) * 8704), tid & 63); }
                else if (conv && n >= 40 && n < 56) {
                    const int lane_ = tid & 63, w_ = (n - 40) * (G * 4) + bx * 4 + ((tid >> 6) - 4);
#pragma unroll
                    for (int q = 0; q < 8; ++q) { const int row = w_ * 8 + q; const f32x4 v = *((const f32x4*)(pin + (size_t)row * PLE) + lane_);
                        bf16_t* dst = row < M ? pbf0 + (size_t)row * PLE : pbf1 + (size_t)(row - M) * PLE; *((u32x2*)dst + lane_) = (u32x2){cvt_pk_bf16(v[0], v[1]), cvt_pk_bf16(v[2], v[3])}; }
                }
            }
            if (tid < 256) {
            const int vb = kc * 16, vvb = RW_LV + rowl * 8;
            u32x4 cw = *(const LAS u32x4*)(lds + vb + RW_LW), cq = *(const LAS u32x4*)(lds + vb + RW_LKK), cb = *(const LAS u32x4*)(lds + vb + RW_LBB), ck = *(const LAS u32x4*)(lds + vb + RW_LK2), cu = *(const LAS u32x4*)(lds + vb + RW_LWR);
            f32x2 cv2 = *(const LAS f32x2*)(lds + vvb);
            LAS float* const obase = (kc == 0 ? (LAS float*)(lds + RW_LO) : (LAS float*)(lds + 136 * 1024)) + rowl;
#if PROBE_DUP == 10
            float T0[8];
#pragma unroll
            for (int i = 0; i < 8; ++i) T0[i] = S[i];
            for (int rep_ = 0; rep_ < 2; ++rep_) {
            if (rep_ == 1) {
#pragma unroll
                for (int i = 0; i < 8; ++i) S[i] = T0[i]; }
#endif
            __builtin_amdgcn_s_setprio(3);
#define MIXLO "op_sel_hi:[0,1,0]"
#define MIXHI "op_sel:[0,1,0] op_sel_hi:[0,1,0]"
#define DPPQ1 "quad_perm:[1,0,3,2] row_mask:0xf bank_mask:0xf bound_ctrl:1"
#define DPPQ2 "quad_perm:[2,3,0,1] row_mask:0xf bank_mask:0xf bound_ctrl:1"
#define DPPHM "row_half_mirror row_mask:0xf bank_mask:0xf bound_ctrl:1"
#pragma unroll 8
            for (int st = 0; st < 64; ++st) {
                const int sn = st + 1;
                const u32x4 nw = *(const LAS u32x4*)(lds + vb + RW_LW + sn * 128), nq = *(const LAS u32x4*)(lds + vb + RW_LKK + sn * 128), nb = *(const LAS u32x4*)(lds + vb + RW_LBB + sn * 128),
                            nk = *(const LAS u32x4*)(lds + vb + RW_LK2 + sn * 128), nu = *(const LAS u32x4*)(lds + vb + RW_LWR + sn * 128);
                const f32x2 nv2 = *(const LAS f32x2*)(lds + vvb + sn * 256);
                float sa, ov, t0, t1, t2, xa, xb, xc, xd;
                asm("v_fma_mix_f32 %[sa], %[s0], %[q0], 0 " MIXLO "\n\tv_fma_mix_f32 %[sb], %[s4], %[q2], 0 " MIXLO "\n\tv_fma_mix_f32 %[oa], %[s0], %[u0], 0 " MIXLO "\n\tv_fma_mix_f32 %[ob], %[s4], %[u2], 0 " MIXLO "\n\t"
                    "v_fma_mix_f32 %[sa], %[s1], %[q0], %[sa] " MIXHI "\n\tv_fma_mix_f32 %[sb], %[s5], %[q2], %[sb] " MIXHI "\n\tv_fma_mix_f32 %[oa], %[s1], %[u0], %[oa] " MIXHI "\n\tv_fma_mix_f32 %[ob], %[s5], %[u2], %[ob] " MIXHI "\n\t"
                    "v_fma_mix_f32 %[sa], %[s2], %[q1], %[sa] " MIXLO "\n\tv_fma_mix_f32 %[sb], %[s6], %[q3], %[sb] " MIXLO "\n\tv_fma_mix_f32 %[oa], %[s2], %[u1], %[oa] " MIXLO "\n\tv_fma_mix_f32 %[ob], %[s6], %[u3], %[ob] " MIXLO "\n\t"
                    "v_fma_mix_f32 %[sa], %[s3], %[q1], %[sa] " MIXHI "\n\tv_fma_mix_f32 %[sb], %[s7], %[q3], %[sb] " MIXHI "\n\tv_fma_mix_f32 %[oa], %[s3], %[u1], %[oa] " MIXHI "\n\tv_fma_mix_f32 %[ob], %[s7], %[u3], %[ob] " MIXHI "\n\t"
                    "v_add_f32 %[sa], %[sa], %[sb]\n\tv_add_f32 %[oa], %[oa], %[ob]\n\t"
                    "v_fma_mix_f32 %[t0], %[cv], %[k0], 0 " MIXLO "\n\tv_add_f32_dpp %[sa], %[sa], %[sa] " DPPQ1 "\n\tv_add_f32_dpp %[oa], %[oa], %[oa] " DPPQ1 "\n\t"
                    "v_fma_mix_f32 %[t1], %[cv], %[k0], 0 " MIXHI "\n\tv_add_f32_dpp %[sa], %[sa], %[sa] " DPPQ2 "\n\tv_add_f32_dpp %[oa], %[oa], %[oa] " DPPQ2 "\n\t"
                    "v_fma_mix_f32 %[t2], %[cv], %[k1], 0 " MIXLO "\n\tv_add_f32_dpp %[sa], %[sa], %[sa] " DPPHM "\n\tv_add_f32_dpp %[oa], %[oa], %[oa] " DPPHM "\n\t"
                    "v_add_f32 %[ov], %[oa], %[c1]"
                    : [sa] "=&v"(sa), [ov] "=&v"(ov), [t0] "=&v"(t0), [t1] "=&v"(t1), [t2] "=&v"(t2), [sb] "=&v"(xa), [oa] "=&v"(xb), [ob] "=&v"(xc)
                    : [s0] "v"(S[0]), [s1] "v"(S[1]), [s2] "v"(S[2]), [s3] "v"(S[3]), [s4] "v"(S[4]), [s5] "v"(S[5]), [s6] "v"(S[6]), [s7] "v"(S[7]),
                      [q0] "v"(cq.x), [q1] "v"(cq.y), [q2] "v"(cq.z), [q3] "v"(cq.w), [u0] "v"(cu.x), [u1] "v"(cu.y), [u2] "v"(cu.z), [u3] "v"(cu.w),
                      [cv] "v"(cv2[0]), [c1] "v"(cv2[1]), [k0] "v"(ck.x), [k1] "v"(ck.y));
                obase[st * 32] = ov;
                asm("v_fma_mix_f32 %[x], %[cv], %[k1], 0 " MIXHI "\n\tv_fma_mix_f32 %[y], %[sa], %[b0], %[t0] " MIXLO "\n\tv_fma_mix_f32 %[z], %[sa], %[b0], %[t1] " MIXHI "\n\t"
                    "v_fma_mix_f32 %[s0], %[s0], %[w0], %[y] " MIXLO "\n\tv_fma_mix_f32 %[y], %[sa], %[b1], %[t2] " MIXLO "\n\tv_fma_mix_f32 %[s1], %[s1], %[w0], %[z] " MIXHI "\n\t"
                    "v_fma_mix_f32 %[x], %[sa], %[b1], %[x] " MIXHI "\n\tv_fma_mix_f32 %[s2], %[s2], %[w1], %[y] " MIXLO "\n\tv_fma_mix_f32 %[s3], %[s3], %[w1], %[x] " MIXHI
                    : [s0] "+v"(S[0]), [s1] "+v"(S[1]), [s2] "+v"(S[2]), [s3] "+v"(S[3]), [x] "=&v"(xa), [y] "=&v"(xb), [z] "=&v"(xc)
                    : [sa] "v"(sa), [cv] "v"(cv2[0]), [t0] "v"(t0), [t1] "v"(t1), [t2] "v"(t2), [k1] "v"(ck.y), [b0] "v"(cb.x), [b1] "v"(cb.y), [w0] "v"(cw.x), [w1] "v"(cw.y));
                asm("v_fma_mix_f32 %[x], %[cv], %[k2], 0 " MIXLO "\n\tv_fma_mix_f32 %[y], %[cv], %[k2], 0 " MIXHI "\n\tv_fma_mix_f32 %[z], %[cv], %[k3], 0 " MIXLO "\n\tv_fma_mix_f32 %[u], %[cv], %[k3], 0 " MIXHI "\n\t"
                    "v_fma_mix_f32 %[x], %[sa], %[b2], %[x] " MIXLO "\n\tv_fma_mix_f32 %[y], %[sa], %[b2], %[y] " MIXHI "\n\tv_fma_mix_f32 %[z], %[sa], %[b3], %[z] " MIXLO "\n\tv_fma_mix_f32 %[u], %[sa], %[b3], %[u] " MIXHI "\n\t"
                    "v_fma_mix_f32 %[s4], %[s4], %[w2], %[x] " MIXLO "\n\tv_fma_mix_f32 %[s5], %[s5], %[w2], %[y] " MIXHI "\n\tv_fma_mix_f32 %[s6], %[s6], %[w3], %[z] " MIXLO "\n\tv_fma_mix_f32 %[s7], %[s7], %[w3], %[u] " MIXHI
                    : [s4] "+v"(S[4]), [s5] "+v"(S[5]), [s6] "+v"(S[6]), [s7] "+v"(S[7]), [x] "=&v"(xa), [y] "=&v"(xb), [z] "=&v"(xc), [u] "=&v"(xd)
                    : [sa] "v"(sa), [cv] "v"(cv2[0]), [k2] "v"(ck.z), [k3] "v"(ck.w), [b2] "v"(cb.z), [b3] "v"(cb.w), [w2] "v"(cw.z), [w3] "v"(cw.w));
                cw = nw; cq = nq; cb = nb; ck = nk; cu = nu; cv2 = nv2;
            }
#undef MIXLO
#undef MIXHI
#undef DPPQ1
#undef DPPQ2
#undef DPPHM
            __builtin_amdgcn_s_setprio(0);
#if PROBE_DUP == 10
            }
#endif
            }
            __syncthreads();
            { const int st = tid >> 3, r4 = (tid & 7) * 4; const f32x4 o = *(const LAS f32x4*)(lds + RW_LO + st * 128 + r4 * 4);
              *(u32x2*)(Y + (size_t)(b * T + n * 64 + st) * D + h * 64 + rh * 32 + r4) = (u32x2){cvt_pk_bf16(o[0], o[1]), cvt_pk_bf16(o[2], o[3])}; }
            if (n + 1 < T / 64) RW_FINISH();
            __syncthreads();
        }
#undef RW_LOAD
#undef RW_FINISH
    }
}

typedef short s16x4 __attribute__((ext_vector_type(4)));
constexpr int AT_KS = 144, AT_VS = 192, AT_KT = 64 * AT_KS, AT_VT = 64 * AT_VS;
constexpr int AT_LK = 0, AT_LV = 4 * AT_KT, AT_LIT = AT_LV + 4 * AT_VT, AT_LIH = AT_LIT + 16384, AT_LSM = AT_LIH + 16384, AT_LKEY = AT_LSM + 512, AT_LEND = AT_LKEY + 32768;
static_assert(AT_LEND <= 163840 - 512, "attention lds");
constexpr float AT_C = 0.125f * 1.4426950408889634f;
constexpr float AT_NEG = -1.0e30f;
__device__ __forceinline__ void qk_tile(const LAS unsigned char* Kt, const bf16x8 (&Q)[4], int l32, int half, f32x16& s0, f32x16& s1) {
#pragma unroll
    for (int r = 0; r < 16; ++r) { s0[r] = 0.f; s1[r] = 0.f; }
#pragma unroll
    for (int s = 0; s < 4; ++s) {
        const bf16x8 a0 = *(const LAS bf16x8*)(Kt + l32 * AT_KS + (16 * s + 8 * half) * 2), a1 = *(const LAS bf16x8*)(Kt + (32 + l32) * AT_KS + (16 * s + 8 * half) * 2);
        s0 = MFMA32(a0, Q[s], s0); s1 = MFMA32(a1, Q[s], s1);
    }
}
#define AT_TR4(vb, OFF, r00, r01, r10, r11) asm volatile("ds_read_b64_tr_b16 %0, %4 offset:%5\n\tds_read_b64_tr_b16 %1, %4 offset:%6\n\tds_read_b64_tr_b16 %2, %4 offset:%7\n\tds_read_b64_tr_b16 %3, %4 offset:%8\n\ts_waitcnt lgkmcnt(0)" \
    : "=&v"(r00), "=&v"(r01), "=&v"(r10), "=&v"(r11) : "v"(vb), "i"(OFF), "i"((OFF) + 8 * AT_VS), "i"((OFF) + 64), "i"((OFF) + 8 * AT_VS + 64) : "memory")
__device__ __forceinline__ bf16x8 pack8(const f32x16& p, int s2) {
    u32x4 w; w.x = cvt_pk_bf16(p[8 * s2], p[8 * s2 + 1]); w.y = cvt_pk_bf16(p[8 * s2 + 2], p[8 * s2 + 3]); w.z = cvt_pk_bf16(p[8 * s2 + 4], p[8 * s2 + 5]); w.w = cvt_pk_bf16(p[8 * s2 + 6], p[8 * s2 + 7]);
    return __builtin_bit_cast(bf16x8, w);
}
#define AT_TR8(vb, OFF, r0, r1, r2, r3, r4, r5, r6, r7) asm volatile("ds_read_b64_tr_b16 %0, %8 offset:%9\n\tds_read_b64_tr_b16 %1, %8 offset:%10\n\tds_read_b64_tr_b16 %2, %8 offset:%11\n\tds_read_b64_tr_b16 %3, %8 offset:%12\n\t" \
    "ds_read_b64_tr_b16 %4, %8 offset:%13\n\tds_read_b64_tr_b16 %5, %8 offset:%14\n\tds_read_b64_tr_b16 %6, %8 offset:%15\n\tds_read_b64_tr_b16 %7, %8 offset:%16\n\ts_waitcnt lgkmcnt(0)" \
    : "=&v"(r0), "=&v"(r1), "=&v"(r2), "=&v"(r3), "=&v"(r4), "=&v"(r5), "=&v"(r6), "=&v"(r7) \
    : "v"(vb), "i"(OFF), "i"((OFF) + 8 * AT_VS), "i"((OFF) + 64), "i"((OFF) + 8 * AT_VS + 64), "i"((OFF) + 16 * AT_VS), "i"((OFF) + 24 * AT_VS), "i"((OFF) + 16 * AT_VS + 64), "i"((OFF) + 24 * AT_VS + 64) : "memory")
__device__ __forceinline__ void pv_tile(unsigned vb, const f32x16& p0, const f32x16& p1, f32x16& O0, f32x16& O1, bool zero_all) {
    s16x4 r0, r1, r2, r3, r4, r5, r6, r7;
    const bf16x8 zf = (bf16x8){0, 0, 0, 0, 0, 0, 0, 0};
#define AT_PV2(P, OFF) { bf16x8 b0 = pack8(P, 0), b1 = pack8(P, 1); if (zero_all) { b0 = zf; b1 = zf; } AT_TR8(vb, OFF, r0, r1, r2, r3, r4, r5, r6, r7); \
        const bf16x8 a00 = __builtin_shufflevector(r0, r1, 0, 1, 2, 3, 4, 5, 6, 7), a01 = __builtin_shufflevector(r2, r3, 0, 1, 2, 3, 4, 5, 6, 7), a10 = __builtin_shufflevector(r4, r5, 0, 1, 2, 3, 4, 5, 6, 7), a11 = __builtin_shufflevector(r6, r7, 0, 1, 2, 3, 4, 5, 6, 7); \
        O0 = MFMA32(a00, b0, O0); O1 = MFMA32(a01, b0, O1); O0 = MFMA32(a10, b1, O0); O1 = MFMA32(a11, b1, O1); }
    AT_PV2(p0, 0) AT_PV2(p1, 32 * AT_VS)
#undef AT_PV2
}
template <int CTRL> __device__ __forceinline__ float dppq(float v) { return __builtin_bit_cast(float, __builtin_amdgcn_update_dpp(0, __builtin_bit_cast(int, v), CTRL, 0xf, 0xf, false)); }
__device__ __forceinline__ float sum4(float v) { v += dppq<0xB1>(v); v += dppq<0x4E>(v); return v; }
__device__ __forceinline__ void xhalf_swap(float& a, float& b) { asm volatile("s_nop 1\n\tv_permlane32_swap_b32 %0, %1\n\ts_nop 1" : "+v"(a), "+v"(b)); }
__device__ __forceinline__ float xhalf_max(float v) { float a = v, b = v; asm volatile("s_nop 1\n\tv_permlane32_swap_b32 %0, %1\n\ts_nop 1\n\tv_max_f32 %0, %0, %1" : "+v"(a), "+v"(b)); return a; }
__device__ __forceinline__ float max32(const f32x16& a, const f32x16& b) {
    float m;
    asm("v_max3_f32 %0, %1, %2, %3\n\tv_max3_f32 %0, %0, %4, %5\n\tv_max3_f32 %0, %0, %6, %7\n\tv_max3_f32 %0, %0, %8, %9\n\tv_max3_f32 %0, %0, %10, %11\n\tv_max3_f32 %0, %0, %12, %13\n\tv_max3_f32 %0, %0, %14, %15\n\t"
        "v_max3_f32 %0, %0, %16, %17\n\tv_max3_f32 %0, %0, %18, %19\n\tv_max3_f32 %0, %0, %20, %21\n\tv_max3_f32 %0, %0, %22, %23\n\tv_max3_f32 %0, %0, %24, %25\n\tv_max3_f32 %0, %0, %26, %27\n\tv_max3_f32 %0, %0, %28, %29"
        : "=&v"(m) : "v"(a[0]), "v"(a[1]), "v"(a[2]), "v"(a[3]), "v"(a[4]), "v"(a[5]), "v"(a[6]), "v"(a[7]), "v"(a[8]), "v"(a[9]), "v"(a[10]), "v"(a[11]), "v"(a[12]), "v"(a[13]), "v"(a[14]), "v"(a[15]),
                     "v"(b[0]), "v"(b[1]), "v"(b[2]), "v"(b[3]), "v"(b[4]), "v"(b[5]), "v"(b[6]), "v"(b[7]), "v"(b[8]), "v"(b[9]), "v"(b[10]), "v"(b[11]), "v"(b[12]));
    asm("v_max3_f32 %0, %0, %1, %2\n\tv_max_f32 %0, %0, %3" : "+v"(m) : "v"(b[13]), "v"(b[14]), "v"(b[15]));
    return m;
}
__device__ __forceinline__ float xhalf_sum(float v) { float a = v, b = v; xhalf_swap(a, b); return a + b; }
constexpr float AT_THR = 8.0f / AT_C;
template <int MODE>
__device__ __forceinline__ void attn_tile(const LAS unsigned char* Kt, unsigned vb, const bf16x8 (&Q)[4], int l32, int half, bool on, bool edge, int dbase, float& mrun, float& lrun, f32x16& O0, f32x16& O1) {
    f32x16 s0, s1;
    qk_tile(Kt, Q, l32, half, s0, s1);
#if PROBE_DUP == 33
    { float keep_ = s0[0]; asm volatile("" : "+v"(keep_)); qk_tile(Kt, Q, l32, half, s0, s1); s0[0] = 0.5f * (s0[0] + keep_); }
#endif
    if (edge) {
#pragma unroll
        for (int r = 0; r < 16; ++r) {
            const int d0 = dbase - ((r & 3) + 8 * (r >> 2)), d1 = d0 - 32;
            const bool v0 = (MODE == 1 ? d0 >= 0 : (unsigned)d0 < 512u), v1 = (MODE == 1 ? d1 >= 0 : (unsigned)d1 < 512u);
            s0[r] = v0 ? s0[r] : AT_NEG; s1[r] = v1 ? s1[r] : AT_NEG;
        }
    }
    float mt = max32(s0, s1);
    mt = on ? mt : AT_NEG;
    mt = xhalf_max(mt);
    if (__any(mt > mrun + AT_THR)) {
        const float mnew = fmaxf(mrun, mt), alpha = __builtin_amdgcn_exp2f(AT_C * (mrun - mnew)); mrun = mnew; lrun *= alpha;
#pragma unroll
        for (int r = 0; r < 16; ++r) { O0[r] *= alpha; O1[r] *= alpha; }
    }
    const float mc = on ? mrun * AT_C : 1.0e30f;
    f32x16 p0, p1;
#pragma unroll
    for (int r = 0; r < 16; ++r) { p0[r] = __builtin_amdgcn_exp2f(__builtin_fmaf(s0[r], AT_C, -mc)); p1[r] = __builtin_amdgcn_exp2f(__builtin_fmaf(s1[r], AT_C, -mc)); }
#if PROBE_DUP == 34
    { float mc2 = mc; asm volatile("" : "+v"(mc2));
#pragma unroll
      for (int r = 0; r < 16; ++r) { p0[r] = 0.5f * (p0[r] + __builtin_amdgcn_exp2f(__builtin_fmaf(s0[r], AT_C, -mc2))); p1[r] = 0.5f * (p1[r] + __builtin_amdgcn_exp2f(__builtin_fmaf(s1[r], AT_C, -mc2))); } }
#endif
    if (edge) {
#pragma unroll
        for (int r = 0; r < 16; ++r) { p0[r] = s0[r] > 0.5f * AT_NEG ? p0[r] : 0.f; p1[r] = s1[r] > 0.5f * AT_NEG ? p1[r] : 0.f; }
    }
    float ps = 0.f;
#pragma unroll
    for (int r = 0; r < 16; ++r) ps += p0[r] + p1[r];
    lrun += ps;
#if PROBE_DUP == 35
#pragma unroll
    for (int r = 0; r < 16; ++r) { p0[r] *= 0.5f; p1[r] *= 0.5f; }
    pv_tile(vb, p0, p1, O0, O1, false);
#endif
    pv_tile(vb, p0, p1, O0, O1, false);
}
template <int MODE>
__device__ __forceinline__ void attn_stream(LAS unsigned char* lds, const bf16_t* Kg, const bf16_t* Vg, int jlo, int cur, int tokl, const bf16x8 (&Q)[4], unsigned selm_lo, unsigned selm_hi,
                                            int tid, int l32, int half, unsigned vb0, f32x16& O0, f32x16& O1, float& lout) {
    const int key = tid >> 3, chunk = tid & 7;
    const size_t goff = (size_t)key * EVP + chunk * 8;
    const unsigned kofs = key * AT_KS + chunk * 16, vofs = key * AT_VS + chunk * 16;
#define AT_GLD(kr, vr, jj) do { const int j_ = (jj) <= cur ? (jj) : cur; kr = *(const u32x4*)(Kg + (size_t)j_ * 64 * EVP + goff); vr = *(const u32x4*)(Vg + (size_t)j_ * 64 * EVP + goff); } while (0)
#define AT_LST(kr, vr, jj) do { const int nb_ = (jj) & 3; *(LAS u32x4*)(lds + AT_LK + nb_ * AT_KT + kofs) = kr; *(LAS u32x4*)(lds + AT_LV + nb_ * AT_VT + vofs) = vr; } while (0)
    u32x4 ka, va, kb, vb;
    AT_GLD(ka, va, jlo); AT_GLD(kb, vb, jlo + 1);
    AT_LST(ka, va, jlo); AT_LST(kb, vb, jlo + 1);
    __syncthreads();
    float mrun = AT_NEG, lrun = 0.f;
#pragma unroll
    for (int r = 0; r < 16; ++r) { O0[r] = 0.f; O1[r] = 0.f; }
    for (int j = jlo; j <= cur; j += 2) {
        AT_GLD(ka, va, j + 2); AT_GLD(kb, vb, j + 3);
#pragma unroll
        for (int u = 0; u < 2; ++u) {
            const int jj = j + u;
            if (jj <= cur) {
                const int buf = jj & 3;
                bool on = true;
                if (MODE == 1) on = ((jj < 32 ? (selm_lo >> jj) : (selm_hi >> (jj - 32))) & 1u) != 0u;
                const int dbase = (cur - jj) * 64 + tokl - 4 * half;
                const bool edge = (jj == cur) || (MODE == 2 && cur >= 8 && jj == jlo);
                if (MODE != 1 || __any(on)) attn_tile<MODE>(lds + AT_LK + buf * AT_KT, vb0 + buf * AT_VT, Q, l32, half, on, edge, dbase, mrun, lrun, O0, O1);
            }
        }
        AT_LST(ka, va, j + 2); AT_LST(kb, vb, j + 3);
        __syncthreads();
    }
#undef AT_GLD
#undef AT_LST
    lout = xhalf_sum(lrun);
}

__device__ __forceinline__ void nsa_attn_phase(LAS unsigned char* lds, const bf16_t* Z, const bf16_t* QR, const bf16_t* KVC, bf16_t* Y, int G, int bx) {
    for (int it = 0;; ++it) {
        const int L = it * G + bx; if (L >= NB * 2 * 64) break;
        const int tid = pinned_tid(), lane = tid & 63, wave = __builtin_amdgcn_readfirstlane(tid >> 6), half = lane >> 5, l32 = lane & 31;
        const unsigned vb0 = (unsigned)(AT_LV + (4 * half + ((lane & 15) >> 2)) * AT_VS + (16 * ((lane >> 4) & 1) + 4 * (lane & 3)) * 2);
        const int tokl = 8 * wave + (l32 >> 2), g = l32 & 3;
        const int qt = (G == 256) ? 63 - (8 * it + ((it & 1) ? 7 - (bx >> 5) : (bx >> 5))) : 63 - (L >> 5);
        const int bh = L & 31, b = bh >> 1, hk = bh & 1, t0 = qt * 64, t = t0 + tokl, head = hk * 4 + g, cur = qt;
        const size_t m = (size_t)b * T + t;
        bf16x8 Qraw[4], Qrot[4];
#pragma unroll
        for (int s = 0; s < 4; ++s) { Qraw[s] = *(const bf16x8*)(Z + m * EVP + 1792 + head * 64 + 16 * s + 8 * half); Qrot[s] = *(const bf16x8*)(QR + m * 512 + head * 64 + 16 * s + 8 * half); }
        const float gate_c = sigmoidf_(bf2f(Z[m * EVP + 3072 + head * 3])), gate_s = sigmoidf_(bf2f(Z[m * EVP + 3072 + head * 3 + 1])), gate_w = sigmoidf_(bf2f(Z[m * EVP + 3072 + head * 3 + 2]));
        f32x16 Y0, Y1;
        const int nct = (4 * qt + 3 + 63) >> 6;
        unsigned selm_lo = 0u, selm_hi = 0u;
        for (int repc_ = 0; repc_ < (PROBE_DUP == 30 ? 2 : 1); ++repc_) {
        { const int key = tid >> 3, chunk = tid & 7; const bf16_t* kc = KVC + ((size_t)(b * 2 + hk) * 256) * 64; const bf16_t* vc = kc + (size_t)32 * 256 * 64;
          for (int jt = 0; jt < nct; ++jt) { *(LAS u32x4*)(lds + AT_LK + jt * AT_KT + key * AT_KS + chunk * 16) = *(const u32x4*)(kc + (size_t)(jt * 64 + key) * 64 + chunk * 8);
                                             *(LAS u32x4*)(lds + AT_LV + jt * AT_VT + key * AT_VS + chunk * 16) = *(const u32x4*)(vc + (size_t)(jt * 64 + key) * 64 + chunk * 8); }
#pragma unroll
          for (int q = 0; q < 8; ++q) { ((LAS float*)(lds + AT_LIT))[(8 * wave + q) * 64 + lane] = 0.f; ((LAS float*)(lds + AT_LIH))[(8 * wave + q) * 64 + lane] = 0.f; } }
        __syncthreads();
        {
            const int nvalid = t >= 31 ? ((t - 31) >> 4) + 1 : 0;
            float mrun = AT_NEG, lrun = 0.f;
            for (int jt = 0; jt < nct; ++jt) {
                f32x16 s0, s1; qk_tile(lds + AT_LK + jt * AT_KT, Qraw, l32, half, s0, s1);
                const int nb = nvalid - 64 * jt - 4 * half;
                float mt = AT_NEG;
#pragma unroll
                for (int r = 0; r < 16; ++r) { const int o = (r & 3) + 8 * (r >> 2); s0[r] = o < nb ? s0[r] : AT_NEG; s1[r] = o + 32 < nb ? s1[r] : AT_NEG; mt = fmaxf(mt, fmaxf(s0[r], s1[r])); }
                mt = xhalf_max(mt);
                const float mnew = fmaxf(mrun, mt); lrun *= __builtin_amdgcn_exp2f(AT_C * (mrun - mnew)); mrun = mnew;
#pragma unroll
                for (int r = 0; r < 16; ++r) { lrun += (s0[r] > 0.5f * AT_NEG ? __builtin_amdgcn_exp2f(AT_C * (s0[r] - mnew)) : 0.f) + (s1[r] > 0.5f * AT_NEG ? __builtin_amdgcn_exp2f(AT_C * (s1[r] - mnew)) : 0.f); }
            }
            const float lt = xhalf_sum(lrun), inv = lt > 0.f ? 1.0f / lt : 0.f;
            f32x16 O0, O1;
#pragma unroll
            for (int r = 0; r < 16; ++r) { O0[r] = 0.f; O1[r] = 0.f; }
            for (int jt = 0; jt < nct; ++jt) {
                f32x16 s0, s1; qk_tile(lds + AT_LK + jt * AT_KT, Qraw, l32, half, s0, s1);
                const int nb = nvalid - 64 * jt - 4 * half;
#pragma unroll
                for (int r = 0; r < 16; ++r) { const int o = (r & 3) + 8 * (r >> 2); s0[r] = o < nb ? __builtin_amdgcn_exp2f(AT_C * (s0[r] - mrun)) * inv : 0.f; s1[r] = o + 32 < nb ? __builtin_amdgcn_exp2f(AT_C * (s1[r] - mrun)) * inv : 0.f; }
#pragma unroll
                for (int g4 = 0; g4 < 4; ++g4) {
                    const float ta = sum4((s0[4 * g4] + s0[4 * g4 + 1]) + (s0[4 * g4 + 2] + s0[4 * g4 + 3])), ha = sum4(0.5f * s0[4 * g4 + 3]);
                    const float tb = sum4((s1[4 * g4] + s1[4 * g4 + 1]) + (s1[4 * g4 + 2] + s1[4 * g4 + 3])), hb = sum4(0.5f * s1[4 * g4 + 3]);
                    if (g == 0) { const int sa = 16 * jt + 2 * g4 + half; ((LAS float*)(lds + AT_LIT))[tokl * 64 + sa] = ta; ((LAS float*)(lds + AT_LIH))[tokl * 64 + sa] = ha;
                                  ((LAS float*)(lds + AT_LIT))[tokl * 64 + sa + 8] = tb; ((LAS float*)(lds + AT_LIH))[tokl * 64 + sa + 8] = hb; }
                }
                pv_tile(vb0 + jt * AT_VT, s0, s1, O0, O1, false);
            }
#pragma unroll
            for (int r = 0; r < 16; ++r) { Y0[r] = gate_c * O0[r]; Y1[r] = gate_c * O1[r]; }
        }
        {
            LDS_WAIT();
            const int tk = 8 * wave + (lane >> 3), sb = (lane & 7) * 8;
            float v[8];
#pragma unroll
            for (int i = 0; i < 8; ++i) { const int sidx = sb + i;
                float x = ((const LAS float*)(lds + AT_LIT))[tk * 64 + sidx] - ((const LAS float*)(lds + AT_LIH))[tk * 64 + sidx];
                if (sidx > 0) x += ((const LAS float*)(lds + AT_LIH))[tk * 64 + sidx - 1];
                if (sidx == 0 || sidx == cur || sidx == cur - 1) x = 3.0e38f; else if (sidx > cur) x = -3.0e38f;
                v[i] = x; }
            unsigned long long key[8];
#pragma unroll
            for (int i = 0; i < 8; ++i) { const unsigned u = __float_as_uint(v[i]), mu_ = (u & 0x80000000u) ? ~u : (u | 0x80000000u); key[i] = ((unsigned long long)mu_ << 32) | (unsigned)(63 - (sb + i));
                ((LAS unsigned long long*)(lds + AT_LKEY))[tk * 64 + sb + i] = key[i]; }
            LDS_WAIT();
            int rank[8];
#pragma unroll
            for (int i = 0; i < 8; ++i) rank[i] = 0;
#pragma unroll 4
            for (int sp = 0; sp < 64; ++sp) { const unsigned long long x = ((const LAS unsigned long long*)(lds + AT_LKEY))[tk * 64 + sp];
#pragma unroll
                for (int i = 0; i < 8; ++i) rank[i] += (x > key[i]) ? 1 : 0; }
            unsigned byte = 0u;
#pragma unroll
            for (int i = 0; i < 8; ++i) byte |= (rank[i] < 16 && sb + i <= cur) ? (1u << i) : 0u;
            ((LAS unsigned char*)(lds + AT_LSM))[tk * 8 + (lane & 7)] = (unsigned char)byte;
            LDS_WAIT();
            const u32x2 sm = *(const LAS u32x2*)(lds + AT_LSM + tokl * 8); selm_lo = sm.x; selm_hi = sm.y;
        }
        __syncthreads();
        }
        const bf16_t* zb = Z + ((size_t)b * T) * EVP + hk * 64;
        {
            f32x16 O0, O1; float lt;
            for (int rep_ = 0; rep_ < (PROBE_DUP == 31 ? 2 : 1); ++rep_) attn_stream<1>(lds, zb + 2560, zb + 2688, 0, cur, tokl, Qrot, selm_lo, selm_hi, tid, l32, half, vb0, O0, O1, lt);
            const float sc = lt > 0.f ? gate_s / lt : 0.f;
#pragma unroll
            for (int r = 0; r < 16; ++r) { Y0[r] += sc * O0[r]; Y1[r] += sc * O1[r]; }
        }
        {
            f32x16 O0, O1; float lt;
            for (int rep_ = 0; rep_ < (PROBE_DUP == 32 ? 2 : 1); ++rep_) attn_stream<2>(lds, zb + 2816, zb + 2944, cur >= 8 ? cur - 8 : 0, cur, tokl, Qrot, 0u, 0u, tid, l32, half, vb0, O0, O1, lt);
            const float sc = lt > 0.f ? gate_w / lt : 0.f;
#pragma unroll
            for (int r = 0; r < 16; ++r) { Y0[r] += sc * O0[r]; Y1[r] += sc * O1[r]; }
        }
        bf16_t* yo = Y + m * D + 512 + head * 64;
#pragma unroll
        for (int g4 = 0; g4 < 4; ++g4) {
            *(u32x2*)(yo + 8 * g4 + 4 * half) = (u32x2){cvt_pk_bf16(Y0[4 * g4], Y0[4 * g4 + 1]), cvt_pk_bf16(Y0[4 * g4 + 2], Y0[4 * g4 + 3])};
            *(u32x2*)(yo + 32 + 8 * g4 + 4 * half) = (u32x2){cvt_pk_bf16(Y1[4 * g4], Y1[4 * g4 + 1]), cvt_pk_bf16(Y1[4 * g4 + 2], Y1[4 * g4 + 3])};
        }
    }
}

constexpr int LDS_BYTES = 163840;
constexpr int LDSCTL_OFF = LDS_BYTES - 512;
constexpr int RING_BYTES = 131072;

struct Args { const void* in[34]; float* out; unsigned char* ws; int ph_lo, ph_hi; };

enum { I_X = 0, I_P, I_POS, I_EVWIN, I_EVWOUT, I_MU, I_W0, I_W2, I_A0, I_A2, I_G2, I_KK, I_KA, I_RK, I_GNG, I_GNB, I_CPOS, I_CW1, I_CW2, I_ODWIN, I_ODWOUT,
       I_HGLB, I_HGNG, I_WRG, I_BRG, I_WRE, I_BRE, I_MW1, I_MW3, I_MW2, I_LNG, I_LNB, I_PLEW, I_PLEGW };

__device__ __forceinline__ void transpose_item(const float* W, int ldw, int k0, int n0, int nvalid, bf16_t* WT, int ldt, int drow0, int dcol0, LAS float* scr, int lane) {
    const int nl = lane & 31; const bool ok = (n0 + nl) < nvalid;
#pragma unroll 8
    for (int i = 0; i < 32; ++i) { const int kk = 2 * i + (lane >> 5); scr[kk * 33 + nl] = ok ? W[(size_t)(k0 + kk) * ldw + n0 + nl] : 0.f; }
    LDS_WAIT(); asm volatile("" ::: "memory");
    const int c = lane & 7;
#pragma unroll
    for (int j = 0; j < 4; ++j) { const int n = (lane >> 3) + 8 * j; const LAS float* s = scr + (8 * c) * 33 + n;
        u32x4 o; o.x = cvt_pk_bf16(s[0 * 33], s[1 * 33]); o.y = cvt_pk_bf16(s[2 * 33], s[3 * 33]); o.z = cvt_pk_bf16(s[4 * 33], s[5 * 33]); o.w = cvt_pk_bf16(s[6 * 33], s[7 * 33]);
        *(u32x4*)(WT + (size_t)(drow0 + n) * ldt + dcol0 + k0 + 8 * c) = o; }
    LDS_WAIT(); asm volatile("" ::: "memory");
}
__device__ __forceinline__ void transpose_item_f8(const float* W, int ldw, int k0, int n0, unsigned char* WT, int ldt, int drow0, LAS float* scr, int lane) {
    const int nl = lane & 31;
#pragma unroll 8
    for (int i = 0; i < 32; ++i) { const int kk = 2 * i + (lane >> 5); scr[kk * 33 + nl] = W[(size_t)(k0 + kk) * ldw + n0 + nl]; }
    LDS_WAIT(); asm volatile("" ::: "memory");
    const int c = lane & 7;
#pragma unroll
    for (int j = 0; j < 4; ++j) { const int n = (lane >> 3) + 8 * j; const LAS float* sp = scr + (8 * c) * 33 + n;
        *(u32x2*)(WT + (size_t)(drow0 + n) * ldt + k0 + 8 * c) = (u32x2){cvt_pk4_fp8(sp[0 * 33], sp[1 * 33], sp[2 * 33], sp[3 * 33]), cvt_pk4_fp8(sp[4 * 33], sp[5 * 33], sp[6 * 33], sp[7 * 33])}; }
    LDS_WAIT(); asm volatile("" ::: "memory");
}
__device__ __forceinline__ void conv_late_item(int it, const float* odin, const float* odout, const float* evout, const float* gatew, const float* plew, unsigned char* ws, LAS float* scr, int lane) {
    const float* W; bf16_t* WT; int K = D, N = D, q = it;
    if (it < 2048) { W = odin; WT = (bf16_t*)(ws + WS_WODIN); N = 4 * D; }
    else if (it < 2560) { q = it - 2048; W = odout; WT = (bf16_t*)(ws + WS_WODOUT); }
    else if (it < 3072) { q = it - 2560; W = evout; WT = (bf16_t*)(ws + WS_WEVOUT); }
    else if (it < 4096) { q = it - 3072; const int l_ = q >> 9; q &= 511; W = gatew + (size_t)l_ * D * D; WT = (bf16_t*)(ws + WS_WGATE) + (size_t)l_ * D * D; }
    else { q = it - 4096; const int l_ = q >> 7; q &= 127; K = PLE; W = plew + (size_t)l_ * PLE * D; WT = (bf16_t*)(ws + WS_WPLE) + (size_t)l_ * D * PLE; }
    const int nblk = N / 32, kb = q / nblk, nb = q % nblk;
    transpose_item(W, N, 64 * kb, 32 * nb, N, WT, K, 32 * nb, 0, scr, lane);
}
__device__ __forceinline__ void conv_matrix(const float* W, int K, int N, int npad, bf16_t* WT, LAS float* scr, int gw, int ngw, int lane) {
    const int nblk = npad / 32, nitems = (K / 64) * nblk;
    for (int it = gw; it < nitems; it += ngw) { const int kb = it / nblk, nb = it % nblk; transpose_item(W, N, 64 * kb, 32 * nb, N, WT, K, 32 * nb, 0, scr, lane); }
}
__device__ __forceinline__ void row_to_bf16(const float* xrow, bf16_t* orow, int lane) {
    const f32x4* xr = (const f32x4*)xrow + lane; u32x2* o8 = (u32x2*)orow + lane;
#pragma unroll
    for (int j = 0; j < 4; ++j) { const f32x4 v = xr[64 * j]; u32x2 w; w.x = cvt_pk_bf16(v[0], v[1]); w.y = cvt_pk_bf16(v[2], v[3]); o8[64 * j] = w; }
}
__device__ __forceinline__ void conv_moe_item(const float* w1, const float* w3, const float* w2, int li, bf16_t* w13, bf16_t* w2t, LAS float* scr, int it, int lane) {
    constexpr int I13 = (1024 / 64) * (512 / 32), I2 = (512 / 64) * (1024 / 32);
    if (it < NEXP * 2 * I13) {
        const int e = it / (2 * I13), r = it % (2 * I13), which = r / I13, q = r % I13, kb = q / 16, nb = q % 16, n0 = 32 * nb;
        const float* W = (which ? w3 : w1) + ((size_t)(li * NEXP + e)) * 1024 * 512;
        transpose_item_f8(W, 512, 64 * kb, n0, (unsigned char*)w13, 1024, e * 1024 + (n0 >> 7) * 256 + which * 128 + (n0 & 127), scr, lane);
    } else {
        const int it2 = it - NEXP * 2 * I13, e = it2 / I2, q = it2 % I2, kb = q / 32, nb = q % 32;
        transpose_item_f8(w2 + ((size_t)(li * NEXP + e)) * 512 * 1024, 1024, 64 * kb, 32 * nb, (unsigned char*)w2t, 512, e * 1024 + 32 * nb, scr, lane);
    }
}
__device__ __forceinline__ void conv_moe_weights(const float* w1, const float* w3, const float* w2, int li, bf16_t* w13, bf16_t* w2t, LAS float* scr, int gw, int ngw, int lane, int parts = 3) {
    constexpr int I13 = (1024 / 64) * (512 / 32);
    if (parts & 1) for (int it = gw; it < NEXP * 2 * I13; it += ngw) {
        const int e = it / (2 * I13), r = it % (2 * I13), which = r / I13, q = r % I13, kb = q / 16, nb = q % 16, n0 = 32 * nb;
        const float* W = (which ? w3 : w1) + ((size_t)(li * NEXP + e)) * 1024 * 512;
        transpose_item_f8(W, 512, 64 * kb, n0, (unsigned char*)w13, 1024, e * 1024 + (n0 >> 7) * 256 + which * 128 + (n0 & 127), scr, lane);
    }
    constexpr int I2 = (512 / 64) * (1024 / 32);
    if (parts & 2) for (int it = gw; it < NEXP * I2; it += ngw) {
        const int e = it / I2, q = it % I2, kb = q / 32, nb = q % 32;
        transpose_item_f8(w2 + ((size_t)(li * NEXP + e)) * 512 * 1024, 1024, 64 * kb, 32 * nb, (unsigned char*)w2t, 512, e * 1024 + 32 * nb, scr, lane);
    }
}

__device__ __forceinline__ int row_elem(int lane, int j) { return (j < 2 ? 0 : 512) + 8 * lane + 4 * (j & 1); }
__device__ __forceinline__ void load_row_bf16(const bf16_t* row, f32x4 (&v)[4], int lane) {
    const u32x4 a = *((const u32x4*)row + lane), b = *((const u32x4*)row + 64 + lane);
    v[0] = (f32x4){bflo(a.x), bfhi(a.x), bflo(a.y), bfhi(a.y)}; v[1] = (f32x4){bflo(a.z), bfhi(a.z), bflo(a.w), bfhi(a.w)};
    v[2] = (f32x4){bflo(b.x), bfhi(b.x), bflo(b.y), bfhi(b.y)}; v[3] = (f32x4){bflo(b.z), bfhi(b.z), bflo(b.w), bfhi(b.w)};
}
__device__ __forceinline__ void store_row_bf16(bf16_t* row, const f32x4 (&v)[4], int lane) {
    *((u32x4*)row + lane) = (u32x4){cvt_pk_bf16(v[0][0], v[0][1]), cvt_pk_bf16(v[0][2], v[0][3]), cvt_pk_bf16(v[1][0], v[1][1]), cvt_pk_bf16(v[1][2], v[1][3])};
    *((u32x4*)row + 64 + lane) = (u32x4){cvt_pk_bf16(v[2][0], v[2][1]), cvt_pk_bf16(v[2][2], v[2][3]), cvt_pk_bf16(v[3][0], v[3][1]), cvt_pk_bf16(v[3][2], v[3][3])};
}
__device__ __forceinline__ void ln_row(f32x4 (&v)[4], const float* g, const float* b, int lane) {
    float s = 0.f;
#pragma unroll
    for (int j = 0; j < 4; ++j) s += (v[j][0] + v[j][1]) + (v[j][2] + v[j][3]);
    const float mean = wave_sum(s) * (1.f / D); float s2 = 0.f;
#pragma unroll
    for (int j = 0; j < 4; ++j) { v[j] = v[j] - mean; s2 += (v[j][0] * v[j][0] + v[j][1] * v[j][1]) + (v[j][2] * v[j][2] + v[j][3] * v[j][3]); }
    const float rstd = __builtin_amdgcn_rsqf(wave_sum(s2) * (1.f / D) + LN_EPS);
#pragma unroll
    for (int j = 0; j < 4; ++j) { const f32x4 gg = *(const f32x4*)(g + row_elem(lane, j)), bb = *(const f32x4*)(b + row_elem(lane, j)); v[j] = v[j] * rstd * gg + bb; }
}

__device__ __forceinline__ const void* ptab_get(LAS unsigned char* lds, int i) {
    const unsigned long long v = ((const volatile LAS unsigned long long*)(lds + 163840 - 512 + 64))[i];
    const unsigned lo = __builtin_amdgcn_readfirstlane((unsigned)v), hi = __builtin_amdgcn_readfirstlane((unsigned)(v >> 32));
    return (const void*)(const GAS char*)(((unsigned long long)hi << 32) | lo);
}
#define INF(i) ((const float*)ptab_get(lds, (i)))
#define WSB ((unsigned char*)ptab_get(lds, 35))
#define OUTP ((float*)ptab_get(lds, 34))
__global__ void __launch_bounds__(NTHR, 2) fwd(Args args) {
    extern __shared__ __attribute__((aligned(16))) unsigned char lds_raw[];
    LAS unsigned char* lds = (LAS unsigned char*)lds_raw;
    const int G = gridDim.x, bx = blockIdx.x;
    const int vcu = (G % 8 == 0) ? (bx % 8) * (G / 8) + bx / 8 : bx;
    const int ngw = G * NWAVES;
#define PH_LOCALS const int tid = pinned_tid(), lane = tid & 63, wave = __builtin_amdgcn_readfirstlane(tid >> 6), gw = vcu * NWAVES + wave; (void)tid; (void)lane; (void)gw;
    LAS unsigned long long* ptab = (LAS unsigned long long*)(lds + LDSCTL_OFF + 64);
    for (int u = threadIdx.x; u < (LDS_BYTES - LDSCTL_OFF) / 4; u += NTHR) ((LAS unsigned*)(lds + LDSCTL_OFF))[u] = 0u;
    __syncthreads();
    if (threadIdx.x == 0) {
#define PT_(i) ptab[i] = (unsigned long long)args.in[i];
        PT_(0) PT_(1) PT_(2) PT_(3) PT_(4) PT_(5) PT_(6) PT_(7) PT_(8) PT_(9) PT_(10) PT_(11) PT_(12) PT_(13) PT_(14) PT_(15) PT_(16) PT_(17) PT_(18) PT_(19) PT_(20) PT_(21) PT_(22) PT_(23) PT_(24) PT_(25) PT_(26) PT_(27) PT_(28) PT_(29) PT_(30) PT_(31) PT_(32) PT_(33)
#undef PT_
        ptab[34] = (unsigned long long)args.out; ptab[35] = (unsigned long long)args.ws;
    }
    __syncthreads();
    XcdBarrier bar = xcd_barrier_post((unsigned*)(args.ws + WS_CTL) + CW_BAR, (volatile LAS unsigned*)(lds + LDSCTL_OFF + 32));
    const int lo = args.ph_lo, hi = args.ph_hi;
    int pc = 0;
#define PH_PTRS unsigned char* const ws = WSB; (void)ws; \
    bf16_t* const W_evin = (bf16_t*)(ws + WS_WEVIN); bf16_t* const W_evout = (bf16_t*)(ws + WS_WEVOUT); bf16_t* const W_odin = (bf16_t*)(ws + WS_WODIN); bf16_t* const W_odout = (bf16_t*)(ws + WS_WODOUT); \
    bf16_t* const W_gate = (bf16_t*)(ws + WS_WGATE); bf16_t* const W_ple = (bf16_t*)(ws + WS_WPLE); bf16_t* const W_m13 = (bf16_t*)(ws + WS_WMOE13); bf16_t* const W_m2 = (bf16_t*)(ws + WS_WMOE2); \
    bf16_t* const pbf = (bf16_t*)(ws + WS_PBF); bf16_t* const XB = (bf16_t*)(ws + WS_XB); bf16_t* const Hb = (bf16_t*)(ws + A_H); bf16_t* const PP = (bf16_t*)(ws + A_XBUF); bf16_t* const XB1 = (bf16_t*)OUTP; bf16_t* const PBF1 = (bf16_t*)OUTP + (size_t)M * D; bf16_t* const PP1 = (bf16_t*)(ws + A_PP1); bf16_t* const ZB = (bf16_t*)(ws + WS_ARENA); \
    (void)W_evin; (void)W_evout; (void)W_odin; (void)W_odout; (void)W_gate; (void)W_ple; (void)W_m13; (void)W_m2; (void)pbf; (void)XB; (void)Hb; (void)PP; (void)XB1; (void)PBF1; (void)PP1; (void)ZB;
#define PH_RUN (pc >= lo && pc < hi)
#define PH_END do { if (pc >= lo && pc + 1 < hi) xcd_barrier(bar); ++pc; } while (0)

    if (PH_RUN) for (int rep_ = 0; rep_ < (PROBE_DUP == 20 ? 2 : 1); ++rep_) { PH_PTRS PH_LOCALS
        LAS float* scr = (LAS float*)(lds + wave * 16384);
        conv_matrix(INF(I_EVWIN), D, EVN, EVP, W_evin, scr, gw, ngw, lane);
        if (G != NB * 16) {
        conv_matrix(INF(I_EVWOUT), D, D, D, W_evout, scr, gw, ngw, lane);
        conv_matrix(INF(I_ODWIN), D, 4 * D, 4 * D, W_odin, scr, gw, ngw, lane);
        conv_matrix(INF(I_ODWOUT), D, D, D, W_odout, scr, gw, ngw, lane);
        for (int li = 0; li < DEPTH; ++li) {
            conv_matrix(INF(I_PLEGW) + (size_t)li * D * D, D, D, D, W_gate + (size_t)li * D * D, scr, gw, ngw, lane);
            conv_matrix(INF(I_PLEW) + (size_t)li * PLE * D, PLE, D, D, W_ple + (size_t)li * D * PLE, scr, gw, ngw, lane);
        }
        }
        { const float* w2 = INF(I_W2); const float* a2 = INF(I_A2); const float* g2 = INF(I_G2); bf16_t* WL = (bf16_t*)(ws + WS_WLORA);
          for (int idx = gw * 64 + lane; idx < 1536 * 256; idx += ngw * 64) { const int n = idx >> 8, k = idx & 255; float v = 0.f;
              if (n < 512) { if (k < 64) v = w2[k * 512 + n]; } else if (n < 1024) { if (k >= 64 && k < 128) v = a2[(k - 64) * 512 + (n - 512)]; } else { if (k >= 128) v = g2[(k - 128) * 512 + (n - 1024)]; }
              WL[idx] = (bf16_t)(cvt_pk_bf16(v, 0.f) & 0xffffu); } }
        { const float* cw1 = INF(I_CW1); bf16_t* WC = (bf16_t*)(ws + WS_WCMP);
          for (int it = gw; it < 4 * 64; it += ngw) { const int zh = it >> 6, q = it & 63, kb = q >> 2, nb = q & 3;
              transpose_item(cw1 + (size_t)zh * 1024 * 128, 128, 64 * kb, 32 * nb, 128, WC, 1024, zh * 128 + 32 * nb, 0, scr, lane); }
          const float* cpos = INF(I_CPOS); float* cb = (float*)(ws + MISC_CMPB);
          for (int o = gw; o < 256; o += ngw) { const int zz = o >> 7, c = o & 127; float a = 0.f; for (int i = lane; i < 2048; i += 64) a += cpos[zz * 2048 + i] * cw1[((size_t)zz * 2048 + i) * 128 + c]; a = wave_sum(a); if (lane == 0) cb[o] = a; } }
        { bf16_t* WRB = (bf16_t*)(ws + WS_WRB); const float* wrg = INF(I_WRG); const float* wre = INF(I_WRE);
          for (int idx = gw * 64 + lane; idx < DEPTH * 256 * 1024; idx += ngw * 64) { const int l_ = idx >> 18, n = (idx >> 10) & 255, k = idx & 1023;
              const float v = n < 4 ? wrg[((size_t)l_ * D + k) * 4 + n] : n < 36 ? wre[((size_t)l_ * D + k) * NEXP + (n - 4)] : 0.f; WRB[idx] = (bf16_t)(cvt_pk_bf16(v, 0.f) & 0xffffu); } }
        { const float* hl = INF(I_HGLB); float* lbt = (float*)(ws + MISC_LBT);
          for (int c = gw * 64 + lane; c < D; c += ngw * 64) { const float a0 = hl[c], a1 = hl[D + c], mx = fmaxf(a0, a1), e0 = __expf(a0 - mx), e1 = __expf(a1 - mx); lbt[c] = e1 / (e0 + e1); } }
        const float* xin_ = INF(I_X);
        for (int m = gw; m < M; m += 4 * ngw) {
            f32x4 v[4][4];
#pragma unroll
            for (int r = 0; r < 4; ++r)
#pragma unroll
                for (int j = 0; j < 4; ++j) v[r][j] = *(const f32x4*)(xin_ + (size_t)(m + r * ngw) * D + row_elem(lane, j));
#pragma unroll
            for (int r = 0; r < 4; ++r) store_row_bf16(XB + (size_t)(m + r * ngw) * D, v[r], lane);
        }
    }
    PH_END;

    for (int li = 0; li < DEPTH; ++li) {
                if (li == 0) {
            if (PH_RUN) { PH_PTRS
                pg8::Gemm g{XB, W_evin, D, D, D}; pg8::DenseOrder S; S.init(M, EVP, G, bx);
                pg8::EpiBf16 E{ZB, EVP, 0u, 0u, nullptr};
                for (int rep_ = 0; rep_ < (PROBE_DUP == 4 ? 2 : 1); ++rep_) pg8::gemm_phase<pg8::EpiBf16, pg8::DenseOrder>(lds, g, S, E);
            }
            PH_END;
            if (PH_RUN) for (int rep_ = 0; rep_ < (PROBE_DUP == 21 ? 2 : 1); ++rep_) { PH_PTRS PH_LOCALS const bool dry_ = (PROBE_DUP == 21 && rep_ == 0);
                const float* mu = INF(I_MU); bf16_t* ACT = (bf16_t*)(ws + A_ACT); const int* posi = (const int*)INF(I_POS); bf16_t* QRB = (bf16_t*)((unsigned char*)OUTP + DOUT_QR); bf16_t* SEGB = (bf16_t*)((unsigned char*)OUTP + DOUT_SEG);
                const float inv_me = exp2f(-(float)(lane & 31) * (13.287712379549449f / 32.0f));
                f32x4 mu8a = (f32x4){0.f, 0.f, 0.f, 0.f}, mu8b = mu8a; if (lane < 32) { mu8a = *(const f32x4*)(mu + 1536 + 8 * lane); mu8b = *(const f32x4*)(mu + 1536 + 8 * lane + 4); }
                LAS float* tb = (LAS float*)(lds + wave * 256);
                for (int m = gw; m < M; m += ngw) {
                    const bf16_t* zrow = ZB + (size_t)m * EVP;
                    if (lane < 32) {
                        const u32x4 zc = *(const u32x4*)(zrow + 1536 + 8 * lane); u32x4 zp = (u32x4){0u, 0u, 0u, 0u};
                        if ((m & (T - 1)) != 0) zp = *(const u32x4*)(zrow - EVP + 1536 + 8 * lane);
                        float v[8], pv[8]; unpack8(zc, v); unpack8(zp, pv);
#pragma unroll
                        for (int j = 0; j < 8; ++j) { v[j] += (j < 4 ? mu8a[j & 3] : mu8b[j & 3]) * (pv[j] - v[j]); if (lane < 8) { const float e2 = __expf(2.0f * fminf(fmaxf(v[j], -15.0f), 15.0f)); v[j] = (e2 - 1.0f) * __builtin_amdgcn_rcpf(e2 + 1.0f); } else if (lane >= 16) v[j] = sigmoidf_(v[j]); }
                        *(u32x4*)(ACT + (size_t)m * 256 + 8 * lane) = (u32x4){cvt_pk_bf16(v[0], v[1]), cvt_pk_bf16(v[2], v[3]), cvt_pk_bf16(v[4], v[5]), cvt_pk_bf16(v[6], v[7])};
                    }
                    if (G != NB * 16) rope_row(m, ZB, QRB, posi, tb, lane, !dry_);
                    if (lane < 48) {
                    } else {
                        const int bq_ = m >> 12, tt = m & (T - 1), jj = tt >> 4, ll = tt & 15;
#pragma unroll
                        for (int q = 0; q < 2; ++q) { const int idx = (lane - 48) * 2 + q, piece = idx >> 3, ch = idx & 7, zsel = piece >> 1, hq = piece & 1;
                            *(u32x4*)(SEGB + ((size_t)zsel * 8192 + (size_t)(bq_ * 256 + jj) * 2 + hq) * 1024 + ll * 64 + ch * 8) = *(const u32x4*)(zrow + 2304 + zsel * 128 + hq * 64 + ch * 8); }
                    }
                    LDS_WAIT();
                }
            }
            PH_END;
            if (PH_RUN) { PH_PTRS
                pg8::Gemm g{(const bf16_t*)(ws + A_ACT), (const bf16_t*)(ws + WS_WLORA), 256, 256, 256}; pg8::DenseOrder S; S.init(M, 1536, G, bx);
                pg8::EpiLora E{INF(I_W0), INF(I_A0), (float*)(ws + A_DEC), (bf16_t*)(ws + A_AA), (bf16_t*)(ws + A_GG)};
                for (int rep_ = 0; rep_ < ((PROBE_DUP == 4 || PROBE_DUP == 42) ? 2 : 1); ++rep_) pg8::gemm_phase<pg8::EpiLora, pg8::DenseOrder>(lds, g, S, E);
            }
            PH_END;
            if (PH_RUN) { PH_PTRS
              if (G > 64 && bx < 64) {
                pg8::Gemm g{(const bf16_t*)((unsigned char*)OUTP + DOUT_SEG), (const bf16_t*)(ws + WS_WCMP), 1024, 1024, 1024}; pg8::CmpOrder S{G, bx};
                pg8::EpiF32 E{(float*)(ws + A_HC2), 256};
                pg8::gemm_phase<pg8::EpiF32, pg8::CmpOrder>(lds, g, S, E);
              } else { PH_LOCALS
                const int gwp = G > 64 ? (bx - 64) * NWAVES + wave : gw, ngwp = G > 64 ? (G - 64) * NWAVES : ngw;
                const float* mu = INF(I_MU); const float* kkp = INF(I_KK); const float* kap = INF(I_KA); const float* rkp = INF(I_RK); const bf16_t* AAp = (const bf16_t*)(ws + A_AA); float* sc4 = (float*)(ws + A_SC4);
                float p_mr[8], p_mk[8], p_kk[8], p_ka[8], p_rk[8];
#pragma unroll
                for (int i = 0; i < 8; ++i) { p_mr[i] = mu[8 * lane + i]; p_mk[i] = mu[512 + 8 * lane + i]; p_kk[i] = kkp[8 * lane + i]; p_ka[i] = kap[8 * lane + i]; p_rk[i] = rkp[8 * lane + i]; }
                for (int m = gwp; m < M; m += ngwp) {
                    const bf16_t* zc = ZB + (size_t)m * EVP + 8 * lane;
                    const u32x4 rw_ = *(const u32x4*)zc, kw_ = *(const u32x4*)(zc + 512), aw_ = *(const u32x4*)(AAp + (size_t)m * 512 + 8 * lane); u32x4 rpw = (u32x4){0u, 0u, 0u, 0u}, kpw = rpw;
                    if ((m & (T - 1)) != 0) { rpw = *(const u32x4*)(zc - EVP); kpw = *(const u32x4*)(zc + 512 - EVP); }
                    float r_[8], k_[8], rp_[8], kp_[8], a_[8]; unpack8(rw_, r_); unpack8(kw_, k_); unpack8(rpw, rp_); unpack8(kpw, kp_); unpack8(aw_, a_);
                    float n2 = 0.f, c1 = 0.f, c2 = 0.f, bc = 0.f;
#pragma unroll
                    for (int i = 0; i < 8; ++i) { const float rr = r_[i] + p_mr[i] * (rp_[i] - r_[i]), k0 = k_[i] + p_mk[i] * (kp_[i] - k_[i]), kk = k0 * p_kk[i], k2 = k0 * (1.0f + (a_[i] - 1.0f) * p_ka[i]);
                        n2 += kk * kk; c1 += kk * a_[i] * rr; c2 += k2 * rr; bc += rr * k2 * p_rk[i]; }
                    n2 = sum8b(n2); c1 = sum8b(c1); c2 = sum8b(c2); bc = sum8b(bc);
                    const float inv = __builtin_amdgcn_rsqf(fmaxf(n2, 1e-24f));
                    if ((lane & 7) == 0) *(f32x4*)(sc4 + ((size_t)m * 8 + (lane >> 3)) * 4) = (f32x4){inv, c1 * inv, c2, bc};
                }
            }
              if (G <= 64) { __syncthreads(); pg8::Gemm g{(const bf16_t*)((unsigned char*)OUTP + DOUT_SEG), (const bf16_t*)(ws + WS_WCMP), 1024, 1024, 1024}; pg8::CmpOrder S{G, bx}; pg8::EpiF32 E{(float*)(ws + A_HC2), 256}; pg8::gemm_phase<pg8::EpiF32, pg8::CmpOrder>(lds, g, S, E); }
            }
            PH_END;
            if (PH_RUN) for (int rep_ = 0; rep_ < (PROBE_DUP == 1 ? 2 : 1); ++rep_) { PH_PTRS rwkv_phase(lds, ZB, (const float*)(ws + A_DEC), (const bf16_t*)(ws + A_AA), (const float*)(ws + A_SC4), INF(I_MU), INF(I_KK), INF(I_KA), XB, G, bx, INF(I_MW1), INF(I_MW3), INF(I_MW2), W_m13, W_m2, G == NB * 16 && PROBE_DUP != 1,
                                   (const float*)(ws + A_HC2), (const float*)(ws + MISC_CMPB), INF(I_CW2), (bf16_t*)(ws + A_KVC2), INF(I_P), pbf, PBF1, ZB, (bf16_t*)((unsigned char*)OUTP + DOUT_QR), (const int*)INF(I_POS),
                                   INF(I_ODWIN), INF(I_ODWOUT), INF(I_EVWOUT), INF(I_PLEGW), INF(I_PLEW), ws); }
            PH_END;
            if (PH_RUN) for (int rep_ = 0; rep_ < (PROBE_DUP == 23 ? 2 : 1); ++rep_) { PH_PTRS PH_LOCALS bf16_t* yout_ = (PROBE_DUP == 23 && rep_ == 0) ? (bf16_t*)(ws + A_DEC) : XB;
                const float* mu = INF(I_MU); const float* gng = INF(I_GNG); const float* gnb = INF(I_GNB); const bf16_t* GGp = (const bf16_t*)(ws + A_GG); const float* sc4 = (const float*)(ws + A_SC4);
                float p_mv[8], p_g[8], p_b[8];
#pragma unroll
                for (int i = 0; i < 8; ++i) { p_mv[i] = mu[1024 + 8 * lane + i]; p_g[i] = gng[8 * lane + i]; p_b[i] = gnb[8 * lane + i]; }
                for (int m = gw; m < M; m += ngw) {
                    const bf16_t* zc = ZB + (size_t)m * EVP + 1024 + 8 * lane;
                    const u32x4 vw_ = *(const u32x4*)zc, ow_ = *(const u32x4*)(XB + (size_t)m * D + 8 * lane), gw_ = *(const u32x4*)(GGp + (size_t)m * 512 + 8 * lane); u32x4 vpw = (u32x4){0u, 0u, 0u, 0u};
                    if ((m & (T - 1)) != 0) vpw = *(const u32x4*)(zc - EVP);
                    const float bc = sc4[((size_t)m * 8 + (lane >> 3)) * 4 + 3];
                    float v_[8], vp_[8], o_[8], g_[8]; unpack8(vw_, v_); unpack8(vpw, vp_); unpack8(ow_, o_); unpack8(gw_, g_);
                    float s1 = 0.f;
#pragma unroll
                    for (int i = 0; i < 8; ++i) s1 += o_[i];
                    const float mean = sum8b(s1) * (1.0f / 64.0f); float s2 = 0.f;
#pragma unroll
                    for (int i = 0; i < 8; ++i) { o_[i] -= mean; s2 += o_[i] * o_[i]; }
                    const float rstd = __builtin_amdgcn_rsqf(sum8b(s2) * (1.0f / 64.0f) + 64e-5f);
                    float y_[8];
#pragma unroll
                    for (int i = 0; i < 8; ++i) { const float vv = v_[i] + p_mv[i] * (vp_[i] - v_[i]); y_[i] = (o_[i] * rstd * p_g[i] + p_b[i] + bc * vv) * g_[i]; }
                    *(u32x4*)(yout_ + (size_t)m * (yout_ == XB ? D : 512) + 8 * lane) = (u32x4){cvt_pk_bf16(y_[0], y_[1]), cvt_pk_bf16(y_[2], y_[3]), cvt_pk_bf16(y_[4], y_[5]), cvt_pk_bf16(y_[6], y_[7])};
                }
            }
            if (PH_RUN && !(G == NB * 16 && PROBE_DUP != 1)) { PH_PTRS PH_LOCALS
                LAS float* w2s = (LAS float*)lds; LAS float* hs = (LAS float*)(lds + 65536 + wave * 512);
                { const float* cw2 = INF(I_CW2); for (int i = tid; i < 2 * 128 * 64; i += NTHR) w2s[i] = cw2[i]; }
                __syncthreads();
                const float* HC = (const float*)(ws + A_HC2); const float* cb = (const float*)(ws + MISC_CMPB); bf16_t* KVC = (bf16_t*)(ws + A_KVC2);
                for (int rr = gw; rr < 2 * 16 * 256 * 2; rr += ngw) {
                    const int hq = rr & 1, n = (rr >> 1) & 255, bq_ = (rr >> 9) & 15, zsel = rr >> 13;
                    float outv = 0.f;
                    if (n < 255) {
                        const float* ha = HC + ((size_t)zsel * 8192 + (size_t)(bq_ * 256 + n) * 2 + hq) * 256; const float* hb = ha + 2 * 256 + 128;
#pragma unroll
                        for (int q = 0; q < 2; ++q) { const int c = lane + 64 * q; const float xx = ha[c] + hb[c] + cb[zsel * 128 + c];
                            hs[c] = 0.5f * xx * (1.0f + tanhf(0.7978845608028654f * (xx + 0.044715f * xx * xx * xx))); }
                        LDS_WAIT();
                        for (int c = 0; c < 128; ++c) outv += hs[c] * w2s[(zsel * 128 + c) * 64 + lane];
                        LDS_WAIT();
                    }
                    KVC[((size_t)(zsel * 32 + bq_ * 2 + hq) * 256 + n) * 64 + lane] = (bf16_t)(cvt_pk_bf16(outv, 0.f) & 0xffffu);
                }
            }
            PH_END;
            if (PH_RUN) for (int rep_ = 0; rep_ < (PROBE_DUP == 2 ? 2 : 1); ++rep_) { PH_PTRS nsa_attn_phase(lds, ZB, (const bf16_t*)((unsigned char*)OUTP + DOUT_QR), (const bf16_t*)(ws + A_KVC2), XB, G, bx); }
            PH_END;
            if (PH_RUN) { PH_PTRS
                pg8::Gemm g{XB, W_evout, D, D, D}; pg8::DenseOrder S; S.init(M, D, G, bx);
                pg8::EpiPre E{INF(I_X), nullptr, Hb};
                for (int rep_ = 0; rep_ < (PROBE_DUP == 4 ? 2 : 1); ++rep_) pg8::gemm_phase<pg8::EpiPre, pg8::DenseOrder>(lds, g, S, E);
            }
            PH_END;
        }
        if (li == 1) {
            if (PH_RUN) { PH_PTRS
                pg8::Gemm g{XB1, W_odin, D, D, D}; pg8::DenseOrder S; S.init(M, 4 * D, G, bx);
                pg8::EpiBf16 E{ZB, 4 * D, 0xF00Fu, 0x00F0u, (const float*)(ws + MISC_LBT)};
                for (int rep_ = 0; rep_ < (PROBE_DUP == 7 ? 2 : 1); ++rep_) pg8::gemm_phase<pg8::EpiBf16, pg8::DenseOrder>(lds, g, S, E);
            }
            PH_END;
            if (PH_RUN) for (int rep_ = 0; rep_ < (PROBE_DUP == 3 ? 2 : 1); ++rep_) { PH_PTRS
                if (G > NB * 8 && bx >= NB * 8) {
                    { pg8::Gemm g{PBF1, W_ple + (size_t)D * PLE, PLE, PLE, PLE}; pg8::DenseOrder S; S.init(M, D, G - NB * 8, bx - NB * 8);
                      pg8::EpiBf16 E{PP1, D, 0u, 0u, nullptr};
                      pg8::gemm_phase<pg8::EpiBf16, pg8::DenseOrder>(lds, g, S, E); }
                    __syncthreads();
                    { PH_LOCALS
                      const int gwi = (bx - NB * 8) * NWAVES + wave, ngwi = (G - NB * 8) * NWAVES;
                      LAS float* scr = (LAS float*)(lds + wave * 8704);
                      conv_moe_weights(INF(I_MW1), INF(I_MW3), INF(I_MW2), 1, W_m13, W_m2, scr, gwi, ngwi, lane, 3); }
                } else hgrn_phase(lds, ZB, INF(I_HGLB), INF(I_HGNG), XB, G, bx); }
            PH_END;
            if (PH_RUN) { PH_PTRS
                pg8::Gemm g{XB, W_odout, D, D, D}; pg8::DenseOrder S; S.init(M, D, G, bx);
                pg8::EpiPre E{nullptr, XB1, Hb};
                for (int rep_ = 0; rep_ < (PROBE_DUP == 7 ? 2 : 1); ++rep_) pg8::gemm_phase<pg8::EpiPre, pg8::DenseOrder>(lds, g, S, E);
            }
            PH_END;
        }
        if (PH_RUN) for (int rep_ = 0; rep_ < (PROBE_DUP == 25 ? 2 : 1); ++rep_) { PH_PTRS PH_LOCALS bf16_t* hout_ = (PROBE_DUP == 25 && rep_ == 0) ? (bf16_t*)(ws + A_XBUF) : Hb;
            const float* lng = INF(I_LNG) + (size_t)li * 2 * D; const float* lnb = INF(I_LNB) + (size_t)li * 2 * D;
            for (int m = gw; m < M; m += 4 * ngw) {
                f32x4 v[4][4];
#pragma unroll
                for (int r = 0; r < 4; ++r) load_row_bf16(Hb + (size_t)(m + r * ngw) * D, v[r], lane);
#pragma unroll
                for (int r = 0; r < 4; ++r) { ln_row(v[r], lng, lnb, lane); store_row_bf16(hout_ + (size_t)(m + r * ngw) * D, v[r], lane);
                    unsigned char* h8 = ws + A_H8 + (size_t)(m + r * ngw) * D + 8 * lane;
                    *(u32x2*)h8 = (u32x2){cvt_pk4_fp8_sat(v[r][0][0], v[r][0][1], v[r][0][2], v[r][0][3]), cvt_pk4_fp8_sat(v[r][1][0], v[r][1][1], v[r][1][2], v[r][1][3])};
                    *(u32x2*)(h8 + 512) = (u32x2){cvt_pk4_fp8_sat(v[r][2][0], v[r][2][1], v[r][2][2], v[r][2][3]), cvt_pk4_fp8_sat(v[r][3][0], v[r][3][1], v[r][3][2], v[r][3][3])}; }
            }
        }
        PH_END;
        if (PH_RUN) { PH_PTRS
            pg8::Gemm g{Hb, (const bf16_t*)(ws + WS_WRB) + (size_t)li * 256 * D, D, D, D}; pg8::DenseOrder S; S.init(M, 256, G, bx);
            pg8::EpiLogit E{(float*)(ws + A_XBUF)};
            pg8::gemm_phase<pg8::EpiLogit, pg8::DenseOrder>(lds, g, S, E);
        }
        PH_END;
        if (PH_RUN) { PH_PTRS PH_LOCALS
            LAS int* hist = (LAS int*)lds;
            if (tid < NEXP) hist[tid] = 0;
            __syncthreads();
            const float* brg = INF(I_BRG) + li * 4; const float* bre = INF(I_BRE) + li * NEXP; const float* LG = (const float*)(ws + A_XBUF);
            int* eid_o = (int*)(ws + MISC_EID); float* gate_o = (float*)(ws + MISC_GATE);
            const int npair = M / 2 / ngw;
            for (int q0 = 0; q0 < npair; q0 += 32) {
                const int q = q0 + (lane >> 1);
                if (q < npair) {
                    const int m = 2 * (gw + q * ngw) + (lane & 1);
                    float lg[36];
#pragma unroll
                    for (int c = 0; c < 9; ++c) { const f32x4 t = *(const f32x4*)(LG + (size_t)m * 64 + 4 * c); lg[4 * c] = t[0]; lg[4 * c + 1] = t[1]; lg[4 * c + 2] = t[2]; lg[4 * c + 3] = t[3]; }
                    float g0 = lg[0] + brg[0], g1 = lg[1] + brg[1], g2 = lg[2] + brg[2], g3 = lg[3] + brg[3];
                    int gs = 0; float gm = g0; if (g1 > gm) { gm = g1; gs = 1; } if (g2 > gm) { gm = g2; gs = 2; } if (g3 > gm) { gm = g3; gs = 3; }
                    const float pg = __builtin_amdgcn_rcpf(__expf(g0 - gm) + __expf(g1 - gm) + __expf(g2 - gm) + __expf(g3 - gm));
                    float le[8];
#pragma unroll
                    for (int e = 0; e < 8; ++e) { const float a = gs == 0 ? lg[4 + e] : gs == 1 ? lg[12 + e] : gs == 2 ? lg[20 + e] : lg[28 + e]; le[e] = a + bre[gs * 8 + e]; }
                    int i1 = 0; float v1 = le[0];
#pragma unroll
                    for (int e = 1; e < 8; ++e) if (le[e] > v1) { v1 = le[e]; i1 = e; }
                    int i2 = -1; float v2 = -3.0e38f;
#pragma unroll
                    for (int e = 0; e < 8; ++e) if (e != i1 && le[e] > v2) { v2 = le[e]; i2 = e; }
                    const float e2 = __expf(v2 - v1), den = __builtin_amdgcn_rcpf(1.0f + e2);
                    const int ea = gs * 8 + i1, eb = gs * 8 + i2;
                    *(int2*)(eid_o + 2 * (size_t)m) = make_int2(ea, eb); *(float2*)(gate_o + 2 * (size_t)m) = make_float2(pg * den, pg * e2 * den);
                    __hip_atomic_fetch_add(&hist[ea], 1, __ATOMIC_RELAXED, __HIP_MEMORY_SCOPE_WORKGROUP); __hip_atomic_fetch_add(&hist[eb], 1, __ATOMIC_RELAXED, __HIP_MEMORY_SCOPE_WORKGROUP);
                }
            }
            __syncthreads();
            if (tid < NEXP) ((int*)(ws + MISC_BCNT))[vcu * NEXP + tid] = hist[tid];
        }
        PH_END;
        if (PH_RUN) for (int rep_ = 0; rep_ < (PROBE_DUP == 26 ? 2 : 1); ++rep_) { PH_PTRS PH_LOCALS
            __syncthreads();
            LAS int* tot = (LAS int*)lds; LAS int* prt = tot + 16 * NEXP; LAS int* cursor = prt + 16 * NEXP; LAS int* startv = cursor + NEXP; LAS int* padv = startv + NEXP;
            const int* bcnt = (const int*)(ws + MISC_BCNT);
            { const int e = tid & 31, part = tid >> 5; int a = 0, p = 0; for (int w = part; w < G; w += 16) { const int c = bcnt[w * NEXP + e]; a += c; if (w < vcu) p += c; } tot[part * NEXP + e] = a; prt[part * NEXP + e] = p; }
            __syncthreads();
            if (tid < NEXP) { int a = 0, p = 0; for (int q = 0; q < 16; ++q) { a += tot[q * NEXP + tid]; p += prt[q * NEXP + tid]; } padv[tid] = (a + 255) & ~255; cursor[tid] = p; }
            __syncthreads();
            if (tid == 0) { int run = 0;
#pragma nounroll
                for (int e = 0; e < NEXP; ++e) { startv[e] = run; run += padv[e]; } }
            __syncthreads();
            if (tid < NEXP) cursor[tid] += startv[tid];
            if (bx == 0) { int* te = (int*)(ws + MISC_TILEE); const int ntl = (startv[NEXP - 1] + padv[NEXP - 1]) >> 8; if (tid == 0) te[0] = ntl;
                for (int t = tid; t < ntl; t += NTHR) { int e = 0;
#pragma nounroll
                    for (int q = 0; q < NEXP; ++q) e += ((startv[q] + padv[q]) <= 256 * t) ? 1 : 0;
                    te[1 + t] = e; } }
            __syncthreads();
            const int* eid_i = (const int*)(ws + MISC_EID); int* slot_o = (int*)(ws + MISC_SLOT); int* toks_o = (int*)(ws + WS_TOKS);
            for (int mm = 2 * gw; mm < M; mm += 2 * ngw) for (int m = mm; m < mm + 2; ++m) {
                int s0 = 0, s1 = 0;
                if (lane == 0) { const int2 ee = *(const int2*)(eid_i + 2 * (size_t)m); s0 = __hip_atomic_fetch_add(&cursor[ee.x], 1, __ATOMIC_RELAXED, __HIP_MEMORY_SCOPE_WORKGROUP); s1 = __hip_atomic_fetch_add(&cursor[ee.y], 1, __ATOMIC_RELAXED, __HIP_MEMORY_SCOPE_WORKGROUP); *(int2*)(slot_o + 2 * (size_t)m) = make_int2(s0, s1); }
                s0 = __builtin_amdgcn_readfirstlane(s0); s1 = __builtin_amdgcn_readfirstlane(s1);
                if (lane == 0) { toks_o[s0] = m; toks_o[s1] = m; }
            }
            { LAS float* scr = (LAS float*)(lds + 16384 + wave * 8704);
              const bool shadow = (G > NB * 8);
              const int parts_ = (li == 1 && shadow) ? 0 : ((li == 0 && G == NB * 16) ? 0 : 3);
              if (parts_) conv_moe_weights(INF(I_MW1), INF(I_MW3), INF(I_MW2), li, W_m13, W_m2, scr, gw, ngw, lane, parts_);
              const int np = (li == 1 && shadow) ? 0 : ((li == 0 && G == NB * 16) ? 0 : ((li == 0 && shadow) ? 2 : 1));
              for (int q = 0; q < np; ++q) { const float* pl = INF(I_P) + (size_t)(li + q) * M * PLE; bf16_t* pd = q ? PBF1 : pbf;
                for (int m = gw; m < M; m += 4 * ngw) { f32x4 v[4];
#pragma unroll
                    for (int r = 0; r < 4; ++r) v[r] = *((const f32x4*)(pl + (size_t)(m + r * ngw) * PLE) + lane);
#pragma unroll
                    for (int r = 0; r < 4; ++r) *((u32x2*)(pd + (size_t)(m + r * ngw) * PLE) + lane) = (u32x2){cvt_pk_bf16(v[r][0], v[r][1]), cvt_pk_bf16(v[r][2], v[r][3])}; } } }
        }
        PH_END;
        if (PH_RUN) { PH_PTRS
            const int* te = (const int*)(ws + MISC_TILEE);
            pg8::MoeOrder S{te + 1, __builtin_amdgcn_readfirstlane(te[0]), G, bx};
            for (int rep_ = 0; rep_ < (PROBE_DUP == 5 ? 2 : 1); ++rep_) pg8::gemm_f8_phase<0>(lds, ws + A_H8, (const unsigned char*)W_m13, D, S, (const int*)(ws + WS_TOKS), ws + A_HID, nullptr);
        }
        PH_END;
        if (PH_RUN) { PH_PTRS
            const int* te = (const int*)(ws + MISC_TILEE);
            pg8::MoeOrder S{te + 1, __builtin_amdgcn_readfirstlane(te[0]), G, bx};
            for (int rep_ = 0; rep_ < (PROBE_DUP == 5 ? 2 : 1); ++rep_) pg8::gemm_f8_phase<1>(lds, ws + A_HID, (const unsigned char*)W_m2, MOE_H, S, nullptr, nullptr, (bf16_t*)(ws + A_XBUF));
        }
        PH_END;
        if (PH_RUN) for (int rep_ = 0; rep_ < (PROBE_DUP == 27 ? 2 : 1); ++rep_) { PH_PTRS PH_LOCALS bf16_t* hout_ = (PROBE_DUP == 27 && rep_ == 0) ? (bf16_t*)OUTP : XB;
            const float* lng = INF(I_LNG) + (size_t)li * 2 * D; const float* lnb = INF(I_LNB) + (size_t)li * 2 * D;
            const int* slot_i = (const int*)(ws + MISC_SLOT); const float* gate_i = (const float*)(ws + MISC_GATE); const bf16_t* ybuf = (const bf16_t*)(ws + A_XBUF);
            for (int m0 = gw; m0 < M; m0 += 2 * ngw) {
                int2 sl[2]; float2 gt[2]; u32x4 hw_[2][2], y0[2][2], y1[2][2];
#pragma unroll
                for (int r = 0; r < 2; ++r) { const int m = m0 + r * ngw; sl[r] = *(const int2*)(slot_i + 2 * (size_t)m); gt[r] = *(const float2*)(gate_i + 2 * (size_t)m); }
#pragma unroll
                for (int r = 0; r < 2; ++r) { const int m = m0 + r * ngw;
#pragma unroll
                    for (int q = 0; q < 2; ++q) { hw_[r][q] = *((const u32x4*)(Hb + (size_t)m * D) + lane + 64 * q); y0[r][q] = *((const u32x4*)(ybuf + (size_t)sl[r].x * D) + lane + 64 * q); y1[r][q] = *((const u32x4*)(ybuf + (size_t)sl[r].y * D) + lane + 64 * q); } }
#pragma unroll
                for (int r = 0; r < 2; ++r) { const int m = m0 + r * ngw; f32x4 v[4];
#pragma unroll
                    for (int q = 0; q < 2; ++q) { const unsigned hh_[4] = {hw_[r][q].x, hw_[r][q].y, hw_[r][q].z, hw_[r][q].w}, ya[4] = {y0[r][q].x, y0[r][q].y, y0[r][q].z, y0[r][q].w}, yb[4] = {y1[r][q].x, y1[r][q].y, y1[r][q].z, y1[r][q].w};
#pragma unroll
                        for (int e = 0; e < 4; ++e) { v[2 * q + (e >> 1)][2 * (e & 1)] = bflo(hh_[e]) * DN_ALPHA + (gt[r].x * bflo(ya[e]) + gt[r].y * bflo(yb[e])); v[2 * q + (e >> 1)][2 * (e & 1) + 1] = bfhi(hh_[e]) * DN_ALPHA + (gt[r].x * bfhi(ya[e]) + gt[r].y * bfhi(yb[e])); } }
                    ln_row(v, lng + D, lnb + D, lane);
                    store_row_bf16(hout_ + (size_t)m * D, v, lane); }
            }
        }
        PH_END;
        if (!(li == 1 && G > NB * 8)) {
        if (PH_RUN) { PH_PTRS PH_LOCALS
            pg8::Gemm g{pbf, W_ple + (size_t)li * D * PLE, PLE, PLE, PLE}; pg8::DenseOrder S; S.init(M, D, G, bx);
            pg8::EpiBf16 E{PP, D, 0u, 0u, nullptr};
            for (int rep_ = 0; rep_ < ((PROBE_DUP == 6 || PROBE_DUP == 41) ? 2 : 1); ++rep_) pg8::gemm_phase<pg8::EpiBf16, pg8::DenseOrder>(lds, g, S, E);
        }
        PH_END;
        }
        if (PH_RUN) { PH_PTRS PH_LOCALS
            pg8::Gemm g{XB, W_gate + (size_t)li * D * D, D, D, D}; pg8::DenseOrder S; S.init(M, D, G, bx);
            pg8::EpiGate E{XB, (li == 1 && G > NB * 8) ? PP1 : PP, li == DEPTH - 1 ? OUTP : nullptr, XB1};
            for (int rep_ = 0; rep_ < (PROBE_DUP == 6 ? 2 : 1); ++rep_) pg8::gemm_phase<pg8::EpiGate, pg8::DenseOrder>(lds, g, S, E);
        }
        PH_END;
    }
#undef PH_RUN
#undef PH_END
}
constexpr int TOTAL_PHASES = 1 + 8 + 9 + 3 + 8;

extern "C" void kernel_launch(void* const* d_in, const int* in_sizes, int n_in, void* d_out, int out_size, void* d_ws, size_t ws_size, hipStream_t stream) {
    static int grid = 0;
    if (grid == 0) {
        if (n_in != 34 || in_sizes[0] != M * D || out_size != M * D || ws_size < WS_END) { fprintf(stderr, "kernel_launch: unexpected shapes: n_in %d in0 %d out %d ws %zu (need %zu)\n", n_in, n_in > 0 ? in_sizes[0] : -1, out_size, ws_size, (size_t)WS_END); grid = -1; return; }
        int dev = 0, cus = 0, per_cu = 0;
        if (hipGetDevice(&dev) != hipSuccess || hipDeviceGetAttribute(&cus, hipDeviceAttributeMultiprocessorCount, dev) != hipSuccess) { grid = -1; return; }
        if (hipFuncSetAttribute((const void*)fwd, hipFuncAttributeMaxDynamicSharedMemorySize, LDS_BYTES) != hipSuccess) { fprintf(stderr, "kernel_launch: hipFuncSetAttribute failed\n"); grid = -1; return; }
        if (hipOccupancyMaxActiveBlocksPerMultiprocessor(&per_cu, (const void*)fwd, NTHR, LDS_BYTES) != hipSuccess || per_cu < 1) fprintf(stderr, "kernel_launch: occupancy query reports %d\n", per_cu);
        (void)hipGetLastError();
        grid = cus;
    }
    if (grid < 0) return;
    if (hipMemsetAsync((char*)d_ws + WS_CTL, 0, CTL_ZERO_BYTES, stream) != hipSuccess) return;
    Args a{};
    for (int i = 0; i < 34; ++i) a.in[i] = d_in[i];
    a.out = (float*)d_out; a.ws = (unsigned char*)d_ws; a.ph_lo = 0; a.ph_hi = TOTAL_PHASES;
    hipLaunchKernelGGL(fwd, dim3(grid), dim3(NTHR), LDS_BYTES, stream, a);
}
```

```cpp
#include <hip/hip_runtime.h>
#ifndef PROBE_DUP
#define PROBE_DUP 0
#endif
#include <cstdio>
#include <cstdint>

#define LAS __attribute__((address_space(3)))
#define GAS __attribute__((address_space(1)))
typedef unsigned short bf16_t;
typedef short bf16x8 __attribute__((ext_vector_type(8)));
typedef float f32x4 __attribute__((ext_vector_type(4)));
typedef float f32x2 __attribute__((ext_vector_type(2)));
typedef unsigned u32x4 __attribute__((ext_vector_type(4)));
typedef unsigned u32x2 __attribute__((ext_vector_type(2)));

constexpr int NB = 16, T = 4096, M = NB * T, D = 1024, PLE = 256, DEPTH = 2;
constexpr float DN_ALPHA = 1.41421356237f;
constexpr float LN_EPS = 1e-5f;
constexpr int EVN = 3096, EVP = 3328;
constexpr int RWC = 1792;
constexpr size_t WNSA8_OFF = (size_t)4 << 20;
constexpr int NEXP = 32, MOE_H = 512, MOE_BLK = 256, MOE_A = 2 * M, MOE_P = MOE_A + NEXP * MOE_BLK, MOE_TILES = MOE_P / 256;

constexpr size_t MiB = 1u << 20;
constexpr size_t WS_CTL = 0, CTL_ZERO_BYTES = 1 * MiB;
constexpr size_t WS_WEVIN = 1 * MiB, WS_WEVOUT = 8 * MiB, WS_WODIN = 10 * MiB, WS_WODOUT = 18 * MiB, WS_WGATE = 20 * MiB, WS_WPLE = 24 * MiB, WS_WLORA = 25 * MiB, WS_WCMP = 26 * MiB;
constexpr size_t WS_MISC = 27 * MiB;
constexpr size_t WS_WMOE13 = 33 * MiB, WS_WMOE2 = 97 * MiB, WS_PBF = 129 * MiB, WS_XB = 161 * MiB, WS_ARENA = 289 * MiB;
constexpr size_t A_H = WS_ARENA, A_HID = WS_ARENA + 128 * MiB, A_H8 = A_HID + 68 * MiB, A_XBUF = WS_ARENA + 264 * MiB, A_PP1 = WS_ARENA + 536 * MiB;
static_assert((size_t)MOE_P * MOE_H <= 68 * MiB && A_H8 + (size_t)M * D <= A_XBUF, "e4m3 buffers");
constexpr size_t A_UNUSED_ = 0;
constexpr size_t A_ACT = WS_ARENA + 416 * MiB, A_DEC = A_ACT + 32 * MiB, A_AA = A_DEC + 128 * MiB, A_GG = A_AA + 64 * MiB;
constexpr size_t A_SC4 = A_ACT;
constexpr size_t DOUT_QR = 160 * MiB, DOUT_SEG = 224 * MiB;
constexpr size_t A_HC2 = WS_ARENA + 704 * MiB, A_KVC2 = A_HC2 + 16 * MiB;
static_assert(A_KVC2 + 2 * MiB <= 1024 * MiB && A_GG + 64 * MiB <= A_HC2, "arena map");
static_assert(A_PP1 + 128 * MiB <= 1024 * MiB && A_PP1 >= WS_ARENA + 512 * MiB && A_XBUF + 272 * MiB <= A_PP1 && A_HID + 136 * MiB <= A_XBUF, "post-mixer arena map");
constexpr size_t WS_END = 1024 * MiB;
constexpr size_t WS_WRB = 29 * MiB;
constexpr size_t MISC_LBT = 31 * MiB;
constexpr size_t WS_TOKS = 30 * MiB;
constexpr size_t MISC_EID = WS_MISC, MISC_GATE = WS_MISC + 512 * 1024, MISC_SLOT = WS_MISC + 1024 * 1024, MISC_BCNT = WS_MISC + 1536 * 1024, MISC_TILEE = MISC_BCNT + 64 * 1024, MISC_CMPB = MISC_TILEE + 4096;
constexpr int CW_BAR = 4096;

constexpr int NWAVES = 8, NTHR = 512;
typedef __bf16 bf16x2_t __attribute__((ext_vector_type(2)));
__device__ __forceinline__ unsigned cvt_pk_bf16(float lo, float hi) { f32x2 v = {lo, hi}; return __builtin_bit_cast(unsigned, __builtin_convertvector(v, bf16x2_t)); }
__device__ __forceinline__ float bf2f(unsigned short b) { return __uint_as_float(((unsigned)b) << 16); }
__device__ __forceinline__ unsigned cvt_pk4_fp8(float a, float b, float c, float d) { int w = __builtin_amdgcn_cvt_pk_fp8_f32(a, b, 0, false); return (unsigned)__builtin_amdgcn_cvt_pk_fp8_f32(c, d, w, true); }
__device__ __forceinline__ float f8clamp(float x) { return __builtin_amdgcn_fmed3f(x, -448.0f, 448.0f); }
__device__ __forceinline__ unsigned cvt_pk4_fp8_sat(float a, float b, float c, float d) { return cvt_pk4_fp8(f8clamp(a), f8clamp(b), f8clamp(c), f8clamp(d)); }
__device__ __forceinline__ float bflo(unsigned w) { return __uint_as_float(w << 16); }
__device__ __forceinline__ float bfhi(unsigned w) { return __uint_as_float(w & 0xffff0000u); }
template <int CTRL, int RM> __device__ __forceinline__ float dpp_addx(float v) { return v + __builtin_bit_cast(float, __builtin_amdgcn_update_dpp(0, __builtin_bit_cast(int, v), CTRL, RM, 0xf, false)); }
__device__ __forceinline__ float wave_sum(float v) {
    v = dpp_addx<0xB1, 0xf>(v); v = dpp_addx<0x4E, 0xf>(v); v = dpp_addx<0x141, 0xf>(v); v = dpp_addx<0x140, 0xf>(v);
    v = dpp_addx<0x142, 0xa>(v); v = dpp_addx<0x143, 0xc>(v);
    return __builtin_bit_cast(float, __builtin_amdgcn_readlane(__builtin_bit_cast(int, v), 63));
}
__device__ __forceinline__ float sigmoidf_(float x) { return __builtin_amdgcn_rcpf(1.0f + __expf(-x)); }
__device__ __forceinline__ float siluf_(float x) { return x * __builtin_amdgcn_rcpf(1.0f + __expf(-x)); }
__device__ __forceinline__ int pinned_tid() { int t = threadIdx.x; asm volatile("" : "+v"(t)); return t; }
#define LDS_WAIT() asm volatile("s_waitcnt lgkmcnt(0)" ::: "memory")
#define VM_WAIT() asm volatile("s_waitcnt vmcnt(0)" ::: "memory")

namespace pg8 {
constexpr int BM = 256, BK = 64, HALF = 128, HTB = HALF * BK * 2, STAGE_BYTES = 8 * HTB, NXCD = 8, WGM = 8;
__host__ __device__ __forceinline__ int lds_byte(int r, int c) { const int st = (r >> 4) * 2 + (c >> 5), rr = r & 15, cc = c & 31, ob = rr * 64 + cc * 2; return st * 1024 + (ob ^ (((ob >> 9) & 1) << 5)); }
__host__ __device__ __forceinline__ void stage_rc(int b, int& R, int& C) { const int st = b / 1024, sb = b % 1024, swz = sb ^ (((sb >> 9) & 1) << 5); R = (st >> 1) * 16 + swz / 64; C = (st & 1) * 32 + (swz % 64) / 2; }
__host__ __device__ __forceinline__ int perm32(int rho) { const int n = rho >> 4, i = rho & 15; return 8 * (i >> 2) + 4 * n + (i & 3); }

struct Unit { int pm, pn, pb; };
struct Gemm { const bf16_t* A; const bf16_t* Bt; int lda, ldb, K; };

struct DenseOrder {
    int nM, nN, nwg, G, c, rpm;
    __device__ void init(int M_, int N_, int G_, int c_) { nM = M_ / BM; nN = N_ / BM; nwg = nM * nN; G = G_; c = c_; rpm = -1; }
    __device__ __forceinline__ bool next(int i, Unit& u) const {
        if (rpm >= 0) { if (i >= nN) return false; u.pm = rpm; u.pn = i; u.pb = i; return true; }
        const long L = (long)i * G + c; if (L >= nwg) return false;
        int wgid = (int)L; { const int q = nwg / NXCD, r = nwg % NXCD, xcd = wgid % NXCD, off = wgid / NXCD; wgid = (xcd < r ? xcd * (q + 1) : r * (q + 1) + (xcd - r) * q) + off; }
        const int nig = WGM * nN, gid = wgid / nig, fm = gid * WGM, gsz = (nM - fm) < WGM ? (nM - fm) : WGM;
        u.pm = fm + ((wgid % nig) % gsz); u.pn = (wgid % nig) / gsz; u.pb = u.pn; return true;
    }
};
struct MoeOrder {
    const int* tile_e; int ntiles, G, c;
    __device__ bool next(int i, Unit& u) const {
        if ((G & 7) == 0) {
            const int x = c & 7, r = c >> 3, w = G >> 3, k = i * w + r, q = k >> 2, t = q * 8 + x;
            if (t >= ntiles) return false;
            u.pm = t; u.pn = k & 3; u.pb = __builtin_amdgcn_readfirstlane(tile_e[t]) * 4 + u.pn; return true;
        }
        const long L = (long)i * G + c; if (L >= (long)ntiles * 4) return false;
        u.pm = (int)(L >> 2); u.pn = (int)(L & 3); u.pb = __builtin_amdgcn_readfirstlane(tile_e[u.pm]) * 4 + u.pn; return true;
    }
};

template <class Epi, class Sched>
__device__ __forceinline__ void gemm_phase(LAS unsigned char* lds, const Gemm g, const Sched& S, const Epi& E) {
    int tid_ = threadIdx.x; asm volatile("" : "+v"(tid_)); const int tid = tid_, wid = __builtin_amdgcn_readfirstlane(tid >> 6), lane = tid & 63, wr = wid >> 2, wc = wid & 3, fr = lane & 15, fq = lane >> 4;
    int K_ = g.K, lda_ = g.lda, ldb_ = g.ldb; asm volatile("" : "+s"(K_), "+s"(lda_), "+s"(ldb_)); const int K = K_, nt = K / BK;
    unsigned voffA[2], voffB[2];
#pragma unroll
    for (int i = 0; i < 2; ++i) { int R, C; stage_rc(tid * 16 + i * 8192, R, C); const int Rb = Epi::PERM ? ((R & ~31) + perm32(R & 31)) : R;
        voffA[i] = (unsigned)(R * lda_ + C) * 2u; voffB[i] = (unsigned)(Rb * ldb_ + C) * 2u; }
    const size_t kstep = (size_t)(BK * 2);
    const size_t hstepA = (size_t)HALF * lda_ * 2, hstepB = (size_t)HALF * ldb_ * 2;
    const size_t tstepA = 2 * hstepA, tstepB = 2 * hstepB;
    const unsigned ldsw = (unsigned)wid * 1024u;
    const int aoff = lds_byte(wr * 64 + fr, fq * 8), boff = lds_byte(wc * 32 + fr, fq * 8);
#define PG8_SA(b, h) (((b) * 2 + (h)) * HTB)
#define PG8_SB(b, h) ((4 + (b) * 2 + (h)) * HTB)
#define PG8_STAGE(bufoff, gbase, voff) do { _Pragma("unroll") for (int _i = 0; _i < 2; ++_i) \
        __builtin_amdgcn_global_load_lds((const unsigned*)((const char*)(gbase) + (voff)[_i]), (LAS unsigned*)(lds + (bufoff) + ldsw + _i * 8192), 16, 0, 0); } while (0)
#define PG8_LDA(dst, b, h) do { _Pragma("unroll") for (int m = 0; m < 4; ++m) _Pragma("unroll") for (int k = 0; k < 2; ++k) dst[m][k] = *(const LAS bf16x8*)(lds + PG8_SA(b, h) + aoff + m * 2048 + k * 1024); } while (0)
#define PG8_LDB(dst, b, h) do { _Pragma("unroll") for (int n = 0; n < 2; ++n) _Pragma("unroll") for (int k = 0; k < 2; ++k) dst[n][k] = *(const LAS bf16x8*)(lds + PG8_SB(b, h) + boff + n * 2048 + k * 1024); } while (0)
#define PG8_MMA(ai, bj, At, Bt) do { __builtin_amdgcn_s_setprio(1); _Pragma("unroll") for (int m = 0; m < 4; ++m) _Pragma("unroll") for (int n = 0; n < 2; ++n) _Pragma("unroll") for (int k = 0; k < 2; ++k) \
        acc[ai][bj][m][n] = __builtin_amdgcn_mfma_f32_16x16x32_bf16(Bt[n][k], At[m][k], acc[ai][bj][m][n], 0, 0, 0); __builtin_amdgcn_s_setprio(0); } while (0)
#define PG8_WAIT_V(n) asm volatile("s_waitcnt vmcnt(" #n ")" ::: "memory")
#define PG8_WAIT_L(n) asm volatile("s_waitcnt lgkmcnt(" #n ")" ::: "memory")
#define PG8_BAR __builtin_amdgcn_s_barrier()
#define PG8_SCHED __builtin_amdgcn_sched_barrier(0)
    Unit cur, nxt; int ui = 0;
    if (!S.next(0, cur)) return;
    f32x4 acc[2][2][4][2];
#pragma unroll
    for (int a = 0; a < 2; ++a)
#pragma unroll
        for (int b = 0; b < 2; ++b)
#pragma unroll
            for (int m = 0; m < 4; ++m)
#pragma unroll
                for (int n = 0; n < 2; ++n) acc[a][b][m][n] = (f32x4){0.f, 0.f, 0.f, 0.f};
    bf16x8 At[4][2], B0[2][2], B1[2][2];
    const char* cA = (const char*)g.A + (size_t)cur.pm * tstepA; const char* cB = (const char*)g.Bt + (size_t)cur.pb * tstepB;
    PG8_STAGE(PG8_SB(0, 0), cB, voffB); PG8_STAGE(PG8_SB(0, 1), cB + hstepB, voffB); PG8_STAGE(PG8_SA(0, 0), cA, voffA); PG8_STAGE(PG8_SA(0, 1), cA + hstepA, voffA);
    if (wr == 1) PG8_BAR;
    PG8_WAIT_V(2); PG8_BAR;
    PG8_STAGE(PG8_SB(1, 0), cB + kstep, voffB); PG8_STAGE(PG8_SA(1, 0), cA + kstep, voffA); PG8_STAGE(PG8_SB(1, 1), cB + hstepB + kstep, voffB);
    PG8_WAIT_V(6); PG8_BAR;
    for (;;) {
        const bool has_next = S.next(ui + 1, nxt);
        const char* nA = has_next ? (const char*)g.A + (size_t)nxt.pm * tstepA : cA; const char* nB = has_next ? (const char*)g.Bt + (size_t)nxt.pb * tstepB : cB;
#pragma nounroll
        for (int t = 0; t < nt; t += 2) {
            const bool last = (t == nt - 2);
            const char* a1 = cA + (size_t)(t + 1) * kstep;
            const char* a2 = last ? nA : cA + (size_t)(t + 2) * kstep; const char* b2 = last ? nB : cB + (size_t)(t + 2) * kstep;
            const char* a3 = a2 + kstep; const char* b3 = b2 + kstep;
            PG8_LDB(B0, 0, 0); PG8_LDB(B1, 0, 1); PG8_SCHED; PG8_LDA(At, 0, 0); PG8_STAGE(PG8_SA(1, 1), a1 + hstepA, voffA);
            PG8_WAIT_V(8); PG8_WAIT_L(0); PG8_BAR; PG8_MMA(0, 0, At, B0); PG8_MMA(0, 1, At, B1); PG8_BAR; PG8_SCHED;
            PG8_LDA(At, 0, 1); PG8_STAGE(PG8_SB(0, 0), b2, voffB); PG8_STAGE(PG8_SB(0, 1), b2 + hstepB, voffB); PG8_STAGE(PG8_SA(0, 0), a2, voffA);
            PG8_WAIT_V(8); PG8_WAIT_L(0); PG8_BAR; PG8_MMA(1, 0, At, B0); PG8_MMA(1, 1, At, B1); PG8_BAR; PG8_SCHED;
            PG8_LDB(B0, 1, 0); PG8_LDB(B1, 1, 1); PG8_SCHED; PG8_LDA(At, 1, 0); PG8_STAGE(PG8_SA(0, 1), a2 + hstepA, voffA);
            PG8_WAIT_V(8); PG8_WAIT_L(0); PG8_BAR; PG8_MMA(0, 0, At, B0); PG8_MMA(0, 1, At, B1); PG8_BAR; PG8_SCHED;
            PG8_LDA(At, 1, 1); PG8_STAGE(PG8_SB(1, 0), b3, voffB); PG8_STAGE(PG8_SB(1, 1), b3 + hstepB, voffB); PG8_STAGE(PG8_SA(1, 0), a3, voffA);
            PG8_WAIT_V(8); PG8_WAIT_L(0); PG8_BAR; PG8_MMA(1, 0, At, B0); PG8_MMA(1, 1, At, B1); PG8_BAR; PG8_SCHED;
        }
        if (wr == 0) PG8_BAR;
        E(acc, cur, wr, wc, fr, fq);
        if (!has_next) break;
#pragma unroll
        for (int a = 0; a < 2; ++a)
#pragma unroll
            for (int b = 0; b < 2; ++b)
#pragma unroll
                for (int m = 0; m < 4; ++m)
#pragma unroll
                    for (int n = 0; n < 2; ++n) acc[a][b][m][n] = (f32x4){0.f, 0.f, 0.f, 0.f};
        cur = nxt; cA = nA; cB = nB; ++ui;
        if (wr == 1) PG8_BAR;
    }
    PG8_WAIT_V(0);
    PG8_BAR;
#undef PG8_SA
#undef PG8_SB
#undef PG8_STAGE
#undef PG8_LDA
#undef PG8_LDB
#undef PG8_MMA
#undef PG8_WAIT_V
#undef PG8_WAIT_L
#undef PG8_BAR
#undef PG8_SCHED
}

template <class Epi, class Sched>
__device__ __forceinline__ void gemm_phase_gather(LAS unsigned char* lds, const Gemm g, const Sched& S, const Epi& E, const int* toks) {
    int tid_ = threadIdx.x; asm volatile("" : "+v"(tid_)); const int tid = tid_, wid = __builtin_amdgcn_readfirstlane(tid >> 6), lane = tid & 63, wr = wid >> 2, wc = wid & 3, fr = lane & 15, fq = lane >> 4;
    int K_ = g.K, lda_ = g.lda, ldb_ = g.ldb; asm volatile("" : "+s"(K_), "+s"(lda_), "+s"(ldb_)); const int K = K_, nt = K / BK;
    unsigned voffB[2]; int RA[2]; unsigned CA[2];
#pragma unroll
    for (int i = 0; i < 2; ++i) { int R, C; stage_rc(tid * 16 + i * 8192, R, C); const int Rb = Epi::PERM ? ((R & ~31) + perm32(R & 31)) : R;
        RA[i] = R; CA[i] = (unsigned)C * 2u; voffB[i] = (unsigned)(Rb * ldb_ + C) * 2u; }
    unsigned voC[2][2], voN[2][2];
#define PG8_GOFF(VO, U) do { _Pragma("unroll") for (int h_ = 0; h_ < 2; ++h_) _Pragma("unroll") for (int i_ = 0; i_ < 2; ++i_) VO[h_][i_] = (unsigned)(toks[(U).pm * BM + h_ * HALF + RA[i_]] & 0xffff) * (unsigned)(lda_ * 2) + CA[i_]; } while (0)
    const size_t kstep = (size_t)(BK * 2);
    const size_t hstepA = (size_t)HALF * lda_ * 2, hstepB = (size_t)HALF * ldb_ * 2;
    const size_t tstepA = 2 * hstepA, tstepB = 2 * hstepB;
    const unsigned ldsw = (unsigned)wid * 1024u;
    const int aoff = lds_byte(wr * 64 + fr, fq * 8), boff = lds_byte(wc * 32 + fr, fq * 8);
#define PG8_SA(b, h) (((b) * 2 + (h)) * HTB)
#define PG8_SB(b, h) ((4 + (b) * 2 + (h)) * HTB)
#define PG8_STAGE(bufoff, gbase, voff) do { _Pragma("unroll") for (int _i = 0; _i < 2; ++_i) \
        __builtin_amdgcn_global_load_lds((const unsigned*)((const char*)(gbase) + (voff)[_i]), (LAS unsigned*)(lds + (bufoff) + ldsw + _i * 8192), 16, 0, 0); } while (0)
#define PG8_LDA(dst, b, h) do { _Pragma("unroll") for (int m = 0; m < 4; ++m) _Pragma("unroll") for (int k = 0; k < 2; ++k) dst[m][k] = *(const LAS bf16x8*)(lds + PG8_SA(b, h) + aoff + m * 2048 + k * 1024); } while (0)
#define PG8_LDB(dst, b, h) do { _Pragma("unroll") for (int n = 0; n < 2; ++n) _Pragma("unroll") for (int k = 0; k < 2; ++k) dst[n][k] = *(const LAS bf16x8*)(lds + PG8_SB(b, h) + boff + n * 2048 + k * 1024); } while (0)
#define PG8_MMA(ai, bj, At, Bt) do { __builtin_amdgcn_s_setprio(1); _Pragma("unroll") for (int m = 0; m < 4; ++m) _Pragma("unroll") for (int n = 0; n < 2; ++n) _Pragma("unroll") for (int k = 0; k < 2; ++k) \
        acc[ai][bj][m][n] = __builtin_amdgcn_mfma_f32_16x16x32_bf16(Bt[n][k], At[m][k], acc[ai][bj][m][n], 0, 0, 0); __builtin_amdgcn_s_setprio(0); } while (0)
#define PG8_WAIT_V(n) asm volatile("s_waitcnt vmcnt(" #n ")" ::: "memory")
#define PG8_WAIT_L(n) asm volatile("s_waitcnt lgkmcnt(" #n ")" ::: "memory")
#define PG8_BAR __builtin_amdgcn_s_barrier()
#define PG8_SCHED __builtin_amdgcn_sched_barrier(0)
    Unit cur, nxt; int ui = 0;
    if (!S.next(0, cur)) return;
    f32x4 acc[2][2][4][2];
#pragma unroll
    for (int a = 0; a < 2; ++a)
#pragma unroll
        for (int b = 0; b < 2; ++b)
#pragma unroll
            for (int m = 0; m < 4; ++m)
#pragma unroll
                for (int n = 0; n < 2; ++n) acc[a][b][m][n] = (f32x4){0.f, 0.f, 0.f, 0.f};
    bf16x8 At[4][2], B0[2][2], B1[2][2];
    const char* const kA = (const char*)g.A; const char* cB = (const char*)g.Bt + (size_t)cur.pb * tstepB;
    PG8_GOFF(voC, cur);
    PG8_STAGE(PG8_SB(0, 0), cB, voffB); PG8_STAGE(PG8_SB(0, 1), cB + hstepB, voffB); PG8_STAGE(PG8_SA(0, 0), kA, voC[0]); PG8_STAGE(PG8_SA(0, 1), kA, voC[1]);
    if (wr == 1) PG8_BAR;
    PG8_WAIT_V(2); PG8_BAR;
    PG8_STAGE(PG8_SB(1, 0), cB + kstep, voffB); PG8_STAGE(PG8_SA(1, 0), kA + kstep, voC[0]); PG8_STAGE(PG8_SB(1, 1), cB + hstepB + kstep, voffB);
    PG8_WAIT_V(6); PG8_BAR;
    for (;;) {
        const bool has_next = S.next(ui + 1, nxt);
        const char* nB = has_next ? (const char*)g.Bt + (size_t)nxt.pb * tstepB : cB;
        if (has_next) PG8_GOFF(voN, nxt); else { _Pragma("unroll") for (int h_ = 0; h_ < 2; ++h_) _Pragma("unroll") for (int i_ = 0; i_ < 2; ++i_) voN[h_][i_] = voC[h_][i_]; }
#pragma nounroll
        for (int t = 0; t < nt; t += 2) {
            const bool last = (t == nt - 2);
            const char* a1 = kA + (size_t)(t + 1) * kstep;
            const char* a2 = last ? kA : kA + (size_t)(t + 2) * kstep; const char* b2 = last ? nB : cB + (size_t)(t + 2) * kstep;
            unsigned vo2[2][2];
#pragma unroll
            for (int h_ = 0; h_ < 2; ++h_)
#pragma unroll
                for (int i_ = 0; i_ < 2; ++i_) vo2[h_][i_] = last ? voN[h_][i_] : voC[h_][i_];
            const char* a3 = a2 + kstep; const char* b3 = b2 + kstep;
            PG8_LDB(B0, 0, 0); PG8_LDB(B1, 0, 1); PG8_SCHED; PG8_LDA(At, 0, 0); PG8_STAGE(PG8_SA(1, 1), a1, voC[1]);
            PG8_WAIT_V(8); PG8_WAIT_L(0); PG8_BAR; PG8_MMA(0, 0, At, B0); PG8_MMA(0, 1, At, B1); PG8_BAR; PG8_SCHED;
            PG8_LDA(At, 0, 1); PG8_STAGE(PG8_SB(0, 0), b2, voffB); PG8_STAGE(PG8_SB(0, 1), b2 + hstepB, voffB); PG8_STAGE(PG8_SA(0, 0), a2, vo2[0]);
            PG8_WAIT_V(8); PG8_WAIT_L(0); PG8_BAR; PG8_MMA(1, 0, At, B0); PG8_MMA(1, 1, At, B1); PG8_BAR; PG8_SCHED;
            PG8_LDB(B0, 1, 0); PG8_LDB(B1, 1, 1); PG8_SCHED; PG8_LDA(At, 1, 0); PG8_STAGE(PG8_SA(0, 1), a2, vo2[1]);
            PG8_WAIT_V(8); PG8_WAIT_L(0); PG8_BAR; PG8_MMA(0, 0, At, B0); PG8_MMA(0, 1, At, B1); PG8_BAR; PG8_SCHED;
            PG8_LDA(At, 1, 1); PG8_STAGE(PG8_SB(1, 0), b3, voffB); PG8_STAGE(PG8_SB(1, 1), b3 + hstepB, voffB); PG8_STAGE(PG8_SA(1, 0), a3, vo2[0]);
            PG8_WAIT_V(8); PG8_WAIT_L(0); PG8_BAR; PG8_MMA(1, 0, At, B0); PG8_MMA(1, 1, At, B1); PG8_BAR; PG8_SCHED;
        }
        if (wr == 0) PG8_BAR;
        E(acc, cur, wr, wc, fr, fq);
        if (!has_next) break;
#pragma unroll
        for (int a = 0; a < 2; ++a)
#pragma unroll
            for (int b = 0; b < 2; ++b)
#pragma unroll
                for (int m = 0; m < 4; ++m)
#pragma unroll
                    for (int n = 0; n < 2; ++n) acc[a][b][m][n] = (f32x4){0.f, 0.f, 0.f, 0.f};
        cur = nxt; cB = nB; ++ui;
#pragma unroll
        for (int h_ = 0; h_ < 2; ++h_)
#pragma unroll
            for (int i_ = 0; i_ < 2; ++i_) voC[h_][i_] = voN[h_][i_];
        if (wr == 1) PG8_BAR;
    }
    PG8_WAIT_V(0);
    PG8_BAR;
#undef PG8_GOFF
#undef PG8_SA
#undef PG8_SB
#undef PG8_STAGE
#undef PG8_LDA
#undef PG8_LDB
#undef PG8_MMA
#undef PG8_WAIT_V
#undef PG8_WAIT_L
#undef PG8_BAR
#undef PG8_SCHED
}


template <bool NT> struct EpiBf16T {
    static constexpr bool PERM = true;
    bf16_t* O; int ldc; unsigned silu_mask; unsigned fg_mask; const float* lbt;
    __device__ __forceinline__ void operator()(const f32x4 (&acc)[2][2][4][2], const Unit& u, int wr, int wc, int fr, int fq) const {
        const int row0 = u.pm * BM + wr * 64 + fr, col0 = u.pn * BM + wc * 32 + 8 * fq;
        const bool act = (silu_mask >> u.pn) & 1u, fgm = (fg_mask >> u.pn) & 1u;
#pragma unroll
        for (int bj = 0; bj < 2; ++bj) {
            f32x4 l0 = (f32x4){0.f, 0.f, 0.f, 0.f}, l1 = l0;
            if (fgm) { const int cc = (col0 & 1023) + bj * HALF; l0 = *(const f32x4*)(lbt + cc); l1 = *(const f32x4*)(lbt + cc + 4); }
#pragma unroll
            for (int ai = 0; ai < 2; ++ai)
#pragma unroll
                for (int m = 0; m < 4; ++m) { bf16_t* rowp = O + (size_t)(row0 + ai * HALF + m * 16) * ldc + col0;
                    f32x4 v0 = acc[ai][bj][m][0], v1 = acc[ai][bj][m][1];
                    if (act) {
#pragma unroll
                        for (int j = 0; j < 4; ++j) { v0[j] = siluf_(v0[j]); v1[j] = siluf_(v1[j]); } }
                    if (fgm) {
#pragma unroll
                        for (int j = 0; j < 4; ++j) { v0[j] = l0[j] + (1.0f - l0[j]) * sigmoidf_(v0[j]); v1[j] = l1[j] + (1.0f - l1[j]) * sigmoidf_(v1[j]); } }
                    u32x4 w; w.x = cvt_pk_bf16(v0[0], v0[1]); w.y = cvt_pk_bf16(v0[2], v0[3]); w.z = cvt_pk_bf16(v1[0], v1[1]); w.w = cvt_pk_bf16(v1[2], v1[3]);
                    if (NT) __builtin_nontemporal_store(w, (u32x4*)(rowp + bj * HALF)); else *(u32x4*)(rowp + bj * HALF) = w; }
        }
    }
};
using EpiBf16 = EpiBf16T<false>; using EpiBf16NT = EpiBf16T<true>;
struct EpiGate {
    static constexpr bool PERM = true;
    const bf16_t* h2; const bf16_t* pp; float* xout; bf16_t* xb;
    __device__ __forceinline__ void operator()(const f32x4 (&acc)[2][2][4][2], const Unit& u, int wr, int wc, int fr, int fq) const {
        const int row0 = u.pm * BM + wr * 64 + fr, col0 = u.pn * BM + wc * 32 + 8 * fq;
#pragma unroll
        for (int ai = 0; ai < 2; ++ai)
#pragma unroll
            for (int m = 0; m < 4; ++m) { const size_t off = (size_t)(row0 + ai * HALF + m * 16) * D + col0;
#pragma unroll
                for (int bj = 0; bj < 2; ++bj) { const size_t o = off + bj * HALF;
                    const u32x4 hw = *(const u32x4*)(h2 + o), pw = *(const u32x4*)(pp + o); const f32x4 a0 = acc[ai][bj][m][0], a1 = acc[ai][bj][m][1];
                    f32x4 r0, r1;
                    r0[0] = bflo(hw.x) + sigmoidf_(a0[0]) * bflo(pw.x); r0[1] = bfhi(hw.x) + sigmoidf_(a0[1]) * bfhi(pw.x); r0[2] = bflo(hw.y) + sigmoidf_(a0[2]) * bflo(pw.y); r0[3] = bfhi(hw.y) + sigmoidf_(a0[3]) * bfhi(pw.y);
                    r1[0] = bflo(hw.z) + sigmoidf_(a1[0]) * bflo(pw.z); r1[1] = bfhi(hw.z) + sigmoidf_(a1[1]) * bfhi(pw.z); r1[2] = bflo(hw.w) + sigmoidf_(a1[2]) * bflo(pw.w); r1[3] = bfhi(hw.w) + sigmoidf_(a1[3]) * bfhi(pw.w);
                    if (xout) { __builtin_nontemporal_store(r0, (f32x4*)(xout + o)); __builtin_nontemporal_store(r1, (f32x4*)(xout + o + 4)); }
                    else *(u32x4*)(xb + o) = (u32x4){cvt_pk_bf16(r0[0], r0[1]), cvt_pk_bf16(r0[2], r0[3]), cvt_pk_bf16(r1[0], r1[1]), cvt_pk_bf16(r1[2], r1[3])}; }
                asm volatile("" ::: "memory"); }
    }
};
struct EpiPre {
    static constexpr bool PERM = true;
    const float* xf; const bf16_t* xh; bf16_t* pre;
    __device__ __forceinline__ void operator()(const f32x4 (&acc)[2][2][4][2], const Unit& u, int wr, int wc, int fr, int fq) const {
        const int row0 = u.pm * BM + wr * 64 + fr, col0 = u.pn * BM + wc * 32 + 8 * fq;
#pragma unroll
        for (int ai = 0; ai < 2; ++ai)
#pragma unroll
            for (int m = 0; m < 4; ++m) { const size_t off = (size_t)(row0 + ai * HALF + m * 16) * D + col0;
#pragma unroll
                for (int bj = 0; bj < 2; ++bj) { const size_t o = off + bj * HALF; f32x4 x0, x1;
                    if (xf) { x0 = *(const f32x4*)(xf + o); x1 = *(const f32x4*)(xf + o + 4); }
                    else { const u32x4 w = *(const u32x4*)(xh + o); x0 = (f32x4){bflo(w.x), bfhi(w.x), bflo(w.y), bfhi(w.y)}; x1 = (f32x4){bflo(w.z), bfhi(w.z), bflo(w.w), bfhi(w.w)}; }
                    const f32x4 r0 = x0 * DN_ALPHA + acc[ai][bj][m][0], r1 = x1 * DN_ALPHA + acc[ai][bj][m][1];
                    *(u32x4*)(pre + o) = (u32x4){cvt_pk_bf16(r0[0], r0[1]), cvt_pk_bf16(r0[2], r0[3]), cvt_pk_bf16(r1[0], r1[1]), cvt_pk_bf16(r1[2], r1[3])}; }
                asm volatile("" ::: "memory"); }
    }
};
struct EpiMoe1 {
    static constexpr bool PERM = true;
    bf16_t* hid;
    __device__ __forceinline__ void operator()(const f32x4 (&acc)[2][2][4][2], const Unit& u, int wr, int wc, int fr, int fq) const {
        const int row0 = u.pm * BM + wr * 64 + fr, col0 = u.pn * HALF + wc * 32 + 8 * fq;
#pragma unroll
        for (int ai = 0; ai < 2; ++ai)
#pragma unroll
            for (int m = 0; m < 4; ++m) { bf16_t* rowp = hid + (size_t)(row0 + ai * HALF + m * 16) * MOE_H + col0;
                f32x4 v0, v1;
#pragma unroll
                for (int j = 0; j < 4; ++j) { v0[j] = siluf_(acc[ai][0][m][0][j]) * acc[ai][1][m][0][j]; v1[j] = siluf_(acc[ai][0][m][1][j]) * acc[ai][1][m][1][j]; }
                u32x4 w; w.x = cvt_pk_bf16(v0[0], v0[1]); w.y = cvt_pk_bf16(v0[2], v0[3]); w.z = cvt_pk_bf16(v1[0], v1[1]); w.w = cvt_pk_bf16(v1[2], v1[3]);
                *(u32x4*)rowp = w; }
    }
};
struct EpiLora {
    static constexpr bool PERM = true;
    const float* w0; const float* a0; bf16_t* dec; bf16_t* aa; bf16_t* gg;
    __device__ __forceinline__ void operator()(const f32x4 (&acc)[2][2][4][2], const Unit& u, int wr, int wc, int fr, int fq) const {
        const int row0 = u.pm * BM + wr * 64 + fr, seg = u.pn >> 1, c0 = (u.pn & 1) * BM + wc * 32 + 8 * fq;
#pragma unroll
        for (int bj = 0; bj < 2; ++bj) {
            const int c = c0 + bj * HALF;
            f32x4 b0 = (f32x4){0.f, 0.f, 0.f, 0.f}, b1 = b0;
            if (seg == 0) { b0 = *(const f32x4*)(w0 + c); b1 = *(const f32x4*)(w0 + c + 4); } else if (seg == 1) { b0 = *(const f32x4*)(a0 + c); b1 = *(const f32x4*)(a0 + c + 4); }
#pragma unroll
            for (int ai = 0; ai < 2; ++ai)
#pragma unroll
                for (int m = 0; m < 4; ++m) { const size_t o = (size_t)(row0 + ai * HALF + m * 16) * 512 + c;
                    f32x4 v0 = acc[ai][bj][m][0] + b0, v1 = acc[ai][bj][m][1] + b1;
                    if (seg == 0) {
#pragma unroll
                        for (int j = 0; j < 4; ++j) { v0[j] = 1.0f - __expf(-0.60653066f * sigmoidf_(v0[j])); v1[j] = 1.0f - __expf(-0.60653066f * sigmoidf_(v1[j])); }
                        __builtin_nontemporal_store((u32x4){cvt_pk_bf16(v0[0], v0[1]), cvt_pk_bf16(v0[2], v0[3]), cvt_pk_bf16(v1[0], v1[1]), cvt_pk_bf16(v1[2], v1[3])}, (u32x4*)(dec + o));
                    } else {
                        if (seg == 1) {
#pragma unroll
                            for (int j = 0; j < 4; ++j) { v0[j] = sigmoidf_(v0[j]); v1[j] = sigmoidf_(v1[j]); } }
                        u32x4 w; w.x = cvt_pk_bf16(v0[0], v0[1]); w.y = cvt_pk_bf16(v0[2], v0[3]); w.z = cvt_pk_bf16(v1[0], v1[1]); w.w = cvt_pk_bf16(v1[2], v1[3]);
                        if (seg == 1) __builtin_nontemporal_store(w, (u32x4*)(aa + o)); else __builtin_nontemporal_store(w, (u32x4*)(gg + o));
                    } }
        }
    }
};
struct EpiF32 {
    static constexpr bool PERM = false;
    float* C; int ldc;
    __device__ __forceinline__ void operator()(const f32x4 (&acc)[2][2][4][2], const Unit& u, int wr, int wc, int fr, int fq) const {
        const int row0 = u.pm * BM + wr * 64 + fr, col0 = u.pn * BM + wc * 32 + 4 * fq;
#pragma unroll
        for (int ai = 0; ai < 2; ++ai)
#pragma unroll
            for (int m = 0; m < 4; ++m) { float* rowp = C + (size_t)(row0 + ai * HALF + m * 16) * ldc + col0;
#pragma unroll
                for (int bj = 0; bj < 2; ++bj)
#pragma unroll
                    for (int n = 0; n < 2; ++n) *(f32x4*)(rowp + bj * HALF + n * 16) = acc[ai][bj][m][n]; }
    }
};
struct CmpOrder {
    int G, c;
    __device__ bool next(int i, Unit& u) const { const int L = i * G + c; if (L >= 64) return false; u.pm = L; u.pn = 0; u.pb = L >> 5; return true; }
};
struct EpiLogit {
    static constexpr bool PERM = false;
    float* LG;
    __device__ __forceinline__ void operator()(const f32x4 (&acc)[2][2][4][2], const Unit& u, int wr, int wc, int fr, int fq) const {
        if (wc >= 2) return;
        const int row0 = u.pm * BM + wr * 64 + fr, col0 = wc * 32 + 4 * fq;
#pragma unroll
        for (int ai = 0; ai < 2; ++ai)
#pragma unroll
            for (int m = 0; m < 4; ++m) { float* rowp = LG + (size_t)(row0 + ai * HALF + m * 16) * 64 + col0;
#pragma unroll
                for (int n = 0; n < 2; ++n) *(f32x4*)(rowp + n * 16) = acc[ai][0][m][n]; }
    }
};

typedef int i32x8 __attribute__((ext_vector_type(8)));
typedef int i32x4_ __attribute__((ext_vector_type(4)));
__device__ __forceinline__ i32x8 f8cat(const bf16x8& a, const bf16x8& b) { return __builtin_shufflevector(__builtin_bit_cast(i32x4_, a), __builtin_bit_cast(i32x4_, b), 0, 1, 2, 3, 4, 5, 6, 7); }
constexpr float Y8_SCALE = 16.0f;
constexpr int RWC_ = 1792;
template <int MODE>
__device__ __forceinline__ void gemm_f8_phase(LAS unsigned char* lds, const unsigned char* A8, const unsigned char* B8, int Kb, const MoeOrder& S, const int* toks, unsigned char* hid8, unsigned char* Y, bf16_t* Zo = nullptr) {
    int tid_ = threadIdx.x; asm volatile("" : "+v"(tid_)); const int tid = tid_, wid = __builtin_amdgcn_readfirstlane(tid >> 6), lane = tid & 63, wr = wid >> 2, wc = wid & 3, fr = lane & 15, fq = lane >> 4;
    int Kb_ = Kb; asm volatile("" : "+s"(Kb_)); const int nt = Kb_ >> 7;
    constexpr int BUFB = 49152, EST = (MODE == 0 ? 4 : 8), NRN = (MODE == 0 ? 4 : 0);
    int RA0; unsigned CA0, voffB0;
    { int R, C; stage_rc(tid * 16, R, C); RA0 = R; CA0 = (unsigned)C * 2u; voffB0 = (unsigned)tid * 16u; }
    const size_t r64 = 8192;
    const unsigned ldsw = (unsigned)wid * 1024u;
    const int aoff = lds_byte(wr * 64 + fr, fq * 8), boff = lds_byte(wc * 32 + fr, fq * 8);
    const size_t hstepB = 16384, tstepB = (size_t)nt * 32768;
#define F8_ROWS(RO, U) do { _Pragma("unroll") for (int h_ = 0; h_ < 2; ++h_) _Pragma("unroll") for (int i_ = 0; i_ < 2; ++i_) { const int r_ = (U).pm * BM + h_ * HALF + RA0 + 64 * i_; \
        RO[h_][i_] = MODE == 2 ? (unsigned)(((U).pm * 2 + h_) * nt) * 16384u + (unsigned)(i_ * 8192 + tid * 16) : (unsigned)(MODE == 0 ? (toks[r_] & 0xffff) : r_) * (unsigned)Kb_ + CA0; } } while (0)
#define F8_DMA(dst, base, voff) __builtin_amdgcn_global_load_lds((const unsigned*)((const char*)(base) + (voff)), (LAS unsigned*)(lds + (dst)), 16, 0, 0)
#define F8_STAGE(U, RO, q, sb) do { const int h_ = (q) >= nt ? 1 : 0; const size_t ko_ = (size_t)((q) - h_ * nt) * 128; const char* bb_ = (const char*)B8 + (size_t)(U).pb * tstepB + ko_ * 256; const unsigned d_ = (unsigned)(sb) * BUFB + ldsw; \
        _Pragma("unroll") for (int i_ = 0; i_ < 2; ++i_) { F8_DMA(d_ + i_ * 8192, (const char*)A8 + (MODE == 2 ? ko_ * 128 : ko_), RO[h_][i_]); F8_DMA(d_ + 16384 + i_ * 8192, bb_ + i_ * r64, voffB0); F8_DMA(d_ + 32768 + i_ * 8192, bb_ + hstepB + i_ * r64, voffB0); } } while (0)
#define F8_WAIT(n) asm volatile("s_waitcnt vmcnt(" #n ")" ::: "memory")
    constexpr int ULIST = 3 * BUFB, UCAP = 512;
    { i32x4_ e = (i32x4_){0, 0, 0, 0}; const int i = tid;
      if (MODE == 2) {
          if ((S.G & 7) == 0) { const int x = S.c & 7, r = S.c >> 3, w = S.G >> 3, k = i * w + r, q = k / 6, t = q * 8 + x; if (t < S.ntiles) e = (i32x4_){t, k % 6, k % 6, 1}; }
          else { const long L = (long)i * S.G + S.c; if (L < (long)S.ntiles * 6) e = (i32x4_){(int)(L / 6), (int)(L % 6), (int)(L % 6), 1}; } }
      else if ((S.G & 7) == 0) { const int x = S.c & 7, r = S.c >> 3, w = S.G >> 3, k = i * w + r, q = k >> 2, t = q * 8 + x; if (t < S.ntiles) e = (i32x4_){t, k & 3, S.tile_e[t] * 4 + (k & 3), 1}; }
      else { const long L = (long)i * S.G + S.c; if (L < (long)S.ntiles * 4) e = (i32x4_){(int)(L >> 2), (int)(L & 3), S.tile_e[(int)(L >> 2)] * 4 + (int)(L & 3), 1}; }
      if (i < UCAP) *(LAS i32x4_*)(lds + ULIST + i * 16) = e; }
    __syncthreads();
#define F8_UNIT(k, U, ok) do { i32x4_ e_ = (i32x4_){0, 0, 0, 0}; if ((k) < UCAP) e_ = *(const LAS i32x4_*)(lds + ULIST + (k) * 16); (U).pm = __builtin_amdgcn_readfirstlane(e_.x); (U).pn = __builtin_amdgcn_readfirstlane(e_.y); \
        (U).pb = __builtin_amdgcn_readfirstlane(e_.z); ok = __builtin_amdgcn_readfirstlane(e_.w) != 0; } while (0)
    Unit cur, nxt; int ui = 0; bool ok0;
    F8_UNIT(0, cur, ok0);
    if (!ok0) return;
    unsigned ro[2][2], rn[2][2];
    F8_ROWS(ro, cur);
    F8_STAGE(cur, ro, 0, 0); F8_STAGE(cur, ro, 1, 1);
    f32x4 acc[2][4][2];
#pragma unroll
    for (int b = 0; b < 2; ++b)
#pragma unroll
        for (int m = 0; m < 4; ++m)
#pragma unroll
            for (int n = 0; n < 2; ++n) acc[b][m][n] = (f32x4){0.f, 0.f, 0.f, 0.f};
    F8_STAGE(cur, ro, 2, 2);
    bf16x8 AtX[4][2], B0X[2][2], B1X[2][2], AtY[4][2], B0Y[2][2], B1Y[2][2];
#define F8_READ_B(B0, B1, slot) do { const LAS unsigned char* tb_ = lds + (slot) * BUFB; \
        _Pragma("unroll") for (int n = 0; n < 2; ++n) _Pragma("unroll") for (int k = 0; k < 2; ++k) { B0[n][k] = *(const LAS bf16x8*)(tb_ + 16384 + boff + n * 2048 + k * 1024); B1[n][k] = *(const LAS bf16x8*)(tb_ + 32768 + boff + n * 2048 + k * 1024); } } while (0)
#define F8_READ_A(At, slot) do { const LAS unsigned char* tb_ = lds + (slot) * BUFB; \
        _Pragma("unroll") for (int m = 0; m < 4; ++m) _Pragma("unroll") for (int k = 0; k < 2; ++k) At[m][k] = *(const LAS bf16x8*)(tb_ + aoff + m * 2048 + k * 1024); } while (0)
#define F8_READ(At, B0, B1, slot) do { F8_READ_B(B0, B1, slot); F8_READ_A(At, slot); } while (0)
#define F8_MMA(At, B0, B1, M0, M1) do { __builtin_amdgcn_s_setprio(1); _Pragma("unroll") for (int m = M0; m < M1; ++m) _Pragma("unroll") for (int n = 0; n < 2; ++n) { \
        acc[0][m][n] = __builtin_amdgcn_mfma_scale_f32_16x16x128_f8f6f4(f8cat(B0[n][0], B0[n][1]), f8cat(At[m][0], At[m][1]), acc[0][m][n], 0, 0, 0, 0, 0, 0); \
        acc[1][m][n] = __builtin_amdgcn_mfma_scale_f32_16x16x128_f8f6f4(f8cat(B1[n][0], B1[n][1]), f8cat(At[m][0], At[m][1]), acc[1][m][n], 0, 0, 0, 0, 0, 0); } __builtin_amdgcn_s_setprio(0); } while (0)
#define F8_STEP(g, AtC, B0C, B1C, AtL, B0L, B1L) do { \
        const bool ex1_ = ((g) + 1 < 2 * nt) || has_next, ex2_ = ((g) + 2 < 2 * nt) || has_next; \
        if (ex1_) { if (!ex2_) F8_WAIT(0); \
            else if (after_epi && unit_start) { if (EST == 4) F8_WAIT(14); else F8_WAIT(18); } \
            else if (after_epi) { if (EST == 4) F8_WAIT(10); else F8_WAIT(14); } \
            else if (unit_start) F8_WAIT(10); \
            else F8_WAIT(6); } \
        after_epi = false; unit_start = false; \
        asm volatile("s_waitcnt lgkmcnt(0)" ::: "memory"); \
          \
        asm volatile("" : "+v"(AtC[0][0]), "+v"(AtC[0][1]), "+v"(AtC[1][0]), "+v"(AtC[1][1]), "+v"(AtC[2][0]), "+v"(AtC[2][1]), "+v"(AtC[3][0]), "+v"(AtC[3][1])); \
        asm volatile("" : "+v"(B0C[0][0]), "+v"(B0C[0][1]), "+v"(B0C[1][0]), "+v"(B0C[1][1]), "+v"(B1C[0][0]), "+v"(B1C[0][1]), "+v"(B1C[1][0]), "+v"(B1C[1][1])); \
        __builtin_amdgcn_s_barrier(); \
        if ((g) == 1) { asm volatile("" : "+v"(rn[0][0]), "+v"(rn[0][1]), "+v"(rn[1][0]), "+v"(rn[1][1])); \
            _Pragma("unroll") for (int h_ = 0; h_ < 2; ++h_) _Pragma("unroll") for (int i_ = 0; i_ < 2; ++i_) \
                rn[h_][i_] = MODE == 2 ? (unsigned)(((has_next ? nxt.pm : cur.pm) * 2 + h_) * nt) * 16384u + (unsigned)(i_ * 8192 + tid * 16) : (unsigned)(MODE == 0 ? (int)(rn[h_][i_] & 0xffffu) : (has_next ? nxt.pm : cur.pm) * BM + h_ * HALF + RA0 + 64 * i_) * (unsigned)Kb_ + CA0; } \
          \
          \
        const bool sc_ = (g) + 3 < 2 * nt, sy_ = sc_ || has_next; const int sq_ = sc_ ? (g) + 3 : (g) + 3 - 2 * nt, sh_ = sq_ >= nt ? 1 : 0; const size_t sk_ = (size_t)(sq_ - sh_ * nt) * 128; \
        const char* sbb_ = (const char*)B8 + (size_t)(sc_ ? cur.pb : nxt.pb) * tstepB + sk_ * 256; const unsigned sd_ = (unsigned)buf * BUFB + ldsw; \
        const unsigned sr0_ = sc_ ? ro[sh_][0] : rn[sh_][0], sr1_ = sc_ ? ro[sh_][1] : rn[sh_][1]; \
        buf = buf == 2 ? 0 : buf + 1; \
        __builtin_amdgcn_sched_barrier(0); \
        if (sy_) F8_DMA(sd_, (const char*)A8 + (MODE == 2 ? sk_ * 128 : sk_), sr0_); \
        __builtin_amdgcn_sched_barrier(0); F8_MMA(AtC, B0C, B1C, 0, 1); __builtin_amdgcn_sched_barrier(0); \
        F8_READ_B(B0L, B1L, buf); if (sy_) { F8_DMA(sd_ + 16384, sbb_, voffB0); F8_DMA(sd_ + 32768, sbb_ + hstepB, voffB0); } \
        __builtin_amdgcn_sched_barrier(0); F8_MMA(AtC, B0C, B1C, 1, 2); __builtin_amdgcn_sched_barrier(0); \
        if (sy_) F8_DMA(sd_ + 8192, (const char*)A8 + (MODE == 2 ? sk_ * 128 : sk_), sr1_); F8_READ_A(AtL, buf); \
        __builtin_amdgcn_sched_barrier(0); F8_MMA(AtC, B0C, B1C, 2, 3); __builtin_amdgcn_sched_barrier(0); \
        if (sy_) { F8_DMA(sd_ + 16384 + 8192, sbb_ + r64, voffB0); F8_DMA(sd_ + 32768 + 8192, sbb_ + hstepB + r64, voffB0); } \
        __builtin_amdgcn_sched_barrier(0); F8_MMA(AtC, B0C, B1C, 3, 4); } while (0)
    int buf = 0; bool after_epi = false, first = true;
    for (;;) {
        bool has_next; F8_UNIT(ui + 1, nxt, has_next);
#pragma unroll
        for (int h_ = 0; h_ < 2; ++h_)
#pragma unroll
            for (int i_ = 0; i_ < 2; ++i_) {
                if (MODE == 0) { const int* p_ = toks + (has_next ? nxt.pm : cur.pm) * BM + h_ * HALF + RA0 + 64 * i_; asm volatile("global_load_dword %0, %1, off" : "=v"(rn[h_][i_]) : "v"(p_) : "memory"); } }
        bool unit_start = !first && NRN != 0;
        if (first) { F8_WAIT(0); __builtin_amdgcn_s_barrier(); F8_READ(AtX, B0X, B1X, 0); }
        first = false;
#pragma nounroll
        for (int g = 0; g < 2 * nt; g += 2) {
            F8_STEP(g, AtX, B0X, B1X, AtY, B0Y, B1Y);
            F8_STEP(g + 1, AtY, B0Y, B1Y, AtX, B0X, B1X);
            if (g + 1 == nt - 1 || g + 1 == 2 * nt - 1) {
                const int ai = g + 1 >= nt ? 1 : 0, row0 = cur.pm * BM + ai * HALF + wr * 64 + fr;
                if (MODE == 0) { const int col0 = cur.pn * HALF + wc * 32 + 8 * fq;
#pragma unroll
                    for (int m = 0; m < 4; ++m) { f32x4 v0, v1;
#pragma unroll
                        for (int j = 0; j < 4; ++j) { v0[j] = siluf_(acc[0][m][0][j]) * acc[1][m][0][j]; v1[j] = siluf_(acc[0][m][1][j]) * acc[1][m][1][j]; }
                        *(u32x2*)(hid8 + (size_t)(row0 + m * 16) * MOE_H + col0) = (u32x2){cvt_pk4_fp8_sat(v0[0], v0[1], v0[2], v0[3]), cvt_pk4_fp8_sat(v1[0], v1[1], v1[2], v1[3])}; }
                } else if (MODE == 2) { const int col0 = RWC_ + cur.pn * BM + wc * 32 + 8 * fq;
#pragma unroll
                    for (int b = 0; b < 2; ++b)
#pragma unroll
                        for (int m = 0; m < 4; ++m) { const f32x4 v0 = acc[b][m][0], v1 = acc[b][m][1];
                            __builtin_nontemporal_store((u32x4){cvt_pk_bf16(v0[0], v0[1]), cvt_pk_bf16(v0[2], v0[3]), cvt_pk_bf16(v1[0], v1[1]), cvt_pk_bf16(v1[2], v1[3])}, (u32x4*)(Zo + (size_t)(row0 + m * 16) * 3328 + col0 + b * HALF)); }
                } else { const int col0 = cur.pn * BM + wc * 32 + 8 * fq;
#pragma unroll
                    for (int b = 0; b < 2; ++b)
#pragma unroll
                        for (int m = 0; m < 4; ++m) { const f32x4 v0 = acc[b][m][0] * Y8_SCALE, v1 = acc[b][m][1] * Y8_SCALE;
                            *(u32x2*)(Y + (size_t)(row0 + m * 16) * D + col0 + b * HALF) = (u32x2){cvt_pk4_fp8_sat(v0[0], v0[1], v0[2], v0[3]), cvt_pk4_fp8_sat(v1[0], v1[1], v1[2], v1[3])}; }
                }
#pragma unroll
                for (int b = 0; b < 2; ++b)
#pragma unroll
                    for (int m = 0; m < 4; ++m)
#pragma unroll
                        for (int n = 0; n < 2; ++n) acc[b][m][n] = (f32x4){0.f, 0.f, 0.f, 0.f};
                after_epi = true;
            }
        }
        if (!has_next) break;
        cur = nxt; ++ui;
#pragma unroll
        for (int h_ = 0; h_ < 2; ++h_)
#pragma unroll
            for (int i_ = 0; i_ < 2; ++i_) ro[h_][i_] = rn[h_][i_];
    }
#undef F8_READ
#undef F8_MMA
#undef F8_STEP
    F8_WAIT(0);
    __builtin_amdgcn_s_barrier();
#undef F8_ROWS
#undef F8_UNIT
#undef F8_DMA
#undef F8_STAGE
#undef F8_WAIT
}
}

#define XB_TMO      128
#define XB_XCNT(j)  (256  + 64 * (j))
#define XB_XSUB(j)  (1280 + 64 * (j))
#define XB_XGEN(j)  (2304 + 64 * (j))
#define XB_TOP      3328
#define XB_TOPGEN   3392
#define XCD_BAR_WORDS 3456
#define XB_SPIN_CAP (1u << 18)
__device__ __forceinline__ unsigned xb_ld(unsigned* p)              { return __hip_atomic_load(p, __ATOMIC_RELAXED, __HIP_MEMORY_SCOPE_AGENT); }
__device__ __forceinline__ unsigned xb_add(unsigned* p, unsigned v) { return __hip_atomic_fetch_add(p, v, __ATOMIC_RELAXED, __HIP_MEMORY_SCOPE_AGENT); }
__device__ __forceinline__ unsigned xb_xcc_id() { return (unsigned)__builtin_amdgcn_s_getreg((3 << 11) | 20) & 0xFu; }
#define XB_SPIN(cond, bar) do { unsigned _sp = 0; while (cond) { __builtin_amdgcn_s_sleep(1); \
    if ((++_sp & 255u) == 0u) { if (xb_ld(&(bar)[XB_TMO])) break; if (_sp > XB_SPIN_CAP) { atomicAdd(&(bar)[XB_TMO], 1u); break; } } } } while (0)
struct XcdBarrier { unsigned* bar; unsigned x; volatile LAS unsigned* st; };
__device__ __forceinline__ XcdBarrier xcd_barrier_post(unsigned* bar, volatile LAS unsigned* st) {
    XcdBarrier b; b.bar = bar; b.x = xb_xcc_id(); b.st = st;
    if (threadIdx.x == 0) (void)xb_add(&bar[XB_XCNT(b.x)], 1u);
    return b;
}
__device__ __forceinline__ void xcd_barrier_complete(unsigned* bar, unsigned x, unsigned& nloc, unsigned& nx) {
    const unsigned G = gridDim.x * gridDim.y * gridDim.z;
    unsigned sum, cnt, mine, sp = 0u;
    for (;;) {
        sum = 0u; cnt = 0u; mine = 0u;
#pragma unroll
        for (unsigned j = 0; j < 16; ++j) { const unsigned c = xb_ld(&bar[XB_XCNT(j)]); sum += c; cnt += (c > 0u) ? 1u : 0u; mine = (j == x) ? c : mine; }
        if (sum == G) break;
        __builtin_amdgcn_s_sleep(1);
        if ((++sp & 255u) == 0u) { if (xb_ld(&bar[XB_TMO])) break; if (sp > XB_SPIN_CAP) { atomicAdd(&bar[XB_TMO], 1u); break; } }
    }
    nloc = mine > 0u ? mine : 1u; nx = cnt > 0u ? cnt : 1u;
}
__device__ __forceinline__ void xcd_barrier(const XcdBarrier& b) {
    asm volatile("s_waitcnt vmcnt(0)" ::: "memory");
    __syncthreads();
    if (threadIdx.x == 0) {
        unsigned* bar = b.bar;
        __builtin_amdgcn_s_waitcnt(0);
        unsigned nloc = b.st[0], nx = b.st[1];
        if (nloc == 0u) { xcd_barrier_complete(bar, b.x, nloc, nx); b.st[0] = nloc; b.st[1] = nx; }
        const unsigned old = xb_add(&bar[XB_XSUB(b.x)], 1u);
        const unsigned gen = old / nloc;
        if (old + 1u == (gen + 1u) * nloc) {
            __builtin_amdgcn_fence(__ATOMIC_RELEASE, "agent");
            asm volatile("s_waitcnt vmcnt(0)" ::: "memory");
            const unsigned og = xb_add(&bar[XB_TOP], 1u);
            const unsigned tg = og / nx;
            if (og + 1u == (tg + 1u) * nx) xb_add(&bar[XB_TOPGEN], 1u);
            else XB_SPIN(xb_ld(&bar[XB_TOPGEN]) == tg, bar);
            __builtin_amdgcn_fence(__ATOMIC_ACQUIRE, "agent");
            xb_add(&bar[XB_XGEN(b.x)], 1u);
            asm volatile("s_waitcnt vmcnt(0)" ::: "memory");
        } else {
            XB_SPIN(xb_ld(&bar[XB_XGEN(b.x)]) == gen, bar);
            __builtin_amdgcn_fence(__ATOMIC_ACQUIRE, "agent");
            asm volatile("s_waitcnt vmcnt(0)" ::: "memory");
        }
    }
    __syncthreads();
}


typedef float f32x16 __attribute__((ext_vector_type(16)));
#define MFMA32(a, b, c) __builtin_amdgcn_mfma_f32_32x32x16_bf16((a), (b), (c), 0, 0, 0)
__device__ __forceinline__ int crow(int reg, int h) { return (reg & 3) + 8 * (reg >> 2) + 4 * h; }
constexpr int HG_LQE = 0, HG_LKE = HG_LQE + 64 * 272, HG_LKTT = HG_LKE + 64 * 272, HG_LVT = HG_LKTT + 128 * 144, HG_LAT = HG_LVT + 128 * 144, HG_LST = HG_LAT + 64 * 144,
              HG_LO = HG_LST + 128 * 272, HG_LBL = HG_LO + 64 * 528, HG_LPART = HG_LBL + 512, HG_LEND = HG_LPART + 4096;
static_assert(HG_LEND <= 163840 - 512, "hgrn lds");
__device__ __forceinline__ void hgrn_phase(LAS unsigned char* lds, const bf16_t* Z, const float* hg_lb, const float* norm_g, bf16_t* OG, int G, int bx) {
    const int tid = pinned_tid(), lane = tid & 63, wave = __builtin_amdgcn_readfirstlane(tid >> 6), half = lane >> 5, l32 = lane & 31;
    const int d = 2 * (tid & 63), jq = tid >> 6;
    for (int unit = bx; unit < NB * 8; unit += G) {
        const int b = unit >> 3, h = unit & 7;
        for (int i = tid; i < 128 * 272 / 4; i += NTHR) ((LAS unsigned*)(lds + HG_LST))[i] = 0u;
        f32x16 S0, S1;
#pragma unroll
        for (int r = 0; r < 16; ++r) { S0[r] = 0.f; S1[r] = 0.f; }
        __syncthreads();
        unsigned qn[8], fn[8], vn[8];
#define HG_LOAD(n_) do { const bf16_t* zr_ = Z + ((size_t)(b * T + (n_) * 64 + jq * 8)) * 4096 + h * 128 + d; \
            _Pragma("unroll") for (int jj = 0; jj < 8; ++jj) { qn[jj] = __builtin_nontemporal_load((const unsigned*)(zr_ + (size_t)jj * 4096)); fn[jj] = __builtin_nontemporal_load((const unsigned*)(zr_ + (size_t)jj * 4096 + 1024)); vn[jj] = __builtin_nontemporal_load((const unsigned*)(zr_ + (size_t)jj * 4096 + 2048)); } } while (0)
        u32x4 gc0, gc1, gn0, gn1;
#define HG_LOADG(n_, A_, B_) do { const bf16_t* gp_ = Z + (size_t)(b * T + (n_) * 64 + (tid >> 3)) * 4096 + 3072 + h * 128 + (tid & 7) * 16; A_ = __builtin_nontemporal_load((const u32x4*)gp_); B_ = __builtin_nontemporal_load((const u32x4*)(gp_ + 8)); } while (0)
        HG_LOAD(0); HG_LOADG(0, gc0, gc1);
        for (int n = 0; n < T / 64; ++n) {
            float q0[8], q1[8], k0[8], k1[8], p0[8], p1[8]; unsigned vr[8];
            float run0 = 1.f, run1 = 1.f;
#pragma unroll
            for (int jj = 0; jj < 8; ++jj) { const float fg0 = bflo(fn[jj]), fg1 = bfhi(fn[jj]); run0 *= fg0; run1 *= fg1; p0[jj] = run0; p1[jj] = run1; k0[jj] = 1.0f - fg0; k1[jj] = 1.0f - fg1;
                q0[jj] = bflo(qn[jj]); q1[jj] = bfhi(qn[jj]); vr[jj] = vn[jj]; }
            *(LAS f32x2*)(lds + HG_LPART + (jq * 128 + d) * 4) = (f32x2){run0, run1};
            __syncthreads();
            float pre0 = 1.f, pre1 = 1.f, tot0 = 1.f, tot1 = 1.f;
#pragma unroll
            for (int q = 0; q < 8; ++q) { const f32x2 pq = *(const LAS f32x2*)(lds + HG_LPART + (q * 128 + d) * 4); tot0 *= pq[0]; tot1 *= pq[1]; if (q < jq) { pre0 *= pq[0]; pre1 *= pq[1]; } }
            if (jq == 0) *(LAS f32x2*)(lds + HG_LBL + d * 4) = (f32x2){tot0, tot1};
            unsigned kt0[4], kt1[4], vt0[4], vt1[4];
#pragma unroll
            for (int jj = 0; jj < 8; ++jj) {
                const float e0 = p0[jj] * pre0, e1 = p1[jj] * pre1, r0 = __builtin_amdgcn_rcpf(e0), r1 = __builtin_amdgcn_rcpf(e1);
                const int j = jq * 8 + jj;
                *(LAS unsigned*)(lds + HG_LQE + j * 272 + d * 2) = cvt_pk_bf16(q0[jj] * e0, q1[jj] * e1);
                *(LAS unsigned*)(lds + HG_LKE + j * 272 + d * 2) = cvt_pk_bf16(k0[jj] * r0, k1[jj] * r1);
                const float t0 = k0[jj] * r0 * tot0, t1 = k1[jj] * r1 * tot1;
                if (jj & 1) { kt0[jj >> 1] = cvt_pk_bf16(p0[jj - 1], t0); kt1[jj >> 1] = cvt_pk_bf16(p1[jj - 1], t1); vt0[jj >> 1] = (vr[jj - 1] & 0xffffu) | (vr[jj] << 16); vt1[jj >> 1] = (vr[jj - 1] >> 16) | (vr[jj] & 0xffff0000u); }
                else { p0[jj] = t0; p1[jj] = t1; }
            }
            *(LAS u32x4*)(lds + HG_LKTT + d * 144 + jq * 16) = (u32x4){kt0[0], kt0[1], kt0[2], kt0[3]}; *(LAS u32x4*)(lds + HG_LKTT + (d + 1) * 144 + jq * 16) = (u32x4){kt1[0], kt1[1], kt1[2], kt1[3]};
            *(LAS u32x4*)(lds + HG_LVT + d * 144 + jq * 16) = (u32x4){vt0[0], vt0[1], vt0[2], vt0[3]}; *(LAS u32x4*)(lds + HG_LVT + (d + 1) * 144 + jq * 16) = (u32x4){vt1[0], vt1[1], vt1[2], vt1[3]};
            __syncthreads();
            if (n + 1 < T / 64) { HG_LOAD(n + 1); HG_LOADG(n + 1, gn0, gn1); }
            if (wave < 4) {
                const int tj = wave >> 1, ti = wave & 1;
                f32x16 acc;
#pragma unroll
                for (int r = 0; r < 16; ++r) acc[r] = 0.f;
                if (tj <= ti) {
#pragma unroll
                    for (int s = 0; s < 8; ++s) {
                        const bf16x8 a = *(const LAS bf16x8*)(lds + HG_LKE + (32 * tj + l32) * 272 + (16 * s + 8 * half) * 2);
                        const bf16x8 bq = *(const LAS bf16x8*)(lds + HG_LQE + (32 * ti + l32) * 272 + (16 * s + 8 * half) * 2);
                        acc = MFMA32(a, bq, acc);
                    }
                }
                const int ig = 32 * ti + l32;
#pragma unroll
                for (int g4 = 0; g4 < 4; ++g4) {
                    const int j0 = 32 * tj + 8 * g4 + 4 * half;
                    float v0 = acc[4 * g4], v1 = acc[4 * g4 + 1], v2 = acc[4 * g4 + 2], v3 = acc[4 * g4 + 3];
                    v0 = (j0 <= ig) ? v0 : 0.f; v1 = (j0 + 1 <= ig) ? v1 : 0.f; v2 = (j0 + 2 <= ig) ? v2 : 0.f; v3 = (j0 + 3 <= ig) ? v3 : 0.f;
                    *(LAS u32x2*)(lds + HG_LAT + ig * 144 + j0 * 2) = (u32x2){cvt_pk_bf16(v0, v1), cvt_pk_bf16(v2, v3)};
                }
            }
            {
                const int td = wave & 3, tc0 = (wave >> 2) * 2;
#pragma unroll
                for (int r = 0; r < 16; ++r) { const float sc = ((LAS float*)(lds + HG_LBL))[32 * td + crow(r, half)]; S0[r] *= sc; S1[r] *= sc; }
#pragma unroll
                for (int s = 0; s < 4; ++s) {
                    const bf16x8 a = *(const LAS bf16x8*)(lds + HG_LKTT + (32 * td + l32) * 144 + (16 * s + 8 * half) * 2);
                    const bf16x8 b0 = *(const LAS bf16x8*)(lds + HG_LVT + (32 * tc0 + l32) * 144 + (16 * s + 8 * half) * 2);
                    const bf16x8 b1 = *(const LAS bf16x8*)(lds + HG_LVT + (32 * (tc0 + 1) + l32) * 144 + (16 * s + 8 * half) * 2);
                    S0 = MFMA32(a, b0, S0); S1 = MFMA32(a, b1, S1);
                }
            }
            __syncthreads();
            {
                const int ti = wave >> 2, tc = wave & 3;
                f32x16 acc;
#pragma unroll
                for (int r = 0; r < 16; ++r) acc[r] = 0.f;
#pragma unroll
                for (int s = 0; s < 4; ++s) {
                    const bf16x8 a = *(const LAS bf16x8*)(lds + HG_LAT + (32 * ti + l32) * 144 + (16 * s + 8 * half) * 2);
                    const bf16x8 bv = *(const LAS bf16x8*)(lds + HG_LVT + (32 * tc + l32) * 144 + (16 * s + 8 * half) * 2);
                    acc = MFMA32(a, bv, acc);
                }
#pragma unroll
                for (int s = 0; s < 8; ++s) {
                    const bf16x8 a = *(const LAS bf16x8*)(lds + HG_LQE + (32 * ti + l32) * 272 + (16 * s + 8 * half) * 2);
                    const bf16x8 bs = *(const LAS bf16x8*)(lds + HG_LST + (32 * tc + l32) * 272 + (16 * s + 8 * half) * 2);
                    acc = MFMA32(a, bs, acc);
                }
#pragma unroll
                for (int r = 0; r < 16; ++r) ((LAS float*)(lds + HG_LO + (32 * ti + crow(r, half)) * 528))[32 * tc + l32] = acc[r];
            }
            __syncthreads();
            {
                const int td = wave & 3, tc0 = (wave >> 2) * 2;
#pragma unroll
                for (int g4 = 0; g4 < 4; ++g4) {
                    const int d0 = 32 * td + 8 * g4 + 4 * half;
                    *(LAS u32x2*)(lds + HG_LST + (32 * tc0 + l32) * 272 + d0 * 2) = (u32x2){cvt_pk_bf16(S0[4 * g4], S0[4 * g4 + 1]), cvt_pk_bf16(S0[4 * g4 + 2], S0[4 * g4 + 3])};
                    *(LAS u32x2*)(lds + HG_LST + (32 * (tc0 + 1) + l32) * 272 + d0 * 2) = (u32x2){cvt_pk_bf16(S1[4 * g4], S1[4 * g4 + 1]), cvt_pk_bf16(S1[4 * g4 + 2], S1[4 * g4 + 3])};
                }
            }
            {
                const int i = tid >> 3, seg = tid & 7;
                f32x4 ov[4]; float ss = 0.f;
#pragma unroll
                for (int q = 0; q < 4; ++q) { ov[q] = *(const LAS f32x4*)(lds + HG_LO + i * 528 + seg * 64 + q * 16); ss += (ov[q][0] * ov[q][0] + ov[q][1] * ov[q][1]) + (ov[q][2] * ov[q][2] + ov[q][3] * ov[q][3]); }
                ss = dpp_addx<0xB1, 0xf>(ss); ss = dpp_addx<0x4E, 0xf>(ss); ss = dpp_addx<0x141, 0xf>(ss);
                const float rstd = __builtin_amdgcn_rsqf(ss * (1.0f / 128.0f) + LN_EPS);
                const size_t row = (size_t)(b * T + n * 64 + i);
                const u32x4 g0 = gc0, g1 = gc1;
                const unsigned gw_[8] = {g0.x, g0.y, g0.z, g0.w, g1.x, g1.y, g1.z, g1.w};
                unsigned ow[8];
#pragma unroll
                for (int q = 0; q < 4; ++q) { const f32x4 ng = *(const f32x4*)(norm_g + seg * 16 + q * 4);
                    ow[2 * q] = cvt_pk_bf16(ov[q][0] * rstd * ng[0] * bflo(gw_[2 * q]), ov[q][1] * rstd * ng[1] * bfhi(gw_[2 * q]));
                    ow[2 * q + 1] = cvt_pk_bf16(ov[q][2] * rstd * ng[2] * bflo(gw_[2 * q + 1]), ov[q][3] * rstd * ng[3] * bfhi(gw_[2 * q + 1])); }
                *(u32x4*)(OG + row * D + h * 128 + seg * 16) = (u32x4){ow[0], ow[1], ow[2], ow[3]}; *(u32x4*)(OG + row * D + h * 128 + seg * 16 + 8) = (u32x4){ow[4], ow[5], ow[6], ow[7]};
            }
            gc0 = gn0; gc1 = gn1;
        }
        __syncthreads();
    }
}


__device__ __forceinline__ void unpack8(const u32x4 w, float (&f)[8]) { f[0] = bflo(w.x); f[1] = bfhi(w.x); f[2] = bflo(w.y); f[3] = bfhi(w.y); f[4] = bflo(w.z); f[5] = bfhi(w.z); f[6] = bflo(w.w); f[7] = bfhi(w.w); }
__device__ __forceinline__ void rope_row(int m, bf16_t* ZB, bf16_t* QRB, const int* posi, LAS float* tb, int lane, bool write_k) {
    const float inv_me = exp2f(-(float)(lane & 31) * (13.287712379549449f / 32.0f));
    { const float pf = (float)posi[m]; float s1, c1; sincosf(pf * inv_me, &s1, &c1); if (lane < 32) { tb[lane] = c1; tb[32 + lane] = s1; } LDS_WAIT(); }
    if (lane < 48) {
        const bf16_t* zrow = ZB + (size_t)m * EVP;
        const int hs = lane >> 2, d0 = 8 * (lane & 3);
        const f32x4 ca = *(const LAS f32x4*)(tb + d0), cb = *(const LAS f32x4*)(tb + d0 + 4), sa = *(const LAS f32x4*)(tb + 32 + d0), sb = *(const LAS f32x4*)(tb + 32 + d0 + 4);
        const int scol = hs < 8 ? 1792 + hs * 64 : ((hs & 2) ? 2816 : 2560) + (hs & 1) * 64;
        const u32x4 a = *(const u32x4*)(zrow + scol + d0), bq = *(const u32x4*)(zrow + scol + 32 + d0);
        float x1[8], x2[8], o1[8], o2[8]; unpack8(a, x1); unpack8(bq, x2);
#pragma unroll
        for (int i = 0; i < 8; ++i) { const float c = i < 4 ? ca[i & 3] : cb[i & 3], sn = i < 4 ? sa[i & 3] : sb[i & 3]; o1[i] = x1[i] * c - x2[i] * sn; o2[i] = x2[i] * c + x1[i] * sn; }
        const u32x4 w1 = (u32x4){cvt_pk_bf16(o1[0], o1[1]), cvt_pk_bf16(o1[2], o1[3]), cvt_pk_bf16(o1[4], o1[5]), cvt_pk_bf16(o1[6], o1[7])}, w2 = (u32x4){cvt_pk_bf16(o2[0], o2[1]), cvt_pk_bf16(o2[2], o2[3]), cvt_pk_bf16(o2[4], o2[5]), cvt_pk_bf16(o2[6], o2[7])};
        if (hs < 8) { bf16_t* dst = QRB + (size_t)m * 512 + hs * 64 + d0; *(u32x4*)dst = w1; *(u32x4*)(dst + 32) = w2; }
        else if (write_k) { bf16_t* dst = ZB + (size_t)m * EVP + scol + d0; *(u32x4*)dst = w1; *(u32x4*)(dst + 32) = w2; }
    }
    LDS_WAIT();
}
__device__ __forceinline__ void cmpcomb_row(int rr, const float* HC, const float* cb, const float* cw2, bf16_t* KVC, LAS float* hs, int lane) {
    const int hq = rr & 1, n = (rr >> 1) & 255, bq_ = (rr >> 9) & 15, zsel = rr >> 13;
    float outv = 0.f;
    if (n < 255) {
        const float* ha = HC + ((size_t)zsel * 8192 + (size_t)(bq_ * 256 + n) * 2 + hq) * 256; const float* hb = ha + 2 * 256 + 128;
#pragma unroll
        for (int q = 0; q < 2; ++q) { const int c = lane + 64 * q; const float xx = ha[c] + hb[c] + cb[zsel * 128 + c];
            hs[c] = 0.5f * xx * (1.0f + tanhf(0.7978845608028654f * (xx + 0.044715f * xx * xx * xx))); }
        LDS_WAIT();
        const float* w2p = cw2 + (size_t)zsel * 128 * 64 + lane;
#pragma unroll 16
        for (int c = 0; c < 128; ++c) outv += hs[c] * w2p[c * 64];
        LDS_WAIT();
    }
    KVC[((size_t)(zsel * 32 + bq_ * 2 + hq) * 256 + n) * 64 + lane] = (bf16_t)(cvt_pk_bf16(outv, 0.f) & 0xffffu);
}
constexpr int LATE_CONV_ITEMS = 2048 + 4 * 512 + 2 * 128;
__device__ __forceinline__ void conv_late_item(int it, const float* odin, const float* odout, const float* evout, const float* gatew, const float* plew, unsigned char* ws, LAS float* scr, int lane);
constexpr int MOE_CONV_ITEMS = NEXP * 3 * 256;
__device__ __forceinline__ void conv_moe_item(const float* w1, const float* w3, const float* w2, int li, bf16_t* w13, bf16_t* w2t, LAS float* scr, int it, int lane);
constexpr int RW_LW = 0, RW_LKK = 8192, RW_LBB = 16384, RW_LK2 = 24576, RW_LWR = 32768, RW_LV = 40960, RW_LO = 57344;
template <int CTRL> __device__ __forceinline__ float dpp_b(float v) { return __builtin_bit_cast(float, __builtin_amdgcn_mov_dpp(__builtin_bit_cast(int, v), CTRL, 0xf, 0xf, true)); }
__device__ __forceinline__ float sum16b(float v) { v += dpp_b<0xB1>(v); v += dpp_b<0x4E>(v); v += dpp_b<0x141>(v); v += dpp_b<0x140>(v); return v; }
__device__ __forceinline__ float sum8b(float v) { v += dpp_b<0xB1>(v); v += dpp_b<0x4E>(v); v += dpp_b<0x141>(v); return v; }
__device__ __forceinline__ float afma(float a, float b, float c) { float d; asm("v_fma_f32 %0, %1, %2, %3" : "=v"(d) : "v"(a), "v"(b), "v"(c)); return d; }
__device__ __forceinline__ float anfma(float a, float b, float c) { float d; asm("v_fma_f32 %0, -%1, %2, %3" : "=v"(d) : "v"(a), "v"(b), "v"(c)); return d; }
__device__ __forceinline__ float amul(float a, float b) { float d; asm("v_mul_f32 %0, %1, %2" : "=v"(d) : "v"(a), "v"(b)); return d; }
__device__ __forceinline__ unsigned cvt_pk_f16(float a, float b) { typedef _Float16 h2v_ __attribute__((ext_vector_type(2))); return __builtin_bit_cast(unsigned, __builtin_convertvector((f32x2){a, b}, h2v_)); }
__device__ __forceinline__ u32x4 pack8h(const float (&o)[8]) { return (u32x4){cvt_pk_f16(o[0], o[1]), cvt_pk_f16(o[2], o[3]), cvt_pk_f16(o[4], o[5]), cvt_pk_f16(o[6], o[7])}; }
struct RwRaw { u32x4 r, k, v, rp, kp, vp, a, wq; f32x4 sc; };
__device__ __forceinline__ void rwkv_phase(LAS unsigned char* lds, const bf16_t* Z, const bf16_t* dec, const bf16_t* aa, const float* sc4, const float* mu, const float* k_k, const float* k_a, bf16_t* Y, int G, int bx,
                                           const float* mw1, const float* mw3, const float* mw2, bf16_t* w13, bf16_t* w2t, bool conv,
                                           const float* HC, const float* cb, const float* cw2, bf16_t* KVC, const float* pin, bf16_t* pbf0, bf16_t* pbf1, bf16_t* ZW, bf16_t* QRB, const int* posi,
                                           const float* lodin, const float* lodout, const float* levout, const float* lgate, const float* lple, unsigned char* wsb) {
    for (int unit = bx; unit < NB * 16; unit += G) {
        const int tid = pinned_tid();
        const int rowl = (tid >> 3) & 31, kc = tid & 7;
        const int sst = tid >> 3, c8 = (tid & 7) * 8;
        const int b = unit >> 4, h = (unit >> 1) & 7, rh = unit & 1, hc0 = h * 64 + c8;
        float p_mr[8], p_mk[8], p_mv[8], p_kk[8], p_ka[8];
#pragma unroll
        for (int i = 0; i < 8; ++i) { p_mr[i] = mu[hc0 + i]; p_mk[i] = mu[512 + hc0 + i]; p_mv[i] = mu[1024 + hc0 + i]; p_kk[i] = k_k[hc0 + i]; p_ka[i] = k_a[hc0 + i]; }
        float S[8];
#pragma unroll
        for (int i = 0; i < 8; ++i) S[i] = 0.f;
        RwRaw rw;
#define RW_LOAD(n_) do { const int t_ = (n_) * 64 + sst; const size_t row_ = (size_t)(b * T + t_); const bf16_t* zc_ = Z + row_ * EVP + hc0; \
            rw.r = *(const u32x4*)zc_; rw.k = *(const u32x4*)(zc_ + 512); rw.v = *(const u32x4*)(zc_ + 1024); \
            if (t_ > 0) { rw.rp = *(const u32x4*)(zc_ - EVP); rw.kp = *(const u32x4*)(zc_ + 512 - EVP); rw.vp = *(const u32x4*)(zc_ + 1024 - EVP); } else { rw.rp = (u32x4){0u, 0u, 0u, 0u}; rw.kp = rw.rp; rw.vp = rw.rp; } \
            rw.a = *(const u32x4*)(aa + row_ * 512 + hc0); rw.wq = *(const u32x4*)(dec + row_ * 512 + hc0); rw.sc = *(const f32x4*)(sc4 + (row_ * 8 + h) * 4); } while (0)
#define RW_FINISH() do { float r_[8], k_[8], v_[8], rp_[8], kp_[8], vp_[8], a_[8], wc_[8]; unpack8(rw.wq, wc_); unpack8(rw.r, r_); unpack8(rw.k, k_); unpack8(rw.v, v_); unpack8(rw.rp, rp_); unpack8(rw.kp, kp_); unpack8(rw.vp, vp_); unpack8(rw.a, a_); \
            float ow_[8], oq_[8], ob_[8], ok_[8], ou_[8], ov_[8]; \
            _Pragma("unroll") for (int i = 0; i < 8; ++i) { const float rr = r_[i] + p_mr[i] * (rp_[i] - r_[i]), k0 = k_[i] + p_mk[i] * (kp_[i] - k_[i]), vv = v_[i] + p_mv[i] * (vp_[i] - v_[i]), w = 1.0f - wc_[i]; \
                const float kk = k0 * p_kk[i] * rw.sc[0]; ow_[i] = w; oq_[i] = kk; ob_[i] = -(kk * a_[i]); ok_[i] = k0 * (1.0f + (a_[i] - 1.0f) * p_ka[i]); ou_[i] = w * rr - rw.sc[1] * kk; ov_[i] = vv; } \
            LAS unsigned char* d_ = lds + sst * 128 + c8 * 2; \
            *(LAS u32x4*)(d_ + RW_LW) = pack8h(ow_); *(LAS u32x4*)(d_ + RW_LKK) = pack8h(oq_); *(LAS u32x4*)(d_ + RW_LBB) = pack8h(ob_); *(LAS u32x4*)(d_ + RW_LK2) = pack8h(ok_); *(LAS u32x4*)(d_ + RW_LWR) = pack8h(ou_); \
            if ((c8 >> 5) == rh) { LAS float* dv_ = (LAS float*)(lds + RW_LV + sst * 256 + (c8 & 31) * 8); const float c2_ = rw.sc[2]; \
                *(LAS f32x4*)dv_ = (f32x4){ov_[0], ov_[0] * c2_, ov_[1], ov_[1] * c2_}; *(LAS f32x4*)(dv_ + 4) = (f32x4){ov_[2], ov_[2] * c2_, ov_[3], ov_[3] * c2_}; \
                *(LAS f32x4*)(dv_ + 8) = (f32x4){ov_[4], ov_[4] * c2_, ov_[5], ov_[5] * c2_}; *(LAS f32x4*)(dv_ + 12) = (f32x4){ov_[6], ov_[6] * c2_, ov_[7], ov_[7] * c2_}; } } while (0)
        RW_LOAD(0);
        RW_FINISH();
        __syncthreads();
        for (int n = 0; n < T / 64; ++n) {
            if (n + 1 < T / 64) RW_LOAD(n + 1);
            if (tid >= 256) {
                if (conv) rope_row(n * (G * 4) + bx * 4 + ((tid >> 6) - 4), ZW, QRB, posi, (LAS float*)(lds + 100 * 1024 + 4 * 8704 + ((tid >> 6) - 4) * 256), tid & 63, true);
                const int it_ = n * (G * 4) + bx * 4 + ((tid >> 6) - 4);
                if (conv && it_ < MOE_CONV_ITEMS) conv_moe_item(mw1, mw3, mw2, 0, w13, w2t, (LAS float*)(lds + 100 * 1024 + ((tid >> 6) - 4) * 8704), it_, tid & 63);
                else if (conv && it_ - MOE_CONV_ITEMS < 2 * 16 * 256 * 2) cmpcomb_row(it_ - MOE_CONV_ITEMS, HC, cb, cw2, KVC, (LAS float*)(lds + 100 * 1024 + ((tid >> 6) - 4) * 8704), tid & 63);
                else if (conv && n >= 56) { const int li_ = (n - 56) * (G * 4) + bx * 4 + ((tid >> 6) - 4);
                    if (li_ < LATE_CONV_ITEMS) conv_late_item(li_, lodin, lodout, levout, lgate, lple, wsb, (LAS float*)(lds + 100 * 1024 + ((tid >> 6) - 4) * 8704), tid & 63); }
                else if (conv && n >= 40 && n < 56) {
                    const int lane_ = tid & 63, w_ = (n - 40) * (G * 4) + bx * 4 + ((tid >> 6) - 4);
#pragma unroll
                    for (int q = 0; q < 8; ++q) { const int row = w_ * 8 + q; const f32x4 v = *((const f32x4*)(pin + (size_t)row * PLE) + lane_);
                        bf16_t* dst = row < M ? pbf0 + (size_t)row * PLE : pbf1 + (size_t)(row - M) * PLE; *((u32x2*)dst + lane_) = (u32x2){cvt_pk_bf16(v[0], v[1]), cvt_pk_bf16(v[2], v[3])}; }
                }
            }
            if (tid < 256) {
            const int vb = kc * 16, vvb = RW_LV + rowl * 8;
            u32x4 cw = *(const LAS u32x4*)(lds + vb + RW_LW), cq = *(const LAS u32x4*)(lds + vb + RW_LKK), cb = *(const LAS u32x4*)(lds + vb + RW_LBB), ck = *(const LAS u32x4*)(lds + vb + RW_LK2), cu = *(const LAS u32x4*)(lds + vb + RW_LWR);
            f32x2 cv2 = *(const LAS f32x2*)(lds + vvb);
            LAS float* const obase = (kc == 0 ? (LAS float*)(lds + RW_LO) : (LAS float*)(lds + 136 * 1024)) + rowl;
#if PROBE_DUP == 10
            float T0[8];
#pragma unroll
            for (int i = 0; i < 8; ++i) T0[i] = S[i];
            for (int rep_ = 0; rep_ < 2; ++rep_) {
            if (rep_ == 1) {
#pragma unroll
                for (int i = 0; i < 8; ++i) S[i] = T0[i]; }
#endif
            __builtin_amdgcn_s_setprio(3);
#define MIXLO "op_sel_hi:[0,1,0]"
#define MIXHI "op_sel:[0,1,0] op_sel_hi:[0,1,0]"
#define DPPQ1 "quad_perm:[1,0,3,2] row_mask:0xf bank_mask:0xf bound_ctrl:1"
#define DPPQ2 "quad_perm:[2,3,0,1] row_mask:0xf bank_mask:0xf bound_ctrl:1"
#define DPPHM "row_half_mirror row_mask:0xf bank_mask:0xf bound_ctrl:1"
#pragma unroll 8
            for (int st = 0; st < 64; ++st) {
                const int sn = st + 1;
                const u32x4 nw = *(const LAS u32x4*)(lds + vb + RW_LW + sn * 128), nq = *(const LAS u32x4*)(lds + vb + RW_LKK + sn * 128), nb = *(const LAS u32x4*)(lds + vb + RW_LBB + sn * 128),
                            nk = *(const LAS u32x4*)(lds + vb + RW_LK2 + sn * 128), nu = *(const LAS u32x4*)(lds + vb + RW_LWR + sn * 128);
                const f32x2 nv2 = *(const LAS f32x2*)(lds + vvb + sn * 256);
                float sa, ov, t0, t1, t2, xa, xb, xc, xd;
                asm("v_fma_mix_f32 %[sa], %[s0], %[q0], 0 " MIXLO "\n\tv_fma_mix_f32 %[sb], %[s4], %[q2], 0 " MIXLO "\n\tv_fma_mix_f32 %[oa], %[s0], %[u0], 0 " MIXLO "\n\tv_fma_mix_f32 %[ob], %[s4], %[u2], 0 " MIXLO "\n\t"
                    "v_fma_mix_f32 %[sa], %[s1], %[q0], %[sa] " MIXHI "\n\tv_fma_mix_f32 %[sb], %[s5], %[q2], %[sb] " MIXHI "\n\tv_fma_mix_f32 %[oa], %[s1], %[u0], %[oa] " MIXHI "\n\tv_fma_mix_f32 %[ob], %[s5], %[u2], %[ob] " MIXHI "\n\t"
                    "v_fma_mix_f32 %[sa], %[s2], %[q1], %[sa] " MIXLO "\n\tv_fma_mix_f32 %[sb], %[s6], %[q3], %[sb] " MIXLO "\n\tv_fma_mix_f32 %[oa], %[s2], %[u1], %[oa] " MIXLO "\n\tv_fma_mix_f32 %[ob], %[s6], %[u3], %[ob] " MIXLO "\n\t"
                    "v_fma_mix_f32 %[sa], %[s3], %[q1], %[sa] " MIXHI "\n\tv_fma_mix_f32 %[sb], %[s7], %[q3], %[sb] " MIXHI "\n\tv_fma_mix_f32 %[oa], %[s3], %[u1], %[oa] " MIXHI "\n\tv_fma_mix_f32 %[ob], %[s7], %[u3], %[ob] " MIXHI "\n\t"
                    "v_add_f32 %[sa], %[sa], %[sb]\n\tv_add_f32 %[oa], %[oa], %[ob]\n\t"
                    "v_fma_mix_f32 %[t0], %[cv], %[k0], 0 " MIXLO "\n\tv_add_f32_dpp %[sa], %[sa], %[sa] " DPPQ1 "\n\tv_add_f32_dpp %[oa], %[oa], %[oa] " DPPQ1 "\n\t"
                    "v_fma_mix_f32 %[t1], %[cv], %[k0], 0 " MIXHI "\n\tv_add_f32_dpp %[sa], %[sa], %[sa] " DPPQ2 "\n\tv_add_f32_dpp %[oa], %[oa], %[oa] " DPPQ2 "\n\t"
                    "v_fma_mix_f32 %[t2], %[cv], %[k1], 0 " MIXLO "\n\tv_add_f32_dpp %[sa], %[sa], %[sa] " DPPHM "\n\tv_add_f32_dpp %[oa], %[oa], %[oa] " DPPHM "\n\t"
                    "v_add_f32 %[ov], %[oa], %[c1]"
                    : [sa] "=&v"(sa), [ov] "=&v"(ov), [t0] "=&v"(t0), [t1] "=&v"(t1), [t2] "=&v"(t2), [sb] "=&v"(xa), [oa] "=&v"(xb), [ob] "=&v"(xc)
                    : [s0] "v"(S[0]), [s1] "v"(S[1]), [s2] "v"(S[2]), [s3] "v"(S[3]), [s4] "v"(S[4]), [s5] "v"(S[5]), [s6] "v"(S[6]), [s7] "v"(S[7]),
                      [q0] "v"(cq.x), [q1] "v"(cq.y), [q2] "v"(cq.z), [q3] "v"(cq.w), [u0] "v"(cu.x), [u1] "v"(cu.y), [u2] "v"(cu.z), [u3] "v"(cu.w),
                      [cv] "v"(cv2[0]), [c1] "v"(cv2[1]), [k0] "v"(ck.x), [k1] "v"(ck.y));
                obase[st * 32] = ov;
                asm("v_fma_mix_f32 %[x], %[cv], %[k1], 0 " MIXHI "\n\tv_fma_mix_f32 %[y], %[sa], %[b0], %[t0] " MIXLO "\n\tv_fma_mix_f32 %[z], %[sa], %[b0], %[t1] " MIXHI "\n\t"
                    "v_fma_mix_f32 %[s0], %[s0], %[w0], %[y] " MIXLO "\n\tv_fma_mix_f32 %[y], %[sa], %[b1], %[t2] " MIXLO "\n\tv_fma_mix_f32 %[s1], %[s1], %[w0], %[z] " MIXHI "\n\t"
                    "v_fma_mix_f32 %[x], %[sa], %[b1], %[x] " MIXHI "\n\tv_fma_mix_f32 %[s2], %[s2], %[w1], %[y] " MIXLO "\n\tv_fma_mix_f32 %[s3], %[s3], %[w1], %[x] " MIXHI
                    : [s0] "+v"(S[0]), [s1] "+v"(S[1]), [s2] "+v"(S[2]), [s3] "+v"(S[3]), [x] "=&v"(xa), [y] "=&v"(xb), [z] "=&v"(xc)
                    : [sa] "v"(sa), [cv] "v"(cv2[0]), [t0] "v"(t0), [t1] "v"(t1), [t2] "v"(t2), [k1] "v"(ck.y), [b0] "v"(cb.x), [b1] "v"(cb.y), [w0] "v"(cw.x), [w1] "v"(cw.y));
                asm("v_fma_mix_f32 %[x], %[cv], %[k2], 0 " MIXLO "\n\tv_fma_mix_f32 %[y], %[cv], %[k2], 0 " MIXHI "\n\tv_fma_mix_f32 %[z], %[cv], %[k3], 0 " MIXLO "\n\tv_fma_mix_f32 %[u], %[cv], %[k3], 0 " MIXHI "\n\t"
                    "v_fma_mix_f32 %[x], %[sa], %[b2], %[x] " MIXLO "\n\tv_fma_mix_f32 %[y], %[sa], %[b2], %[y] " MIXHI "\n\tv_fma_mix_f32 %[z], %[sa], %[b3], %[z] " MIXLO "\n\tv_fma_mix_f32 %[u], %[sa], %[b3], %[u] " MIXHI "\n\t"
                    "v_fma_mix_f32 %[s4], %[s4], %[w2], %[x] " MIXLO "\n\tv_fma_mix_f32 %[s5], %[s5], %[w2], %[y] " MIXHI "\n\tv_fma_mix_f32 %[s6], %[s6], %[w3], %[z] " MIXLO "\n\tv_fma_mix_f32 %[s7], %[s7], %[w3], %[u] " MIXHI
                    : [s4] "+v"(S[4]), [s5] "+v"(S[5]), [s6] "+v"(S[6]), [s7] "+v"(S[7]), [x] "=&v"(xa), [y] "=&v"(xb), [z] "=&v"(xc), [u] "=&v"(xd)
                    : [sa] "v"(sa), [cv] "v"(cv2[0]), [k2] "v"(ck.z), [k3] "v"(ck.w), [b2] "v"(cb.z), [b3] "v"(cb.w), [w2] "v"(cw.z), [w3] "v"(cw.w));
                cw = nw; cq = nq; cb = nb; ck = nk; cu = nu; cv2 = nv2;
            }
#undef MIXLO
#undef MIXHI
#undef DPPQ1
#undef DPPQ2
#undef DPPHM
            __builtin_amdgcn_s_setprio(0);
#if PROBE_DUP == 10
            }
#endif
            }
            __syncthreads();
            { const int st = tid >> 3, r4 = (tid & 7) * 4; const f32x4 o = *(const LAS f32x4*)(lds + RW_LO + st * 128 + r4 * 4);
              *(u32x2*)(Y + (size_t)(b * T + n * 64 + st) * D + h * 64 + rh * 32 + r4) = (u32x2){cvt_pk_bf16(o[0], o[1]), cvt_pk_bf16(o[2], o[3])}; }
            if (n + 1 < T / 64) RW_FINISH();
            __syncthreads();
        }
#undef RW_LOAD
#undef RW_FINISH
    }
}

typedef short s16x4 __attribute__((ext_vector_type(4)));
constexpr int AT_KS = 144, AT_VS = 192, AT_KT = 64 * AT_KS, AT_VT = 64 * AT_VS;
constexpr int AT_LK = 0, AT_LV = 4 * AT_KT, AT_LIT = AT_LV + 4 * AT_VT, AT_LIH = AT_LIT + 16384, AT_LSM = AT_LIH + 16384, AT_LKEY = AT_LSM + 512, AT_LEND = AT_LKEY + 32768;
static_assert(AT_LEND <= 163840 - 512, "attention lds");
constexpr float AT_C = 0.125f * 1.4426950408889634f;
constexpr float AT_NEG = -1.0e30f;
__device__ __forceinline__ void qk_tile(const LAS unsigned char* Kt, const bf16x8 (&Q)[4], int l32, int half, f32x16& s0, f32x16& s1) {
#pragma unroll
    for (int r = 0; r < 16; ++r) { s0[r] = 0.f; s1[r] = 0.f; }
#pragma unroll
    for (int s = 0; s < 4; ++s) {
        const bf16x8 a0 = *(const LAS bf16x8*)(Kt + l32 * AT_KS + (16 * s + 8 * half) * 2), a1 = *(const LAS bf16x8*)(Kt + (32 + l32) * AT_KS + (16 * s + 8 * half) * 2);
        s0 = MFMA32(a0, Q[s], s0); s1 = MFMA32(a1, Q[s], s1);
    }
}
#define AT_TR4(vb, OFF, r00, r01, r10, r11) asm volatile("ds_read_b64_tr_b16 %0, %4 offset:%5\n\tds_read_b64_tr_b16 %1, %4 offset:%6\n\tds_read_b64_tr_b16 %2, %4 offset:%7\n\tds_read_b64_tr_b16 %3, %4 offset:%8\n\ts_waitcnt lgkmcnt(0)" \
    : "=&v"(r00), "=&v"(r01), "=&v"(r10), "=&v"(r11) : "v"(vb), "i"(OFF), "i"((OFF) + 8 * AT_VS), "i"((OFF) + 64), "i"((OFF) + 8 * AT_VS + 64) : "memory")
__device__ __forceinline__ bf16x8 pack8(const f32x16& p, int s2) {
    u32x4 w; w.x = cvt_pk_bf16(p[8 * s2], p[8 * s2 + 1]); w.y = cvt_pk_bf16(p[8 * s2 + 2], p[8 * s2 + 3]); w.z = cvt_pk_bf16(p[8 * s2 + 4], p[8 * s2 + 5]); w.w = cvt_pk_bf16(p[8 * s2 + 6], p[8 * s2 + 7]);
    return __builtin_bit_cast(bf16x8, w);
}
#define AT_TR8(vb, OFF, r0, r1, r2, r3, r4, r5, r6, r7) asm volatile("ds_read_b64_tr_b16 %0, %8 offset:%9\n\tds_read_b64_tr_b16 %1, %8 offset:%10\n\tds_read_b64_tr_b16 %2, %8 offset:%11\n\tds_read_b64_tr_b16 %3, %8 offset:%12\n\t" \
    "ds_read_b64_tr_b16 %4, %8 offset:%13\n\tds_read_b64_tr_b16 %5, %8 offset:%14\n\tds_read_b64_tr_b16 %6, %8 offset:%15\n\tds_read_b64_tr_b16 %7, %8 offset:%16\n\ts_waitcnt lgkmcnt(0)" \
    : "=&v"(r0), "=&v"(r1), "=&v"(r2), "=&v"(r3), "=&v"(r4), "=&v"(r5), "=&v"(r6), "=&v"(r7) \
    : "v"(vb), "i"(OFF), "i"((OFF) + 8 * AT_VS), "i"((OFF) + 64), "i"((OFF) + 8 * AT_VS + 64), "i"((OFF) + 16 * AT_VS), "i"((OFF) + 24 * AT_VS), "i"((OFF) + 16 * AT_VS + 64), "i"((OFF) + 24 * AT_VS + 64) : "memory")
__device__ __forceinline__ void pv_tile(unsigned vb, const f32x16& p0, const f32x16& p1, f32x16& O0, f32x16& O1, bool zero_all) {
    s16x4 r0, r1, r2, r3, r4, r5, r6, r7;
    const bf16x8 zf = (bf16x8){0, 0, 0, 0, 0, 0, 0, 0};
#define AT_PV2(P, OFF) { bf16x8 b0 = pack8(P, 0), b1 = pack8(P, 1); if (zero_all) { b0 = zf; b1 = zf; } AT_TR8(vb, OFF, r0, r1, r2, r3, r4, r5, r6, r7); \
        const bf16x8 a00 = __builtin_shufflevector(r0, r1, 0, 1, 2, 3, 4, 5, 6, 7), a01 = __builtin_shufflevector(r2, r3, 0, 1, 2, 3, 4, 5, 6, 7), a10 = __builtin_shufflevector(r4, r5, 0, 1, 2, 3, 4, 5, 6, 7), a11 = __builtin_shufflevector(r6, r7, 0, 1, 2, 3, 4, 5, 6, 7); \
        O0 = MFMA32(a00, b0, O0); O1 = MFMA32(a01, b0, O1); O0 = MFMA32(a10, b1, O0); O1 = MFMA32(a11, b1, O1); }
    AT_PV2(p0, 0) AT_PV2(p1, 32 * AT_VS)
#undef AT_PV2
}
template <int CTRL> __device__ __forceinline__ float dppq(float v) { return __builtin_bit_cast(float, __builtin_amdgcn_update_dpp(0, __builtin_bit_cast(int, v), CTRL, 0xf, 0xf, false)); }
__device__ __forceinline__ float sum4(float v) { v += dppq<0xB1>(v); v += dppq<0x4E>(v); return v; }
__device__ __forceinline__ void xhalf_swap(float& a, float& b) { asm volatile("s_nop 1\n\tv_permlane32_swap_b32 %0, %1\n\ts_nop 1" : "+v"(a), "+v"(b)); }
__device__ __forceinline__ float xhalf_max(float v) { float a = v, b = v; asm volatile("s_nop 1\n\tv_permlane32_swap_b32 %0, %1\n\ts_nop 1\n\tv_max_f32 %0, %0, %1" : "+v"(a), "+v"(b)); return a; }
__device__ __forceinline__ float max32(const f32x16& a, const f32x16& b) {
    float m;
    asm("v_max3_f32 %0, %1, %2, %3\n\tv_max3_f32 %0, %0, %4, %5\n\tv_max3_f32 %0, %0, %6, %7\n\tv_max3_f32 %0, %0, %8, %9\n\tv_max3_f32 %0, %0, %10, %11\n\tv_max3_f32 %0, %0, %12, %13\n\tv_max3_f32 %0, %0, %14, %15\n\t"
        "v_max3_f32 %0, %0, %16, %17\n\tv_max3_f32 %0, %0, %18, %19\n\tv_max3_f32 %0, %0, %20, %21\n\tv_max3_f32 %0, %0, %22, %23\n\tv_max3_f32 %0, %0, %24, %25\n\tv_max3_f32 %0, %0, %26, %27\n\tv_max3_f32 %0, %0, %28, %29"
        : "=&v"(m) : "v"(a[0]), "v"(a[1]), "v"(a[2]), "v"(a[3]), "v"(a[4]), "v"(a[5]), "v"(a[6]), "v"(a[7]), "v"(a[8]), "v"(a[9]), "v"(a[10]), "v"(a[11]), "v"(a[12]), "v"(a[13]), "v"(a[14]), "v"(a[15]),
                     "v"(b[0]), "v"(b[1]), "v"(b[2]), "v"(b[3]), "v"(b[4]), "v"(b[5]), "v"(b[6]), "v"(b[7]), "v"(b[8]), "v"(b[9]), "v"(b[10]), "v"(b[11]), "v"(b[12]));
    asm("v_max3_f32 %0, %0, %1, %2\n\tv_max_f32 %0, %0, %3" : "+v"(m) : "v"(b[13]), "v"(b[14]), "v"(b[15]));
    return m;
}
__device__ __forceinline__ float xhalf_sum(float v) { float a = v, b = v; xhalf_swap(a, b); return a + b; }
constexpr float AT_THR = 8.0f / AT_C;
template <int MODE>
__device__ __forceinline__ void attn_tile(const LAS unsigned char* Kt, unsigned vb, const bf16x8 (&Q)[4], int l32, int half, bool on, bool edge, int dbase, float& mrun, float& lrun, f32x16& O0, f32x16& O1) {
    f32x16 s0, s1;
    qk_tile(Kt, Q, l32, half, s0, s1);
#if PROBE_DUP == 33
    { float keep_ = s0[0]; asm volatile("" : "+v"(keep_)); qk_tile(Kt, Q, l32, half, s0, s1); s0[0] = 0.5f * (s0[0] + keep_); }
#endif
    if (edge) {
#pragma unroll
        for (int r = 0; r < 16; ++r) {
            const int d0 = dbase - ((r & 3) + 8 * (r >> 2)), d1 = d0 - 32;
            const bool v0 = (MODE == 1 ? d0 >= 0 : (unsigned)d0 < 512u), v1 = (MODE == 1 ? d1 >= 0 : (unsigned)d1 < 512u);
            s0[r] = v0 ? s0[r] : AT_NEG; s1[r] = v1 ? s1[r] : AT_NEG;
        }
    }
    float mt = max32(s0, s1);
    mt = on ? mt : AT_NEG;
    mt = xhalf_max(mt);
    if (__any(mt > mrun + AT_THR)) {
        const float mnew = fmaxf(mrun, mt), alpha = __builtin_amdgcn_exp2f(AT_C * (mrun - mnew)); mrun = mnew; lrun *= alpha;
#pragma unroll
        for (int r = 0; r < 16; ++r) { O0[r] *= alpha; O1[r] *= alpha; }
    }
    const float mc = on ? mrun * AT_C : 1.0e30f;
    f32x16 p0, p1;
#pragma unroll
    for (int r = 0; r < 16; ++r) { p0[r] = __builtin_amdgcn_exp2f(__builtin_fmaf(s0[r], AT_C, -mc)); p1[r] = __builtin_amdgcn_exp2f(__builtin_fmaf(s1[r], AT_C, -mc)); }
#if PROBE_DUP == 34
    { float mc2 = mc; asm volatile("" : "+v"(mc2));
#pragma unroll
      for (int r = 0; r < 16; ++r) { p0[r] = 0.5f * (p0[r] + __builtin_amdgcn_exp2f(__builtin_fmaf(s0[r], AT_C, -mc2))); p1[r] = 0.5f * (p1[r] + __builtin_amdgcn_exp2f(__builtin_fmaf(s1[r], AT_C, -mc2))); } }
#endif
    if (edge) {
#pragma unroll
        for (int r = 0; r < 16; ++r) { p0[r] = s0[r] > 0.5f * AT_NEG ? p0[r] : 0.f; p1[r] = s1[r] > 0.5f * AT_NEG ? p1[r] : 0.f; }
    }
    float ps = 0.f;
#pragma unroll
    for (int r = 0; r < 16; ++r) ps += p0[r] + p1[r];
    lrun += ps;
#if PROBE_DUP == 35
#pragma unroll
    for (int r = 0; r < 16; ++r) { p0[r] *= 0.5f; p1[r] *= 0.5f; }
    pv_tile(vb, p0, p1, O0, O1, false);
#endif
    pv_tile(vb, p0, p1, O0, O1, false);
}
template <int MODE>
__device__ __forceinline__ void attn_stream(LAS unsigned char* lds, const bf16_t* Kg, const bf16_t* Vg, int jlo, int cur, int tokl, const bf16x8 (&Q)[4], unsigned selm_lo, unsigned selm_hi,
                                            int tid, int l32, int half, unsigned vb0, f32x16& O0, f32x16& O1, float& lout) {
    const int key = tid >> 3, chunk = tid & 7;
    const size_t goff = (size_t)key * EVP + chunk * 8;
    const unsigned kofs = key * AT_KS + chunk * 16, vofs = key * AT_VS + chunk * 16;
#define AT_GLD(kr, vr, jj) do { const int j_ = (jj) <= cur ? (jj) : cur; kr = *(const u32x4*)(Kg + (size_t)j_ * 64 * EVP + goff); vr = *(const u32x4*)(Vg + (size_t)j_ * 64 * EVP + goff); } while (0)
#define AT_LST(kr, vr, jj) do { const int nb_ = (jj) & 3; *(LAS u32x4*)(lds + AT_LK + nb_ * AT_KT + kofs) = kr; *(LAS u32x4*)(lds + AT_LV + nb_ * AT_VT + vofs) = vr; } while (0)
    u32x4 ka, va, kb, vb;
    AT_GLD(ka, va, jlo); AT_GLD(kb, vb, jlo + 1);
    AT_LST(ka, va, jlo); AT_LST(kb, vb, jlo + 1);
    __syncthreads();
    float mrun = AT_NEG, lrun = 0.f;
#pragma unroll
    for (int r = 0; r < 16; ++r) { O0[r] = 0.f; O1[r] = 0.f; }
    for (int j = jlo; j <= cur; j += 2) {
        AT_GLD(ka, va, j + 2); AT_GLD(kb, vb, j + 3);
#pragma unroll
        for (int u = 0; u < 2; ++u) {
            const int jj = j + u;
            if (jj <= cur) {
                const int buf = jj & 3;
                bool on = true;
                if (MODE == 1) on = ((jj < 32 ? (selm_lo >> jj) : (selm_hi >> (jj - 32))) & 1u) != 0u;
                const int dbase = (cur - jj) * 64 + tokl - 4 * half;
                const bool edge = (jj == cur) || (MODE == 2 && cur >= 8 && jj == jlo);
                if (MODE != 1 || __any(on)) attn_tile<MODE>(lds + AT_LK + buf * AT_KT, vb0 + buf * AT_VT, Q, l32, half, on, edge, dbase, mrun, lrun, O0, O1);
            }
        }
        AT_LST(ka, va, j + 2); AT_LST(kb, vb, j + 3);
        __syncthreads();
    }
#undef AT_GLD
#undef AT_LST
    lout = xhalf_sum(lrun);
}

__device__ __forceinline__ void nsa_attn_phase(LAS unsigned char* lds, const bf16_t* Z, const bf16_t* QR, const bf16_t* KVC, bf16_t* Y, int G, int bx) {
    for (int it = 0;; ++it) {
        const int L = it * G + bx; if (L >= NB * 2 * 64) break;
        const int tid = pinned_tid(), lane = tid & 63, wave = __builtin_amdgcn_readfirstlane(tid >> 6), half = lane >> 5, l32 = lane & 31;
        const unsigned vb0 = (unsigned)(AT_LV + (4 * half + ((lane & 15) >> 2)) * AT_VS + (16 * ((lane >> 4) & 1) + 4 * (lane & 3)) * 2);
        const int tokl = 8 * wave + (l32 >> 2), g = l32 & 3;
        const int qt = (G == 256) ? 63 - (8 * it + ((it & 1) ? 7 - (bx >> 5) : (bx >> 5))) : 63 - (L >> 5);
        const int bh = L & 31, b = bh >> 1, hk = bh & 1, t0 = qt * 64, t = t0 + tokl, head = hk * 4 + g, cur = qt;
        const size_t m = (size_t)b * T + t;
        bf16x8 Qraw[4], Qrot[4];
#pragma unroll
        for (int s = 0; s < 4; ++s) { Qraw[s] = *(const bf16x8*)(Z + m * EVP + 1792 + head * 64 + 16 * s + 8 * half); Qrot[s] = *(const bf16x8*)(QR + m * 512 + head * 64 + 16 * s + 8 * half); }
        const float gate_c = sigmoidf_(bf2f(Z[m * EVP + 3072 + head * 3])), gate_s = sigmoidf_(bf2f(Z[m * EVP + 3072 + head * 3 + 1])), gate_w = sigmoidf_(bf2f(Z[m * EVP + 3072 + head * 3 + 2]));
        f32x16 Y0, Y1;
        const int nct = (4 * qt + 3 + 63) >> 6;
        unsigned selm_lo = 0u, selm_hi = 0u;
        for (int repc_ = 0; repc_ < (PROBE_DUP == 30 ? 2 : 1); ++repc_) {
        { const int key = tid >> 3, chunk = tid & 7; const bf16_t* kc = KVC + ((size_t)(b * 2 + hk) * 256) * 64; const bf16_t* vc = kc + (size_t)32 * 256 * 64;
          { u32x4 kq[4], vq[4];
#pragma unroll
            for (int jt = 0; jt < 4; ++jt) { kq[jt] = *(const u32x4*)(kc + (size_t)(jt * 64 + key) * 64 + chunk * 8); vq[jt] = *(const u32x4*)(vc + (size_t)(jt * 64 + key) * 64 + chunk * 8); }
#pragma unroll
            for (int jt = 0; jt < 4; ++jt) { *(LAS u32x4*)(lds + AT_LK + jt * AT_KT + key * AT_KS + chunk * 16) = kq[jt]; *(LAS u32x4*)(lds + AT_LV + jt * AT_VT + key * AT_VS + chunk * 16) = vq[jt]; } }
#pragma unroll
          for (int q = 0; q < 8; ++q) { ((LAS float*)(lds + AT_LIT))[(8 * wave + q) * 64 + lane] = 0.f; ((LAS float*)(lds + AT_LIH))[(8 * wave + q) * 64 + lane] = 0.f; } }
        __syncthreads();
        {
            const int nvalid = t >= 31 ? ((t - 31) >> 4) + 1 : 0;
            float mrun = AT_NEG, lrun = 0.f;
            for (int jt = 0; jt < nct; ++jt) {
                f32x16 s0, s1; qk_tile(lds + AT_LK + jt * AT_KT, Qraw, l32, half, s0, s1);
                const int nb = nvalid - 64 * jt - 4 * half;
                float mt = AT_NEG;
#pragma unroll
                for (int r = 0; r < 16; ++r) { const int o = (r & 3) + 8 * (r >> 2); s0[r] = o < nb ? s0[r] : AT_NEG; s1[r] = o + 32 < nb ? s1[r] : AT_NEG; mt = fmaxf(mt, fmaxf(s0[r], s1[r])); }
                mt = xhalf_max(mt);
                const float mnew = fmaxf(mrun, mt); lrun *= __builtin_amdgcn_exp2f(AT_C * (mrun - mnew)); mrun = mnew;
#pragma unroll
                for (int r = 0; r < 16; ++r) { lrun += (s0[r] > 0.5f * AT_NEG ? __builtin_amdgcn_exp2f(AT_C * (s0[r] - mnew)) : 0.f) + (s1[r] > 0.5f * AT_NEG ? __builtin_amdgcn_exp2f(AT_C * (s1[r] - mnew)) : 0.f); }
            }
            const float lt = xhalf_sum(lrun), inv = lt > 0.f ? 1.0f / lt : 0.f;
            f32x16 O0, O1;
#pragma unroll
            for (int r = 0; r < 16; ++r) { O0[r] = 0.f; O1[r] = 0.f; }
            for (int jt = 0; jt < nct; ++jt) {
                f32x16 s0, s1; qk_tile(lds + AT_LK + jt * AT_KT, Qraw, l32, half, s0, s1);
                const int nb = nvalid - 64 * jt - 4 * half;
#pragma unroll
                for (int r = 0; r < 16; ++r) { const int o = (r & 3) + 8 * (r >> 2); s0[r] = o < nb ? __builtin_amdgcn_exp2f(AT_C * (s0[r] - mrun)) * inv : 0.f; s1[r] = o + 32 < nb ? __builtin_amdgcn_exp2f(AT_C * (s1[r] - mrun)) * inv : 0.f; }
#pragma unroll
                for (int g4 = 0; g4 < 4; ++g4) {
                    const float ta = sum4((s0[4 * g4] + s0[4 * g4 + 1]) + (s0[4 * g4 + 2] + s0[4 * g4 + 3])), ha = sum4(0.5f * s0[4 * g4 + 3]);
                    const float tb = sum4((s1[4 * g4] + s1[4 * g4 + 1]) + (s1[4 * g4 + 2] + s1[4 * g4 + 3])), hb = sum4(0.5f * s1[4 * g4 + 3]);
                    if (g == 0) { const int sa = 16 * jt + 2 * g4 + half; ((LAS float*)(lds + AT_LIT))[tokl * 64 + sa] = ta; ((LAS float*)(lds + AT_LIH))[tokl * 64 + sa] = ha;
                                  ((LAS float*)(lds + AT_LIT))[tokl * 64 + sa + 8] = tb; ((LAS float*)(lds + AT_LIH))[tokl * 64 + sa + 8] = hb; }
                }
                pv_tile(vb0 + jt * AT_VT, s0, s1, O0, O1, false);
            }
#pragma unroll
            for (int r = 0; r < 16; ++r) { Y0[r] = gate_c * O0[r]; Y1[r] = gate_c * O1[r]; }
        }
        {
            LDS_WAIT();
            const int tk = 8 * wave + (lane >> 3), sb = (lane & 7) * 8;
            float v[8];
#pragma unroll
            for (int i = 0; i < 8; ++i) { const int sidx = sb + i;
                float x = ((const LAS float*)(lds + AT_LIT))[tk * 64 + sidx] - ((const LAS float*)(lds + AT_LIH))[tk * 64 + sidx];
                if (sidx > 0) x += ((const LAS float*)(lds + AT_LIH))[tk * 64 + sidx - 1];
                if (sidx == 0 || sidx == cur || sidx == cur - 1) x = 3.0e38f; else if (sidx > cur) x = -3.0e38f;
                v[i] = x; }
            unsigned long long key[8];
#pragma unroll
            for (int i = 0; i < 8; ++i) { const unsigned u = __float_as_uint(v[i]), mu_ = (u & 0x80000000u) ? ~u : (u | 0x80000000u); key[i] = ((unsigned long long)mu_ << 32) | (unsigned)(63 - (sb + i));
                ((LAS unsigned long long*)(lds + AT_LKEY))[tk * 64 + sb + i] = key[i]; }
            LDS_WAIT();
            int rank[8];
#pragma unroll
            for (int i = 0; i < 8; ++i) rank[i] = 0;
#pragma unroll 4
            for (int sp = 0; sp < 64; ++sp) { const unsigned long long x = ((const LAS unsigned long long*)(lds + AT_LKEY))[tk * 64 + sp];
#pragma unroll
                for (int i = 0; i < 8; ++i) rank[i] += (x > key[i]) ? 1 : 0; }
            unsigned byte = 0u;
#pragma unroll
            for (int i = 0; i < 8; ++i) byte |= (rank[i] < 16 && sb + i <= cur) ? (1u << i) : 0u;
            ((LAS unsigned char*)(lds + AT_LSM))[tk * 8 + (lane & 7)] = (unsigned char)byte;
            LDS_WAIT();
            const u32x2 sm = *(const LAS u32x2*)(lds + AT_LSM + tokl * 8); selm_lo = sm.x; selm_hi = sm.y;
        }
        __syncthreads();
        }
        const bf16_t* zb = Z + ((size_t)b * T) * EVP + hk * 64;
        {
            f32x16 O0, O1; float lt;
            for (int rep_ = 0; rep_ < (PROBE_DUP == 31 ? 2 : 1); ++rep_) attn_stream<1>(lds, zb + 2560, zb + 2688, 0, cur, tokl, Qrot, selm_lo, selm_hi, tid, l32, half, vb0, O0, O1, lt);
            const float sc = lt > 0.f ? gate_s / lt : 0.f;
#pragma unroll
            for (int r = 0; r < 16; ++r) { Y0[r] += sc * O0[r]; Y1[r] += sc * O1[r]; }
        }
        {
            f32x16 O0, O1; float lt;
            for (int rep_ = 0; rep_ < (PROBE_DUP == 32 ? 2 : 1); ++rep_) attn_stream<2>(lds, zb + 2816, zb + 2944, cur >= 8 ? cur - 8 : 0, cur, tokl, Qrot, 0u, 0u, tid, l32, half, vb0, O0, O1, lt);
            const float sc = lt > 0.f ? gate_w / lt : 0.f;
#pragma unroll
            for (int r = 0; r < 16; ++r) { Y0[r] += sc * O0[r]; Y1[r] += sc * O1[r]; }
        }
        bf16_t* yo = Y + m * D + 512 + head * 64;
#pragma unroll
        for (int g4 = 0; g4 < 4; ++g4) {
            *(u32x2*)(yo + 8 * g4 + 4 * half) = (u32x2){cvt_pk_bf16(Y0[4 * g4], Y0[4 * g4 + 1]), cvt_pk_bf16(Y0[4 * g4 + 2], Y0[4 * g4 + 3])};
            *(u32x2*)(yo + 32 + 8 * g4 + 4 * half) = (u32x2){cvt_pk_bf16(Y1[4 * g4], Y1[4 * g4 + 1]), cvt_pk_bf16(Y1[4 * g4 + 2], Y1[4 * g4 + 3])};
        }
    }
}

constexpr int LDS_BYTES = 163840;
constexpr int LDSCTL_OFF = LDS_BYTES - 512;
constexpr int RING_BYTES = 131072;

struct Args { const void* in[34]; float* out; unsigned char* ws; int ph_lo, ph_hi; };

enum { I_X = 0, I_P, I_POS, I_EVWIN, I_EVWOUT, I_MU, I_W0, I_W2, I_A0, I_A2, I_G2, I_KK, I_KA, I_RK, I_GNG, I_GNB, I_CPOS, I_CW1, I_CW2, I_ODWIN, I_ODWOUT,
       I_HGLB, I_HGNG, I_WRG, I_BRG, I_WRE, I_BRE, I_MW1, I_MW3, I_MW2, I_LNG, I_LNB, I_PLEW, I_PLEGW };

__device__ __forceinline__ void transpose_item(const float* W, int ldw, int k0, int n0, int nvalid, bf16_t* WT, int ldt, int drow0, int dcol0, LAS float* scr, int lane) {
    const int nl = lane & 31; const bool ok = (n0 + nl) < nvalid;
#pragma unroll 8
    for (int i = 0; i < 32; ++i) { const int kk = 2 * i + (lane >> 5); scr[kk * 33 + nl] = ok ? W[(size_t)(k0 + kk) * ldw + n0 + nl] : 0.f; }
    LDS_WAIT(); asm volatile("" ::: "memory");
    const int c = lane & 7;
#pragma unroll
    for (int j = 0; j < 4; ++j) { const int n = (lane >> 3) + 8 * j; const LAS float* s = scr + (8 * c) * 33 + n;
        u32x4 o; o.x = cvt_pk_bf16(s[0 * 33], s[1 * 33]); o.y = cvt_pk_bf16(s[2 * 33], s[3 * 33]); o.z = cvt_pk_bf16(s[4 * 33], s[5 * 33]); o.w = cvt_pk_bf16(s[6 * 33], s[7 * 33]);
        *(u32x4*)(WT + (size_t)(drow0 + n) * ldt + dcol0 + k0 + 8 * c) = o; }
    LDS_WAIT(); asm volatile("" ::: "memory");
}
__device__ __forceinline__ void transpose_item_f8(const float* W, int ldw, int k0, int n0, unsigned char* WT, int ldt, int drow0, LAS float* scr, int lane, int nvalid = 1 << 30) {
    const int nl = lane & 31; const bool ok = (n0 + nl) < nvalid;
#pragma unroll 8
    for (int i = 0; i < 32; ++i) { const int kk = 2 * i + (lane >> 5); scr[kk * 33 + nl] = ok ? W[(size_t)(k0 + kk) * ldw + n0 + nl] : 0.f; }
    LDS_WAIT(); asm volatile("" ::: "memory");
    const int c = lane & 7;
#pragma unroll
    for (int j = 0; j < 4; ++j) { const int n = (lane >> 3) + 8 * j; const LAS float* sp = scr + (8 * c) * 33 + n;
        const int grow = drow0 + n, tl = grow >> 8, hh = (grow >> 7) & 1, y = grow & 127, R = (y & ~31) + 16 * ((y >> 2) & 1) + 4 * ((y & 31) >> 3) + (y & 3), k = k0 + 8 * c;
        *(u32x2*)(WT + ((size_t)tl * (ldt >> 7) + (k >> 7)) * 32768 + hh * 16384 + pg8::lds_byte(R, (k & 127) >> 1)) = (u32x2){cvt_pk4_fp8(sp[0 * 33], sp[1 * 33], sp[2 * 33], sp[3 * 33]), cvt_pk4_fp8(sp[4 * 33], sp[5 * 33], sp[6 * 33], sp[7 * 33])}; }
    LDS_WAIT(); asm volatile("" ::: "memory");
}
__device__ __forceinline__ void conv_late_item(int it, const float* odin, const float* odout, const float* evout, const float* gatew, const float* plew, unsigned char* ws, LAS float* scr, int lane) {
    const float* W; bf16_t* WT; int K = D, N = D, q = it;
    if (it < 2048) { W = odin; WT = (bf16_t*)(ws + WS_WODIN); N = 4 * D; }
    else if (it < 2560) { q = it - 2048; W = odout; WT = (bf16_t*)(ws + WS_WODOUT); }
    else if (it < 3072) { q = it - 2560; W = evout; WT = (bf16_t*)(ws + WS_WEVOUT); }
    else if (it < 4096) { q = it - 3072; const int l_ = q >> 9; q &= 511; W = gatew + (size_t)l_ * D * D; WT = (bf16_t*)(ws + WS_WGATE) + (size_t)l_ * D * D; }
    else { q = it - 4096; const int l_ = q >> 7; q &= 127; K = PLE; W = plew + (size_t)l_ * PLE * D; WT = (bf16_t*)(ws + WS_WPLE) + (size_t)l_ * D * PLE; }
    const int nblk = N / 32, kb = q / nblk, nb = q % nblk;
    transpose_item(W, N, 64 * kb, 32 * nb, N, WT, K, 32 * nb, 0, scr, lane);
}
__device__ __forceinline__ void conv_matrix(const float* W, int K, int N, int npad, bf16_t* WT, LAS float* scr, int gw, int ngw, int lane) {
    const int nblk = npad / 32, nitems = (K / 64) * nblk;
    for (int it = gw; it < nitems; it += ngw) { const int kb = it / nblk, nb = it % nblk; transpose_item(W, N, 64 * kb, 32 * nb, N, WT, K, 32 * nb, 0, scr, lane); }
}
__device__ __forceinline__ void row_to_bf16(const float* xrow, bf16_t* orow, int lane) {
    const f32x4* xr = (const f32x4*)xrow + lane; u32x2* o8 = (u32x2*)orow + lane;
#pragma unroll
    for (int j = 0; j < 4; ++j) { const f32x4 v = xr[64 * j]; u32x2 w; w.x = cvt_pk_bf16(v[0], v[1]); w.y = cvt_pk_bf16(v[2], v[3]); o8[64 * j] = w; }
}
__device__ __forceinline__ void conv_moe_item(const float* w1, const float* w3, const float* w2, int li, bf16_t* w13, bf16_t* w2t, LAS float* scr, int it, int lane) {
    constexpr int I13 = (1024 / 64) * (512 / 32), I2 = (512 / 64) * (1024 / 32);
    if (it < NEXP * 2 * I13) {
        const int e = it / (2 * I13), r = it % (2 * I13), which = r / I13, q = r % I13, kb = q / 16, nb = q % 16, n0 = 32 * nb;
        const float* W = (which ? w3 : w1) + ((size_t)(li * NEXP + e)) * 1024 * 512;
        transpose_item_f8(W, 512, 64 * kb, n0, (unsigned char*)w13, 1024, e * 1024 + (n0 >> 7) * 256 + which * 128 + (n0 & 127), scr, lane);
    } else {
        const int it2 = it - NEXP * 2 * I13, e = it2 / I2, q = it2 % I2, kb = q / 32, nb = q % 32;
        transpose_item_f8(w2 + ((size_t)(li * NEXP + e)) * 512 * 1024, 1024, 64 * kb, 32 * nb, (unsigned char*)w2t, 512, e * 1024 + 32 * nb, scr, lane);
    }
}
__device__ __forceinline__ void conv_moe_weights(const float* w1, const float* w3, const float* w2, int li, bf16_t* w13, bf16_t* w2t, LAS float* scr, int gw, int ngw, int lane, int parts = 3) {
    constexpr int I13 = (1024 / 64) * (512 / 32);
    if (parts & 1) for (int it = gw; it < NEXP * 2 * I13; it += ngw) {
        const int e = it / (2 * I13), r = it % (2 * I13), which = r / I13, q = r % I13, kb = q / 16, nb = q % 16, n0 = 32 * nb;
        const float* W = (which ? w3 : w1) + ((size_t)(li * NEXP + e)) * 1024 * 512;
        transpose_item_f8(W, 512, 64 * kb, n0, (unsigned char*)w13, 1024, e * 1024 + (n0 >> 7) * 256 + which * 128 + (n0 & 127), scr, lane);
    }
    constexpr int I2 = (512 / 64) * (1024 / 32);
    if (parts & 2) for (int it = gw; it < NEXP * I2; it += ngw) {
        const int e = it / I2, q = it % I2, kb = q / 32, nb = q % 32;
        transpose_item_f8(w2 + ((size_t)(li * NEXP + e)) * 512 * 1024, 1024, 64 * kb, 32 * nb, (unsigned char*)w2t, 512, e * 1024 + 32 * nb, scr, lane);
    }
}

__device__ __forceinline__ int row_elem(int lane, int j) { return (j < 2 ? 0 : 512) + 8 * lane + 4 * (j & 1); }
__device__ __forceinline__ void load_row_bf16(const bf16_t* row, f32x4 (&v)[4], int lane) {
    const u32x4 a = *((const u32x4*)row + lane), b = *((const u32x4*)row + 64 + lane);
    v[0] = (f32x4){bflo(a.x), bfhi(a.x), bflo(a.y), bfhi(a.y)}; v[1] = (f32x4){bflo(a.z), bfhi(a.z), bflo(a.w), bfhi(a.w)};
    v[2] = (f32x4){bflo(b.x), bfhi(b.x), bflo(b.y), bfhi(b.y)}; v[3] = (f32x4){bflo(b.z), bfhi(b.z), bflo(b.w), bfhi(b.w)};
}
__device__ __forceinline__ void store_row_bf16(bf16_t* row, const f32x4 (&v)[4], int lane) {
    *((u32x4*)row + lane) = (u32x4){cvt_pk_bf16(v[0][0], v[0][1]), cvt_pk_bf16(v[0][2], v[0][3]), cvt_pk_bf16(v[1][0], v[1][1]), cvt_pk_bf16(v[1][2], v[1][3])};
    *((u32x4*)row + 64 + lane) = (u32x4){cvt_pk_bf16(v[2][0], v[2][1]), cvt_pk_bf16(v[2][2], v[2][3]), cvt_pk_bf16(v[3][0], v[3][1]), cvt_pk_bf16(v[3][2], v[3][3])};
}
__device__ __forceinline__ void ln_row(f32x4 (&v)[4], const float* g, const float* b, int lane) {
    float s = 0.f;
#pragma unroll
    for (int j = 0; j < 4; ++j) s += (v[j][0] + v[j][1]) + (v[j][2] + v[j][3]);
    const float mean = wave_sum(s) * (1.f / D); float s2 = 0.f;
#pragma unroll
    for (int j = 0; j < 4; ++j) { v[j] = v[j] - mean; s2 += (v[j][0] * v[j][0] + v[j][1] * v[j][1]) + (v[j][2] * v[j][2] + v[j][3] * v[j][3]); }
    const float rstd = __builtin_amdgcn_rsqf(wave_sum(s2) * (1.f / D) + LN_EPS);
#pragma unroll
    for (int j = 0; j < 4; ++j) { const f32x4 gg = *(const f32x4*)(g + row_elem(lane, j)), bb = *(const f32x4*)(b + row_elem(lane, j)); v[j] = v[j] * rstd * gg + bb; }
}

__device__ __forceinline__ const void* ptab_get(LAS unsigned char* lds, int i) {
    const unsigned long long v = ((const volatile LAS unsigned long long*)(lds + 163840 - 512 + 64))[i];
    const unsigned lo = __builtin_amdgcn_readfirstlane((unsigned)v), hi = __builtin_amdgcn_readfirstlane((unsigned)(v >> 32));
    return (const void*)(const GAS char*)(((unsigned long long)hi << 32) | lo);
}
#define INF(i) ((const float*)ptab_get(lds, (i)))
#define WSB ((unsigned char*)ptab_get(lds, 35))
#define OUTP ((float*)ptab_get(lds, 34))
__global__ void __launch_bounds__(NTHR, 2) fwd(Args args) {
    extern __shared__ __attribute__((aligned(16))) unsigned char lds_raw[];
    LAS unsigned char* lds = (LAS unsigned char*)lds_raw;
    const int G = gridDim.x, bx = blockIdx.x;
    const int vcu = (G % 8 == 0) ? (bx % 8) * (G / 8) + bx / 8 : bx;
    const int ngw = G * NWAVES;
#define PH_LOCALS const int tid = pinned_tid(), lane = tid & 63, wave = __builtin_amdgcn_readfirstlane(tid >> 6), gw = vcu * NWAVES + wave; (void)tid; (void)lane; (void)gw;
    LAS unsigned long long* ptab = (LAS unsigned long long*)(lds + LDSCTL_OFF + 64);
    for (int u = threadIdx.x; u < (LDS_BYTES - LDSCTL_OFF) / 4; u += NTHR) ((LAS unsigned*)(lds + LDSCTL_OFF))[u] = 0u;
    __syncthreads();
    if (threadIdx.x == 0) {
#define PT_(i) ptab[i] = (unsigned long long)args.in[i];
        PT_(0) PT_(1) PT_(2) PT_(3) PT_(4) PT_(5) PT_(6) PT_(7) PT_(8) PT_(9) PT_(10) PT_(11) PT_(12) PT_(13) PT_(14) PT_(15) PT_(16) PT_(17) PT_(18) PT_(19) PT_(20) PT_(21) PT_(22) PT_(23) PT_(24) PT_(25) PT_(26) PT_(27) PT_(28) PT_(29) PT_(30) PT_(31) PT_(32) PT_(33)
#undef PT_
        ptab[34] = (unsigned long long)args.out; ptab[35] = (unsigned long long)args.ws;
    }
    __syncthreads();
    XcdBarrier bar = xcd_barrier_post((unsigned*)(args.ws + WS_CTL) + CW_BAR, (volatile LAS unsigned*)(lds + LDSCTL_OFF + 32));
    const int lo = args.ph_lo, hi = args.ph_hi;
    int pc = 0;
#define PH_PTRS unsigned char* const ws = WSB; (void)ws; \
    bf16_t* const W_evin = (bf16_t*)(ws + WS_WEVIN); bf16_t* const W_evout = (bf16_t*)(ws + WS_WEVOUT); bf16_t* const W_odin = (bf16_t*)(ws + WS_WODIN); bf16_t* const W_odout = (bf16_t*)(ws + WS_WODOUT); \
    bf16_t* const W_gate = (bf16_t*)(ws + WS_WGATE); bf16_t* const W_ple = (bf16_t*)(ws + WS_WPLE); bf16_t* const W_m13 = (bf16_t*)(ws + WS_WMOE13); bf16_t* const W_m2 = (bf16_t*)(ws + WS_WMOE2); \
    bf16_t* const pbf = (bf16_t*)(ws + WS_PBF); bf16_t* const XB = (bf16_t*)(ws + WS_XB); bf16_t* const Hb = (bf16_t*)(ws + A_H); bf16_t* const PP = (bf16_t*)(ws + A_XBUF + 136 * MiB);     bf16_t* const XB1 = (bf16_t*)OUTP; bf16_t* const PBF1 = (bf16_t*)OUTP + (size_t)M * D; bf16_t* const PP1 = (bf16_t*)(ws + A_PP1); bf16_t* const ZB = (bf16_t*)(ws + WS_ARENA); \
    (void)W_evin; (void)W_evout; (void)W_odin; (void)W_odout; (void)W_gate; (void)W_ple; (void)W_m13; (void)W_m2; (void)pbf; (void)XB; (void)Hb; (void)PP; (void)XB1; (void)PBF1; (void)PP1; (void)ZB;
#define PH_RUN (pc >= lo && pc < hi)
#define PH_END do { if (pc >= lo && pc + 1 < hi) xcd_barrier(bar); ++pc; } while (0)
#define OWN_TILE(var) int var; { int bxo_ = bx; asm volatile("" : "+s"(bxo_)); pg8::DenseOrder S_; S_.init(M, 256, G, bxo_); pg8::Unit u_ = {0, 0, 0}; S_.next(0, u_); var = u_.pm; }
#define PH_END_LOCAL(local) do { if (pc >= lo && pc + 1 < hi) { if (local) __syncthreads(); else xcd_barrier(bar); } ++pc; } while (0)

    if (PH_RUN) for (int rep_ = 0; rep_ < (PROBE_DUP == 20 ? 2 : 1); ++rep_) { PH_PTRS PH_LOCALS
        constexpr int XW = 6;
        if (wave >= XW) { const int gw_s = vcu * (NWAVES - XW) + (wave - XW), ngw_s = G * (NWAVES - XW);
          { const int gw = gw_s, ngw = ngw_s; (void)gw; (void)ngw;
        LAS float* scr = (LAS float*)(lds + wave * 16384);
          for (int it = gw; it < 16 * (56 + 48); it += ngw) { const int kb = it / 104, nb = it % 104;
              if (nb < 56) transpose_item(INF(I_EVWIN), EVN, 64 * kb, 32 * nb, EVN, W_evin, D, 32 * nb, 0, scr, lane);
              else transpose_item_f8(INF(I_EVWIN) + RWC, EVN, 64 * kb, 32 * (nb - 56), (unsigned char*)W_evin + WNSA8_OFF, D, 32 * (nb - 56), scr, lane, EVN - RWC); }
          if (G != NB * 16) {
          conv_matrix(INF(I_EVWOUT), D, D, D, W_evout, scr, gw, ngw, lane);
          conv_matrix(INF(I_ODWIN), D, 4 * D, 4 * D, W_odin, scr, gw, ngw, lane);
          conv_matrix(INF(I_ODWOUT), D, D, D, W_odout, scr, gw, ngw, lane);
          for (int li = 0; li < DEPTH; ++li) {
              conv_matrix(INF(I_PLEGW) + (size_t)li * D * D, D, D, D, W_gate + (size_t)li * D * D, scr, gw, ngw, lane);
              conv_matrix(INF(I_PLEW) + (size_t)li * PLE * D, PLE, D, D, W_ple + (size_t)li * D * PLE, scr, gw, ngw, lane);
          }
          }
          { const float* w2 = INF(I_W2); const float* a2 = INF(I_A2); const float* g2 = INF(I_G2); bf16_t* WL = (bf16_t*)(ws + WS_WLORA);
            for (int idx = gw * 64 + lane; idx < 1536 * 256; idx += ngw * 64) { const int n = idx >> 8, k = idx & 255; float v = 0.f;
                if (n < 512) { if (k < 64) v = w2[k * 512 + n]; } else if (n < 1024) { if (k >= 64 && k < 128) v = a2[(k - 64) * 512 + (n - 512)]; } else { if (k >= 128) v = g2[(k - 128) * 512 + (n - 1024)]; }
                WL[idx] = (bf16_t)(cvt_pk_bf16(v, 0.f) & 0xffffu); } }
          { const float* cw1 = INF(I_CW1); bf16_t* WC = (bf16_t*)(ws + WS_WCMP);
            for (int it = gw; it < 4 * 64; it += ngw) { const int zh = it >> 6, q = it & 63, kb = q >> 2, nb = q & 3;
                transpose_item(cw1 + (size_t)zh * 1024 * 128, 128, 64 * kb, 32 * nb, 128, WC, 1024, zh * 128 + 32 * nb, 0, scr, lane); }
            const float* cpos = INF(I_CPOS); float* cb = (float*)(ws + MISC_CMPB);
            for (int o = gw; o < 256; o += ngw) { const int zz = o >> 7, c = o & 127; float a = 0.f; float cp_[32], cw_[32];
#pragma unroll
                for (int j = 0; j < 32; ++j) { const int i = lane + 64 * j; cp_[j] = cpos[zz * 2048 + i]; cw_[j] = cw1[((size_t)zz * 2048 + i) * 128 + c]; }
#pragma unroll
                for (int j = 0; j < 32; ++j) a += cp_[j] * cw_[j];
                a = wave_sum(a); if (lane == 0) cb[o] = a; } }
          { bf16_t* WRB = (bf16_t*)(ws + WS_WRB); const float* wrg = INF(I_WRG); const float* wre = INF(I_WRE);
            for (int idx = gw * 64 + lane; idx < DEPTH * 256 * 1024; idx += ngw * 64) { const int l_ = idx >> 18, n = (idx >> 10) & 255, k = idx & 1023;
                const float v = n < 4 ? wrg[((size_t)l_ * D + k) * 4 + n] : n < 36 ? wre[((size_t)l_ * D + k) * NEXP + (n - 4)] : 0.f; WRB[idx] = (bf16_t)(cvt_pk_bf16(v, 0.f) & 0xffffu); } }
          { const float* hl = INF(I_HGLB); float* lbt = (float*)(ws + MISC_LBT);
            for (int c = gw * 64 + lane; c < D; c += ngw * 64) { const float a0 = hl[c], a1 = hl[D + c], mx = fmaxf(a0, a1), e0 = __expf(a0 - mx), e1 = __expf(a1 - mx); lbt[c] = e1 / (e0 + e1); } }
          } }
        else { const int gx = vcu * XW + wave, ngx = G * XW;
        const float* xin_ = INF(I_X);
          for (int g4 = gx; g4 < M / 4; g4 += ngx) { const int m = 4 * g4;
              f32x4 v[4][4];
#pragma unroll
              for (int r = 0; r < 4; ++r)
#pragma unroll
                  for (int j = 0; j < 4; ++j) v[r][j] = __builtin_nontemporal_load((const f32x4*)(xin_ + (size_t)(m + r) * D + row_elem(lane, j)));
#pragma unroll
              for (int r = 0; r < 4; ++r) { store_row_bf16(XB + (size_t)(m + r) * D, v[r], lane);
                  const int xr_ = m + r; unsigned char* x8 = ws + A_AA + (size_t)(xr_ >> 7) * (8 * 16384) + pg8::lds_byte(xr_ & 127, ((8 * lane) & 127) >> 1);
                  *(u32x2*)(x8 + (size_t)((8 * lane) >> 7) * 16384) = (u32x2){cvt_pk4_fp8_sat(v[r][0][0], v[r][0][1], v[r][0][2], v[r][0][3]), cvt_pk4_fp8_sat(v[r][1][0], v[r][1][1], v[r][1][2], v[r][1][3])};
                  *(u32x2*)(x8 + (size_t)(((8 * lane) >> 7) + 4) * 16384) = (u32x2){cvt_pk4_fp8_sat(v[r][2][0], v[r][2][1], v[r][2][2], v[r][2][3]), cvt_pk4_fp8_sat(v[r][3][0], v[r][3][1], v[r][3][2], v[r][3][3])}; }
          }
        }
    }
    PH_END;

    for (int li = 0; li < DEPTH; ++li) {
                if (li == 0) {
            if (PH_RUN) { PH_PTRS
                pg8::Gemm g{XB, W_evin, D, D, D}; pg8::DenseOrder S; S.init(M, RWC, G, bx);
                pg8::EpiBf16NT E{ZB, EVP, 0u, 0u, nullptr};
                for (int rep_ = 0; rep_ < (PROBE_DUP == 4 ? 2 : 1); ++rep_) pg8::gemm_phase<pg8::EpiBf16NT, pg8::DenseOrder>(lds, g, S, E);
                __syncthreads();
                pg8::MoeOrder S2{nullptr, M / 256, G, bx};
                pg8::gemm_f8_phase<2>(lds, ws + A_AA, (const unsigned char*)W_evin + WNSA8_OFF, D, S2, nullptr, nullptr, nullptr, ZB);
            }
            PH_END;
            if (PH_RUN) for (int rep_ = 0; rep_ < (PROBE_DUP == 21 ? 2 : 1); ++rep_) { PH_PTRS PH_LOCALS const bool dry_ = (PROBE_DUP == 21 && rep_ == 0);
                const float* mu = INF(I_MU); bf16_t* ACT = (bf16_t*)(ws + A_ACT); const int* posi = (const int*)INF(I_POS); bf16_t* QRB = (bf16_t*)((unsigned char*)OUTP + DOUT_QR); bf16_t* SEGB = (bf16_t*)((unsigned char*)OUTP + DOUT_SEG);
                const float inv_me = exp2f(-(float)(lane & 31) * (13.287712379549449f / 32.0f));
                f32x4 mu8a = (f32x4){0.f, 0.f, 0.f, 0.f}, mu8b = mu8a; if (lane < 32) { mu8a = *(const f32x4*)(mu + 1536 + 8 * lane); mu8b = *(const f32x4*)(mu + 1536 + 8 * lane + 4); }
                LAS float* tb = (LAS float*)(lds + wave * 256);
                for (int m0 = gw; m0 < M; m0 += 4 * ngw) {
                    u32x4 zc[4], zp[4], sg[4][2];
#pragma unroll
                    for (int r = 0; r < 4; ++r) { const int m = min(m0 + r * ngw, M - 1); const bf16_t* zrow = ZB + (size_t)m * EVP; const bf16_t* zprev = (m & (T - 1)) != 0 ? zrow - EVP : zrow;
                        zc[r] = *(const u32x4*)(zrow + 1536 + 8 * (lane & 31)); zp[r] = *(const u32x4*)(zprev + 1536 + 8 * (lane & 31));
#pragma unroll
                        for (int q = 0; q < 2; ++q) { const int idx = (lane & 15) * 2 + q, piece = idx >> 3, ch = idx & 7, zsel = piece >> 1, hq = piece & 1; sg[r][q] = *(const u32x4*)(zrow + 2304 + zsel * 128 + hq * 64 + ch * 8); } }
#pragma unroll
                    for (int r = 0; r < 4; ++r) { const int m = m0 + r * ngw;
                        if (m < M) {
                            if (lane < 32) { const unsigned keep = (m & (T - 1)) != 0 ? 0xffffffffu : 0u;
                                float v[8], pv[8]; unpack8(zc[r], v); unpack8((u32x4){zp[r].x & keep, zp[r].y & keep, zp[r].z & keep, zp[r].w & keep}, pv);
#pragma unroll
                                for (int j = 0; j < 8; ++j) { v[j] += (j < 4 ? mu8a[j & 3] : mu8b[j & 3]) * (pv[j] - v[j]); if (lane < 8) { const float e2 = __expf(2.0f * fminf(fmaxf(v[j], -15.0f), 15.0f)); v[j] = (e2 - 1.0f) * __builtin_amdgcn_rcpf(e2 + 1.0f); } else if (lane >= 16) v[j] = sigmoidf_(v[j]); }
                                *(u32x4*)(ACT + (size_t)m * 256 + 8 * lane) = (u32x4){cvt_pk_bf16(v[0], v[1]), cvt_pk_bf16(v[2], v[3]), cvt_pk_bf16(v[4], v[5]), cvt_pk_bf16(v[6], v[7])};
                            }
                            if (G != NB * 16) { rope_row(m, ZB, QRB, posi, tb, lane, !dry_); LDS_WAIT(); }
                            if (lane >= 48) { const int bq_ = m >> 12, tt = m & (T - 1), jj = tt >> 4, ll = tt & 15;
#pragma unroll
                                for (int q = 0; q < 2; ++q) { const int idx = (lane - 48) * 2 + q, piece = idx >> 3, ch = idx & 7, zsel = piece >> 1, hq = piece & 1;
                                    *(u32x4*)(SEGB + ((size_t)zsel * 8192 + (size_t)(bq_ * 256 + jj) * 2 + hq) * 1024 + ll * 64 + ch * 8) = sg[r][q]; } }
                        } }
                }
            }
            PH_END;
            if (PH_RUN) { PH_PTRS
                pg8::Gemm g{(const bf16_t*)(ws + A_ACT), (const bf16_t*)(ws + WS_WLORA), 256, 256, 256}; pg8::DenseOrder S; S.init(M, 1536, G, bx);
                pg8::EpiLora E{INF(I_W0), INF(I_A0), (bf16_t*)(ws + A_DEC), (bf16_t*)(ws + A_AA), (bf16_t*)(ws + A_GG)};
                for (int rep_ = 0; rep_ < ((PROBE_DUP == 4 || PROBE_DUP == 42) ? 2 : 1); ++rep_) pg8::gemm_phase<pg8::EpiLora, pg8::DenseOrder>(lds, g, S, E);
            }
            PH_END;
            if (PH_RUN) { PH_PTRS
              if (G > 64 && bx < 64) {
                pg8::Gemm g{(const bf16_t*)((unsigned char*)OUTP + DOUT_SEG), (const bf16_t*)(ws + WS_WCMP), 1024, 1024, 1024}; pg8::CmpOrder S{G, bx};
                pg8::EpiF32 E{(float*)(ws + A_HC2), 256};
                pg8::gemm_phase<pg8::EpiF32, pg8::CmpOrder>(lds, g, S, E);
              } else { PH_LOCALS
                const int gwp = G > 64 ? (bx - 64) * NWAVES + wave : gw, ngwp = G > 64 ? (G - 64) * NWAVES : ngw;
                const float* mu = INF(I_MU); const float* kkp = INF(I_KK); const float* kap = INF(I_KA); const float* rkp = INF(I_RK); const bf16_t* AAp = (const bf16_t*)(ws + A_AA); float* sc4 = (float*)(ws + A_SC4);
                float p_mr[8], p_mk[8], p_kk[8], p_ka[8], p_rk[8];
#pragma unroll
                for (int i = 0; i < 8; ++i) { p_mr[i] = mu[8 * lane + i]; p_mk[i] = mu[512 + 8 * lane + i]; p_kk[i] = kkp[8 * lane + i]; p_ka[i] = kap[8 * lane + i]; p_rk[i] = rkp[8 * lane + i]; }
                for (int m = gwp; m < M; m += ngwp) {
                    const bf16_t* zc = ZB + (size_t)m * EVP + 8 * lane;
                    const u32x4 rw_ = *(const u32x4*)zc, kw_ = *(const u32x4*)(zc + 512), aw_ = *(const u32x4*)(AAp + (size_t)m * 512 + 8 * lane); u32x4 rpw = (u32x4){0u, 0u, 0u, 0u}, kpw = rpw;
                    if ((m & (T - 1)) != 0) { rpw = *(const u32x4*)(zc - EVP); kpw = *(const u32x4*)(zc + 512 - EVP); }
                    float r_[8], k_[8], rp_[8], kp_[8], a_[8]; unpack8(rw_, r_); unpack8(kw_, k_); unpack8(rpw, rp_); unpack8(kpw, kp_); unpack8(aw_, a_);
                    float n2 = 0.f, c1 = 0.f, c2 = 0.f, bc = 0.f;
#pragma unroll
                    for (int i = 0; i < 8; ++i) { const float rr = r_[i] + p_mr[i] * (rp_[i] - r_[i]), k0 = k_[i] + p_mk[i] * (kp_[i] - k_[i]), kk = k0 * p_kk[i], k2 = k0 * (1.0f + (a_[i] - 1.0f) * p_ka[i]);
                        n2 += kk * kk; c1 += kk * a_[i] * rr; c2 += k2 * rr; bc += rr * k2 * p_rk[i]; }
                    n2 = sum8b(n2); c1 = sum8b(c1); c2 = sum8b(c2); bc = sum8b(bc);
                    const float inv = __builtin_amdgcn_rsqf(fmaxf(n2, 1e-24f));
                    if ((lane & 7) == 0) *(f32x4*)(sc4 + ((size_t)m * 8 + (lane >> 3)) * 4) = (f32x4){inv, c1 * inv, c2, bc};
                }
            }
              if (G <= 64) { __syncthreads(); pg8::Gemm g{(const bf16_t*)((unsigned char*)OUTP + DOUT_SEG), (const bf16_t*)(ws + WS_WCMP), 1024, 1024, 1024}; pg8::CmpOrder S{G, bx}; pg8::EpiF32 E{(float*)(ws + A_HC2), 256}; pg8::gemm_phase<pg8::EpiF32, pg8::CmpOrder>(lds, g, S, E); }
            }
            PH_END;
            if (PH_RUN) for (int rep_ = 0; rep_ < (PROBE_DUP == 1 ? 2 : 1); ++rep_) { PH_PTRS rwkv_phase(lds, ZB, (const bf16_t*)(ws + A_DEC), (const bf16_t*)(ws + A_AA), (const float*)(ws + A_SC4), INF(I_MU), INF(I_KK), INF(I_KA), XB, G, bx, INF(I_MW1), INF(I_MW3), INF(I_MW2), W_m13, W_m2, G == NB * 16 && PROBE_DUP != 1,
                                   (const float*)(ws + A_HC2), (const float*)(ws + MISC_CMPB), INF(I_CW2), (bf16_t*)(ws + A_KVC2), INF(I_P), pbf, PBF1, ZB, (bf16_t*)((unsigned char*)OUTP + DOUT_QR), (const int*)INF(I_POS),
                                   INF(I_ODWIN), INF(I_ODWOUT), INF(I_EVWOUT), INF(I_PLEGW), INF(I_PLEW), ws); }
            PH_END;
            if (PH_RUN) for (int rep_ = 0; rep_ < (PROBE_DUP == 23 ? 2 : 1); ++rep_) { PH_PTRS PH_LOCALS bf16_t* yout_ = (PROBE_DUP == 23 && rep_ == 0) ? (bf16_t*)(ws + A_DEC) : XB;
                const float* mu = INF(I_MU); const float* gng = INF(I_GNG); const float* gnb = INF(I_GNB); const bf16_t* GGp = (const bf16_t*)(ws + A_GG); const float* sc4 = (const float*)(ws + A_SC4);
                float p_mv[8], p_g[8], p_b[8];
#pragma unroll
                for (int i = 0; i < 8; ++i) { p_mv[i] = mu[1024 + 8 * lane + i]; p_g[i] = gng[8 * lane + i]; p_b[i] = gnb[8 * lane + i]; }
                for (int m0 = gw; m0 < M; m0 += 4 * ngw) {
                    u32x4 vw4[4], ow4[4], gw4[4], vp4[4]; float bc4[4];
#pragma unroll
                    for (int r = 0; r < 4; ++r) { const int m = min(m0 + r * ngw, M - 1); const bf16_t* zc = ZB + (size_t)m * EVP + 1024 + 8 * lane;
                        vw4[r] = *(const u32x4*)zc; ow4[r] = *(const u32x4*)(XB + (size_t)m * D + 8 * lane); gw4[r] = *(const u32x4*)(GGp + (size_t)m * 512 + 8 * lane);
                        vp4[r] = *(const u32x4*)((m & (T - 1)) != 0 ? zc - EVP : zc); bc4[r] = sc4[((size_t)m * 8 + (lane >> 3)) * 4 + 3]; }
#pragma unroll
                    for (int r = 0; r < 4; ++r) { const int m = m0 + r * ngw; const unsigned keep = (m & (T - 1)) != 0 ? 0xffffffffu : 0u;
                        const float bc = bc4[r];
                        float v_[8], vp_[8], o_[8], g_[8]; unpack8(vw4[r], v_); unpack8((u32x4){vp4[r].x & keep, vp4[r].y & keep, vp4[r].z & keep, vp4[r].w & keep}, vp_); unpack8(ow4[r], o_); unpack8(gw4[r], g_);
                        float s1 = 0.f;
#pragma unroll
                        for (int i = 0; i < 8; ++i) s1 += o_[i];
                        const float mean = sum8b(s1) * (1.0f / 64.0f); float s2 = 0.f;
#pragma unroll
                        for (int i = 0; i < 8; ++i) { o_[i] -= mean; s2 += o_[i] * o_[i]; }
                        const float rstd = __builtin_amdgcn_rsqf(sum8b(s2) * (1.0f / 64.0f) + 64e-5f);
                        float y_[8];
#pragma unroll
                        for (int i = 0; i < 8; ++i) { const float vv = v_[i] + p_mv[i] * (vp_[i] - v_[i]); y_[i] = (o_[i] * rstd * p_g[i] + p_b[i] + bc * vv) * g_[i]; }
                        if (m < M) *(u32x4*)(yout_ + (size_t)m * (yout_ == XB ? D : 512) + 8 * lane) = (u32x4){cvt_pk_bf16(y_[0], y_[1]), cvt_pk_bf16(y_[2], y_[3]), cvt_pk_bf16(y_[4], y_[5]), cvt_pk_bf16(y_[6], y_[7])}; }
                }
            }
            if (PH_RUN && !(G == NB * 16 && PROBE_DUP != 1)) { PH_PTRS PH_LOCALS
                LAS float* w2s = (LAS float*)lds; LAS float* hs = (LAS float*)(lds + 65536 + wave * 512);
                { const float* cw2 = INF(I_CW2); for (int i = tid; i < 2 * 128 * 64; i += NTHR) w2s[i] = cw2[i]; }
                __syncthreads();
                const float* HC = (const float*)(ws + A_HC2); const float* cb = (const float*)(ws + MISC_CMPB); bf16_t* KVC = (bf16_t*)(ws + A_KVC2);
                for (int rr = gw; rr < 2 * 16 * 256 * 2; rr += ngw) {
                    const int hq = rr & 1, n = (rr >> 1) & 255, bq_ = (rr >> 9) & 15, zsel = rr >> 13;
                    float outv = 0.f;
                    if (n < 255) {
                        const float* ha = HC + ((size_t)zsel * 8192 + (size_t)(bq_ * 256 + n) * 2 + hq) * 256; const float* hb = ha + 2 * 256 + 128;
#pragma unroll
                        for (int q = 0; q < 2; ++q) { const int c = lane + 64 * q; const float xx = ha[c] + hb[c] + cb[zsel * 128 + c];
                            hs[c] = 0.5f * xx * (1.0f + tanhf(0.7978845608028654f * (xx + 0.044715f * xx * xx * xx))); }
                        LDS_WAIT();
                        for (int c = 0; c < 128; ++c) outv += hs[c] * w2s[(zsel * 128 + c) * 64 + lane];
                        LDS_WAIT();
                    }
                    KVC[((size_t)(zsel * 32 + bq_ * 2 + hq) * 256 + n) * 64 + lane] = (bf16_t)(cvt_pk_bf16(outv, 0.f) & 0xffffu);
                }
            }
            PH_END_LOCAL(G == NB * 16 && PROBE_DUP != 1);
            if (PH_RUN) for (int rep_ = 0; rep_ < (PROBE_DUP == 2 ? 2 : 1); ++rep_) { PH_PTRS nsa_attn_phase(lds, ZB, (const bf16_t*)((unsigned char*)OUTP + DOUT_QR), (const bf16_t*)(ws + A_KVC2), XB, G, bx); }
            PH_END;
            if (PH_RUN) { PH_PTRS
                pg8::Gemm g{XB, W_evout, D, D, D}; pg8::DenseOrder S; S.init(M, D, G, bx);
                pg8::EpiPre E{INF(I_X), nullptr, Hb};
                for (int rep_ = 0; rep_ < (PROBE_DUP == 4 ? 2 : 1); ++rep_) pg8::gemm_phase<pg8::EpiPre, pg8::DenseOrder>(lds, g, S, E);
            }
            PH_END;
        }
        if (li == 1) {
            if (PH_RUN) { PH_PTRS
                pg8::Gemm g{XB1, W_odin, D, D, D}; pg8::DenseOrder S; S.init(M, 4 * D, G, bx);
                pg8::EpiBf16NT E{ZB, 4 * D, 0xF00Fu, 0x00F0u, (const float*)(ws + MISC_LBT)};
                for (int rep_ = 0; rep_ < (PROBE_DUP == 7 ? 2 : 1); ++rep_) pg8::gemm_phase<pg8::EpiBf16NT, pg8::DenseOrder>(lds, g, S, E);
            }
            PH_END;
            if (PH_RUN) for (int rep_ = 0; rep_ < (PROBE_DUP == 3 ? 2 : 1); ++rep_) { PH_PTRS
                if (G > NB * 8 && bx >= NB * 8) {
                    { pg8::Gemm g{PBF1, W_ple + (size_t)D * PLE, PLE, PLE, PLE}; pg8::DenseOrder S; S.init(M, D, G - NB * 8, bx - NB * 8);
                      pg8::EpiBf16 E{PP1, D, 0u, 0u, nullptr};
                      pg8::gemm_phase<pg8::EpiBf16, pg8::DenseOrder>(lds, g, S, E); }
                    __syncthreads();
                    { PH_LOCALS
                      const int gwi = (bx - NB * 8) * NWAVES + wave, ngwi = (G - NB * 8) * NWAVES;
                      LAS float* scr = (LAS float*)(lds + wave * 8704);
                      conv_moe_weights(INF(I_MW1), INF(I_MW3), INF(I_MW2), 1, W_m13, W_m2, scr, gwi, ngwi, lane, 3); }
                } else hgrn_phase(lds, ZB, INF(I_HGLB), INF(I_HGNG), XB, G, bx); }
            PH_END;
            if (PH_RUN) { PH_PTRS
                pg8::Gemm g{XB, W_odout, D, D, D}; pg8::DenseOrder S; S.init(M, D, G, bx);
                pg8::EpiPre E{nullptr, XB1, Hb};
                for (int rep_ = 0; rep_ < (PROBE_DUP == 7 ? 2 : 1); ++rep_) pg8::gemm_phase<pg8::EpiPre, pg8::DenseOrder>(lds, g, S, E);
            }
            PH_END;
        }
        if (PH_RUN) for (int rep_ = 0; rep_ < (PROBE_DUP == 25 ? 2 : 1); ++rep_) { PH_PTRS PH_LOCALS bf16_t* hout_ = (PROBE_DUP == 25 && rep_ == 0) ? (bf16_t*)(ws + A_XBUF) : Hb;
            const float* lng = INF(I_LNG) + (size_t)li * 2 * D; const float* lnb = INF(I_LNB) + (size_t)li * 2 * D;
            const bool fuse = (G == NB * 16); int m_lo = gw, m_hi = M, m_it = 4 * ngw, m_rs = ngw;
            if (fuse) { int bxo_ = bx; asm volatile("" : "+s"(bxo_)); pg8::DenseOrder S_; S_.init(M, 256, G, bxo_); pg8::Unit u_ = {0, 0, 0}; S_.next(0, u_);     m_lo = u_.pm * 256 + wave * 32; m_hi = m_lo + 32; m_it = 4; m_rs = 1; }
            for (int m = m_lo; m < m_hi; m += m_it) {
                f32x4 v[4][4];
#pragma unroll
                for (int r = 0; r < 4; ++r) load_row_bf16(Hb + (size_t)(m + r * m_rs) * D, v[r], lane);
#pragma unroll
                for (int r = 0; r < 4; ++r) { ln_row(v[r], lng, lnb, lane); store_row_bf16(hout_ + (size_t)(m + r * m_rs) * D, v[r], lane);
                    unsigned char* h8 = ws + A_H8 + (size_t)(m + r * m_rs) * D + 8 * lane;
                    *(u32x2*)h8 = (u32x2){cvt_pk4_fp8_sat(v[r][0][0], v[r][0][1], v[r][0][2], v[r][0][3]), cvt_pk4_fp8_sat(v[r][1][0], v[r][1][1], v[r][1][2], v[r][1][3])};
                    *(u32x2*)(h8 + 512) = (u32x2){cvt_pk4_fp8_sat(v[r][2][0], v[r][2][1], v[r][2][2], v[r][2][3]), cvt_pk4_fp8_sat(v[r][3][0], v[r][3][1], v[r][3][2], v[r][3][3])}; }
            }
        }
        PH_END_LOCAL(G == NB * 16);
        if (PH_RUN) { PH_PTRS
            pg8::Gemm g{Hb, (const bf16_t*)(ws + WS_WRB) + (size_t)li * 256 * D, D, D, D}; pg8::DenseOrder S; S.init(M, 256, G, bx);
            pg8::EpiLogit E{(float*)(ws + A_XBUF)};
            pg8::gemm_phase<pg8::EpiLogit, pg8::DenseOrder>(lds, g, S, E);
        }
        PH_END_LOCAL(G == NB * 16);
        if (PH_RUN) { PH_PTRS PH_LOCALS
            LAS int* hist = (LAS int*)lds;
            if (tid < NEXP) hist[tid] = 0;
            __syncthreads();
            const float* brg = INF(I_BRG) + li * 4; const float* bre = INF(I_BRE) + li * NEXP; const float* LG = (const float*)(ws + A_XBUF);
            int* eid_o = (int*)(ws + MISC_EID); float* gate_o = (float*)(ws + MISC_GATE);
            const int npair = M / 2 / ngw;
            for (int q0 = 0; q0 < npair; q0 += 32) {
                const int q = q0 + (lane >> 1);
                if (q < npair) {
                    int m = 2 * (gw + q * ngw) + (lane & 1);
                    if (G == NB * 16) { int bxo_ = bx; asm volatile("" : "+s"(bxo_)); pg8::DenseOrder S_; S_.init(M, 256, G, bxo_); pg8::Unit u_ = {0, 0, 0}; S_.next(0, u_);     m = u_.pm * 256 + wave * 32 + 2 * q + (lane & 1); }
                    float lg[36];
#pragma unroll
                    for (int c = 0; c < 9; ++c) { const f32x4 t = *(const f32x4*)(LG + (size_t)m * 64 + 4 * c); lg[4 * c] = t[0]; lg[4 * c + 1] = t[1]; lg[4 * c + 2] = t[2]; lg[4 * c + 3] = t[3]; }
                    float g0 = lg[0] + brg[0], g1 = lg[1] + brg[1], g2 = lg[2] + brg[2], g3 = lg[3] + brg[3];
                    int gs = 0; float gm = g0; if (g1 > gm) { gm = g1; gs = 1; } if (g2 > gm) { gm = g2; gs = 2; } if (g3 > gm) { gm = g3; gs = 3; }
                    const float pg = __builtin_amdgcn_rcpf(__expf(g0 - gm) + __expf(g1 - gm) + __expf(g2 - gm) + __expf(g3 - gm));
                    float le[8];
#pragma unroll
                    for (int e = 0; e < 8; ++e) { const float a = gs == 0 ? lg[4 + e] : gs == 1 ? lg[12 + e] : gs == 2 ? lg[20 + e] : lg[28 + e]; le[e] = a + bre[gs * 8 + e]; }
                    int i1 = 0; float v1 = le[0];
#pragma unroll
                    for (int e = 1; e < 8; ++e) if (le[e] > v1) { v1 = le[e]; i1 = e; }
                    int i2 = -1; float v2 = -3.0e38f;
#pragma unroll
                    for (int e = 0; e < 8; ++e) if (e != i1 && le[e] > v2) { v2 = le[e]; i2 = e; }
                    const float e2 = __expf(v2 - v1), den = __builtin_amdgcn_rcpf(1.0f + e2);
                    const int ea = gs * 8 + i1, eb = gs * 8 + i2;
                    *(int2*)(eid_o + 2 * (size_t)m) = make_int2(ea, eb); *(float2*)(gate_o + 2 * (size_t)m) = make_float2(pg * den, pg * e2 * den);
                    __hip_atomic_fetch_add(&hist[ea], 1, __ATOMIC_RELAXED, __HIP_MEMORY_SCOPE_WORKGROUP); __hip_atomic_fetch_add(&hist[eb], 1, __ATOMIC_RELAXED, __HIP_MEMORY_SCOPE_WORKGROUP);
                }
            }
            __syncthreads();
            if (tid < NEXP) ((int*)(ws + MISC_BCNT))[vcu * NEXP + tid] = hist[tid];
        }
        PH_END;
        if (PH_RUN) for (int rep_ = 0; rep_ < (PROBE_DUP == 26 ? 2 : 1); ++rep_) { PH_PTRS PH_LOCALS
            __syncthreads();
            LAS int* tot = (LAS int*)lds; LAS int* prt = tot + 16 * NEXP; LAS int* cursor = prt + 16 * NEXP; LAS int* startv = cursor + NEXP; LAS int* padv = startv + NEXP;
            const int* bcnt = (const int*)(ws + MISC_BCNT);
            { const int e = tid & 31, part = tid >> 5; int a = 0, p = 0; for (int w = part; w < G; w += 16) { const int c = bcnt[w * NEXP + e]; a += c; if (w < vcu) p += c; } tot[part * NEXP + e] = a; prt[part * NEXP + e] = p; }
            __syncthreads();
            if (tid < NEXP) { int a = 0, p = 0; for (int q = 0; q < 16; ++q) { a += tot[q * NEXP + tid]; p += prt[q * NEXP + tid]; } padv[tid] = (a + 255) & ~255; cursor[tid] = p; }
            __syncthreads();
            if (tid == 0) { int run = 0;
#pragma nounroll
                for (int e = 0; e < NEXP; ++e) { startv[e] = run; run += padv[e]; } }
            __syncthreads();
            if (tid < NEXP) cursor[tid] += startv[tid];
            if (bx == 0) { int* te = (int*)(ws + MISC_TILEE); const int ntl = (startv[NEXP - 1] + padv[NEXP - 1]) >> 8; if (tid == 0) te[0] = ntl;
                for (int t = tid; t < ntl; t += NTHR) { int e = 0;
#pragma nounroll
                    for (int q = 0; q < NEXP; ++q) e += ((startv[q] + padv[q]) <= 256 * t) ? 1 : 0;
                    te[1 + t] = e; } }
            __syncthreads();
            const int* eid_i = (const int*)(ws + MISC_EID); int* slot_o = (int*)(ws + MISC_SLOT); int* toks_o = (int*)(ws + WS_TOKS);
            int mm_lo = 2 * gw, mm_hi = M, mm_it = 2 * ngw;
            if (G == NB * 16) { int bxo_ = bx; asm volatile("" : "+s"(bxo_)); pg8::DenseOrder S_; S_.init(M, 256, G, bxo_); pg8::Unit u_ = {0, 0, 0}; S_.next(0, u_);     mm_lo = u_.pm * 256 + wave * 32; mm_hi = mm_lo + 32; mm_it = 2; }
            for (int mm = mm_lo; mm < mm_hi; mm += mm_it) for (int m = mm; m < mm + 2; ++m) {
                int s0 = 0, s1 = 0;
                if (lane == 0) { const int2 ee = *(const int2*)(eid_i + 2 * (size_t)m); s0 = __hip_atomic_fetch_add(&cursor[ee.x], 1, __ATOMIC_RELAXED, __HIP_MEMORY_SCOPE_WORKGROUP); s1 = __hip_atomic_fetch_add(&cursor[ee.y], 1, __ATOMIC_RELAXED, __HIP_MEMORY_SCOPE_WORKGROUP); *(int2*)(slot_o + 2 * (size_t)m) = make_int2(s0, s1); }
                s0 = __builtin_amdgcn_readfirstlane(s0); s1 = __builtin_amdgcn_readfirstlane(s1);
                if (lane == 0) { toks_o[s0] = m; toks_o[s1] = m; }
            }
            { LAS float* scr = (LAS float*)(lds + 16384 + wave * 8704);
              const bool shadow = (G > NB * 8);
              const int parts_ = (li == 1 && shadow) ? 0 : ((li == 0 && G == NB * 16) ? 0 : 3);
              if (parts_) conv_moe_weights(INF(I_MW1), INF(I_MW3), INF(I_MW2), li, W_m13, W_m2, scr, gw, ngw, lane, parts_);
              const int np = (li == 1 && shadow) ? 0 : ((li == 0 && G == NB * 16) ? 0 : ((li == 0 && shadow) ? 2 : 1));
              for (int q = 0; q < np; ++q) { const float* pl = INF(I_P) + (size_t)(li + q) * M * PLE; bf16_t* pd = q ? PBF1 : pbf;
                for (int m = gw; m < M; m += 4 * ngw) { f32x4 v[4];
#pragma unroll
                    for (int r = 0; r < 4; ++r) v[r] = *((const f32x4*)(pl + (size_t)(m + r * ngw) * PLE) + lane);
#pragma unroll
                    for (int r = 0; r < 4; ++r) *((u32x2*)(pd + (size_t)(m + r * ngw) * PLE) + lane) = (u32x2){cvt_pk_bf16(v[r][0], v[r][1]), cvt_pk_bf16(v[r][2], v[r][3])}; } } }
        }
        PH_END;
        if (PH_RUN) { PH_PTRS
            const int* te = (const int*)(ws + MISC_TILEE);
            pg8::MoeOrder S{te + 1, __builtin_amdgcn_readfirstlane(te[0]), G, bx};
            for (int rep_ = 0; rep_ < (PROBE_DUP == 5 ? 2 : 1); ++rep_) pg8::gemm_f8_phase<0>(lds, ws + A_H8, (const unsigned char*)W_m13, D, S, (const int*)(ws + WS_TOKS), ws + A_HID, nullptr);
        }
        PH_END;
        if (PH_RUN) { PH_PTRS
            const int* te = (const int*)(ws + MISC_TILEE);
            pg8::MoeOrder S{te + 1, __builtin_amdgcn_readfirstlane(te[0]), G, bx};
            for (int rep_ = 0; rep_ < (PROBE_DUP == 5 ? 2 : 1); ++rep_) pg8::gemm_f8_phase<1>(lds, ws + A_HID, (const unsigned char*)W_m2, MOE_H, S, nullptr, nullptr, ws + A_XBUF);
        }
        PH_END;
        if (PH_RUN) for (int rep_ = 0; rep_ < (PROBE_DUP == 27 ? 2 : 1); ++rep_) { PH_PTRS PH_LOCALS bf16_t* hout_ = (PROBE_DUP == 27 && rep_ == 0) ? (bf16_t*)OUTP : XB;
            const float* lng = INF(I_LNG) + (size_t)li * 2 * D; const float* lnb = INF(I_LNB) + (size_t)li * 2 * D;
            const int* slot_i = (const int*)(ws + MISC_SLOT); const float* gate_i = (const float*)(ws + MISC_GATE); const unsigned char* ybuf = ws + A_XBUF;
#define CMB_SL(SL, GT, mb) do { _Pragma("unroll") for (int r = 0; r < 2; ++r) { const int m = min((mb) + r * c_rs, c_hi - 1); SL[r] = *(const int2*)(slot_i + 2 * (size_t)m); GT[r] = *(const float2*)(gate_i + 2 * (size_t)m); } } while (0)
#define CMB_LD(HW, Y0, Y1, SL, mb) do { _Pragma("unroll") for (int r = 0; r < 2; ++r) { const int m = min((mb) + r * c_rs, c_hi - 1); _Pragma("unroll") for (int q = 0; q < 2; ++q) { \
                HW[r][q] = *((const u32x4*)(Hb + (size_t)m * D) + lane + 64 * q); Y0[r][q] = *((const u32x2*)(ybuf + (size_t)SL[r].x * D) + lane + 64 * q); Y1[r][q] = *((const u32x2*)(ybuf + (size_t)SL[r].y * D) + lane + 64 * q); } } } while (0)
#define CMB_DO(HW, Y0, Y1, GT, mb) do { _Pragma("unroll") for (int r = 0; r < 2; ++r) { const int m = (mb) + r * c_rs; f32x4 v[4]; \
                const float g0_ = GT[r].x * (1.0f / pg8::Y8_SCALE), g1_ = GT[r].y * (1.0f / pg8::Y8_SCALE); \
                _Pragma("unroll") for (int q = 0; q < 2; ++q) { const unsigned hh_[4] = {HW[r][q].x, HW[r][q].y, HW[r][q].z, HW[r][q].w}, ya[2] = {Y0[r][q].x, Y0[r][q].y}, yb[2] = {Y1[r][q].x, Y1[r][q].y}; \
                    _Pragma("unroll") for (int w = 0; w < 2; ++w) { const f32x2 a0 = __builtin_amdgcn_cvt_pk_f32_fp8((int)ya[w], false), a1 = __builtin_amdgcn_cvt_pk_f32_fp8((int)ya[w], true), b0 = __builtin_amdgcn_cvt_pk_f32_fp8((int)yb[w], false), b1 = __builtin_amdgcn_cvt_pk_f32_fp8((int)yb[w], true); \
                        v[2 * q + w][0] = bflo(hh_[2 * w]) * DN_ALPHA + (g0_ * a0[0] + g1_ * b0[0]); v[2 * q + w][1] = bfhi(hh_[2 * w]) * DN_ALPHA + (g0_ * a0[1] + g1_ * b0[1]); \
                        v[2 * q + w][2] = bflo(hh_[2 * w + 1]) * DN_ALPHA + (g0_ * a1[0] + g1_ * b1[0]); v[2 * q + w][3] = bfhi(hh_[2 * w + 1]) * DN_ALPHA + (g0_ * a1[1] + g1_ * b1[1]); } } \
                if (m < c_hi) { ln_row(v, lng + D, lnb + D, lane); store_row_bf16(hout_ + (size_t)m * D, v, lane); } } } while (0)
            { int2 slA[2], slB[2]; float2 gtA[2], gtB[2], gtN[2]; u32x4 hA[2][2], hB[2][2]; u32x2 y0A[2][2], y1A[2][2], y0B[2][2], y1B[2][2];
              int c_lo = gw, c_hi = M, c_rs = ngw, step = 2 * ngw;
              if (G == NB * 16) { OWN_TILE(tl_) c_lo = tl_ * 256 + wave * 32; c_hi = c_lo + 32; c_rs = 1; step = 2; }
              CMB_SL(slA, gtA, c_lo); CMB_SL(slB, gtB, c_lo + step);
              CMB_LD(hA, y0A, y1A, slA, c_lo);
              for (int m0 = c_lo; m0 < c_hi; m0 += 2 * step) {
                  CMB_LD(hB, y0B, y1B, slB, m0 + step);
                  CMB_SL(slA, gtN, m0 + 2 * step);
                  CMB_DO(hA, y0A, y1A, gtA, m0);
                  CMB_LD(hA, y0A, y1A, slA, m0 + 2 * step);
#pragma unroll
                  for (int r = 0; r < 2; ++r) gtA[r] = gtN[r];
                  CMB_SL(slB, gtN, m0 + 3 * step);
                  if (m0 + step < c_hi) CMB_DO(hB, y0B, y1B, gtB, m0 + step);
#pragma unroll
                  for (int r = 0; r < 2; ++r) gtB[r] = gtN[r];
              } }
#undef CMB_SL
#undef CMB_LD
#undef CMB_DO
        }
        PH_END_LOCAL(G == NB * 16);
        if (!(li == 1 && G > NB * 8)) {
        if (PH_RUN) { PH_PTRS PH_LOCALS
            pg8::Gemm g{pbf, W_ple + (size_t)li * D * PLE, PLE, PLE, PLE}; pg8::DenseOrder S; S.init(M, D, G, bx); if (G == NB * 16) { OWN_TILE(tl_) S.rpm = tl_; }
            pg8::EpiBf16 E{PP, D, 0u, 0u, nullptr};
            for (int rep_ = 0; rep_ < ((PROBE_DUP == 6 || PROBE_DUP == 41) ? 2 : 1); ++rep_) pg8::gemm_phase<pg8::EpiBf16, pg8::DenseOrder>(lds, g, S, E);
        }
        PH_END_LOCAL(G == NB * 16);
        }
        if (PH_RUN) { PH_PTRS PH_LOCALS
            pg8::Gemm g{XB, W_gate + (size_t)li * D * D, D, D, D}; pg8::DenseOrder S; S.init(M, D, G, bx); if (G == NB * 16) { OWN_TILE(tl_) S.rpm = tl_; }
            pg8::EpiGate E{XB, (li == 1 && G > NB * 8) ? PP1 : PP, li == DEPTH - 1 ? OUTP : nullptr, XB1};
            for (int rep_ = 0; rep_ < (PROBE_DUP == 6 ? 2 : 1); ++rep_) pg8::gemm_phase<pg8::EpiGate, pg8::DenseOrder>(lds, g, S, E);
        }
        PH_END;
    }
#undef PH_RUN
#undef PH_END
}
constexpr int TOTAL_PHASES = 1 + 8 + 9 + 3 + 8;

extern "C" void kernel_launch(void* const* d_in, const int* in_sizes, int n_in, void* d_out, int out_size, void* d_ws, size_t ws_size, hipStream_t stream) {
    static int grid = 0;
    if (grid == 0) {
        if (n_in != 34 || in_sizes[0] != M * D || out_size != M * D || ws_size < WS_END) { fprintf(stderr, "kernel_launch: unexpected shapes: n_in %d in0 %d out %d ws %zu (need %zu)\n", n_in, n_in > 0 ? in_sizes[0] : -1, out_size, ws_size, (size_t)WS_END); grid = -1; return; }
        int dev = 0, cus = 0, per_cu = 0;
        if (hipGetDevice(&dev) != hipSuccess || hipDeviceGetAttribute(&cus, hipDeviceAttributeMultiprocessorCount, dev) != hipSuccess) { grid = -1; return; }
        if (hipFuncSetAttribute((const void*)fwd, hipFuncAttributeMaxDynamicSharedMemorySize, LDS_BYTES) != hipSuccess) { fprintf(stderr, "kernel_launch: hipFuncSetAttribute failed\n"); grid = -1; return; }
        if (hipOccupancyMaxActiveBlocksPerMultiprocessor(&per_cu, (const void*)fwd, NTHR, LDS_BYTES) != hipSuccess || per_cu < 1) fprintf(stderr, "kernel_launch: occupancy query reports %d\n", per_cu);
        (void)hipGetLastError();
        grid = cus;
    }
    if (grid < 0) return;
    if (hipMemsetAsync((char*)d_ws + WS_CTL, 0, CTL_ZERO_BYTES, stream) != hipSuccess) return;
    Args a{};
    for (int i = 0; i < 34; ++i) a.in[i] = d_in[i];
    a.out = (float*)d_out; a.ws = (unsigned char*)d_ws; a.ph_lo = 0; a.ph_hi = TOTAL_PHASES;
    hipLaunchKernelGGL(fwd, dim3(grid), dim3(NTHR), LDS_BYTES, stream, a);
}
```
